# Optimizing an MI355X kernel written in HIP

```python
import jax, jax.numpy as jnp
from jax import lax
import numpy as np

D_MODEL = 1024
BATCH = 2
SEQ = 8192
DEPTH = 1

D_MIX = D_MODEL
ATT_HEADS = 8
ATT_HEAD_DIM = 64
ATT_WIDTH = ATT_HEADS * ATT_HEAD_DIM
DILATED_PATTERNS = ((128, 1), (512, 4), (2048, 16))
Q_BLOCK = 128
ROPE_THETA = 10000.0
GLA_HEADS = 4
GLA_KEY_DIM = 64
GLA_VAL_DIM = 128
GLA_KEY_WIDTH = GLA_HEADS * GLA_KEY_DIM
GLA_VAL_WIDTH = GLA_HEADS * GLA_VAL_DIM
GLA_GATE_RANK = 16
GLA_GATE_NORMALIZER = 16.0
GLA_CHUNK = 64
IN_SPLITS = (ATT_WIDTH, ATT_WIDTH, ATT_WIDTH, GLA_KEY_WIDTH, GLA_KEY_WIDTH,
             GLA_VAL_WIDTH, GLA_VAL_WIDTH, GLA_GATE_RANK)
D_IN = sum(IN_SPLITS)
N_EXPERTS = 32
TOP_K = 4
D_FF = D_MODEL
SWIGLU_LIMIT = 7.0
SWIGLU_ALPHA = 1.702
MOE_BLOCK = 128
NORM_EPS = 1e-6
N_MOD = 6

kernel_name = "hybrid_dilated_gla_moe_block"


def rms_norm(x, g):
    xf = x.astype(jnp.float32)
    y = xf * lax.rsqrt(jnp.mean(xf * xf, axis=-1, keepdims=True) + NORM_EPS)
    return (y * g.astype(jnp.float32)).astype(x.dtype)


def rope(x, positions):
    half = x.shape[-1] // 2
    inv_freq = ROPE_THETA ** (-jnp.arange(half, dtype=jnp.float32) / half)
    ang = positions.astype(jnp.float32)[:, None] * inv_freq[None, :]
    cos, sin = jnp.cos(ang), jnp.sin(ang)
    xf = x.astype(jnp.float32)
    x1, x2 = xf[..., :half], xf[..., half:]
    return jnp.concatenate([x1 * cos - x2 * sin, x2 * cos + x1 * sin], axis=-1).astype(x.dtype)


def dilated_attention(q, k, v):
    B, H, S, hd = q.shape
    n_blk = S // Q_BLOCK

    def block(i):
        q0 = i * Q_BLOCK
        qb = lax.dynamic_slice_in_dim(q, q0, Q_BLOCK, axis=2).astype(jnp.float32)
        t = q0 + jnp.arange(Q_BLOCK)
        outs, lses = [], []
        for window, dil in DILATED_PATTERNS:
            offs = jnp.arange(window // dil + 1) * dil
            idx = t[:, None] - offs[None, :]
            valid = idx >= 0
            idx = jnp.maximum(idx, 0)
            kg = jnp.take(k, idx, axis=2).astype(jnp.float32)
            vg = jnp.take(v, idx, axis=2).astype(jnp.float32)
            s = jnp.einsum('bhqd,bhqjd->bhqj', qb, kg)
            s = jnp.where(valid, s, -jnp.inf)
            m = jnp.max(s, axis=-1, keepdims=True)
            p = jnp.exp(s - m)
            l = jnp.sum(p, axis=-1, keepdims=True)
            outs.append(jnp.einsum('bhqj,bhqjd->bhqd', p, vg) / l)
            lses.append(m + jnp.log(l))
        w = jax.nn.softmax(jnp.stack(lses, axis=0), axis=0)
        return jnp.sum(w * jnp.stack(outs, axis=0), axis=0)

    o = lax.map(block, jnp.arange(n_blk))
    o = o.transpose(1, 0, 3, 2, 4).reshape(B, S, H * hd)
    return o.astype(q.dtype)


def gated_linear_attention(q, k, v, log_a):
    B, H, S, dk = q.shape
    dv = v.shape[-1]
    C = GLA_CHUNK
    N = S // C
    qf = q.astype(jnp.float32).reshape(B, H, N, C, dk) * (dk ** -0.5)
    kf = k.astype(jnp.float32).reshape(B, H, N, C, dk)
    vf = v.astype(jnp.float32).reshape(B, H, N, C, dv)
    b = jnp.cumsum(log_a.reshape(B, H, N, C, dk), axis=3)
    b_last = b[:, :, :, -1:, :]
    q_dec = qf * jnp.exp(b)
    att = jnp.einsum('bhncd,bhnjd->bhncj', q_dec, kf * jnp.exp(-b))
    causal = jnp.tril(jnp.ones((C, C), dtype=bool))
    att = jnp.where(causal, att, 0.0)
    o_intra = jnp.einsum('bhncj,bhnje->bhnce', att, vf)
    u = jnp.einsum('bhncd,bhnce->nbhde', kf * jnp.exp(b_last - b), vf)
    a = jnp.exp(b_last[:, :, :, 0, :]).transpose(2, 0, 1, 3)

    def step(state, inp):
        a_n, u_n = inp
        return a_n[..., None] * state + u_n, state

    _, s_prev = lax.scan(step, jnp.zeros((B, H, dk, dv), jnp.float32), (a, u))
    o_inter = jnp.einsum('bhncd,nbhde->bhnce', q_dec, s_prev)
    return (o_intra + o_inter).reshape(B, H, S, dv)


def hybrid_mixer(h, w_in, w_gate_lr, b_gate, g_gla, w_out):
    B, S, _ = h.shape
    proj = h @ w_in
    split_points = [int(s) for s in np.cumsum(IN_SPLITS)[:-1]]
    q_a, k_a, v_a, q_g, k_g, v_g, r_g, g_lr = jnp.split(proj, split_points, axis=-1)

    def heads(t, n):
        return t.reshape(B, S, n, -1).transpose(0, 2, 1, 3)

    pos = jnp.arange(S)
    qa = rope(heads(q_a, ATT_HEADS), pos) * (ATT_HEAD_DIM ** -0.5)
    ka = rope(heads(k_a, ATT_HEADS), pos)
    o_att = dilated_attention(qa, ka, heads(v_a, ATT_HEADS))
    gate_logit = (g_lr @ w_gate_lr + b_gate).astype(jnp.float32)
    log_a = jax.nn.log_sigmoid(gate_logit) / GLA_GATE_NORMALIZER
    o_g = gated_linear_attention(heads(q_g, GLA_HEADS), heads(k_g, GLA_HEADS),
                                 heads(v_g, GLA_HEADS), heads(log_a, GLA_HEADS))
    o_g = rms_norm(o_g, g_gla)
    o_g = o_g.transpose(0, 2, 1, 3).reshape(B, S, GLA_VAL_WIDTH).astype(h.dtype) * jax.nn.silu(r_g)
    return jnp.concatenate([o_att, o_g], axis=-1) @ w_out


def moe_ffn(h, router_w, router_b, w_gate_up, b_gate_up, w_down, b_down):
    B, S, D = h.shape
    T = B * S
    xt = h.reshape(T, D)
    logits = (xt @ router_w + router_b).astype(jnp.float32)
    top_v, top_i = lax.top_k(logits, TOP_K)
    gates = jax.nn.softmax(top_v, axis=-1)
    A = T * TOP_K
    e_flat = top_i.reshape(A)
    tok_flat = jnp.arange(A, dtype=jnp.int32) // TOP_K
    g_flat = gates.reshape(A)
    order = jnp.argsort(e_flat)
    e_sorted = e_flat[order]
    counts = jnp.bincount(e_flat, length=N_EXPERTS)
    start = jnp.cumsum(counts) - counts
    padded = (counts + MOE_BLOCK - 1) // MOE_BLOCK * MOE_BLOCK
    pend = jnp.cumsum(padded)
    pstart = pend - padded
    dest = pstart[e_sorted] + jnp.arange(A, dtype=jnp.int32) - start[e_sorted]
    n_blocks = -(-(A + N_EXPERTS * (MOE_BLOCK - 1)) // MOE_BLOCK)
    P = n_blocks * MOE_BLOCK
    tok_buf = jnp.full((P,), T, dtype=jnp.int32).at[dest].set(tok_flat[order])
    gate_buf = jnp.zeros((P,), jnp.float32).at[dest].set(g_flat[order])
    blk_e = jnp.minimum(jnp.searchsorted(pend, jnp.arange(n_blocks) * MOE_BLOCK, side='right'),
                        N_EXPERTS - 1)
    xpad = jnp.concatenate([xt, jnp.zeros((1, D), xt.dtype)], axis=0)

    def expert_block(args):
        idx, e = args
        xb = xpad[idx]
        gu = xb @ w_gate_up[e] + b_gate_up[e]
        x_glu = jnp.minimum(gu[:, ::2], SWIGLU_LIMIT)
        x_lin = jnp.clip(gu[:, 1::2], -SWIGLU_LIMIT, SWIGLU_LIMIT)
        act = x_glu * jax.nn.sigmoid(SWIGLU_ALPHA * x_glu) * (x_lin + 1.0)
        return act @ w_down[e] + b_down[e]

    out_buf = lax.map(expert_block, (tok_buf.reshape(n_blocks, MOE_BLOCK), blk_e))
    out_buf = out_buf.reshape(P, D) * gate_buf[:, None].astype(out_buf.dtype)
    out = jnp.zeros((T + 1, D), out_buf.dtype).at[tok_buf].add(out_buf)
    return out[:T].reshape(B, S, D)


def setup_inputs(seed: int = 0) -> dict:
    key = jax.random.key(seed)
    ks = jax.random.split(key, 20)
    L = DEPTH

    def nrm(k, shape, scale):
        return jax.random.normal(k, shape, jnp.float32) * scale

    return {
        "x": nrm(ks[0], (BATCH, SEQ, D_MODEL), 1.0),
        "c": nrm(ks[1], (BATCH, D_MODEL), 1.0),
        "w_mod": nrm(ks[2], (L, D_MODEL, N_MOD * D_MODEL), 0.5 * D_MODEL ** -0.5),
        "b_mod": nrm(ks[3], (L, N_MOD * D_MODEL), 0.02),
        "g_pre_mix": 1.0 + nrm(ks[4], (L, D_MODEL), 0.05),
        "w_in": nrm(ks[5], (L, D_MODEL, D_IN), D_MODEL ** -0.5),
        "w_gate_lr": nrm(ks[6], (L, GLA_GATE_RANK, GLA_KEY_WIDTH), GLA_GATE_RANK ** -0.5),
        "b_gate": nrm(ks[7], (L, GLA_KEY_WIDTH), 0.1),
        "g_gla": 1.0 + nrm(ks[8], (L, GLA_VAL_DIM), 0.05),
        "w_out": nrm(ks[9], (L, D_MIX, D_MODEL), D_MIX ** -0.5),
        "g_post_mix": 1.0 + nrm(ks[10], (L, D_MODEL), 0.05),
        "g_pre_ffn": 1.0 + nrm(ks[11], (L, D_MODEL), 0.05),
        "router_w": nrm(ks[12], (L, D_MODEL, N_EXPERTS), D_MODEL ** -0.5),
        "router_b": nrm(ks[13], (L, N_EXPERTS), 0.01),
        "w_gate_up": nrm(ks[14], (L, N_EXPERTS, D_MODEL, 2 * D_FF), D_MODEL ** -0.5),
        "b_gate_up": nrm(ks[15], (L, N_EXPERTS, 2 * D_FF), 0.02),
        "w_down": nrm(ks[16], (L, N_EXPERTS, D_FF, D_MODEL), D_FF ** -0.5),
        "b_down": nrm(ks[17], (L, N_EXPERTS, D_MODEL), 0.02),
        "g_post_ffn": 1.0 + nrm(ks[18], (L, D_MODEL), 0.05),
    }


def reference(x, c, w_mod, b_mod, g_pre_mix, w_in, w_gate_lr, b_gate, g_gla, w_out,
              g_post_mix, g_pre_ffn, router_w, router_b, w_gate_up, b_gate_up,
              w_down, b_down, g_post_ffn):
    for l in range(DEPTH):
        mod = jax.nn.silu(c) @ w_mod[l] + b_mod[l]
        shift1, scale1, gate1, shift2, scale2, gate2 = jnp.split(mod[:, None, :], N_MOD, axis=-1)
        h = rms_norm(x, g_pre_mix[l]) * (1.0 + scale1) + shift1
        y = hybrid_mixer(h, w_in[l], w_gate_lr[l], b_gate[l], g_gla[l], w_out[l])
        x = x + gate1 * rms_norm(y, g_post_mix[l])
        h = rms_norm(x, g_pre_ffn[l]) * (1.0 + scale2) + shift2
        y = moe_ffn(h, router_w[l], router_b[l], w_gate_up[l], b_gate_up[l], w_down[l], b_down[l])
        x = x + gate2 * rms_norm(y, g_post_ffn[l])
    return x
```

```cpp
#include <hip/hip_runtime.h>
#include <hip/hip_cooperative_groups.h>
#include <cstdio>
#include <cstdint>
#include <cmath>
namespace cg = cooperative_groups;

#ifndef ONE_LAUNCH
#define ONE_LAUNCH 0
#endif

typedef unsigned short bf16_t;
typedef short bf16x8 __attribute__((ext_vector_type(8)));
typedef float f32x4 __attribute__((ext_vector_type(4)));

constexpr int T = 16384, D = 1024, S = 8192;
constexpr int DIN = 3088, DINP = 3200;
constexpr int NE = 32, DFF = 1024;
constexpr int PMAX = 65536 + NE * 128;
constexpr int NTHREADS = 256;
constexpr int LDS_BYTES = 66560;
constexpr int NPHASE = 13;
constexpr float EPS = 1e-6f;
constexpr float LOG2E = 1.4426950408889634f;

constexpr size_t al(size_t x) { return (x + 255) & ~(size_t)255; }
constexpr size_t WS_CTL   = 0;
constexpr size_t CTL_BYTES = 65536;
constexpr size_t WS_MOD   = WS_CTL + CTL_BYTES;
constexpr size_t WS_ROPE  = al(WS_MOD + 2 * 6144 * 4);
constexpr size_t WS_WINT  = al(WS_ROPE + (size_t)S * 32 * 2 * 4);
constexpr size_t WS_WOUTT = al(WS_WINT + (size_t)DINP * D * 2);
constexpr size_t WS_WGUT  = al(WS_WOUTT + (size_t)D * D * 2);
constexpr size_t WS_WDT   = al(WS_WGUT + (size_t)NE * 2048 * D * 2);
constexpr size_t WS_H     = al(WS_WDT + (size_t)NE * D * DFF * 2);
constexpr size_t WS_QA    = al(WS_H + (size_t)T * D * 2);
constexpr size_t WS_KA    = al(WS_QA + (size_t)T * 512 * 2);
constexpr size_t WS_VT1   = al(WS_KA + (size_t)T * 512 * 2);
constexpr size_t WS_VT4   = al(WS_VT1 + (size_t)T * 512 * 2);
constexpr size_t WS_VT16  = al(WS_VT4 + (size_t)T * 512 * 2);
constexpr size_t WS_QG    = al(WS_VT16 + (size_t)T * 512 * 2);
constexpr size_t WS_KG    = al(WS_QG + (size_t)T * 256 * 2);
constexpr size_t WS_VG    = al(WS_KG + (size_t)T * 256 * 2);
constexpr size_t WS_RG    = al(WS_VG + (size_t)T * 512 * 2);
constexpr size_t WS_GLR   = al(WS_RG + (size_t)T * 512 * 2);
constexpr size_t WS_UT    = al(WS_GLR + (size_t)T * 16 * 4);
constexpr size_t WS_AG    = al(WS_UT + (size_t)1024 * 128 * 64 * 4);
constexpr size_t WS_SPT   = al(WS_AG + (size_t)1024 * 64 * 4);
constexpr size_t WS_CAT   = al(WS_SPT + (size_t)1024 * 128 * 64 * 2);
constexpr size_t WS_TOPI  = al(WS_CAT + (size_t)T * D * 2);
constexpr size_t WS_GATE  = al(WS_TOPI + (size_t)T * 4 * 4);
constexpr size_t WS_POS   = al(WS_GATE + (size_t)T * 4 * 4);
constexpr size_t WS_SLOT  = al(WS_POS + (size_t)T * 4 * 4);
constexpr size_t WS_TOK   = al(WS_SLOT + (size_t)T * 4 * 4);
constexpr size_t WS_ACT   = al(WS_TOK + (size_t)PMAX * 4);
constexpr size_t WS_YMIX  = WS_ACT;
constexpr size_t WS_YE    = al(WS_ACT + (size_t)PMAX * DFF * 2);
constexpr size_t WS_END   = al(WS_YE + (size_t)PMAX * D * 2);
static_assert((size_t)T * D * 4 <= (size_t)PMAX * DFF * 2, "YMIX alias fits in ACT");
constexpr int CW_CNT = 1024;

struct Params {
    const float *x, *c, *w_mod, *b_mod, *g_pre_mix, *w_in, *w_gate_lr, *b_gate, *g_gla, *w_out, *g_post_mix, *g_pre_ffn,
                *router_w, *router_b, *w_gate_up, *b_gate_up, *w_down, *b_down, *g_post_ffn;
    float* out; unsigned char* ws;
    int ph_lo, ph_hi;
    float inv_freq[32];
};

__device__ __forceinline__ unsigned f2bf(float f) { unsigned u = __builtin_bit_cast(unsigned, f); return (u + 0x7fffu + ((u >> 16) & 1u)) >> 16; }
__device__ __forceinline__ unsigned pk2(float lo, float hi) { return f2bf(lo) | (f2bf(hi) << 16); }
__device__ __forceinline__ float bf2f(unsigned short b) { return __builtin_bit_cast(float, (unsigned)b << 16); }
__device__ __forceinline__ float wave_sum(float v) {
#pragma unroll
    for (int o = 1; o < 64; o <<= 1) v += __shfl_xor(v, o);
    return v;
}
__device__ __forceinline__ float fexp2(float x) { return __builtin_amdgcn_exp2f(x); }
__device__ __forceinline__ float fexp(float x) { return __builtin_amdgcn_exp2f(x * LOG2E); }
__device__ __forceinline__ float flog(float x) { return __builtin_amdgcn_logf(x) * 0.6931471805599453f; }
__device__ __forceinline__ float fsilu(float x) { return x / (1.f + fexp(-x)); }

__device__ __forceinline__ void gemm_tile_128(const bf16_t* a0, const bf16_t* a1, const bf16_t* b0, const bf16_t* b1, int K, unsigned char* lds, f32x4 (&acc)[4][4]) {
    const int tid = threadIdx.x, lane = tid & 63, wid = tid >> 6, wr = wid >> 1, wc = wid & 1, fr = lane & 15, fq = lane >> 4;
    unsigned char* sA = lds; unsigned char* sB = lds + 8192;
    const int wofs = (tid >> 2) * 64 + (tid & 3) * 16;
    uint4 ra0 = *(const uint4*)a0, ra1 = *(const uint4*)a1, rb0 = *(const uint4*)b0, rb1 = *(const uint4*)b1;
    const int nk = K / 32;
    for (int kt = 0; kt < nk; ++kt) {
        __syncthreads();
        *(uint4*)(sA + wofs) = ra0; *(uint4*)(sA + wofs + 4096) = ra1; *(uint4*)(sB + wofs) = rb0; *(uint4*)(sB + wofs + 4096) = rb1;
        __syncthreads();
        if (kt + 1 < nk) { const int o = (kt + 1) * 32; ra0 = *(const uint4*)(a0 + o); ra1 = *(const uint4*)(a1 + o); rb0 = *(const uint4*)(b0 + o); rb1 = *(const uint4*)(b1 + o); }
        bf16x8 af[4], bfr[4];
#pragma unroll
        for (int m = 0; m < 4; ++m) af[m] = *(const bf16x8*)(sA + (wr * 64 + m * 16 + fr) * 64 + fq * 16);
#pragma unroll
        for (int n = 0; n < 4; ++n) bfr[n] = *(const bf16x8*)(sB + (wc * 64 + n * 16 + fr) * 64 + fq * 16);
#pragma unroll
        for (int m = 0; m < 4; ++m)
#pragma unroll
            for (int n = 0; n < 4; ++n) acc[m][n] = __builtin_amdgcn_mfma_f32_16x16x32_bf16(af[m], bfr[n], acc[m][n], 0, 0, 0);
    }
}

__device__ __forceinline__ void transpose_item(const float* W, int ldw, int nvalid, bf16_t* WT, int K, int k0, int n0, float* scr, int lane, bool glu_perm) {
#pragma unroll 8
    for (int i = 0; i < 32; ++i) { const int kk = 2 * i + (lane >> 5); const int col = n0 + (lane & 31);
        scr[kk * 33 + (lane & 31)] = (col < nvalid) ? W[(size_t)(k0 + kk) * ldw + col] : 0.f; }
    asm volatile("s_waitcnt lgkmcnt(0)" ::: "memory");
    const int c = lane & 7;
#pragma unroll
    for (int j = 0; j < 4; ++j) { const int n = (lane >> 3) + 8 * j; const float* s = scr + (8 * c) * 33 + n;
        uint4 o; o.x = pk2(s[0 * 33], s[1 * 33]); o.y = pk2(s[2 * 33], s[3 * 33]); o.z = pk2(s[4 * 33], s[5 * 33]); o.w = pk2(s[6 * 33], s[7 * 33]);
        const int orow = glu_perm ? (n0 + (n >> 1) + 16 * (n & 1)) : (n0 + n);
        *(uint4*)(WT + (size_t)orow * K + k0 + 8 * c) = o; }
    asm volatile("s_waitcnt lgkmcnt(0)" ::: "memory");
}

__device__ void phase_prep(const Params& p, unsigned char* lds) {
    const int tid = threadIdx.x, lane = tid & 63, wave = tid >> 6;
    unsigned char* ws = p.ws;
    if ((int)blockIdx.x < 192) {
        float* sl = (float*)lds;
        float* red = sl + 2048;
        for (int i = tid; i < 2048; i += NTHREADS) sl[i] = fsilu(p.c[i]);
        __syncthreads();
        for (int it = blockIdx.x; it < 192; it += gridDim.x) {
            const int col = it * 32 + (tid & 31), kg = tid >> 5;
            float a0 = 0.f, a1 = 0.f;
#pragma unroll 8
            for (int kk = 0; kk < 128; ++kk) { const int k = kg * 128 + kk; const float w = p.w_mod[(size_t)k * 6144 + col]; a0 += sl[k] * w; a1 += sl[1024 + k] * w; }
            red[(kg * 32 + (tid & 31)) * 2 + 0] = a0; red[(kg * 32 + (tid & 31)) * 2 + 1] = a1;
            __syncthreads();
            if (tid < 64) { const int b = tid >> 5, cg_ = tid & 31; float s = 0.f;
#pragma unroll
                for (int g = 0; g < 8; ++g) s += red[(g * 32 + cg_) * 2 + b];
                const int cc = it * 32 + cg_; ((float*)(ws + WS_MOD))[b * 6144 + cc] = s + p.b_mod[cc]; }
            __syncthreads();
        }
    }
    __syncthreads();
    {
        float2* rope = (float2*)(ws + WS_ROPE);
        for (int i = blockIdx.x * NTHREADS + tid; i < S * 32; i += gridDim.x * NTHREADS) {
            const int pos = i >> 5, d = i & 31;
            const float angf = (float)pos * p.inv_freq[d];
            const double ang = (double)angf;
            const double TWO_PI = 6.283185307179586476925286766559, HALF_PI = 1.5707963267948966192313216916398;
            const double n = __builtin_rint(ang / TWO_PI);
            const double rr = ang - n * TWO_PI;
            const double q = __builtin_rint(rr / HALF_PI);
            const double y = rr - q * HALF_PI;
            const double y2 = y * y;
            const double sy = y * (1.0 + y2 * (-1.0 / 6 + y2 * (1.0 / 120 + y2 * (-1.0 / 5040 + y2 * (1.0 / 362880 + y2 * (-1.0 / 39916800 + y2 * (1.0 / 6227020800.0)))))));
            const double cy = 1.0 + y2 * (-0.5 + y2 * (1.0 / 24 + y2 * (-1.0 / 720 + y2 * (1.0 / 40320 + y2 * (-1.0 / 3628800 + y2 * (1.0 / 479001600.0))))));
            const int qi = ((int)q) & 3;
            double cs, sn;
            if (qi == 0) { cs = cy; sn = sy; } else if (qi == 1) { cs = -sy; sn = cy; } else if (qi == 2) { cs = -cy; sn = -sy; } else { cs = sy; sn = -cy; }
            rope[i] = make_float2((float)cs, (float)sn);
        }
    }
    {
        float* scr = (float*)(lds + wave * 8448);
        const int gw = blockIdx.x * 4 + wave, ngw = gridDim.x * 4;
        constexpr int I_IN = 16 * 100, I_OUT = 16 * 32, I_GU = 16 * 64, I_DN = 16 * 32;
        constexpr int NITEMS = I_IN + I_OUT + NE * I_GU + NE * I_DN;
        for (int it = gw; it < NITEMS; it += ngw) {
            int r = it;
            if (r < I_IN) { transpose_item(p.w_in, DIN, DIN, (bf16_t*)(ws + WS_WINT), D, (r / 100) * 64, (r % 100) * 32, scr, lane, false); continue; }
            r -= I_IN;
            if (r < I_OUT) { transpose_item(p.w_out, D, D, (bf16_t*)(ws + WS_WOUTT), D, (r / 32) * 64, (r % 32) * 32, scr, lane, false); continue; }
            r -= I_OUT;
            if (r < NE * I_GU) { const int e = r / I_GU, q = r % I_GU;
                transpose_item(p.w_gate_up + (size_t)e * D * 2048, 2048, 2048, (bf16_t*)(ws + WS_WGUT) + (size_t)e * 2048 * D, D, (q / 64) * 64, (q % 64) * 32, scr, lane, true); continue; }
            r -= NE * I_GU;
            { const int e = r / I_DN, q = r % I_DN;
                transpose_item(p.w_down + (size_t)e * DFF * D, D, D, (bf16_t*)(ws + WS_WDT) + (size_t)e * D * DFF, DFF, (q / 32) * 64, (q % 32) * 32, scr, lane, false); }
        }
    }
}

__device__ void phase_prenorm(const Params& p) {
    const int tid = threadIdx.x, lane = tid & 63, wave = tid >> 6;
    const float* mod = (const float*)(p.ws + WS_MOD);
    bf16_t* H = (bf16_t*)(p.ws + WS_H);
    for (int m = blockIdx.x * 4 + wave; m < T; m += gridDim.x * 4) {
        const int b = m >> 13;
        const float4* xr = (const float4*)(p.x + (size_t)m * D) + lane;
        float4 v[4]; float ss = 0.f;
#pragma unroll
        for (int j = 0; j < 4; ++j) { v[j] = xr[64 * j]; ss += v[j].x * v[j].x + v[j].y * v[j].y + v[j].z * v[j].z + v[j].w * v[j].w; }
        const float rstd = rsqrtf(wave_sum(ss) * (1.f / D) + EPS);
#pragma unroll
        for (int j = 0; j < 4; ++j) { const int c = 4 * lane + 256 * j;
            const float4 g = *(const float4*)(p.g_pre_mix + c), sh = *(const float4*)(mod + b * 6144 + c), sc = *(const float4*)(mod + b * 6144 + 1024 + c);
            const float h0 = v[j].x * rstd * g.x * (1.f + sc.x) + sh.x, h1 = v[j].y * rstd * g.y * (1.f + sc.y) + sh.y;
            const float h2 = v[j].z * rstd * g.z * (1.f + sc.z) + sh.z, h3 = v[j].w * rstd * g.w * (1.f + sc.w) + sh.w;
            uint2 o; o.x = pk2(h0, h1); o.y = pk2(h2, h3);
            *(uint2*)(H + (size_t)m * D + c) = o; }
    }
}

__device__ void phase_gemm_in(const Params& p, unsigned char* lds) {
    const int tid = threadIdx.x, lane = tid & 63, wid = tid >> 6, wr = wid >> 1, wc = wid & 1, fr = lane & 15, fq = lane >> 4;
    unsigned char* ws = p.ws;
    const bf16_t* A = (const bf16_t*)(ws + WS_H); const bf16_t* Bt = (const bf16_t*)(ws + WS_WINT);
    const float2* rope = (const float2*)(ws + WS_ROPE);
    constexpr int NTM = T / 128, NTN = DINP / 128;
    for (int id = blockIdx.x; id < NTM * NTN; id += gridDim.x) {
        const int tn = id % NTN, tm = id / NTN;
        const int row0 = tm * 128, n0 = tn * 128;
        const int r = tid >> 2, ch = (tid & 3) * 8;
        f32x4 acc[4][4];
#pragma unroll
        for (int m = 0; m < 4; ++m)
#pragma unroll
            for (int n = 0; n < 4; ++n) acc[m][n] = (f32x4){0.f, 0.f, 0.f, 0.f};
        gemm_tile_128(A + (size_t)(row0 + r) * D + ch, A + (size_t)(row0 + r + 64) * D + ch, Bt + (size_t)(n0 + r) * D + ch, Bt + (size_t)(n0 + r + 64) * D + ch, D, lds, acc);
        if (n0 < 1024) {
            const bool isq = n0 < 512;
            bf16_t* dst = (bf16_t*)(ws + (isq ? WS_QA : WS_KA));
            const int head = ((n0 & 511) >> 6) + wc;
            const float scl = isq ? 0.125f : 1.f;
#pragma unroll
            for (int m = 0; m < 4; ++m)
#pragma unroll
                for (int j = 0; j < 4; ++j) { const int row = row0 + wr * 64 + m * 16 + fq * 4 + j, pos = row & (S - 1);
#pragma unroll
                    for (int n = 0; n < 2; ++n) { const int d = n * 16 + fr; const float2 cs = rope[pos * 32 + d];
                        const float x1 = acc[m][n][j], x2 = acc[m][n + 2][j];
                        const float o1 = (x1 * cs.x - x2 * cs.y) * scl, o2 = (x2 * cs.x + x1 * cs.y) * scl;
                        dst[(size_t)row * 512 + head * 64 + d] = (bf16_t)f2bf(o1); dst[(size_t)row * 512 + head * 64 + d + 32] = (bf16_t)f2bf(o2); } }
        } else if (n0 < 1536) {
            bf16_t* vt1 = (bf16_t*)(ws + WS_VT1); bf16_t* vt4 = (bf16_t*)(ws + WS_VT4); bf16_t* vt16 = (bf16_t*)(ws + WS_VT16);
#pragma unroll
            for (int m = 0; m < 4; ++m) { const int row = row0 + wr * 64 + m * 16 + fq * 4, b = row >> 13, pos = row & (S - 1);
#pragma unroll
                for (int n = 0; n < 4; ++n) { const int col = n0 - 1024 + wc * 64 + n * 16 + fr, head = col >> 6, dv = col & 63;
                    const size_t base = (size_t)((b * 8 + head) * 64 + dv) * S;
                    uint2 o; o.x = pk2(acc[m][n][0], acc[m][n][1]); o.y = pk2(acc[m][n][2], acc[m][n][3]);
                    *(uint2*)(vt1 + base + pos) = o;
#pragma unroll
                    for (int j = 0; j < 4; ++j) { const bf16_t hv = (bf16_t)f2bf(acc[m][n][j]);
                        vt4[base + j * 2048 + (pos >> 2)] = hv;
                        vt16[base + ((pos & 15) + j) * 512 + (pos >> 4)] = hv; } } }
        } else if (n0 < 3072) {
            bf16_t* dst; int ldc, cb;
            if (n0 < 1792) { dst = (bf16_t*)(ws + WS_QG); ldc = 256; cb = n0 - 1536; }
            else if (n0 < 2048) { dst = (bf16_t*)(ws + WS_KG); ldc = 256; cb = n0 - 1792; }
            else if (n0 < 2560) { dst = (bf16_t*)(ws + WS_VG); ldc = 512; cb = n0 - 2048; }
            else { dst = (bf16_t*)(ws + WS_RG); ldc = 512; cb = n0 - 2560; }
#pragma unroll
            for (int m = 0; m < 4; ++m)
#pragma unroll
                for (int n = 0; n < 4; ++n)
#pragma unroll
                    for (int j = 0; j < 4; ++j) { const int row = row0 + wr * 64 + m * 16 + fq * 4 + j; dst[(size_t)row * ldc + cb + wc * 64 + n * 16 + fr] = (bf16_t)f2bf(acc[m][n][j]); }
        } else {
            float* glr = (float*)(ws + WS_GLR);
            if (wc == 0) {
#pragma unroll
                for (int m = 0; m < 4; ++m)
#pragma unroll
                    for (int j = 0; j < 4; ++j) { const int row = row0 + wr * 64 + m * 16 + fq * 4 + j; glr[(size_t)row * 16 + fr] = acc[m][0][j]; }
            }
        }
    }
}

__device__ void phase_attn(const Params& p) {
    const int tid = threadIdx.x, lane = tid & 63, wave = tid >> 6;
    const int qi = lane & 15, g = lane >> 4;
    unsigned char* ws = p.ws;
    const bf16_t* QA = (const bf16_t*)(ws + WS_QA); const bf16_t* KA = (const bf16_t*)(ws + WS_KA);
    bf16_t* CAT = (bf16_t*)(ws + WS_CAT);
    for (int id = blockIdx.x; id < 2048; id += gridDim.x) {
        const int bh = id >> 7, blk = (id >> 2) & 31, r = (id & 3) * 4 + wave;
        const int b = bh >> 3, h = bh & 7;
        const int tq = 256 * blk + r + 16 * qi;
        const bf16_t* qrow = QA + ((size_t)(b * S + tq) * 512 + h * 64 + 8 * g);
        const bf16x8 qf0 = *(const bf16x8*)qrow, qf1 = *(const bf16x8*)(qrow + 32);
        float mrun = -1e30f, lrun = 0.f;
        f32x4 o[4];
#pragma unroll
        for (int n = 0; n < 4; ++n) o[n] = (f32x4){0.f, 0.f, 0.f, 0.f};
        for (int pat = 0; pat < 3; ++pat) {
            const int lg = 2 * pat, d = 1 << lg;
            const int rho = r & (d - 1);
            const int cq = (tq - rho) >> lg;
            const int kstart = ((256 * blk) >> lg) - (pat == 2 ? 144 : 128);
            const int nch = (pat == 0) ? 12 : (pat == 1 ? 6 : 5);
            const bf16_t* vt = (const bf16_t*)(ws + (pat == 0 ? WS_VT1 : (pat == 1 ? WS_VT4 : WS_VT16))) + (size_t)(bh * 64) * S + rho * (S >> lg);
            for (int ch = 0; ch < nch; ++ch) {
                const int kc0 = kstart + 32 * ch;
                const int key0 = kc0 + 8 * (qi >> 2) + (qi & 3), key1 = key0 + 4;
                const int tok0 = rho + d * (key0 < 0 ? 0 : key0), tok1 = rho + d * (key1 < 0 ? 0 : key1);
                const bf16_t* k0p = KA + ((size_t)(b * S + tok0) * 512 + h * 64 + 8 * g);
                const bf16_t* k1p = KA + ((size_t)(b * S + tok1) * 512 + h * 64 + 8 * g);
                const bf16x8 ka00 = *(const bf16x8*)k0p, ka01 = *(const bf16x8*)(k0p + 32), ka10 = *(const bf16x8*)k1p, ka11 = *(const bf16x8*)(k1p + 32);
                const int kb = kc0 + 8 * g;
                const int kbc = kb < 0 ? 0 : kb;
                bf16x8 vf[4];
#pragma unroll
                for (int n = 0; n < 4; ++n) vf[n] = *(const bf16x8*)(vt + (size_t)(16 * n + qi) * S + kbc);
                f32x4 st0 = (f32x4){0.f, 0.f, 0.f, 0.f}, st1 = (f32x4){0.f, 0.f, 0.f, 0.f};
                st0 = __builtin_amdgcn_mfma_f32_16x16x32_bf16(ka00, qf0, st0, 0, 0, 0);
                st0 = __builtin_amdgcn_mfma_f32_16x16x32_bf16(ka01, qf1, st0, 0, 0, 0);
                st1 = __builtin_amdgcn_mfma_f32_16x16x32_bf16(ka10, qf0, st1, 0, 0, 0);
                st1 = __builtin_amdgcn_mfma_f32_16x16x32_bf16(ka11, qf1, st1, 0, 0, 0);
                float sv[8]; bool vd[8];
#pragma unroll
                for (int j = 0; j < 8; ++j) { const int kk = kb + j; const int dlt = cq - kk; vd[j] = (kk >= 0) && (dlt >= 0) && (dlt <= 128); sv[j] = (j < 4) ? st0[j] : st1[j - 4]; }
                float mx = -1e30f;
#pragma unroll
                for (int j = 0; j < 8; ++j) mx = vd[j] ? fmaxf(mx, sv[j]) : mx;
                mx = fmaxf(mx, __shfl_xor(mx, 16)); mx = fmaxf(mx, __shfl_xor(mx, 32));
                const float mn = fmaxf(mrun, mx);
                const float alpha = fexp2((mrun - mn) * LOG2E);
                float pj[8]; float ps = 0.f;
#pragma unroll
                for (int j = 0; j < 8; ++j) { pj[j] = vd[j] ? fexp2((sv[j] - mn) * LOG2E) : 0.f; ps += pj[j]; }
                lrun = lrun * alpha + ps; mrun = mn;
                bf16x8 pf;
#pragma unroll
                for (int j = 0; j < 8; ++j) pf[j] = (short)f2bf(pj[j]);
#pragma unroll
                for (int n = 0; n < 4; ++n) { o[n] = o[n] * alpha; o[n] = __builtin_amdgcn_mfma_f32_16x16x32_bf16(vf[n], pf, o[n], 0, 0, 0); }
            }
        }
        lrun += __shfl_xor(lrun, 16); lrun += __shfl_xor(lrun, 32);
        const float inv = 1.f / lrun;
        bf16_t* orow = CAT + (size_t)(b * S + tq) * D + h * 64 + 4 * g;
#pragma unroll
        for (int n = 0; n < 4; ++n) { uint2 ov; ov.x = pk2(o[n][0] * inv, o[n][1] * inv); ov.y = pk2(o[n][2] * inv, o[n][3] * inv); *(uint2*)(orow + 16 * n) = ov; }
    }
}

constexpr int TS = 72;
constexpr int GL_LA = 0, GL_A1 = 16640, GL_A2 = GL_A1 + 64 * TS * 2, GL_VT = GL_A2 + 64 * TS * 2, GL_ATT = GL_VT + 128 * TS * 2;
static_assert(GL_ATT + 64 * TS * 2 <= LDS_BYTES, "gla lds");

template <int MODE>
__device__ __forceinline__ void gla_prep(const Params& p, unsigned char* lds, int item) {
    const int tid = threadIdx.x;
    unsigned char* ws = p.ws;
    const int bh4 = item >> 7, n = item & 127, b = bh4 >> 2, hh = bh4 & 3;
    const int t0 = b * S + n * 64;
    float* LA = (float*)(lds + GL_LA);
    bf16_t* A1 = (bf16_t*)(lds + GL_A1); bf16_t* A2 = (bf16_t*)(lds + GL_A2); bf16_t* VTl = (bf16_t*)(lds + GL_VT);
    const float* glr = (const float*)(ws + WS_GLR);
    {
        const int dd = tid & 63, cgp = tid >> 6;
        float w[16];
#pragma unroll
        for (int r = 0; r < 16; ++r) w[r] = p.w_gate_lr[r * 256 + hh * 64 + dd];
        const float bias = p.b_gate[hh * 64 + dd];
        for (int c = cgp * 16; c < cgp * 16 + 16; ++c) {
            const float4* gp = (const float4*)(glr + (size_t)(t0 + c) * 16);
            const float4 g0 = gp[0], g1 = gp[1], g2 = gp[2], g3 = gp[3];
            float z = bias;
            z += g0.x * w[0] + g0.y * w[1] + g0.z * w[2] + g0.w * w[3];
            z += g1.x * w[4] + g1.y * w[5] + g1.z * w[6] + g1.w * w[7];
            z += g2.x * w[8] + g2.y * w[9] + g2.z * w[10] + g2.w * w[11];
            z += g3.x * w[12] + g3.y * w[13] + g3.z * w[14] + g3.w * w[15];
            const float ls = fminf(z, 0.f) - flog(1.f + fexp(-fabsf(z)));
            LA[c * 65 + dd] = ls * (1.f / 16.f);
        }
    }
    __syncthreads();
    if (tid < 64) { float run = 0.f; for (int c = 0; c < 64; ++c) { run += LA[c * 65 + tid]; LA[c * 65 + tid] = run; } }
    __syncthreads();
    {
        const int c = tid >> 2, d0 = (tid & 3) * 16;
        const bf16_t* kp = (const bf16_t*)(ws + WS_KG) + (size_t)(t0 + c) * 256 + hh * 64 + d0;
        uint4 kr0 = *(const uint4*)kp, kr1 = *(const uint4*)(kp + 8);
        unsigned kw[8] = {kr0.x, kr0.y, kr0.z, kr0.w, kr1.x, kr1.y, kr1.z, kr1.w};
        if (MODE == 0) {
#pragma unroll
            for (int i = 0; i < 16; ++i) { const int dd = d0 + i; const float kv = bf2f((unsigned short)((kw[i >> 1] >> ((i & 1) * 16)) & 0xffff));
                const float f = fexp(LA[63 * 65 + dd] - LA[c * 65 + dd]);
                A1[dd * TS + c] = (bf16_t)f2bf(kv * f); }
        } else {
            const bf16_t* qp = (const bf16_t*)(ws + WS_QG) + (size_t)(t0 + c) * 256 + hh * 64 + d0;
            uint4 qr0 = *(const uint4*)qp, qr1 = *(const uint4*)(qp + 8);
            unsigned qw[8] = {qr0.x, qr0.y, qr0.z, qr0.w, qr1.x, qr1.y, qr1.z, qr1.w};
            unsigned oq[8], ok[8];
#pragma unroll
            for (int i = 0; i < 8; ++i) {
                const float bb0 = LA[c * 65 + d0 + 2 * i], bb1 = LA[c * 65 + d0 + 2 * i + 1];
                const float q0 = bf2f((unsigned short)(qw[i] & 0xffff)), q1 = bf2f((unsigned short)(qw[i] >> 16));
                const float k0 = bf2f((unsigned short)(kw[i] & 0xffff)), k1 = bf2f((unsigned short)(kw[i] >> 16));
                oq[i] = pk2(q0 * 0.125f * fexp(bb0), q1 * 0.125f * fexp(bb1));
                ok[i] = pk2(k0 * fexp(-bb0), k1 * fexp(-bb1));
            }
            *(uint4*)(A1 + c * TS + d0) = make_uint4(oq[0], oq[1], oq[2], oq[3]); *(uint4*)(A1 + c * TS + d0 + 8) = make_uint4(oq[4], oq[5], oq[6], oq[7]);
            *(uint4*)(A2 + c * TS + d0) = make_uint4(ok[0], ok[1], ok[2], ok[3]); *(uint4*)(A2 + c * TS + d0 + 8) = make_uint4(ok[4], ok[5], ok[6], ok[7]);
        }
        const int e0 = (tid & 3) * 32;
        const bf16_t* vp = (const bf16_t*)(ws + WS_VG) + (size_t)(t0 + c) * 512 + hh * 128 + e0;
#pragma unroll
        for (int q = 0; q < 4; ++q) { const uint4 vr = *(const uint4*)(vp + 8 * q); const unsigned vw[4] = {vr.x, vr.y, vr.z, vr.w};
#pragma unroll
            for (int i = 0; i < 4; ++i) { VTl[(e0 + 8 * q + 2 * i) * TS + c] = (bf16_t)(vw[i] & 0xffff); VTl[(e0 + 8 * q + 2 * i + 1) * TS + c] = (bf16_t)(vw[i] >> 16); } }
    }
    __syncthreads();
}

__device__ void phase_gla1(const Params& p, unsigned char* lds) {
    const int tid = threadIdx.x, lane = tid & 63, w = tid >> 6, fr = lane & 15, fq = lane >> 4;
    float* UT = (float*)(p.ws + WS_UT); float* AG = (float*)(p.ws + WS_AG);
    const float* LA = (const float*)(lds + GL_LA);
    const bf16_t* A1 = (const bf16_t*)(lds + GL_A1); const bf16_t* VTl = (const bf16_t*)(lds + GL_VT);
    for (int item = blockIdx.x; item < 1024; item += gridDim.x) {
        gla_prep<0>(p, lds, item);
        f32x4 acc[8];
#pragma unroll
        for (int n = 0; n < 8; ++n) acc[n] = (f32x4){0.f, 0.f, 0.f, 0.f};
#pragma unroll
        for (int ks = 0; ks < 2; ++ks) {
            const bf16x8 af = *(const bf16x8*)(A1 + (16 * w + fr) * TS + ks * 32 + fq * 8);
#pragma unroll
            for (int n = 0; n < 8; ++n) { const bf16x8 bfr = *(const bf16x8*)(VTl + (16 * n + fr) * TS + ks * 32 + fq * 8);
                acc[n] = __builtin_amdgcn_mfma_f32_16x16x32_bf16(af, bfr, acc[n], 0, 0, 0); }
        }
#pragma unroll
        for (int n = 0; n < 8; ++n) *(f32x4*)(UT + ((size_t)item * 128 + 16 * n + fr) * 64 + 16 * w + 4 * fq) = acc[n];
        if (tid < 64) AG[item * 64 + tid] = fexp(LA[63 * 65 + tid]);
        __syncthreads();
    }
}
__device__ void phase_gla2(const Params& p) {
    const float* UT = (const float*)(p.ws + WS_UT); const float* AG = (const float*)(p.ws + WS_AG);
    bf16_t* SPT = (bf16_t*)(p.ws + WS_SPT);
    for (int rec = blockIdx.x * NTHREADS + threadIdx.x; rec < 65536; rec += gridDim.x * NTHREADS) {
        const int bh4 = rec >> 13, e = (rec >> 6) & 127, dd = rec & 63;
        float st = 0.f;
#pragma unroll 8
        for (int n = 0; n < 128; ++n) { const int item = bh4 * 128 + n; const size_t idx = ((size_t)item * 128 + e) * 64 + dd;
            SPT[idx] = (bf16_t)f2bf(st);
            st = AG[item * 64 + dd] * st + UT[idx]; }
    }
}
__device__ void phase_gla3(const Params& p, unsigned char* lds) {
    const int tid = threadIdx.x, lane = tid & 63, w = tid >> 6, fr = lane & 15, fq = lane >> 4;
    unsigned char* ws = p.ws;
    const bf16_t* SPT = (const bf16_t*)(ws + WS_SPT); const bf16_t* RG = (const bf16_t*)(ws + WS_RG);
    bf16_t* CAT = (bf16_t*)(ws + WS_CAT);
    const bf16_t* A1 = (const bf16_t*)(lds + GL_A1); const bf16_t* A2 = (const bf16_t*)(lds + GL_A2); const bf16_t* VTl = (const bf16_t*)(lds + GL_VT);
    bf16_t* ATT = (bf16_t*)(lds + GL_ATT);
    for (int item = blockIdx.x; item < 1024; item += gridDim.x) {
        gla_prep<1>(p, lds, item);
        const int bh4 = item >> 7, n_ = item & 127, b = bh4 >> 2, hh = bh4 & 3;
        const int t0 = b * S + n_ * 64;
        const bf16x8 aq0 = *(const bf16x8*)(A1 + (16 * w + fr) * TS + fq * 8), aq1 = *(const bf16x8*)(A1 + (16 * w + fr) * TS + 32 + fq * 8);
#pragma unroll
        for (int np = 0; np < 4; ++np) {
            f32x4 a = (f32x4){0.f, 0.f, 0.f, 0.f};
            if (np <= w) {
                const bf16x8 b0 = *(const bf16x8*)(A2 + (16 * np + fr) * TS + fq * 8), b1 = *(const bf16x8*)(A2 + (16 * np + fr) * TS + 32 + fq * 8);
                a = __builtin_amdgcn_mfma_f32_16x16x32_bf16(aq0, b0, a, 0, 0, 0);
                a = __builtin_amdgcn_mfma_f32_16x16x32_bf16(aq1, b1, a, 0, 0, 0);
            }
#pragma unroll
            for (int j = 0; j < 4; ++j) { const int c = 16 * w + 4 * fq + j, cp = 16 * np + fr; ATT[c * TS + cp] = (bf16_t)f2bf(cp <= c ? a[j] : 0.f); }
        }
        __syncthreads();
        const bf16x8 at0 = *(const bf16x8*)(ATT + (16 * w + fr) * TS + fq * 8), at1 = *(const bf16x8*)(ATT + (16 * w + fr) * TS + 32 + fq * 8);
        f32x4 acc[8];
#pragma unroll
        for (int n = 0; n < 8; ++n) {
            acc[n] = (f32x4){0.f, 0.f, 0.f, 0.f};
            const bf16x8 v0 = *(const bf16x8*)(VTl + (16 * n + fr) * TS + fq * 8), v1 = *(const bf16x8*)(VTl + (16 * n + fr) * TS + 32 + fq * 8);
            const bf16_t* sp = SPT + ((size_t)item * 128 + 16 * n + fr) * 64 + fq * 8;
            const bf16x8 s0 = *(const bf16x8*)sp, s1 = *(const bf16x8*)(sp + 32);
            acc[n] = __builtin_amdgcn_mfma_f32_16x16x32_bf16(at0, v0, acc[n], 0, 0, 0);
            acc[n] = __builtin_amdgcn_mfma_f32_16x16x32_bf16(at1, v1, acc[n], 0, 0, 0);
            acc[n] = __builtin_amdgcn_mfma_f32_16x16x32_bf16(aq0, s0, acc[n], 0, 0, 0);
            acc[n] = __builtin_amdgcn_mfma_f32_16x16x32_bf16(aq1, s1, acc[n], 0, 0, 0);
        }
#pragma unroll
        for (int j = 0; j < 4; ++j) {
            float ss = 0.f;
#pragma unroll
            for (int n = 0; n < 8; ++n) ss += acc[n][j] * acc[n][j];
            ss += __shfl_xor(ss, 1); ss += __shfl_xor(ss, 2); ss += __shfl_xor(ss, 4); ss += __shfl_xor(ss, 8);
            const float rstd = rsqrtf(ss * (1.f / 128.f) + EPS);
            const int t = t0 + 16 * w + 4 * fq + j;
#pragma unroll
            for (int n = 0; n < 8; ++n) { const int e = 16 * n + fr;
                const float rv = bf2f(RG[(size_t)t * 512 + hh * 128 + e]);
                const float val = acc[n][j] * rstd * p.g_gla[e] * fsilu(rv);
                CAT[(size_t)t * D + 512 + hh * 128 + e] = (bf16_t)f2bf(val); }
        }
        __syncthreads();
    }
}

__device__ void phase_gemm_out(const Params& p, unsigned char* lds) {
    const int tid = threadIdx.x, lane = tid & 63, wid = tid >> 6, wr = wid >> 1, wc = wid & 1, fr = lane & 15, fq = lane >> 4;
    const bf16_t* A = (const bf16_t*)(p.ws + WS_CAT); const bf16_t* Bt = (const bf16_t*)(p.ws + WS_WOUTT);
    float* Y = (float*)(p.ws + WS_YMIX);
    for (int id = blockIdx.x; id < (T / 128) * 8; id += gridDim.x) {
        const int tn = id & 7, tm = id >> 3, row0 = tm * 128, n0 = tn * 128, r = tid >> 2, ch = (tid & 3) * 8;
        f32x4 acc[4][4];
#pragma unroll
        for (int m = 0; m < 4; ++m)
#pragma unroll
            for (int n = 0; n < 4; ++n) acc[m][n] = (f32x4){0.f, 0.f, 0.f, 0.f};
        gemm_tile_128(A + (size_t)(row0 + r) * D + ch, A + (size_t)(row0 + r + 64) * D + ch, Bt + (size_t)(n0 + r) * D + ch, Bt + (size_t)(n0 + r + 64) * D + ch, D, lds, acc);
#pragma unroll
        for (int m = 0; m < 4; ++m)
#pragma unroll
            for (int n = 0; n < 4; ++n)
#pragma unroll
                for (int j = 0; j < 4; ++j) Y[(size_t)(row0 + wr * 64 + m * 16 + fq * 4 + j) * D + n0 + wc * 64 + n * 16 + fr] = acc[m][n][j];
    }
}

constexpr int HS_STRIDE = 1028;
__device__ void phase_postmix(const Params& p, unsigned char* lds) {
    const int tid = threadIdx.x, lane = tid & 63, wave = tid >> 6;
    unsigned char* ws = p.ws;
    const float* mod = (const float*)(ws + WS_MOD);
    const float* Y = (const float*)(ws + WS_YMIX);
    bf16_t* H = (bf16_t*)(ws + WS_H);
    float* hs = (float*)lds;
    float* part = (float*)lds;
    float* lg = (float*)(lds + 8192);
    int* sel_e = (int*)(lds + 8192 + 2048);
    float* sel_g = (float*)(lds + 8192 + 2048 + 256);
    int* lcnt = (int*)(lds + 8192 + 2048 + 512);
    int* lbase = (int*)(lds + 8192 + 2048 + 640);
    int* lrank = (int*)(lds + 8192 + 2048 + 768);
    int* CNT = (int*)(ws + WS_CTL) + CW_CNT;
    for (int grp = blockIdx.x; grp < T / 16; grp += gridDim.x) {
        const int m0 = grp * 16;
        for (int i = 0; i < 4; ++i) {
            const int rl = wave * 4 + i, m = m0 + rl, b = m >> 13;
            const float4* yr = (const float4*)(Y + (size_t)m * D) + lane;
            const float4* xr = (const float4*)(p.x + (size_t)m * D) + lane;
            float4 yv[4]; float ss = 0.f;
#pragma unroll
            for (int j = 0; j < 4; ++j) { yv[j] = yr[64 * j]; ss += yv[j].x * yv[j].x + yv[j].y * yv[j].y + yv[j].z * yv[j].z + yv[j].w * yv[j].w; }
            const float rstd1 = rsqrtf(wave_sum(ss) * (1.f / D) + EPS);
            float4 x1[4]; float ss2 = 0.f;
#pragma unroll
            for (int j = 0; j < 4; ++j) { const int c = 4 * lane + 256 * j;
                const float4 xv = xr[64 * j], g = *(const float4*)(p.g_post_mix + c), gt = *(const float4*)(mod + b * 6144 + 2048 + c);
                x1[j].x = xv.x + gt.x * (yv[j].x * rstd1 * g.x); x1[j].y = xv.y + gt.y * (yv[j].y * rstd1 * g.y);
                x1[j].z = xv.z + gt.z * (yv[j].z * rstd1 * g.z); x1[j].w = xv.w + gt.w * (yv[j].w * rstd1 * g.w);
                ss2 += x1[j].x * x1[j].x + x1[j].y * x1[j].y + x1[j].z * x1[j].z + x1[j].w * x1[j].w;
                *(float4*)(p.out + (size_t)m * D + c) = x1[j]; }
            const float rstd2 = rsqrtf(wave_sum(ss2) * (1.f / D) + EPS);
#pragma unroll
            for (int j = 0; j < 4; ++j) { const int c = 4 * lane + 256 * j;
                const float4 g = *(const float4*)(p.g_pre_ffn + c), sh = *(const float4*)(mod + b * 6144 + 3072 + c), sc = *(const float4*)(mod + b * 6144 + 4096 + c);
                float4 h;
                h.x = x1[j].x * rstd2 * g.x * (1.f + sc.x) + sh.x; h.y = x1[j].y * rstd2 * g.y * (1.f + sc.y) + sh.y;
                h.z = x1[j].z * rstd2 * g.z * (1.f + sc.z) + sh.z; h.w = x1[j].w * rstd2 * g.w * (1.f + sc.w) + sh.w;
                uint2 o; o.x = pk2(h.x, h.y); o.y = pk2(h.z, h.w);
                *(uint2*)(H + (size_t)m * D + c) = o;
                *(float4*)(hs + rl * HS_STRIDE + c) = h; }
        }
        __syncthreads();
        f32x4 a0 = (f32x4){0.f, 0.f, 0.f, 0.f}, a1 = (f32x4){0.f, 0.f, 0.f, 0.f};
        {
            const int r16 = lane & 15, kq = lane >> 4;
            const float* hp = hs + r16 * HS_STRIDE + 256 * wave + kq;
            const float* wp = p.router_w + (size_t)(256 * wave + kq) * 32 + r16;
#pragma unroll 8
            for (int ks = 0; ks < 64; ++ks) {
                const float av = hp[4 * ks];
                const float b0 = wp[(size_t)(4 * ks) * 32], b1 = wp[(size_t)(4 * ks) * 32 + 16];
                a0 = __builtin_amdgcn_mfma_f32_16x16x4f32(av, b0, a0, 0, 0, 0);
                a1 = __builtin_amdgcn_mfma_f32_16x16x4f32(av, b1, a1, 0, 0, 0);
            }
        }
        __syncthreads();
        {
            const int fr = lane & 15, fq = lane >> 4;
#pragma unroll
            for (int j = 0; j < 4; ++j) { part[(wave * 16 + 4 * fq + j) * 32 + fr] = a0[j]; part[(wave * 16 + 4 * fq + j) * 32 + 16 + fr] = a1[j]; }
        }
        __syncthreads();
        for (int i = tid; i < 512; i += NTHREADS) { const int e = i & 31; lg[i] = part[i] + part[512 + i] + part[1024 + i] + part[1536 + i] + p.router_b[e]; }
        if (tid < 32) lcnt[tid] = 0;
        __syncthreads();
        if (tid < 16) {
            float v[32];
#pragma unroll
            for (int e = 0; e < 32; ++e) v[e] = lg[tid * 32 + e];
            float tv[4]; int ti[4];
#pragma unroll
            for (int k = 0; k < 4; ++k) {
                float best = -3.0e38f; int bi = 0;
#pragma unroll
                for (int e = 0; e < 32; ++e) { if (v[e] > best) { best = v[e]; bi = e; } }
                tv[k] = best; ti[k] = bi;
#pragma unroll
                for (int e = 0; e < 32; ++e) { if (e == bi) v[e] = -3.0e38f; }
            }
            const float e0 = 1.f, e1 = fexp(tv[1] - tv[0]), e2 = fexp(tv[2] - tv[0]), e3 = fexp(tv[3] - tv[0]);
            const float inv = 1.f / (e0 + e1 + e2 + e3);
            sel_e[tid * 4 + 0] = ti[0]; sel_e[tid * 4 + 1] = ti[1]; sel_e[tid * 4 + 2] = ti[2]; sel_e[tid * 4 + 3] = ti[3];
            sel_g[tid * 4 + 0] = e0 * inv; sel_g[tid * 4 + 1] = e1 * inv; sel_g[tid * 4 + 2] = e2 * inv; sel_g[tid * 4 + 3] = e3 * inv;
        }
        __syncthreads();
        if (tid < 64) lrank[tid] = atomicAdd(&lcnt[sel_e[tid]], 1);
        __syncthreads();
        if (tid < 32) { const int c = lcnt[tid]; lbase[tid] = c > 0 ? atomicAdd(&CNT[tid], c) : 0; }
        __syncthreads();
        if (tid < 64) { const int a = m0 * 4 + tid; const int e = sel_e[tid];
            ((int*)(ws + WS_TOPI))[a] = e; ((float*)(ws + WS_GATE))[a] = sel_g[tid]; ((int*)(ws + WS_POS))[a] = lbase[e] + lrank[tid]; }
        __syncthreads();
    }
}

__device__ __forceinline__ void compute_pstart(const Params& p, int* ps) {
    if (threadIdx.x == 0) { const int* CNT = (const int*)(p.ws + WS_CTL) + CW_CNT; int run = 0;
        for (int e = 0; e < NE; ++e) { ps[e] = run; const int c = __hip_atomic_load(&CNT[e], __ATOMIC_RELAXED, __HIP_MEMORY_SCOPE_AGENT); run += (c + 127) & ~127; }
        ps[NE] = run; }
    __syncthreads();
}

__device__ void phase_slots(const Params& p, unsigned char* lds) {
    const int tid = threadIdx.x;
    int* ps = (int*)(lds + LDS_BYTES - 256);
    compute_pstart(p, ps);
    unsigned char* ws = p.ws;
    const int* TOPI = (const int*)(ws + WS_TOPI); const int* POS = (const int*)(ws + WS_POS);
    int* SLOT = (int*)(ws + WS_SLOT); int* TOK = (int*)(ws + WS_TOK);
    for (int a = blockIdx.x * NTHREADS + tid; a < T * 4; a += gridDim.x * NTHREADS) { const int slot = ps[TOPI[a]] + POS[a]; SLOT[a] = slot; TOK[slot] = a >> 2; }
    if (blockIdx.x == 0) { const int* CNT = (const int*)(ws + WS_CTL) + CW_CNT;
        for (int e = 0; e < NE; ++e) { const int c = __hip_atomic_load(&CNT[e], __ATOMIC_RELAXED, __HIP_MEMORY_SCOPE_AGENT); const int pe = ps[e + 1] - ps[e];
            for (int i = c + tid; i < pe; i += NTHREADS) TOK[ps[e] + i] = 0; } }
    __syncthreads();
}

__device__ void phase_moe_up(const Params& p, unsigned char* lds) {
    const int tid = threadIdx.x, lane = tid & 63, wid = tid >> 6, wr = wid >> 1, wc = wid & 1, fr = lane & 15, fq = lane >> 4;
    unsigned char* ws = p.ws;
    int* ps = (int*)(lds + LDS_BYTES - 256);
    compute_pstart(p, ps);
    const int ntile = ps[NE] >> 7;
    const bf16_t* H = (const bf16_t*)(ws + WS_H); const bf16_t* W = (const bf16_t*)(ws + WS_WGUT); const int* TOK = (const int*)(ws + WS_TOK);
    bf16_t* ACT = (bf16_t*)(ws + WS_ACT);
    for (int id = blockIdx.x; id < ntile * 16; id += gridDim.x) {
        const int rt = id >> 4, nt = id & 15, slot0 = rt * 128;
        int e = 0;
        for (int q = 1; q < NE; ++q) e = (ps[q] <= slot0) ? q : e;
        const int r = tid >> 2, ch = (tid & 3) * 8;
        const int tk0 = TOK[slot0 + r], tk1 = TOK[slot0 + r + 64];
        const bf16_t* Bt = W + ((size_t)e * 2048 + nt * 128) * D;
        f32x4 acc[4][4];
#pragma unroll
        for (int m = 0; m < 4; ++m)
#pragma unroll
            for (int n = 0; n < 4; ++n) acc[m][n] = (f32x4){0.f, 0.f, 0.f, 0.f};
        gemm_tile_128(H + (size_t)tk0 * D + ch, H + (size_t)tk1 * D + ch, Bt + (size_t)r * D + ch, Bt + (size_t)(r + 64) * D + ch, D, lds, acc);
        const float* bgu = p.b_gate_up + (size_t)e * 2048;
#pragma unroll
        for (int g2 = 0; g2 < 2; ++g2) { const int jcol = nt * 64 + wc * 32 + g2 * 16 + fr;
            const float bg = bgu[2 * jcol], bl = bgu[2 * jcol + 1];
#pragma unroll
            for (int m = 0; m < 4; ++m)
#pragma unroll
                for (int j = 0; j < 4; ++j) { const int row = slot0 + wr * 64 + m * 16 + fq * 4 + j;
                    float gl = acc[m][2 * g2][j] + bg, ln = acc[m][2 * g2 + 1][j] + bl;
                    gl = fminf(gl, 7.f); ln = fminf(fmaxf(ln, -7.f), 7.f);
                    const float a = gl / (1.f + fexp(-1.702f * gl)) * (ln + 1.f);
                    ACT[(size_t)row * DFF + jcol] = (bf16_t)f2bf(a); } }
    }
    __syncthreads();
}

__device__ void phase_moe_down(const Params& p, unsigned char* lds) {
    const int tid = threadIdx.x, lane = tid & 63, wid = tid >> 6, wr = wid >> 1, wc = wid & 1, fr = lane & 15, fq = lane >> 4;
    unsigned char* ws = p.ws;
    int* ps = (int*)(lds + LDS_BYTES - 256);
    compute_pstart(p, ps);
    const int ntile = ps[NE] >> 7;
    const bf16_t* ACT = (const bf16_t*)(ws + WS_ACT); const bf16_t* W = (const bf16_t*)(ws + WS_WDT);
    bf16_t* YE = (bf16_t*)(ws + WS_YE);
    for (int id = blockIdx.x; id < ntile * 8; id += gridDim.x) {
        const int rt = id >> 3, nt = id & 7, slot0 = rt * 128;
        int e = 0;
        for (int q = 1; q < NE; ++q) e = (ps[q] <= slot0) ? q : e;
        const int r = tid >> 2, ch = (tid & 3) * 8;
        const bf16_t* Bt = W + ((size_t)e * D + nt * 128) * DFF;
        f32x4 acc[4][4];
#pragma unroll
        for (int m = 0; m < 4; ++m)
#pragma unroll
            for (int n = 0; n < 4; ++n) acc[m][n] = (f32x4){0.f, 0.f, 0.f, 0.f};
        gemm_tile_128(ACT + (size_t)(slot0 + r) * DFF + ch, ACT + (size_t)(slot0 + r + 64) * DFF + ch, Bt + (size_t)r * DFF + ch, Bt + (size_t)(r + 64) * DFF + ch, DFF, lds, acc);
        const float* bd = p.b_down + (size_t)e * D;
#pragma unroll
        for (int n = 0; n < 4; ++n) { const int col = nt * 128 + wc * 64 + n * 16 + fr; const float bv = bd[col];
#pragma unroll
            for (int m = 0; m < 4; ++m)
#pragma unroll
                for (int j = 0; j < 4; ++j) YE[(size_t)(slot0 + wr * 64 + m * 16 + fq * 4 + j) * D + col] = (bf16_t)f2bf(acc[m][n][j] + bv); }
    }
    __syncthreads();
}

__device__ void phase_combine(const Params& p) {
    const int tid = threadIdx.x, lane = tid & 63, wave = tid >> 6;
    unsigned char* ws = p.ws;
    const float* mod = (const float*)(ws + WS_MOD);
    const bf16_t* YE = (const bf16_t*)(ws + WS_YE);
    const int* SLOT = (const int*)(ws + WS_SLOT); const float* GATE = (const float*)(ws + WS_GATE);
    for (int m = blockIdx.x * 4 + wave; m < T; m += gridDim.x * 4) {
        const int b = m >> 13;
        float4 y[4];
#pragma unroll
        for (int j = 0; j < 4; ++j) y[j] = make_float4(0.f, 0.f, 0.f, 0.f);
#pragma unroll
        for (int k = 0; k < 4; ++k) { const int slot = SLOT[m * 4 + k]; const float gk = GATE[m * 4 + k];
            const uint2* yr = (const uint2*)(YE + (size_t)slot * D) + lane;
#pragma unroll
            for (int j = 0; j < 4; ++j) { const uint2 u = yr[64 * j];
                y[j].x += gk * bf2f((unsigned short)(u.x & 0xffff)); y[j].y += gk * bf2f((unsigned short)(u.x >> 16));
                y[j].z += gk * bf2f((unsigned short)(u.y & 0xffff)); y[j].w += gk * bf2f((unsigned short)(u.y >> 16)); } }
        float ss = 0.f;
#pragma unroll
        for (int j = 0; j < 4; ++j) ss += y[j].x * y[j].x + y[j].y * y[j].y + y[j].z * y[j].z + y[j].w * y[j].w;
        const float rstd = rsqrtf(wave_sum(ss) * (1.f / D) + EPS);
#pragma unroll
        for (int j = 0; j < 4; ++j) { const int c = 4 * lane + 256 * j;
            float4* op = (float4*)(p.out + (size_t)m * D + c);
            const float4 x1 = *op, g = *(const float4*)(p.g_post_ffn + c), gt = *(const float4*)(mod + b * 6144 + 5120 + c);
            float4 o;
            o.x = x1.x + gt.x * (y[j].x * rstd * g.x); o.y = x1.y + gt.y * (y[j].y * rstd * g.y);
            o.z = x1.z + gt.z * (y[j].z * rstd * g.z); o.w = x1.w + gt.w * (y[j].w * rstd * g.w);
            *op = o; }
    }
}

__global__ void __launch_bounds__(NTHREADS, 2) fwd_kernel(Params p) {
    __shared__ __attribute__((aligned(16))) unsigned char lds[LDS_BYTES];
    cg::grid_group grid = cg::this_grid();
    const int lo = p.ph_lo, hi = p.ph_hi;
#define PHASE(k, call) if (lo <= (k) && (k) < hi) { call; if ((k) + 1 < hi) grid.sync(); }
    PHASE(0, phase_prep(p, lds))
    PHASE(1, phase_prenorm(p))
    PHASE(2, phase_gemm_in(p, lds))
    PHASE(3, phase_attn(p))
    PHASE(4, phase_gla1(p, lds))
    PHASE(5, phase_gla2(p))
    PHASE(6, phase_gla3(p, lds))
    PHASE(7, phase_gemm_out(p, lds))
    PHASE(8, phase_postmix(p, lds))
    PHASE(9, phase_slots(p, lds))
    PHASE(10, phase_moe_up(p, lds))
    PHASE(11, phase_moe_down(p, lds))
    PHASE(12, phase_combine(p))
#undef PHASE
}

extern "C" void kernel_launch(void* const* d_in, const int* in_sizes, int n_in, void* d_out, int out_size, void* d_ws, size_t ws_size, hipStream_t stream) {
    static int grid_blocks = 0;
    if (grid_blocks == 0) {
        if (n_in != 19 || out_size != T * D || ws_size < WS_END) { fprintf(stderr, "kernel_launch: unexpected shapes (n_in %d out %d ws %zu need %zu)\n", n_in, out_size, ws_size, (size_t)WS_END); grid_blocks = -1; return; }
        int dev = 0, cus = 0, per_cu = 0;
        hipGetDevice(&dev);
        hipDeviceGetAttribute(&cus, hipDeviceAttributeMultiprocessorCount, dev);
        hipOccupancyMaxActiveBlocksPerMultiprocessor(&per_cu, fwd_kernel, NTHREADS, 0);
        if (per_cu < 1) per_cu = 1;
        if (per_cu > 2) per_cu = 2;
        grid_blocks = cus * per_cu;
    }
    if (grid_blocks < 0) return;
    hipMemsetAsync((char*)d_ws + WS_CTL, 0, CTL_BYTES, stream);
    Params p{};
    p.x = (const float*)d_in[0]; p.c = (const float*)d_in[1]; p.w_mod = (const float*)d_in[2]; p.b_mod = (const float*)d_in[3];
    p.g_pre_mix = (const float*)d_in[4]; p.w_in = (const float*)d_in[5]; p.w_gate_lr = (const float*)d_in[6]; p.b_gate = (const float*)d_in[7];
    p.g_gla = (const float*)d_in[8]; p.w_out = (const float*)d_in[9]; p.g_post_mix = (const float*)d_in[10]; p.g_pre_ffn = (const float*)d_in[11];
    p.router_w = (const float*)d_in[12]; p.router_b = (const float*)d_in[13]; p.w_gate_up = (const float*)d_in[14]; p.b_gate_up = (const float*)d_in[15];
    p.w_down = (const float*)d_in[16]; p.b_down = (const float*)d_in[17]; p.g_post_ffn = (const float*)d_in[18];
    p.out = (float*)d_out; p.ws = (unsigned char*)d_ws;
    for (int d = 0; d < 32; ++d) p.inv_freq[d] = powf(10000.0f, -(float)d / 32.0f);
#if ONE_LAUNCH
    p.ph_lo = 0; p.ph_hi = NPHASE;
    void* args[] = {&p};
    hipError_t e = hipLaunchCooperativeKernel((void*)fwd_kernel, dim3(grid_blocks), dim3(NTHREADS), args, 0, stream);
    if (e != hipSuccess) fprintf(stderr, "cooperative launch failed: %s (grid %d)\n", hipGetErrorString(e), grid_blocks);
#else
    for (int k = 0; k < NPHASE; ++k) { p.ph_lo = k; p.ph_hi = k + 1; hipLaunchKernelGGL(fwd_kernel, dim3(grid_blocks), dim3(NTHREADS), 0, stream, p); }
#endif
}
```

```cpp
#include <hip/hip_runtime.h>
#include <cstdio>
#include <cstdint>
#include <cmath>

#ifndef ONE_LAUNCH
#define ONE_LAUNCH 1
#endif

typedef unsigned short bf16_t;
typedef short bf16x8 __attribute__((ext_vector_type(8)));
typedef float f32x4 __attribute__((ext_vector_type(4)));
typedef unsigned u32x4 __attribute__((ext_vector_type(4)));
#define LAS __attribute__((address_space(3)))

constexpr int T = 16384, D = 1024, S = 8192;
constexpr int DIN = 3088, DINP = 3104;
constexpr int NE = 32, DFF = 1024;
constexpr int PMAX = 65536 + NE * 256;
constexpr int NTHREADS = 512, NW = 8;
constexpr int LDS_STAGE = 131072;
constexpr int LDS_PS = LDS_STAGE;
constexpr int LDS_BARW = LDS_STAGE + 256;
constexpr int LDS_CNT = LDS_STAGE + 512;
constexpr int LDS_TOKB = LDS_STAGE + 1024;
constexpr int LDS_BYTES = LDS_STAGE + 4096;
constexpr int NPHASE = 11;
constexpr float EPS = 1e-6f;
constexpr float LOG2E = 1.4426950408889634f;

constexpr size_t al(size_t x) { return (x + 255) & ~(size_t)255; }
constexpr size_t WS_CTL   = 0;
constexpr size_t CTL_BYTES = 65536;
constexpr size_t WS_MOD   = WS_CTL + CTL_BYTES;
constexpr size_t WS_ROPE  = al(WS_MOD + 2 * 6144 * 4);
constexpr size_t WS_WINT  = al(WS_ROPE + (size_t)S * 32 * 2 * 4);
constexpr size_t WS_WOUTT = al(WS_WINT + (size_t)DINP * D * 2);
constexpr size_t WS_WGUT  = al(WS_WOUTT + (size_t)D * D * 2);
constexpr size_t WS_WDT   = al(WS_WGUT + (size_t)NE * 2048 * D * 2);
constexpr size_t WS_H     = al(WS_WDT + (size_t)NE * D * DFF * 2);
constexpr size_t WS_QA    = al(WS_H + (size_t)T * D * 2);
constexpr size_t WS_KA    = al(WS_QA + (size_t)T * 512 * 2);
constexpr size_t WS_VA    = al(WS_KA + (size_t)T * 512 * 2);
constexpr size_t WS_VB    = al(WS_VA + (size_t)T * 512 * 2);
constexpr size_t WS_QG    = al(WS_VB + (size_t)T * 512 * 2);
constexpr size_t WS_KG    = al(WS_QG + (size_t)T * 256 * 2);
constexpr size_t WS_VG    = al(WS_KG + (size_t)T * 256 * 2);
constexpr size_t WS_RG    = al(WS_VG + (size_t)T * 512 * 2);
constexpr size_t WS_GLR   = al(WS_RG + (size_t)T * 512 * 2);
constexpr size_t WS_UT    = al(WS_GLR + (size_t)T * 16 * 4);
constexpr size_t WS_AG    = al(WS_UT + (size_t)1024 * 128 * 64 * 4);
constexpr size_t WS_SPT   = al(WS_AG + (size_t)1024 * 64 * 4);
constexpr size_t WS_CAT   = al(WS_SPT + (size_t)1024 * 128 * 64 * 2);
constexpr size_t WS_TOPI  = al(WS_CAT + (size_t)T * D * 2);
constexpr size_t WS_GATE  = al(WS_TOPI + (size_t)T * 4 * 4);
constexpr size_t WS_POS   = al(WS_GATE + (size_t)T * 4 * 4);
constexpr size_t WS_SLOT  = al(WS_POS + (size_t)T * 4 * 4);
constexpr size_t WS_TOK   = al(WS_SLOT + (size_t)T * 4 * 4);
constexpr size_t WS_ACT   = al(WS_TOK + (size_t)NE * T * 4);
constexpr size_t WS_YMIX  = WS_ACT;
constexpr size_t WS_X1    = WS_UT;
constexpr size_t WS_YE    = al(WS_ACT + (size_t)PMAX * DFF * 2);
constexpr size_t WS_IDT   = al(WS_YE + (size_t)PMAX * D * 2);
constexpr size_t WS_END   = al(WS_IDT + (size_t)PMAX * 4);
static_assert((size_t)T * D * 4 <= (size_t)PMAX * DFF * 2, "YMIX alias fits in ACT");
static_assert(WS_X1 + (size_t)T * D * 2 <= WS_AG, "X1 alias fits in UT");
constexpr int CW_CNT = 4096;
constexpr int CW_UPCNT = 4352;
constexpr int CW_MODCNT = 4224;

struct Params {
    const float *x, *c, *w_mod, *b_mod, *g_pre_mix, *w_in, *w_gate_lr, *b_gate, *g_gla, *w_out, *g_post_mix, *g_pre_ffn,
                *router_w, *router_b, *w_gate_up, *b_gate_up, *w_down, *b_down, *g_post_ffn;
    float* out; unsigned char* ws;
    int ph_lo, ph_hi;
    float inv_freq[32];
};

__device__ __forceinline__ unsigned f2bf(float f) { unsigned u = __builtin_bit_cast(unsigned, f); return (u + 0x7fffu + ((u >> 16) & 1u)) >> 16; }
typedef float f32x2_t __attribute__((ext_vector_type(2))); typedef __bf16 bf16x2_t __attribute__((ext_vector_type(2)));
__device__ __forceinline__ unsigned pk2(float lo, float hi) { f32x2_t v = {lo, hi}; bf16x2_t b = __builtin_convertvector(v, bf16x2_t); return __builtin_bit_cast(unsigned, b); }
__device__ __forceinline__ float bf2f(unsigned short b) { return __builtin_bit_cast(float, (unsigned)b << 16); }
__device__ __forceinline__ float4 ntload4(const float4* p) { const f32x4 t = __builtin_nontemporal_load((const f32x4*)p); return make_float4(t[0], t[1], t[2], t[3]); }
__device__ __forceinline__ uint2 ntload2(const uint2* p) { typedef unsigned u32x2 __attribute__((ext_vector_type(2))); const u32x2 t = __builtin_nontemporal_load((const u32x2*)p); return make_uint2(t[0], t[1]); }
__device__ __forceinline__ void ntstore4(float4* p, float4 v) { const f32x4 t = {v.x, v.y, v.z, v.w}; __builtin_nontemporal_store(t, (f32x4*)p); }
__device__ __forceinline__ void ntstore2(uint2* p, uint2 v) { typedef unsigned u32x2 __attribute__((ext_vector_type(2))); const u32x2 t = {v.x, v.y}; __builtin_nontemporal_store(t, (u32x2*)p); }
__device__ __forceinline__ void ntstore4u(uint4* p, uint4 v) { const u32x4 t = {v.x, v.y, v.z, v.w}; __builtin_nontemporal_store(t, (u32x4*)p); }
__device__ __forceinline__ float wave_sum(float v) {
#pragma unroll
    for (int o = 1; o < 64; o <<= 1) v += __shfl_xor(v, o);
    return v;
}
__device__ __forceinline__ float fexp2(float x) { return __builtin_amdgcn_exp2f(x); }
__device__ __forceinline__ float fexp(float x) { return __builtin_amdgcn_exp2f(x * LOG2E); }
__device__ __forceinline__ float flog(float x) { return __builtin_amdgcn_logf(x) * 0.6931471805599453f; }
__device__ __forceinline__ float fsilu(float x) { return x / (1.f + fexp(-x)); }

#define GAS __attribute__((address_space(1)))
namespace pg8 {
constexpr int BM = 256, BK = 64, HALF = 128, HTB = HALF * BK * 2, NXCD = 8, WGM = 8;
__host__ __device__ __forceinline__ int lds_byte(int r, int c) { const int st = (r >> 4) * 2 + (c >> 5), rr = r & 15, cc = c & 31, ob = rr * 64 + cc * 2; return st * 1024 + (ob ^ (((ob >> 9) & 1) << 5)); }
__host__ __device__ __forceinline__ void stage_rc(int b, int& R, int& C) { const int st = b / 1024, sb = b % 1024, swz = sb ^ (((sb >> 9) & 1) << 5); R = (st >> 1) * 16 + swz / 64; C = (st & 1) * 32 + (swz % 64) / 2; }
__host__ __device__ __forceinline__ int perm32(int rho) { const int n = rho >> 4, i = rho & 15; return 8 * (i >> 2) + 4 * n + (i & 3); }

struct Unit { const char* A; const char* B; unsigned ao[2][2]; int row0, pn, e, nvalid, tb0; };

__device__ __forceinline__ int xcd_remap(int wgid, int nwg) { const int q = nwg / NXCD, r = nwg % NXCD, xcd = wgid % NXCD, off = wgid / NXCD; return (xcd < r ? xcd * (q + 1) : r * (q + 1) + (xcd - r) * q) + off; }
__device__ __forceinline__ const char* uptr(const char* p) {
    const unsigned long long v = (unsigned long long)p;
    const unsigned lo = __builtin_amdgcn_readfirstlane((unsigned)v), hi = __builtin_amdgcn_readfirstlane((unsigned)(v >> 32));
    return (const char*)(((unsigned long long)hi << 32) | lo);
}

template <class Epi, class Sched>
__device__ __forceinline__ void gemm_phase(LAS unsigned char* lds, const int K, const Sched& S, const Epi& E) {
    constexpr bool GATHER = Sched::GATHER;
    const int tid = threadIdx.x, wid = __builtin_amdgcn_readfirstlane(tid >> 6), lane = tid & 63, wr = wid >> 2, wc = wid & 3, fr = lane & 15, fq = lane >> 4;
    const int nt = K / BK;
    unsigned voffA[2], voffB[2];
#pragma unroll
    for (int i = 0; i < 2; ++i) { int R, C; stage_rc(tid * 16 + i * 8192, R, C); const int Rb = Epi::PERM ? ((R & ~31) + perm32(R & 31)) : R;
        voffA[i] = (unsigned)(R * K + C) * 2u; voffB[i] = (unsigned)(Rb * K + C) * 2u; }
    const size_t kstep = (size_t)(BK * 2);
    const size_t hstep = (size_t)HALF * K * 2;
    const unsigned ldsw = (unsigned)wid * 1024u;
    const int aoff = lds_byte(wr * 64 + fr, fq * 8), boff = lds_byte(wc * 32 + fr, fq * 8);
#define PG8_SA(b, h) (((b) * 2 + (h)) * HTB)
#define PG8_SB(b, h) ((4 + (b) * 2 + (h)) * HTB)
#define PG8_STAGE(bufoff, gbase, voff) do { _Pragma("unroll") for (int _i = 0; _i < 2; ++_i) \
        __builtin_amdgcn_global_load_lds((const unsigned*)((const char*)(gbase) + (voff)[_i]), (LAS unsigned*)(lds + (bufoff) + ldsw + _i * 8192), 16, 0, 0); } while (0)
#define PG8_STAGE_A(bufoff, ap, ao, h) do { if constexpr (GATHER) PG8_STAGE(bufoff, ap, (ao)[h]); else PG8_STAGE(bufoff, (ap) + (size_t)(h) * hstep, voffA); } while (0)
#define PG8_LDA(dst, b, h) do { _Pragma("unroll") for (int m = 0; m < 4; ++m) _Pragma("unroll") for (int k = 0; k < 2; ++k) dst[m][k] = *(const LAS bf16x8*)(lds + PG8_SA(b, h) + aoff + m * 2048 + k * 1024); } while (0)
#define PG8_LDB(dst, b, h) do { _Pragma("unroll") for (int n = 0; n < 2; ++n) _Pragma("unroll") for (int k = 0; k < 2; ++k) dst[n][k] = *(const LAS bf16x8*)(lds + PG8_SB(b, h) + boff + n * 2048 + k * 1024); } while (0)
#define PG8_MMA(ai, bj, At, Bt) do { __builtin_amdgcn_s_setprio(1); _Pragma("unroll") for (int m = 0; m < 4; ++m) _Pragma("unroll") for (int n = 0; n < 2; ++n) _Pragma("unroll") for (int k = 0; k < 2; ++k) \
        acc[ai][bj][m][n] = __builtin_amdgcn_mfma_f32_16x16x32_bf16(Bt[n][k], At[m][k], acc[ai][bj][m][n], 0, 0, 0); __builtin_amdgcn_s_setprio(0); } while (0)
#define PG8_UCOPY(d, s_) do { (d).A = (s_).A; (d).B = (s_).B; (d).row0 = (s_).row0; (d).pn = (s_).pn; (d).e = (s_).e; (d).nvalid = (s_).nvalid; (d).tb0 = (s_).tb0; } while (0)
#define PG8_WAIT_V(n) asm volatile("s_waitcnt vmcnt(" #n ")" ::: "memory")
#define PG8_WAIT_L(n) asm volatile("s_waitcnt lgkmcnt(" #n ")" ::: "memory")
#define PG8_BAR __builtin_amdgcn_s_barrier()
#define PG8_SCHED __builtin_amdgcn_sched_barrier(0)
    Unit cur, nxt; int ui = 0;
    int pend = -1;
    if (!S.next(0, cur)) return;
    if constexpr (GATHER) S.first_rows(cur);
    f32x4 acc[2][2][4][2];
#pragma unroll
    for (int a = 0; a < 2; ++a)
#pragma unroll
        for (int b = 0; b < 2; ++b)
#pragma unroll
            for (int m = 0; m < 4; ++m)
#pragma unroll
                for (int n = 0; n < 2; ++n) acc[a][b][m][n] = (f32x4){0.f, 0.f, 0.f, 0.f};
    bf16x8 At[4][2], B0[2][2], B1[2][2];
#ifndef PG8_SP2
#define PG8_SP2 1
#endif
#if PG8_SP2
    PG8_STAGE(PG8_SB(0, 0), cur.B, voffB); PG8_STAGE(PG8_SB(0, 1), cur.B + hstep, voffB); PG8_STAGE_A(PG8_SA(0, 0), cur.A, cur.ao, 0); PG8_STAGE_A(PG8_SA(0, 1), cur.A, cur.ao, 1);
    if (wr == 1) PG8_BAR;
    PG8_WAIT_V(2); PG8_BAR;
#else
    PG8_STAGE(PG8_SB(0, 0), cur.B, voffB); PG8_STAGE_A(PG8_SA(0, 0), cur.A, cur.ao, 0); PG8_STAGE(PG8_SB(0, 1), cur.B + hstep, voffB); PG8_STAGE_A(PG8_SA(0, 1), cur.A, cur.ao, 1);
    if (wr == 1) PG8_BAR;
    PG8_WAIT_V(4); PG8_BAR;
#endif
    PG8_STAGE(PG8_SB(1, 0), cur.B + kstep, voffB); PG8_STAGE_A(PG8_SA(1, 0), cur.A + kstep, cur.ao, 0); PG8_STAGE(PG8_SB(1, 1), cur.B + hstep + kstep, voffB);
    PG8_WAIT_V(6); PG8_BAR;
    for (;;) {
        const bool has_next = S.next(ui + 1, nxt);
        if constexpr (GATHER) { if (has_next && wid < 4) S.prefetch_rows(nxt, (LAS unsigned*)(lds + LDS_TOKB + ((ui + 1) & 1) * 1024 + wid * 256), wid, lane); }
        if constexpr (Sched::HOOKS) { if (has_next) S.poll(nxt, (LAS unsigned*)(lds + LDS_BARW + 32 + wid * 4), lane); }
        if (!has_next) { PG8_UCOPY(nxt, cur); }
        for (int t = 0; t < nt; t += 2) {
            const bool last = (t == nt - 2);
            if constexpr (Sched::HOOKS) {
                if (t == 2 && pend >= 0) { S.publish(pend, lane); pend = -1; }
                if (last && has_next) S.a_ready(nxt, (const LAS unsigned*)(lds + LDS_BARW + 32 + wid * 4));
            }
            const char* a1 = cur.A + (size_t)(t + 1) * kstep;
            const char* a2 = last ? nxt.A : cur.A + (size_t)(t + 2) * kstep; const char* b2 = last ? nxt.B : cur.B + (size_t)(t + 2) * kstep;
            const char* a3 = a2 + kstep; const char* b3 = b2 + kstep;
            unsigned o2[2][2];
            if constexpr (GATHER) {
                const LAS int* tb = (const LAS int*)(lds + LDS_TOKB + ((ui + 1) & 1) * 1024);
#pragma unroll
                for (int q = 0; q < 2; ++q) { int R, C; stage_rc(tid * 16 + q * 8192, R, C);
#pragma unroll
                    for (int h = 0; h < 2; ++h) { const int i = h * HALF + R; const int tk = i < nxt.nvalid ? tb[i] : 0; o2[h][q] = (last && has_next) ? (unsigned)(tk * K + C) * 2u : cur.ao[h][q]; } }
            }
#if !PG8_SP2
            PG8_LDB(B0, 0, 0); PG8_SCHED; PG8_LDA(At, 0, 0); PG8_STAGE_A(PG8_SA(1, 1), a1, cur.ao, 1);
            PG8_WAIT_L(8); PG8_BAR; PG8_WAIT_L(0); PG8_MMA(0, 0, At, B0); PG8_BAR; PG8_SCHED;
            PG8_LDB(B1, 0, 1); PG8_STAGE(PG8_SB(0, 0), b2, voffB);
            PG8_BAR; PG8_WAIT_L(0); PG8_MMA(0, 1, At, B1); PG8_BAR;
            PG8_LDA(At, 0, 1); PG8_STAGE_A(PG8_SA(0, 0), a2, o2, 0);
            PG8_BAR; PG8_WAIT_L(0); PG8_MMA(1, 0, At, B0); PG8_BAR; PG8_SCHED;
            PG8_STAGE(PG8_SB(0, 1), b2 + hstep, voffB);
            PG8_WAIT_V(6); PG8_BAR; PG8_MMA(1, 1, At, B1); PG8_BAR;
            PG8_LDB(B0, 1, 0); PG8_SCHED; PG8_LDA(At, 1, 0); PG8_STAGE_A(PG8_SA(0, 1), a2, o2, 1);
            PG8_WAIT_L(8); PG8_BAR; PG8_WAIT_L(0); PG8_MMA(0, 0, At, B0); PG8_BAR; PG8_SCHED;
            PG8_LDB(B1, 1, 1); PG8_STAGE(PG8_SB(1, 0), b3, voffB);
            PG8_BAR; PG8_WAIT_L(0); PG8_MMA(0, 1, At, B1); PG8_BAR;
            PG8_LDA(At, 1, 1); PG8_STAGE_A(PG8_SA(1, 0), a3, o2, 0);
            PG8_BAR; PG8_WAIT_L(0); PG8_MMA(1, 0, At, B0); PG8_BAR; PG8_SCHED;
            PG8_STAGE(PG8_SB(1, 1), b3 + hstep, voffB);
            PG8_WAIT_V(6); PG8_BAR; PG8_MMA(1, 1, At, B1); PG8_BAR;
#else
            PG8_LDB(B0, 0, 0); PG8_LDB(B1, 0, 1); PG8_SCHED; PG8_LDA(At, 0, 0); PG8_STAGE_A(PG8_SA(1, 1), a1, cur.ao, 1);
            PG8_WAIT_V(8); PG8_WAIT_L(0); PG8_BAR; PG8_MMA(0, 0, At, B0); PG8_MMA(0, 1, At, B1); PG8_BAR; PG8_SCHED;
            PG8_LDA(At, 0, 1); PG8_STAGE(PG8_SB(0, 0), b2, voffB); PG8_STAGE(PG8_SB(0, 1), b2 + hstep, voffB); PG8_STAGE_A(PG8_SA(0, 0), a2, o2, 0);
            PG8_WAIT_V(8); PG8_WAIT_L(0); PG8_BAR; PG8_MMA(1, 0, At, B0); PG8_MMA(1, 1, At, B1); PG8_BAR; PG8_SCHED;
            PG8_LDB(B0, 1, 0); PG8_LDB(B1, 1, 1); PG8_SCHED; PG8_LDA(At, 1, 0); PG8_STAGE_A(PG8_SA(0, 1), a2, o2, 1);
            PG8_WAIT_V(8); PG8_WAIT_L(0); PG8_BAR; PG8_MMA(0, 0, At, B0); PG8_MMA(0, 1, At, B1); PG8_BAR; PG8_SCHED;
            PG8_LDA(At, 1, 1); PG8_STAGE(PG8_SB(1, 0), b3, voffB); PG8_STAGE(PG8_SB(1, 1), b3 + hstep, voffB); PG8_STAGE_A(PG8_SA(1, 0), a3, o2, 0);
            PG8_WAIT_V(8); PG8_WAIT_L(0); PG8_BAR; PG8_MMA(1, 0, At, B0); PG8_MMA(1, 1, At, B1); PG8_BAR; PG8_SCHED;
#endif
        }
        if (wr == 0) PG8_BAR;
        E(acc, cur, wr, wc, fr, fq);
        if constexpr (Sched::HOOKS) pend = S.pub_tile(cur);
        if (!has_next) break;
#pragma unroll
        for (int a = 0; a < 2; ++a)
#pragma unroll
            for (int b = 0; b < 2; ++b)
#pragma unroll
                for (int m = 0; m < 4; ++m)
#pragma unroll
                    for (int n = 0; n < 2; ++n) acc[a][b][m][n] = (f32x4){0.f, 0.f, 0.f, 0.f};
        PG8_UCOPY(cur, nxt); ++ui;
        if constexpr (GATHER) {
            const LAS int* tb = (const LAS int*)(lds + LDS_TOKB + (ui & 1) * 1024);
#pragma unroll
            for (int q = 0; q < 2; ++q) { int R, C; stage_rc(tid * 16 + q * 8192, R, C);
#pragma unroll
                for (int h = 0; h < 2; ++h) { const int i = h * HALF + R; const int tk = i < cur.nvalid ? tb[i] : 0; cur.ao[h][q] = (unsigned)(tk * K + C) * 2u; } }
        }
        if (wr == 1) PG8_BAR;
    }
    PG8_WAIT_V(0);
    if constexpr (Sched::HOOKS) { if (pend >= 0) S.publish(pend, lane); }
    PG8_BAR;
#undef PG8_SA
#undef PG8_SB
#undef PG8_STAGE
#undef PG8_STAGE_A
#undef PG8_LDA
#undef PG8_LDB
#undef PG8_MMA
#undef PG8_WAIT_V
#undef PG8_UCOPY
#undef PG8_WAIT_L
#undef PG8_BAR
#undef PG8_SCHED
}

struct DenseSched {
    static constexpr bool GATHER = false, HOOKS = false;
    const char* A; const char* Bt; int K, nM, nN, nwg, G, c;
    __device__ __forceinline__ void init(const void* A_, const void* Bt_, int M, int N, int K_) {
        A = uptr((const char*)A_); Bt = uptr((const char*)Bt_); K = K_; nM = M / BM; nN = N / BM; nwg = nM * nN; G = gridDim.x; c = blockIdx.x;
    }
    __device__ __forceinline__ bool next(int i, Unit& u) const {
        const long L = (long)i * G + c; if (L >= nwg) return false;
        const int wgid = xcd_remap((int)L, nwg);
        const int nig = WGM * nN, gid = wgid / nig, fm = gid * WGM, gsz = (nM - fm) < WGM ? (nM - fm) : WGM;
        const int pm = fm + ((wgid % nig) % gsz), pn = (wgid % nig) / gsz;
        u.A = A + (size_t)pm * BM * K * 2; u.B = Bt + (size_t)pn * BM * K * 2; u.row0 = pm * BM; u.pn = pn; u.e = 0; u.nvalid = BM; u.tb0 = 0;
        return true;
    }
};
template <bool GATHER_>
struct MoeSched {
    static constexpr bool GATHER = GATHER_, HOOKS = false;
    const char* A; const char* W; int K, nN, rows_per_e, nwg, G, c; const int* ps; const int* cn; const int* tok;
    __device__ __forceinline__ void init(const void* A_, const void* W_, int K_, int nN_, int rows_per_e_, const int* ps_, const int* tok_) {
        A = uptr((const char*)A_); W = uptr((const char*)W_); K = K_; nN = nN_; rows_per_e = rows_per_e_; ps = ps_; cn = ps_ + (LDS_CNT - LDS_PS) / 4; tok = (const int*)uptr((const char*)tok_); G = gridDim.x; c = blockIdx.x;
        nwg = __builtin_amdgcn_readfirstlane((ps[NE] >> 8) * nN);
    }
    __device__ __forceinline__ bool next(int i, Unit& u) const {
        const long L = (long)i * G + c; if (L >= nwg) return false;
        const int wgid = xcd_remap((int)L, nwg);
        const int rt = wgid / nN, pn = wgid % nN, slot0 = rt * BM;
        int e = 0;
        for (int q = 1; q < NE; ++q) e = (ps[q] <= slot0) ? q : e;
        e = __builtin_amdgcn_readfirstlane(e);
        u.B = W + ((size_t)e * rows_per_e + (size_t)pn * BM) * K * 2; u.row0 = slot0; u.pn = pn; u.e = e;
        const int pos0 = __builtin_amdgcn_readfirstlane(slot0 - ps[e]);
        u.nvalid = __builtin_amdgcn_readfirstlane(cn[e]) - pos0; u.tb0 = e * T + pos0;
        if constexpr (GATHER) u.A = A; else u.A = A + (size_t)slot0 * K * 2;
        return true;
    }
    __device__ __forceinline__ void first_rows(Unit& u) const {
#pragma unroll
        for (int q = 0; q < 2; ++q) { int R, C; stage_rc(threadIdx.x * 16 + q * 8192, R, C);
#pragma unroll
            for (int h = 0; h < 2; ++h) { const int i = h * HALF + R; const int tk = i < u.nvalid ? tok[u.tb0 + i] : 0; u.ao[h][q] = (unsigned)(tk * K + C) * 2u; } }
    }
    __device__ __forceinline__ void prefetch_rows(const Unit& u, LAS unsigned* dst, int wid, int lane) const {
        __builtin_amdgcn_global_load_lds((const unsigned*)(tok + u.tb0 + wid * 64 + lane), dst, 4, 0, 0);
    }
};
struct MoeSched2 {
    static constexpr bool GATHER = true, HOOKS = true;
    const char* ws; int K, nU, nwg, G, c, U0, U1, D0, D1; const int* ps; const int* cn; const int* tok; GAS int* upcnt;
    __device__ __forceinline__ void init(unsigned char* ws_, const int* ps_, int nloc, int rank, int base) {
        ws = uptr((const char*)ws_); K = D; ps = ps_; cn = ps_ + (LDS_CNT - LDS_PS) / 4; tok = (const int*)(ws + WS_TOK); upcnt = (GAS int*)(ws + WS_CTL) + CW_UPCNT;
        G = __builtin_amdgcn_readfirstlane(nloc); c = __builtin_amdgcn_readfirstlane(rank);
        const int rt = __builtin_amdgcn_readfirstlane(ps[NE] >> 8), gt = gridDim.x;
        U0 = __builtin_amdgcn_readfirstlane(rt * 8 * base / gt); U1 = __builtin_amdgcn_readfirstlane(rt * 8 * (base + nloc) / gt);
        D0 = __builtin_amdgcn_readfirstlane(rt * 4 * base / gt); D1 = __builtin_amdgcn_readfirstlane(rt * 4 * (base + nloc) / gt);
        nU = U1 - U0; nwg = nU + (D1 - D0);
    }
    __device__ __forceinline__ bool next(int i, Unit& u) const {
        const int L = i * G + c; if (L >= nwg) return false;
        const bool dn = L >= nU;
        const int wgid = dn ? D0 + L - nU : U0 + L;
        const int rt = dn ? wgid >> 2 : wgid >> 3, pn = dn ? wgid & 3 : wgid & 7, slot0 = rt * BM;
        const int sh = (8 * rt >= U0 && 8 * rt + 8 <= U1 && 4 * rt >= D0 && 4 * rt + 4 <= D1) ? 0 : 64;
        int e = 0;
        for (int q = 1; q < NE; ++q) e = (ps[q] <= slot0) ? q : e;
        e = __builtin_amdgcn_readfirstlane(e);
        u.row0 = slot0; u.pn = pn;
        const int pos0 = __builtin_amdgcn_readfirstlane(slot0 - ps[e]);
        if (dn) { u.B = ws + WS_WDT + ((size_t)e * 1024 + (size_t)pn * BM) * (size_t)(D * 2); u.A = ws + WS_ACT; u.e = e | 32 | sh; u.nvalid = BM; u.tb0 = (int)((WS_IDT - WS_TOK) / 4) + slot0; }
        else    { u.B = ws + WS_WGUT + ((size_t)e * 2048 + (size_t)pn * BM) * (size_t)(D * 2); u.A = ws + WS_H; u.e = e | sh; u.nvalid = __builtin_amdgcn_readfirstlane(cn[e]) - pos0; u.tb0 = e * T + pos0; }
        return true;
    }
    __device__ __forceinline__ void first_rows(Unit& u) const {
#pragma unroll
        for (int q = 0; q < 2; ++q) { int R, C; stage_rc(threadIdx.x * 16 + q * 8192, R, C);
#pragma unroll
            for (int h = 0; h < 2; ++h) { const int i = h * HALF + R; const int tk = i < u.nvalid ? tok[u.tb0 + i] : 0; u.ao[h][q] = (unsigned)(tk * K + C) * 2u; } }
    }
    __device__ __forceinline__ void prefetch_rows(const Unit& u, LAS unsigned* dst, int wid, int lane) const {
        __builtin_amdgcn_global_load_lds((const unsigned*)(tok + u.tb0 + wid * 64 + lane), dst, 4, 0, 0);
    }
    __device__ __forceinline__ void poll(const Unit& u, LAS unsigned* w, int lane) const {
        if ((u.e & 32) && lane == 0) __builtin_amdgcn_global_load_lds((const GAS unsigned*)(upcnt + (u.row0 >> 8)), w, 4, 0, 16  );
    }
    __device__ __forceinline__ void a_ready(const Unit& u, const LAS unsigned* w) const {
        if (u.e & 32) {
            const int rdy = __builtin_amdgcn_readfirstlane((int)*w);
            if (rdy < 64) { const GAS int* cp = upcnt + (u.row0 >> 8); int spins = 0;
                while (__hip_atomic_load(cp, __ATOMIC_RELAXED, __HIP_MEMORY_SCOPE_AGENT) < 64 && ++spins < (1 << 22)) __builtin_amdgcn_s_sleep(4); }
            if (u.e & 64) asm volatile("buffer_inv sc1" ::: "memory");
            else asm volatile("" ::: "memory");
        }
    }
    __device__ __forceinline__ int pub_tile(const Unit& u) const { return (u.e & 32) ? -1 : ((u.row0 >> 8) | ((u.e & 64) << 10)); }
    __device__ __forceinline__ void publish(int pt, int lane) const {
        if (pt & 0x10000) { __builtin_amdgcn_fence(__ATOMIC_RELEASE, "agent"); asm volatile("s_waitcnt vmcnt(0)" ::: "memory"); }
        if (lane == 0) __hip_atomic_fetch_add(upcnt + (pt & 0xffff), 1, __ATOMIC_RELAXED, __HIP_MEMORY_SCOPE_AGENT);
    }
};
}

__device__ __forceinline__ int win_row(int oc) {
    if (oc >= 1024) return oc;
    const int base = oc & ~511, o = oc & 511;
    return base + 32 * ((o >> 6) * 2 + ((o & 31) >> 4)) + 8 * ((o & 15) >> 2) + 4 * ((o >> 5) & 1) + (o & 3);
}
__device__ __forceinline__ int wgu_row(int oc) { const int jj = oc >> 1, il = oc & 1; return 32 * (jj >> 4) + 8 * ((jj & 15) >> 2) + 4 * il + (jj & 3); }

struct CvtItem { const float* W; bf16_t* WT; int ldw, nvalid, K, k0, n0, map; };
__device__ __forceinline__ void cvt_load(const CvtItem& it, int lane, float4 (&v)[8]) {
    const int col = it.n0 + (lane & 7) * 4;
    const float* src = it.W + (size_t)(it.k0 + (lane >> 3)) * it.ldw + col;
#pragma unroll
    for (int i = 0; i < 8; ++i) { const f32x4 t = (col < it.nvalid) ? __builtin_nontemporal_load((const f32x4*)(src + (size_t)(8 * i) * it.ldw)) : (f32x4){0.f, 0.f, 0.f, 0.f};
        v[i] = make_float4(t[0], t[1], t[2], t[3]); }
}
__device__ __forceinline__ void cvt_store(const CvtItem& it, int lane, const float4 (&v)[8], float* scr) {
    const int r8 = lane >> 3, c4 = (lane & 7) * 4;
#pragma unroll
    for (int i = 0; i < 8; ++i) { float* d = scr + (8 * i + r8) * 33 + c4; d[0] = v[i].x; d[1] = v[i].y; d[2] = v[i].z; d[3] = v[i].w; }
    asm volatile("s_waitcnt lgkmcnt(0)" ::: "memory");
    const int c = lane & 7;
#pragma unroll
    for (int j = 0; j < 4; ++j) { const int n = (lane >> 3) + 8 * j; const float* s = scr + (8 * c) * 33 + n;
        uint4 o; o.x = pk2(s[0 * 33], s[1 * 33]); o.y = pk2(s[2 * 33], s[3 * 33]); o.z = pk2(s[4 * 33], s[5 * 33]); o.w = pk2(s[6 * 33], s[7 * 33]);
        const int oc = it.n0 + n;
        const int orow = it.map == 1 ? win_row(oc) : (it.map == 2 ? wgu_row(oc) : oc);
        ntstore4u((uint4*)(it.WT + (size_t)orow * it.K + it.k0 + 8 * c), o); }
    asm volatile("s_waitcnt lgkmcnt(0)" ::: "memory");
}
__device__ void phase_prep(const Params& p, unsigned char* lds) {
    const int tid = threadIdx.x, lane = tid & 63, wave = tid >> 6;
    unsigned char* ws = p.ws;
    for (int i = blockIdx.x * NTHREADS + tid; i < PMAX; i += gridDim.x * NTHREADS) ((int*)(ws + WS_IDT))[i] = i;
    if ((int)blockIdx.x < 192) {
        float* sl = (float*)lds;
        float* red = sl + 2048;
        for (int i = tid; i < 2048; i += NTHREADS) sl[i] = fsilu(p.c[i]);
        __syncthreads();
        for (int it = blockIdx.x; it < 192; it += gridDim.x) {
            const int col = it * 32 + (tid & 31), kg = tid >> 5;
            float a0 = 0.f, a1 = 0.f;
#pragma unroll 8
            for (int kk = 0; kk < 64; ++kk) { const int k = kg * 64 + kk; const float w = __builtin_nontemporal_load(p.w_mod + (size_t)k * 6144 + col); a0 += sl[k] * w; a1 += sl[1024 + k] * w; }
            red[(kg * 32 + (tid & 31)) * 2 + 0] = a0; red[(kg * 32 + (tid & 31)) * 2 + 1] = a1;
            __syncthreads();
            if (tid < 64) { const int b = tid >> 5, cg_ = tid & 31; float s = 0.f;
#pragma unroll
                for (int g = 0; g < 16; ++g) s += red[(g * 32 + cg_) * 2 + b];
                const int cc = it * 32 + cg_;
                __hip_atomic_store((float*)(ws + WS_MOD) + b * 6144 + cc, s + p.b_mod[cc], __ATOMIC_RELAXED, __HIP_MEMORY_SCOPE_AGENT);
                asm volatile("s_waitcnt vmcnt(0)" ::: "memory"); }
            __syncthreads();
            if (tid == 0) __hip_atomic_fetch_add((unsigned*)(ws + WS_CTL) + CW_MODCNT, 1u, __ATOMIC_RELAXED, __HIP_MEMORY_SCOPE_AGENT);
        }
    }
    __syncthreads();
    {
        float2* rope = (float2*)(ws + WS_ROPE);
        for (int i = blockIdx.x * NTHREADS + tid; i < S * 32; i += gridDim.x * NTHREADS) {
            const int pos = i >> 5, d = i & 31;
            const float angf = (float)pos * p.inv_freq[d];
            const double ang = (double)angf;
            const double TWO_PI = 6.283185307179586476925286766559, HALF_PI = 1.5707963267948966192313216916398;
            const double n = __builtin_rint(ang / TWO_PI);
            const double rr = ang - n * TWO_PI;
            const double q = __builtin_rint(rr / HALF_PI);
            const double y = rr - q * HALF_PI;
            const double y2 = y * y;
            const double sy = y * (1.0 + y2 * (-1.0 / 6 + y2 * (1.0 / 120 + y2 * (-1.0 / 5040 + y2 * (1.0 / 362880 + y2 * (-1.0 / 39916800 + y2 * (1.0 / 6227020800.0)))))));
            const double cy = 1.0 + y2 * (-0.5 + y2 * (1.0 / 24 + y2 * (-1.0 / 720 + y2 * (1.0 / 40320 + y2 * (-1.0 / 3628800 + y2 * (1.0 / 479001600.0))))));
            const int qi = ((int)q) & 3;
            double cs, sn;
            if (qi == 0) { cs = cy; sn = sy; } else if (qi == 1) { cs = -sy; sn = cy; } else if (qi == 2) { cs = -cy; sn = -sy; } else { cs = sy; sn = -cy; }
            rope[i] = make_float2((float)cs, (float)sn);
        }
    }
    {
        float* scr = (float*)(lds + wave * 8448);
        const int gw = blockIdx.x * NW + wave, ngw = gridDim.x * NW;
        constexpr int I_IN = 16 * 97, I_OUT = 16 * 32, I_GU = 16 * 64, I_DN = 16 * 32;
        constexpr int NITEMS = I_IN + I_OUT + NE * I_GU + NE * I_DN;
        auto decode = [&](int r, CvtItem& it) {
            if (r < I_IN) { it.W = p.w_in; it.WT = (bf16_t*)(ws + WS_WINT); it.ldw = DIN; it.nvalid = DIN; it.K = D; it.k0 = (r / 97) * 64; it.n0 = (r % 97) * 32; it.map = 1; return; }
            r -= I_IN;
            if (r < I_OUT) { it.W = p.w_out; it.WT = (bf16_t*)(ws + WS_WOUTT); it.ldw = D; it.nvalid = D; it.K = D; it.k0 = (r / 32) * 64; it.n0 = (r % 32) * 32; it.map = 0; return; }
            r -= I_OUT;
            if (r < NE * I_GU) { const int e = r / I_GU, q = r % I_GU;
                it.W = p.w_gate_up + (size_t)e * D * 2048; it.WT = (bf16_t*)(ws + WS_WGUT) + (size_t)e * 2048 * D; it.ldw = 2048; it.nvalid = 2048; it.K = D; it.k0 = (q / 64) * 64; it.n0 = (q % 64) * 32; it.map = 2; return; }
            r -= NE * I_GU;
            { const int e = r / I_DN, q = r % I_DN;
                it.W = p.w_down + (size_t)e * DFF * D; it.WT = (bf16_t*)(ws + WS_WDT) + (size_t)e * D * DFF; it.ldw = D; it.nvalid = D; it.K = DFF; it.k0 = (q / 32) * 64; it.n0 = (q % 32) * 32; it.map = 0; }
        };
        if (gw < NITEMS) {
            CvtItem cur, nxt; float4 vc[8], vn[8];
            decode(gw, cur); cvt_load(cur, lane, vc);
            for (int r = gw; r < NITEMS; r += ngw) {
                const bool more = r + ngw < NITEMS;
                if (more) { decode(r + ngw, nxt); cvt_load(nxt, lane, vn); }
                cvt_store(cur, lane, vc, scr);
                if (more) { cur = nxt;
#pragma unroll
                    for (int i = 0; i < 8; ++i) vc[i] = vn[i]; }
            }
        }
    }
}

__device__ void phase_prenorm(const Params& p) {
    const int tid = threadIdx.x, lane = tid & 63, wave = tid >> 6;
    if (tid == 0) {
        unsigned* cnt = (unsigned*)(p.ws + WS_CTL) + CW_MODCNT; unsigned sp = 0;
        while (__hip_atomic_load(cnt, __ATOMIC_RELAXED, __HIP_MEMORY_SCOPE_AGENT) < 192u) { __builtin_amdgcn_s_sleep(2); if (++sp > (1u << 20)) break; }
        __builtin_amdgcn_fence(__ATOMIC_ACQUIRE, "agent");
        asm volatile("s_waitcnt vmcnt(0)" ::: "memory");
    }
    __syncthreads();
    const float* mod = (const float*)(p.ws + WS_MOD);
    bf16_t* H = (bf16_t*)(p.ws + WS_H);
    for (int m0 = (blockIdx.x * NW + wave) * 2; m0 < T; m0 += gridDim.x * NW * 2) {
        float4 v[2][4];
#pragma unroll
        for (int q = 0; q < 2; ++q) { const float4* xr = (const float4*)(p.x + (size_t)(m0 + q) * D) + lane;
#pragma unroll
            for (int j = 0; j < 4; ++j) v[q][j] = ntload4(xr + 64 * j); }
#pragma unroll
        for (int q = 0; q < 2; ++q) {
            const int m = m0 + q, b = m >> 13;
            float ss = 0.f;
#pragma unroll
            for (int j = 0; j < 4; ++j) ss += v[q][j].x * v[q][j].x + v[q][j].y * v[q][j].y + v[q][j].z * v[q][j].z + v[q][j].w * v[q][j].w;
            const float rstd = rsqrtf(wave_sum(ss) * (1.f / D) + EPS);
#pragma unroll
            for (int j = 0; j < 4; ++j) { const int c = 4 * lane + 256 * j;
                const float4 g = *(const float4*)(p.g_pre_mix + c), sh = *(const float4*)(mod + b * 6144 + c), sc = *(const float4*)(mod + b * 6144 + 1024 + c);
                const float h0 = v[q][j].x * rstd * g.x * (1.f + sc.x) + sh.x, h1 = v[q][j].y * rstd * g.y * (1.f + sc.y) + sh.y;
                const float h2 = v[q][j].z * rstd * g.z * (1.f + sc.z) + sh.z, h3 = v[q][j].w * rstd * g.w * (1.f + sc.w) + sh.w;
                uint2 o; o.x = pk2(h0, h1); o.y = pk2(h2, h3);
                *(uint2*)(H + (size_t)m * D + c) = o; }
        }
    }
}

struct EpiIn {
    static constexpr bool PERM = true;
    unsigned char* ws;
    __device__ __forceinline__ void operator()(const f32x4 (&acc)[2][2][4][2], const pg8::Unit& u, int wr, int wc, int fr, int fq) const {
        const int cbase = u.pn * 256;
        if (cbase < 1024) {
            const bool isq = cbase < 512;
            bf16_t* dst = (bf16_t*)(ws + (isq ? WS_QA : WS_KA));
            const float2* rope = (const float2*)(ws + WS_ROPE);
            const float scl = isq ? 0.125f * LOG2E : 1.f;
#pragma unroll
            for (int bj = 0; bj < 2; ++bj) {
                const int grp = ((cbase & 511) >> 5) + 4 * bj + wc, head = grp >> 1, dl = (grp & 1) * 16 + 4 * fq;
#pragma unroll
                for (int ai = 0; ai < 2; ++ai)
#pragma unroll
                    for (int m = 0; m < 4; ++m) { const int row = u.row0 + 128 * ai + 64 * wr + 16 * m + fr, pos = row & (S - 1);
                        const float4 c01 = *(const float4*)(rope + pos * 32 + dl), c23 = *(const float4*)(rope + pos * 32 + dl + 2);
                        const f32x4 x1 = acc[ai][bj][m][0], x2 = acc[ai][bj][m][1];
                        uint2 lo, hi;
                        lo.x = pk2((x1[0] * c01.x - x2[0] * c01.y) * scl, (x1[1] * c01.z - x2[1] * c01.w) * scl);
                        lo.y = pk2((x1[2] * c23.x - x2[2] * c23.y) * scl, (x1[3] * c23.z - x2[3] * c23.w) * scl);
                        hi.x = pk2((x2[0] * c01.x + x1[0] * c01.y) * scl, (x2[1] * c01.z + x1[1] * c01.w) * scl);
                        hi.y = pk2((x2[2] * c23.x + x1[2] * c23.y) * scl, (x2[3] * c23.z + x1[3] * c23.w) * scl);
                        const int bh = (row >> 13) * 8 + head;
                        bf16_t* o = dst + ((size_t)(bh * S + (pos & 15) * 512 + (pos >> 4)) * 64 + dl); *(uint2*)o = lo; *(uint2*)(o + 32) = hi; }
            }
        } else {
            bf16_t* dst; int ldc, cb;
            if (cbase < 1536) { dst = (bf16_t*)(ws + WS_VA); ldc = 512; cb = cbase - 1024; }
            else if (cbase < 1792) { dst = (bf16_t*)(ws + WS_QG); ldc = 256; cb = cbase - 1536; }
            else if (cbase < 2048) { dst = (bf16_t*)(ws + WS_KG); ldc = 256; cb = cbase - 1792; }
            else if (cbase < 2560) { dst = (bf16_t*)(ws + WS_VG); ldc = 512; cb = cbase - 2048; }
            else { dst = (bf16_t*)(ws + WS_RG); ldc = 512; cb = cbase - 2560; }
#pragma unroll
            for (int ai = 0; ai < 2; ++ai)
#pragma unroll
                for (int m = 0; m < 4; ++m) { const int row = u.row0 + 128 * ai + 64 * wr + 16 * m + fr;
#pragma unroll
                    for (int bj = 0; bj < 2; ++bj) { const f32x4 v0 = acc[ai][bj][m][0], v1 = acc[ai][bj][m][1];
                        u32x4 w; w.x = pk2(v0[0], v0[1]); w.y = pk2(v0[2], v0[3]); w.z = pk2(v1[0], v1[1]); w.w = pk2(v1[2], v1[3]);
                        *(u32x4*)(dst + (size_t)row * ldc + cb + 128 * bj + 32 * wc + 8 * fq) = w; } }
        }
    }
};

__device__ void phase_gemm_in(const Params& p, unsigned char* lds) {
    unsigned char* ws = p.ws;
    {
        pg8::DenseSched Sd; Sd.init(ws + WS_H, ws + WS_WINT, T, 3072, D);
        EpiIn E{ws};
        pg8::gemm_phase<EpiIn, pg8::DenseSched>((LAS unsigned char*)lds, D, Sd, E);
    }
    const int tid = threadIdx.x, lane = tid & 63, wave = tid >> 6, fr = lane & 15, fq = lane >> 4;
    const bf16_t* H = (const bf16_t*)(ws + WS_H); const bf16_t* Wl = (const bf16_t*)(ws + WS_WINT) + (size_t)3072 * D;
    float* glr = (float*)(ws + WS_GLR);
    float* part = (float*)lds;
    for (int item = blockIdx.x; item < T / 64; item += gridDim.x) {
        const int mt = wave & 3, kh = wave >> 2, r0 = item * 64 + mt * 16;
        f32x4 a = (f32x4){0.f, 0.f, 0.f, 0.f};
        const bf16_t* ap = H + (size_t)(r0 + fr) * D + kh * 512 + fq * 8;
        const bf16_t* bp = Wl + (size_t)fr * D + kh * 512 + fq * 8;
#pragma unroll 4
        for (int ks = 0; ks < 16; ++ks) a = __builtin_amdgcn_mfma_f32_16x16x32_bf16(*(const bf16x8*)(ap + ks * 32), *(const bf16x8*)(bp + ks * 32), a, 0, 0, 0);
        __syncthreads();
        if (kh == 1) {
#pragma unroll
            for (int j = 0; j < 4; ++j) part[(mt * 16 + 4 * fq + j) * 16 + fr] = a[j];
        }
        __syncthreads();
        if (kh == 0) {
#pragma unroll
            for (int j = 0; j < 4; ++j) glr[(size_t)(r0 + 4 * fq + j) * 16 + fr] = a[j] + part[(mt * 16 + 4 * fq + j) * 16 + fr];
        }
    }
    __syncthreads();
}

__device__ void vtrans_items(const Params& p, unsigned char* lds) {
    const int tid = threadIdx.x;
    unsigned char* ws = p.ws;
    const bf16_t* VA = (const bf16_t*)(ws + WS_VA);
    bf16_t* vb = (bf16_t*)(ws + WS_VB);
    constexpr int VS = 72;
    bf16_t* tile = (bf16_t*)lds;
    for (int item = blockIdx.x; item < 512; item += gridDim.x) {
        const int bh = item >> 5, blk = item & 31, b = bh >> 3, h = bh & 7, pos0 = blk * 256;
        { const int tok = tid >> 1, hf = tid & 1;
          const uint4* src = (const uint4*)(VA + (size_t)(b * S + pos0 + tok) * 512 + h * 64 + hf * 32);
          uint4 v0 = src[0], v1 = src[1], v2 = src[2], v3 = src[3];
          uint4* d = (uint4*)(tile + tok * VS + hf * 32);
          d[0] = v0; d[1] = v1; d[2] = v2; d[3] = v3; }
        __syncthreads();
        const int dv = tid >> 3, l8 = tid & 7;
#pragma unroll
        for (int cc = 0; cc < 2; ++cc) { const int cls = 2 * l8 + cc;
#pragma unroll
            for (int hh = 0; hh < 2; ++hh) { unsigned w[4];
#pragma unroll
                for (int i = 0; i < 4; ++i) w[i] = (unsigned)tile[(16 * (hh * 8 + 2 * i) + cls) * VS + dv] | ((unsigned)tile[(16 * (hh * 8 + 2 * i + 1) + cls) * VS + dv] << 16);
                const int blkidx = (bh * S + cls * 512 + 16 * blk + hh * 8) >> 3;
                *(uint4*)(vb + ((size_t)blkidx * 64 + dv) * 8) = make_uint4(w[0], w[1], w[2], w[3]); } }
        __syncthreads();
    }
}

struct AttnFrag { bf16x8 ka[4], vf[4]; };
__device__ __forceinline__ void attn_load(AttnFrag& f, const bf16_t* kp, const bf16_t* vp) {
    f.ka[0] = *(const bf16x8*)kp; f.ka[1] = *(const bf16x8*)(kp + 32); f.ka[2] = *(const bf16x8*)(kp + 256); f.ka[3] = *(const bf16x8*)(kp + 288);
#pragma unroll
    for (int n = 0; n < 4; ++n) f.vf[n] = *(const bf16x8*)(vp + n * 128);
}
struct AttnState { float m, l; f32x4 o[4]; bf16x8 q0, q1; };
__device__ __forceinline__ float max2a(float a, float b) { float r; asm("v_max_f32_e32 %0, %1, %2" : "=v"(r) : "v"(a), "v"(b)); return r; }
__device__ __forceinline__ float max3a(float a, float b, float c) { float r; asm("v_max3_f32 %0, %1, %2, %3" : "=v"(r) : "v"(a), "v"(b), "v"(c)); return r; }
__device__ __forceinline__ float rowmax4(float x) {
    const unsigned u = __builtin_bit_cast(unsigned, x);
    const auto a = __builtin_amdgcn_permlane16_swap(u, u, false, false);
    const float y = fmaxf(__builtin_bit_cast(float, a[0]), __builtin_bit_cast(float, a[1]));
    const unsigned v = __builtin_bit_cast(unsigned, y);
    const auto b = __builtin_amdgcn_permlane32_swap(v, v, false, false);
    return fmaxf(__builtin_bit_cast(float, b[0]), __builtin_bit_cast(float, b[1]));
}
template <bool FIRST>
__device__ __forceinline__ float attn_scores(const AttnFrag& f, const AttnState& t, const int d0, const int js, float (&sv)[8]) {
    const float nm = FIRST ? 0.f : -t.m;
    f32x4 st0 = (f32x4){nm, nm, nm, nm}, st1 = (f32x4){nm, nm, nm, nm};
    st0 = __builtin_amdgcn_mfma_f32_16x16x32_bf16(f.ka[0], t.q0, st0, 0, 0, 0);
    st0 = __builtin_amdgcn_mfma_f32_16x16x32_bf16(f.ka[1], t.q1, st0, 0, 0, 0);
    st1 = __builtin_amdgcn_mfma_f32_16x16x32_bf16(f.ka[2], t.q0, st1, 0, 0, 0);
    st1 = __builtin_amdgcn_mfma_f32_16x16x32_bf16(f.ka[3], t.q1, st1, 0, 0, 0);
#pragma unroll
    for (int j = 0; j < 8; ++j) { const bool vd = (unsigned)(d0 - (j << js)) <= 128u; const float x = (j < 4) ? st0[j] : st1[j - 4]; sv[j] = vd ? x : -3.0e38f; }
    float mx = max3a(max3a(sv[0], sv[1], sv[2]), max3a(sv[3], sv[4], sv[5]), max2a(sv[6], sv[7]));
    return rowmax4(mx);
}
__device__ __forceinline__ void attn_grow(AttnState& t, float (&sv)[8], const float mx) {
    const float gr = fmaxf(mx, 0.f), alpha = fexp2(-gr);
    t.m += gr;
#pragma unroll
    for (int j = 0; j < 8; ++j) sv[j] -= gr;
    t.l = t.l * alpha;
#pragma unroll
    for (int n = 0; n < 4; ++n) t.o[n] = t.o[n] * alpha;
}
__device__ __forceinline__ void attn_pv(const AttnFrag& f, AttnState& t, const float (&sv)[8]) {
    float pj[8];
#pragma unroll
    for (int j = 0; j < 8; ++j) pj[j] = fexp2(sv[j]);
    t.l += ((pj[0] + pj[1]) + (pj[2] + pj[3])) + ((pj[4] + pj[5]) + (pj[6] + pj[7]));
    u32x4 pw; pw.x = pk2(pj[0], pj[1]); pw.y = pk2(pj[2], pj[3]); pw.z = pk2(pj[4], pj[5]); pw.w = pk2(pj[6], pj[7]);
    const bf16x8 pf = __builtin_bit_cast(bf16x8, pw);
#pragma unroll
    for (int n = 0; n < 4; ++n) t.o[n] = __builtin_amdgcn_mfma_f32_16x16x32_bf16(f.vf[n], pf, t.o[n], 0, 0, 0);
}
template <bool FIRST>
__device__ __forceinline__ void attn_math2(const AttnFrag& fa, const AttnFrag& fb, AttnState& ta, AttnState& tb, const int d0a, const int d0b, const int js) {
    float sa[8], sb[8];
    const float mxa = attn_scores<FIRST>(fa, ta, d0a, js, sa), mxb = attn_scores<FIRST>(fb, tb, d0b, js, sb);
    if (FIRST) {
        ta.m = mxa; tb.m = mxb;
#pragma unroll
        for (int j = 0; j < 8; ++j) { sa[j] -= mxa; sb[j] -= mxb; }
    } else if (__any(fmaxf(mxa, mxb) > 8.f)) {
        attn_grow(ta, sa, mxa); attn_grow(tb, sb, mxb);
    }
    attn_pv(fa, ta, sa); attn_pv(fb, tb, sb);
}
__device__ void phase_attn(const Params& p, unsigned char* lds) {
    const int tid = threadIdx.x, lane = tid & 63, wave = tid >> 6, qi = lane & 15, g = lane >> 4, gp = qi >> 2, jj = qi & 3;
    unsigned char* ws = p.ws;
    const bf16_t* QA = (const bf16_t*)(ws + WS_QA);
    bf16_t* CAT = (bf16_t*)(ws + WS_CAT);
    const bf16_t* K = (const bf16_t*)(ws + WS_KA); const bf16_t* V = (const bf16_t*)(ws + WS_VB);
    constexpr int LV = 49152;
    constexpr int CLS8 = 8 * 512 * 64;
    const int nwg = gridDim.x, xg = blockIdx.x & 7, xl = blockIdx.x >> 3;
    const bool xord = (nwg & 7) == 0;
    const int k0 = xord ? xl : (int)blockIdx.x, kst = xord ? (nwg >> 3) : nwg, kend = xord ? 64 : 512;
    for (int k = k0; k < kend; k += kst) {
        const int idd = xord ? ((xg + 8 * (k >> 5)) << 5) + (k & 31) : k;
        const int bh = idd >> 5, blk = idd & 31, r = wave, b = bh >> 3, h = bh & 7;
        const int tq = 256 * blk + r + 16 * qi, rho4 = r & 3;
        __syncthreads();
        uint4 pre[12];
#pragma unroll
        for (int i = 0; i < 6; ++i) { const int pid = tid + 512 * i, row = pid >> 3, cls = row / 24, il = row - cls * 24;
            pre[i] = *(const uint4*)(K + ((bh * S + cls * 512 + 16 * blk - 8 + il) * 64 + (pid & 7) * 8)); }
#pragma unroll
        for (int i = 0; i < 6; ++i) { const int vp = tid + 512 * i, b3 = vp >> 6, cls = b3 / 3, bl = b3 - cls * 3;
            pre[6 + i] = *(const uint4*)(V + ((((bh * S + cls * 512 + 16 * blk - 8) >> 3) + bl) * 512 + (vp & 63) * 8)); }
        const int ks16 = ((16 * blk) & ~31) - 128;
        const int c16 = ks16 < 0 ? ((-ks16) >> 5) : 0;
        const int kb16 = (bh * S + r * 512 + ks16 + 8 * gp + jj) * 64 + 8 * g, vb16 = (((bh * S + r * 512 + ks16) >> 3) + g) * 512 + qi * 8;
        const int dq16 = 16 * blk + qi - (ks16 + 8 * g);
        const int c4 = blk == 0 ? 4 : (blk == 1 ? 2 : 0);
        const int kb4 = (bh * S + (rho4 + 4 * gp) * 512 + 16 * blk - 32 + jj) * 64 + 8 * g, vb4 = ((bh * S + (rho4 + 4 * g) * 512 + 16 * blk - 32) >> 3) * 512 + qi * 8;
        const int dq4 = 4 * qi + 128 + (r >> 2) - g;
        AttnFrag fxa, fxb, fya;
        attn_load(fxa, K + (kb16 + 4 * 2048), V + (vb16 + 4 * 2048)); attn_load(fxb, K + (kb16 + 4 * 2048 + CLS8), V + (vb16 + 4 * 2048 + CLS8));
        attn_load(fya, K + kb4, V + vb4);
        AttnState ta, tb;
        { const bf16_t* qrow = QA + ((size_t)(bh * S + r * 512 + 16 * blk + qi) * 64 + 8 * g);
          ta.q0 = *(const bf16x8*)qrow; ta.q1 = *(const bf16x8*)(qrow + 32); tb.q0 = *(const bf16x8*)(qrow + CLS8); tb.q1 = *(const bf16x8*)(qrow + CLS8 + 32); }
        ta.m = 0.f; tb.m = 0.f; ta.l = 0.f; tb.l = 0.f;
#pragma unroll
        for (int n = 0; n < 4; ++n) { ta.o[n] = (f32x4){0.f, 0.f, 0.f, 0.f}; tb.o[n] = ta.o[n]; }
        attn_math2<true>(fxa, fxb, ta, tb, dq16 - 128, dq16 - 128, 0);
        {
            const int m0 = c4 <= 0 ? 0 : (1 << 20), m1 = c4 <= 1 ? 0 : (1 << 20), m2 = c4 <= 2 ? 0 : (1 << 20);
            attn_load(fxa, K + (kb4 + 1 * 512), V + (vb4 + 1 * 512));
            attn_math2<false>(fya, fya, ta, tb, dq4 - m0, dq4 + 2 - m0, 2);
            attn_load(fya, K + (kb4 + 2 * 512), V + (vb4 + 2 * 512));
            attn_math2<false>(fxa, fxa, ta, tb, dq4 - 32 - m1, dq4 + 2 - 32 - m1, 2);
            attn_math2<false>(fya, fya, ta, tb, dq4 - 64 - m2, dq4 + 2 - 64 - m2, 2);
        }
#pragma unroll
        for (int i = 0; i < 12; ++i) *(uint4*)(lds + (tid + 512 * i) * 16) = pre[i];
        __syncthreads();
        {
            const int d1 = 16 * qi + 128 + r - g;
            const unsigned char* kl = lds + (gp * 24 + jj) * 128 + g * 16;
            const unsigned char* vl = lds + LV + g * 3072 + qi * 16;
            int c1 = (blk == 0 ? 4 : 0);
            const unsigned char* kl4 = lds + ((rho4 + 4 * gp) * 24 + jj) * 128 + g * 16;
            const unsigned char* vl4 = lds + LV + (rho4 + 4 * g) * 3072 + qi * 16;
            const int c4l = c4 > 3 ? c4 : 3;
#define ATTN_D1_CHUNK() do { const int w = c1 >> 2, q = c1 & 3; const unsigned char* kq = kl + q * 12288 + w * 1024; const unsigned char* vq = vl + q * 12288 + w * 1024; \
                fya.ka[0] = *(const bf16x8*)kq; fya.ka[1] = *(const bf16x8*)(kq + 64); fya.ka[2] = *(const bf16x8*)(kq + 512); fya.ka[3] = *(const bf16x8*)(kq + 576); \
                _Pragma("unroll") for (int n = 0; n < 4; ++n) fya.vf[n] = *(const bf16x8*)(vq + n * 256); \
                attn_math2<false>(fya, fya, ta, tb, d1 - 128 * w - 4 * q, d1 + 8 - 128 * w - 4 * q, 4); ++c1; } while (0)
#define ATTN_D4_CHUNK(w4) do { const unsigned char* kq = kl4 + ((w4) - 3) * 1024; const unsigned char* vq = vl4 + ((w4) - 3) * 1024; \
                fya.ka[0] = *(const bf16x8*)kq; fya.ka[1] = *(const bf16x8*)(kq + 64); fya.ka[2] = *(const bf16x8*)(kq + 512); fya.ka[3] = *(const bf16x8*)(kq + 576); \
                _Pragma("unroll") for (int n = 0; n < 4; ++n) fya.vf[n] = *(const bf16x8*)(vq + n * 256); \
                attn_math2<false>(fya, fya, ta, tb, dq4 - 32 * (w4), dq4 + 2 - 32 * (w4), 2); } while (0)
            for (int cc = c16; cc < 4; ++cc) {
                attn_load(fxa, K + (kb16 + cc * 2048), V + (vb16 + cc * 2048)); attn_load(fxb, K + (kb16 + cc * 2048 + CLS8), V + (vb16 + cc * 2048 + CLS8));
                for (int q3 = 0; q3 < 3 && c1 < 12; ++q3) ATTN_D1_CHUNK();
                if (3 + (cc - c16) >= c4l && 3 + (cc - c16) < 6) ATTN_D4_CHUNK(3 + (cc - c16));
                attn_math2<false>(fxa, fxb, ta, tb, dq16 - 32 * cc, dq16 - 32 * cc, 0);
            }
            while (c1 < 12) ATTN_D1_CHUNK();
            for (int w4 = (4 - c16 < 3 ? 3 + (4 - c16) : 6); w4 < 6; ++w4) { if (w4 >= c4l) ATTN_D4_CHUNK(w4); }
#undef ATTN_D1_CHUNK
#undef ATTN_D4_CHUNK
        }
        {
            float la = ta.l, lb = tb.l;
            la += __shfl_xor(la, 16); la += __shfl_xor(la, 32); lb += __shfl_xor(lb, 16); lb += __shfl_xor(lb, 32);
            const float ia = 1.f / la, ib = 1.f / lb;
            bf16_t* orow = CAT + (size_t)(b * S + tq) * D + h * 64 + 4 * g;
#pragma unroll
            for (int n = 0; n < 4; ++n) { uint2 ov; ov.x = pk2(ta.o[n][0] * ia, ta.o[n][1] * ia); ov.y = pk2(ta.o[n][2] * ia, ta.o[n][3] * ia); *(uint2*)(orow + 16 * n) = ov;
                uint2 ow; ow.x = pk2(tb.o[n][0] * ib, tb.o[n][1] * ib); ow.y = pk2(tb.o[n][2] * ib, tb.o[n][3] * ib); *(uint2*)(orow + 8 * D + 16 * n) = ow; }
        }
    }
}

constexpr int TS = 72;
constexpr int GL_LA = 0, GL_A1 = 16640, GL_A2 = GL_A1 + 64 * TS * 2, GL_VT = GL_A2 + 64 * TS * 2, GL_ATT = GL_VT + 128 * TS * 2;
static_assert(GL_ATT + 64 * TS * 2 <= 65536, "gla lds");

struct GlaIn { uint4 kr0, kr1, qr0, qr1, vr[4]; float4 gl; };
template <int MODE>
__device__ __forceinline__ void gla_fetch(const Params& p, int item, int tid, GlaIn& in) {
    unsigned char* ws = p.ws;
    const int bh4 = item >> 7, n = item & 127, b = bh4 >> 2, hh = bh4 & 3;
    const int t0 = b * S + n * 64;
    const int c = tid >> 2, d0 = (tid & 3) * 16, e0 = (tid & 3) * 32;
    const bf16_t* kp = (const bf16_t*)(ws + WS_KG) + (size_t)(t0 + c) * 256 + hh * 64 + d0;
    in.kr0 = *(const uint4*)kp; in.kr1 = *(const uint4*)(kp + 8);
    const bf16_t* qp = (const bf16_t*)(ws + WS_QG) + (size_t)(t0 + c) * 256 + hh * 64 + d0;
    in.qr0 = make_uint4(0, 0, 0, 0); in.qr1 = make_uint4(0, 0, 0, 0);
    if (MODE == 1) { in.qr0 = *(const uint4*)qp; in.qr1 = *(const uint4*)(qp + 8); }
    const bf16_t* vp = (const bf16_t*)(ws + WS_VG) + (size_t)(t0 + c) * 512 + hh * 128 + e0;
#pragma unroll
    for (int q = 0; q < 4; ++q) in.vr[q] = *(const uint4*)(vp + 8 * q);
    in.gl = *(const float4*)((const float*)(ws + WS_GLR) + (size_t)t0 * 16 + tid * 4);
}
template <int MODE>
__device__ __forceinline__ void gla_prep(const Params& p, unsigned char* lds, int item, int tid, const GlaIn& in) {
    const int bh4 = item >> 7, hh = bh4 & 3;
    float* LA = (float*)(lds + GL_LA);
    bf16_t* A1 = (bf16_t*)(lds + GL_A1); bf16_t* A2 = (bf16_t*)(lds + GL_A2); bf16_t* VTl = (bf16_t*)(lds + GL_VT);
    const int c = tid >> 2, d0 = (tid & 3) * 16, e0 = (tid & 3) * 32;
    const uint4 kr0 = in.kr0, kr1 = in.kr1, qr0 = in.qr0, qr1 = in.qr1;
    float* GLRL = (float*)(lds + GL_ATT + 1024);
    *(float4*)(GLRL + tid * 4) = in.gl;
    __syncthreads();
    {
        const int dd = tid & 63, cgp = tid >> 6;
        float w[16];
#pragma unroll
        for (int r = 0; r < 16; ++r) w[r] = p.w_gate_lr[r * 256 + hh * 64 + dd];
        const float bias = p.b_gate[hh * 64 + dd];
        float pre[16]; float run = 0.f;
#pragma unroll
        for (int i = 0; i < 16; ++i) {
            const float4* gp = (const float4*)(GLRL + (cgp * 16 + i) * 16);
            const float4 g0 = gp[0], g1 = gp[1], g2 = gp[2], g3 = gp[3];
            float z = bias;
            z += g0.x * w[0] + g0.y * w[1] + g0.z * w[2] + g0.w * w[3];
            z += g1.x * w[4] + g1.y * w[5] + g1.z * w[6] + g1.w * w[7];
            z += g2.x * w[8] + g2.y * w[9] + g2.z * w[10] + g2.w * w[11];
            z += g3.x * w[12] + g3.y * w[13] + g3.z * w[14] + g3.w * w[15];
            const float ls = fminf(z, 0.f) - flog(1.f + fexp(-fabsf(z)));
            run += ls * (1.f / 16.f); pre[i] = run;
        }
        float* tot = (float*)(lds + GL_ATT);
        tot[cgp * 64 + dd] = run;
        __syncthreads();
        float off = 0.f;
#pragma unroll
        for (int gq = 0; gq < 3; ++gq) off += (gq < cgp) ? tot[gq * 64 + dd] : 0.f;
#pragma unroll
        for (int i = 0; i < 16; ++i) LA[(cgp * 16 + i) * 65 + dd] = pre[i] + off;
    }
    __syncthreads();
    {
        unsigned kw[8] = {kr0.x, kr0.y, kr0.z, kr0.w, kr1.x, kr1.y, kr1.z, kr1.w};
        if (MODE == 0) {
#pragma unroll
            for (int i = 0; i < 16; ++i) { const int dd = d0 + i; const float kv = bf2f((unsigned short)((kw[i >> 1] >> ((i & 1) * 16)) & 0xffff));
                const float f = fexp(LA[63 * 65 + dd] - LA[c * 65 + dd]);
                A1[dd * TS + c] = (bf16_t)f2bf(kv * f); }
        } else {
            unsigned qw[8] = {qr0.x, qr0.y, qr0.z, qr0.w, qr1.x, qr1.y, qr1.z, qr1.w};
            unsigned oq[8], ok[8];
#pragma unroll
            for (int i = 0; i < 8; ++i) {
                const float bb0 = LA[c * 65 + d0 + 2 * i], bb1 = LA[c * 65 + d0 + 2 * i + 1];
                const float q0 = bf2f((unsigned short)(qw[i] & 0xffff)), q1 = bf2f((unsigned short)(qw[i] >> 16));
                const float k0 = bf2f((unsigned short)(kw[i] & 0xffff)), k1 = bf2f((unsigned short)(kw[i] >> 16));
                oq[i] = pk2(q0 * 0.125f * fexp(bb0), q1 * 0.125f * fexp(bb1));
                ok[i] = pk2(k0 * fexp(-bb0), k1 * fexp(-bb1));
            }
            *(uint4*)(A1 + c * TS + d0) = make_uint4(oq[0], oq[1], oq[2], oq[3]); *(uint4*)(A1 + c * TS + d0 + 8) = make_uint4(oq[4], oq[5], oq[6], oq[7]);
            *(uint4*)(A2 + c * TS + d0) = make_uint4(ok[0], ok[1], ok[2], ok[3]); *(uint4*)(A2 + c * TS + d0 + 8) = make_uint4(ok[4], ok[5], ok[6], ok[7]);
        }
#pragma unroll
        for (int q = 0; q < 4; ++q) { const unsigned vw[4] = {in.vr[q].x, in.vr[q].y, in.vr[q].z, in.vr[q].w};
#pragma unroll
            for (int i = 0; i < 4; ++i) { VTl[(e0 + 8 * q + 2 * i) * TS + c] = (bf16_t)(vw[i] & 0xffff); VTl[(e0 + 8 * q + 2 * i + 1) * TS + c] = (bf16_t)(vw[i] >> 16); } }
    }
    __syncthreads();
}

__device__ void gla1_items(const Params& p, unsigned char* lds0) {
    const int half = threadIdx.x >> 8, tid = threadIdx.x & 255, lane = tid & 63, w = tid >> 6, fr = lane & 15, fq = lane >> 4;
    unsigned char* lds = lds0 + half * 65536;
    float* UT = (float*)(p.ws + WS_UT); float* AG = (float*)(p.ws + WS_AG);
    const float* LA = (const float*)(lds + GL_LA);
    const bf16_t* A1 = (const bf16_t*)(lds + GL_A1); const bf16_t* VTl = (const bf16_t*)(lds + GL_VT);
    GlaIn cur, nxt;
    if ((int)blockIdx.x < 512) gla_fetch<0>(p, 2 * blockIdx.x + half, tid, cur);
    for (int it = blockIdx.x; it < 512; it += gridDim.x) {
        const int item = 2 * it + half;
        const bool more = it + (int)gridDim.x < 512;
        if (more) gla_fetch<0>(p, 2 * (it + gridDim.x) + half, tid, nxt);
        gla_prep<0>(p, lds, item, tid, cur);
        f32x4 acc[8];
#pragma unroll
        for (int n = 0; n < 8; ++n) acc[n] = (f32x4){0.f, 0.f, 0.f, 0.f};
#pragma unroll
        for (int ks = 0; ks < 2; ++ks) {
            const bf16x8 af = *(const bf16x8*)(A1 + (16 * w + fr) * TS + ks * 32 + fq * 8);
#pragma unroll
            for (int n = 0; n < 8; ++n) { const bf16x8 bfr = *(const bf16x8*)(VTl + (16 * n + fr) * TS + ks * 32 + fq * 8);
                acc[n] = __builtin_amdgcn_mfma_f32_16x16x32_bf16(af, bfr, acc[n], 0, 0, 0); }
        }
#pragma unroll
        for (int n = 0; n < 8; ++n) *(f32x4*)(UT + ((size_t)item * 128 + 16 * n + fr) * 64 + 16 * w + 4 * fq) = acc[n];
        if (tid < 64) AG[item * 64 + tid] = fexp(LA[63 * 65 + tid]);
        __syncthreads();
        if (more) cur = nxt;
    }
}
__device__ void gla2_scan(const Params& p) {
    const float* UT = (const float*)(p.ws + WS_UT); const float* AG = (const float*)(p.ws + WS_AG);
    bf16_t* SPT = (bf16_t*)(p.ws + WS_SPT);
    for (int rec = blockIdx.x * NTHREADS + threadIdx.x; rec < 65536; rec += gridDim.x * NTHREADS) {
        const int bh4 = rec >> 13, e = (rec >> 6) & 127, dd = rec & 63;
        float st = 0.f;
        for (int n0 = 0; n0 < 128; n0 += 32) {
            float av[32], uv[32];
#pragma unroll
            for (int q = 0; q < 32; ++q) { const int item = bh4 * 128 + n0 + q; av[q] = AG[item * 64 + dd]; uv[q] = UT[((size_t)item * 128 + e) * 64 + dd]; }
#pragma unroll
            for (int q = 0; q < 32; ++q) { const int item = bh4 * 128 + n0 + q; SPT[((size_t)item * 128 + e) * 64 + dd] = (bf16_t)f2bf(st); st = av[q] * st + uv[q]; }
        }
    }
}
__device__ void gla3_items(const Params& p, unsigned char* lds0) {
    const int half = threadIdx.x >> 8, tid = threadIdx.x & 255, lane = tid & 63, w = tid >> 6, fr = lane & 15, fq = lane >> 4;
    unsigned char* lds = lds0 + half * 65536;
    unsigned char* ws = p.ws;
    const bf16_t* SPT = (const bf16_t*)(ws + WS_SPT); const bf16_t* RG = (const bf16_t*)(ws + WS_RG);
    bf16_t* CAT = (bf16_t*)(ws + WS_CAT);
    const bf16_t* A1 = (const bf16_t*)(lds + GL_A1); const bf16_t* A2 = (const bf16_t*)(lds + GL_A2); const bf16_t* VTl = (const bf16_t*)(lds + GL_VT);
    bf16_t* ATT = (bf16_t*)(lds + GL_ATT);
    GlaIn cur, nxt;
    if ((int)blockIdx.x < 512) gla_fetch<1>(p, 2 * blockIdx.x + half, tid, cur);
    for (int it = blockIdx.x; it < 512; it += gridDim.x) {
        const int item = 2 * it + half;
        const bool more = it + (int)gridDim.x < 512;
        const int bh4 = item >> 7, n_ = item & 127, b = bh4 >> 2, hh = bh4 & 3;
        const int t0 = b * S + n_ * 64;
        bf16x8 sf[8][2]; uint2 rw[8];
#pragma unroll
        for (int n = 0; n < 8; ++n) { const bf16_t* sp = SPT + ((size_t)item * 128 + 16 * n + fr) * 64 + fq * 8; sf[n][0] = *(const bf16x8*)sp; sf[n][1] = *(const bf16x8*)(sp + 32);
            rw[n] = *(const uint2*)(RG + (size_t)(t0 + 16 * w + fr) * 512 + hh * 128 + 16 * n + 4 * fq); }
        if (more) gla_fetch<1>(p, 2 * (it + gridDim.x) + half, tid, nxt);
        gla_prep<1>(p, lds, item, tid, cur);
        const bf16x8 aq0 = *(const bf16x8*)(A1 + (16 * w + fr) * TS + fq * 8), aq1 = *(const bf16x8*)(A1 + (16 * w + fr) * TS + 32 + fq * 8);
#pragma unroll
        for (int np = 0; np < 4; ++np) {
            f32x4 a = (f32x4){0.f, 0.f, 0.f, 0.f};
            if (np <= w) {
                const bf16x8 b0 = *(const bf16x8*)(A2 + (16 * np + fr) * TS + fq * 8), b1 = *(const bf16x8*)(A2 + (16 * np + fr) * TS + 32 + fq * 8);
                a = __builtin_amdgcn_mfma_f32_16x16x32_bf16(aq0, b0, a, 0, 0, 0);
                a = __builtin_amdgcn_mfma_f32_16x16x32_bf16(aq1, b1, a, 0, 0, 0);
            }
#pragma unroll
            for (int j = 0; j < 4; ++j) { const int c = 16 * w + 4 * fq + j, cp = 16 * np + fr; ATT[c * TS + cp] = (bf16_t)f2bf(cp <= c ? a[j] : 0.f); }
        }
        __syncthreads();
        const bf16x8 at0 = *(const bf16x8*)(ATT + (16 * w + fr) * TS + fq * 8), at1 = *(const bf16x8*)(ATT + (16 * w + fr) * TS + 32 + fq * 8);
        f32x4 acc[8];
#pragma unroll
        for (int n = 0; n < 8; ++n) {
            acc[n] = (f32x4){0.f, 0.f, 0.f, 0.f};
            const bf16x8 v0 = *(const bf16x8*)(VTl + (16 * n + fr) * TS + fq * 8), v1 = *(const bf16x8*)(VTl + (16 * n + fr) * TS + 32 + fq * 8);
            const bf16x8 s0 = sf[n][0], s1 = sf[n][1];
            acc[n] = __builtin_amdgcn_mfma_f32_16x16x32_bf16(v0, at0, acc[n], 0, 0, 0);
            acc[n] = __builtin_amdgcn_mfma_f32_16x16x32_bf16(v1, at1, acc[n], 0, 0, 0);
            acc[n] = __builtin_amdgcn_mfma_f32_16x16x32_bf16(s0, aq0, acc[n], 0, 0, 0);
            acc[n] = __builtin_amdgcn_mfma_f32_16x16x32_bf16(s1, aq1, acc[n], 0, 0, 0);
        }
        {
            float ss = 0.f;
#pragma unroll
            for (int n = 0; n < 8; ++n) ss += acc[n][0] * acc[n][0] + acc[n][1] * acc[n][1] + acc[n][2] * acc[n][2] + acc[n][3] * acc[n][3];
            ss += __shfl_xor(ss, 16); ss += __shfl_xor(ss, 32);
            const float rstd = rsqrtf(ss * (1.f / 128.f) + EPS);
            const int t = t0 + 16 * w + fr;
#pragma unroll
            for (int n = 0; n < 8; ++n) { const int e = 16 * n + 4 * fq;
                const float4 gg = *(const float4*)(p.g_gla + e);
                const float r0 = bf2f((unsigned short)(rw[n].x & 0xffff)), r1 = bf2f((unsigned short)(rw[n].x >> 16)), r2 = bf2f((unsigned short)(rw[n].y & 0xffff)), r3 = bf2f((unsigned short)(rw[n].y >> 16));
                uint2 ov; ov.x = pk2(acc[n][0] * rstd * gg.x * fsilu(r0), acc[n][1] * rstd * gg.y * fsilu(r1)); ov.y = pk2(acc[n][2] * rstd * gg.z * fsilu(r2), acc[n][3] * rstd * gg.w * fsilu(r3));
                *(uint2*)(CAT + (size_t)t * D + 512 + hh * 128 + e) = ov; }
        }
        __syncthreads();
        if (more) cur = nxt;
    }
}

struct EpiBf16Plain {
    static constexpr bool PERM = true;
    bf16_t* C; int ldc;
    __device__ __forceinline__ void operator()(const f32x4 (&acc)[2][2][4][2], const pg8::Unit& u, int wr, int wc, int fr, int fq) const {
#pragma unroll
        for (int ai = 0; ai < 2; ++ai)
#pragma unroll
            for (int m = 0; m < 4; ++m) { const int row = u.row0 + 128 * ai + 64 * wr + 16 * m + fr;
#pragma unroll
                for (int bj = 0; bj < 2; ++bj) { const f32x4 v0 = acc[ai][bj][m][0], v1 = acc[ai][bj][m][1];
                    u32x4 w; w.x = pk2(v0[0], v0[1]); w.y = pk2(v0[2], v0[3]); w.z = pk2(v1[0], v1[1]); w.w = pk2(v1[2], v1[3]);
                    *(u32x4*)(C + (size_t)row * ldc + 256 * u.pn + 128 * bj + 32 * wc + 8 * fq) = w; } }
    }
};
__device__ void phase_gemm_out(const Params& p, unsigned char* lds) {
    pg8::DenseSched Sd; Sd.init(p.ws + WS_CAT, p.ws + WS_WOUTT, T, D, D);
    EpiBf16Plain E{(bf16_t*)(p.ws + WS_YMIX), D};
    pg8::gemm_phase<EpiBf16Plain, pg8::DenseSched>((LAS unsigned char*)lds, D, Sd, E);
}

constexpr int HS_STRIDE = 1028;
__device__ void phase_postmix(const Params& p, unsigned char* lds, const bool dry) {
    const int tid = threadIdx.x, lane = tid & 63, wave = tid >> 6;
    unsigned char* ws = p.ws;
    const float* mod = (const float*)(ws + WS_MOD);
    const bf16_t* Y = (const bf16_t*)(ws + WS_YMIX);
    bf16_t* H = (bf16_t*)(ws + WS_H);
    bf16_t* X1 = (bf16_t*)(ws + WS_X1);
    float* hs = (float*)lds;
    float* part = (float*)(lds + 66048);
    float* lg = (float*)(lds + 66048 + 16384);
    float* tvs = lg + 512;
    int* tis = (int*)(tvs + 64);
    constexpr int MAXG = 8;
    int* sel_e = tis + 64;
    float* sel_g = (float*)(sel_e + MAXG * 64);
    int* lrank = (int*)(sel_g + MAXG * 64);
    int* lcnt = lrank + MAXG * 64;
    int* lbase = lcnt + 32;
    int* CNT = (int*)(ws + WS_CTL) + CW_CNT;
    float wb0[32], wb1[32];
    { const float* wp = p.router_w + (size_t)(128 * wave + (lane >> 4)) * 32 + (lane & 15);
#pragma unroll
      for (int ks = 0; ks < 32; ++ks) { wb0[ks] = wp[(size_t)(4 * ks) * 32]; wb1[ks] = wp[(size_t)(4 * ks) * 32 + 16]; } }
    if (tid < 32) lcnt[tid] = 0;
    int gl = 0, grp0 = blockIdx.x;
    uint2 yw[2][4]; float4 xv[2][4];
    if ((int)blockIdx.x < T / 16) {
#pragma unroll
        for (int i = 0; i < 2; ++i) { const int m = blockIdx.x * 16 + wave * 2 + i;
            const uint2* yr = (const uint2*)(Y + (size_t)m * D) + lane; const float4* xr = (const float4*)(p.x + (size_t)m * D) + lane;
#pragma unroll
            for (int j = 0; j < 4; ++j) { yw[i][j] = ntload2(yr + 64 * j); xv[i][j] = ntload4(xr + 64 * j); } }
    }
    for (int grp = blockIdx.x; grp < T / 16; grp += gridDim.x) {
        const int m0 = grp * 16;
#pragma unroll
        for (int i = 0; i < 2; ++i) {
            const int rl = wave * 2 + i, m = m0 + rl, b = m >> 13;
            float4 yv[4]; float ss = 0.f;
#pragma unroll
            for (int j = 0; j < 4; ++j) { const uint2 w = yw[i][j];
                yv[j] = make_float4(bf2f((unsigned short)(w.x & 0xffff)), bf2f((unsigned short)(w.x >> 16)), bf2f((unsigned short)(w.y & 0xffff)), bf2f((unsigned short)(w.y >> 16)));
                ss += yv[j].x * yv[j].x + yv[j].y * yv[j].y + yv[j].z * yv[j].z + yv[j].w * yv[j].w; }
            const float rstd1 = rsqrtf(wave_sum(ss) * (1.f / D) + EPS);
            float4 x1[4]; float ss2 = 0.f;
#pragma unroll
            for (int j = 0; j < 4; ++j) { const int c = 4 * lane + 256 * j;
                const float4 xq = xv[i][j], g = *(const float4*)(p.g_post_mix + c), gt = *(const float4*)(mod + b * 6144 + 2048 + c);
                x1[j].x = xq.x + gt.x * (yv[j].x * rstd1 * g.x); x1[j].y = xq.y + gt.y * (yv[j].y * rstd1 * g.y);
                x1[j].z = xq.z + gt.z * (yv[j].z * rstd1 * g.z); x1[j].w = xq.w + gt.w * (yv[j].w * rstd1 * g.w);
                ss2 += x1[j].x * x1[j].x + x1[j].y * x1[j].y + x1[j].z * x1[j].z + x1[j].w * x1[j].w;
                { uint2 xo; xo.x = pk2(x1[j].x, x1[j].y); xo.y = pk2(x1[j].z, x1[j].w); ntstore2((uint2*)(X1 + (size_t)m * D + c), xo); } }
            const float rstd2 = rsqrtf(wave_sum(ss2) * (1.f / D) + EPS);
#pragma unroll
            for (int j = 0; j < 4; ++j) { const int c = 4 * lane + 256 * j;
                const float4 g = *(const float4*)(p.g_pre_ffn + c), sh = *(const float4*)(mod + b * 6144 + 3072 + c), sc = *(const float4*)(mod + b * 6144 + 4096 + c);
                float4 h;
                h.x = x1[j].x * rstd2 * g.x * (1.f + sc.x) + sh.x; h.y = x1[j].y * rstd2 * g.y * (1.f + sc.y) + sh.y;
                h.z = x1[j].z * rstd2 * g.z * (1.f + sc.z) + sh.z; h.w = x1[j].w * rstd2 * g.w * (1.f + sc.w) + sh.w;
                uint2 o; o.x = pk2(h.x, h.y); o.y = pk2(h.z, h.w);
                *(uint2*)(H + (size_t)m * D + c) = o;
                *(float4*)(hs + rl * HS_STRIDE + c) = h; }
        }
        if (grp + (int)gridDim.x < T / 16) {
#pragma unroll
            for (int i = 0; i < 2; ++i) { const int m = (grp + gridDim.x) * 16 + wave * 2 + i;
                const uint2* yr = (const uint2*)(Y + (size_t)m * D) + lane; const float4* xr = (const float4*)(p.x + (size_t)m * D) + lane;
#pragma unroll
                for (int j = 0; j < 4; ++j) { yw[i][j] = ntload2(yr + 64 * j); xv[i][j] = ntload4(xr + 64 * j); } }
        }
        __syncthreads();
        f32x4 a0 = (f32x4){0.f, 0.f, 0.f, 0.f}, a1 = (f32x4){0.f, 0.f, 0.f, 0.f};
        {
            const float* hp = hs + (lane & 15) * HS_STRIDE + 128 * wave + (lane >> 4);
#pragma unroll
            for (int ks = 0; ks < 32; ++ks) {
                const float av = hp[4 * ks];
                a0 = __builtin_amdgcn_mfma_f32_16x16x4f32(av, wb0[ks], a0, 0, 0, 0);
                a1 = __builtin_amdgcn_mfma_f32_16x16x4f32(av, wb1[ks], a1, 0, 0, 0);
            }
        }
        {
            const int fr = lane & 15, fq = lane >> 4;
#pragma unroll
            for (int j = 0; j < 4; ++j) { part[(wave * 16 + 4 * fq + j) * 32 + fr] = a0[j]; part[(wave * 16 + 4 * fq + j) * 32 + 16 + fr] = a1[j]; }
        }
        __syncthreads();
        { const int e = tid & 31; float s = p.router_b[e];
#pragma unroll
          for (int w8 = 0; w8 < 8; ++w8) s += part[w8 * 512 + tid];
          lg[tid] = s; }
        __syncthreads();
        {
            const int row = tid >> 5, e = tid & 31; const float v = lg[tid]; int rank = 0;
#pragma unroll
            for (int q = 0; q < 32; ++q) { const float u = lg[row * 32 + q]; rank += (u > v || (u == v && q < e)) ? 1 : 0; }
            if (rank < 4) { tvs[row * 4 + rank] = v; tis[row * 4 + rank] = e; }
        }
        __syncthreads();
        if (tid < 64) { const int row = tid >> 2, k = tid & 3;
            const float t0 = tvs[row * 4], e1 = fexp(tvs[row * 4 + 1] - t0), e2 = fexp(tvs[row * 4 + 2] - t0), e3 = fexp(tvs[row * 4 + 3] - t0);
            const float inv = 1.f / (1.f + e1 + e2 + e3);
            const float ek = k == 0 ? 1.f : (k == 1 ? e1 : (k == 2 ? e2 : e3));
            const int e = tis[tid];
            sel_e[gl * 64 + tid] = e; sel_g[gl * 64 + tid] = ek * inv;
            lrank[gl * 64 + tid] = atomicAdd(&lcnt[e], 1); }
        ++gl;
        const bool lastg = grp + (int)gridDim.x >= T / 16;
        if (gl == MAXG || lastg) {
            __syncthreads();
            if (tid < 32) { const int c = lcnt[tid]; lbase[tid] = (c > 0 && !dry) ? atomicAdd(&CNT[tid], c) : 0; }
            __syncthreads();
            if (!dry) for (int i = tid; i < gl * 64; i += NTHREADS) { const int gq = i >> 6, a = (grp0 + gq * (int)gridDim.x) * 64 + (i & 63); const int e = sel_e[i];
                const int pos = lbase[e] + lrank[i];
                ((int*)(ws + WS_TOPI))[a] = e; ((float*)(ws + WS_GATE))[a] = sel_g[i]; ((int*)(ws + WS_POS))[a] = pos; ((int*)(ws + WS_TOK))[e * T + pos] = a >> 2; }
            __syncthreads();
            if (tid < 32) lcnt[tid] = 0;
            gl = 0; grp0 = grp + gridDim.x;
        }
        __syncthreads();
    }
}

__device__ __forceinline__ void compute_pstart(const Params& p, unsigned char* lds) {
    int* ps = (int*)(lds + LDS_PS); int* cn = (int*)(lds + LDS_CNT);
    if (threadIdx.x < 64) {
        const int lane = threadIdx.x;
        const int* CNT = (const int*)(p.ws + WS_CTL) + CW_CNT;
        const int c = lane < NE ? __hip_atomic_load(&CNT[lane], __ATOMIC_RELAXED, __HIP_MEMORY_SCOPE_AGENT) : 0;
        int incl = (c + 255) & ~255;
#pragma unroll
        for (int o = 1; o < 32; o <<= 1) { const int t = __shfl_up(incl, o); if (lane >= o) incl += t; }
        if (lane < NE) { ps[lane + 1] = incl; cn[lane] = c; }
        if (lane == 0) ps[0] = 0;
    }
    __syncthreads();
}

struct EpiUp {
    static constexpr bool PERM = true;
    bf16_t* ACT; const float* bgu;
    __device__ __forceinline__ void operator()(const f32x4 (&acc)[2][2][4][2], const pg8::Unit& u, int wr, int wc, int fr, int fq) const {
#pragma unroll
        for (int bj = 0; bj < 2; ++bj) {
            const int grp = 8 * u.pn + 4 * bj + wc, jc = 16 * grp + 4 * fq;
            const float* bp = bgu + (size_t)(u.e & 31) * 2048 + 2 * jc;
            const float4 b01 = *(const float4*)bp, b23 = *(const float4*)(bp + 4);
            const float bg[4] = {b01.x, b01.z, b23.x, b23.z}, bl[4] = {b01.y, b01.w, b23.y, b23.w};
#pragma unroll
            for (int ai = 0; ai < 2; ++ai)
#pragma unroll
                for (int m = 0; m < 4; ++m) { const int row = u.row0 + 128 * ai + 64 * wr + 16 * m + fr;
                    float a[4];
#pragma unroll
                    for (int j = 0; j < 4; ++j) { float gl = acc[ai][bj][m][0][j] + bg[j], ln = acc[ai][bj][m][1][j] + bl[j];
                        gl = fminf(gl, 7.f); ln = fminf(fmaxf(ln, -7.f), 7.f);
                        a[j] = gl / (1.f + fexp(-1.702f * gl)) * (ln + 1.f); }
                    uint2 o; o.x = pk2(a[0], a[1]); o.y = pk2(a[2], a[3]);
                    *(uint2*)(ACT + (size_t)row * DFF + jc) = o; }
        }
    }
};
__device__ void phase_moe_up(const Params& p, unsigned char* lds) {
    int* ps = (int*)(lds + LDS_PS);
    compute_pstart(p, lds);
    pg8::MoeSched<true> Sm; Sm.init(p.ws + WS_H, p.ws + WS_WGUT, D, 8, 2048, ps, (const int*)(p.ws + WS_TOK));
    EpiUp E{(bf16_t*)(p.ws + WS_ACT), p.b_gate_up};
    pg8::gemm_phase<EpiUp, pg8::MoeSched<true>>((LAS unsigned char*)lds, D, Sm, E);
}

struct EpiDown {
    static constexpr bool PERM = true;
    bf16_t* YE; const float* bd;
    __device__ __forceinline__ void operator()(const f32x4 (&acc)[2][2][4][2], const pg8::Unit& u, int wr, int wc, int fr, int fq) const {
#pragma unroll
        for (int bj = 0; bj < 2; ++bj) {
            const int c0 = 256 * u.pn + 128 * bj + 32 * wc + 8 * fq;
            const float* bp = bd + (size_t)(u.e & 31) * D + c0;
            const float4 b0 = *(const float4*)bp, b1 = *(const float4*)(bp + 4);
#pragma unroll
            for (int ai = 0; ai < 2; ++ai)
#pragma unroll
                for (int m = 0; m < 4; ++m) { const int row = u.row0 + 128 * ai + 64 * wr + 16 * m + fr;
                    const f32x4 v0 = acc[ai][bj][m][0], v1 = acc[ai][bj][m][1];
                    u32x4 w; w.x = pk2(v0[0] + b0.x, v0[1] + b0.y); w.y = pk2(v0[2] + b0.z, v0[3] + b0.w); w.z = pk2(v1[0] + b1.x, v1[1] + b1.y); w.w = pk2(v1[2] + b1.z, v1[3] + b1.w);
                    *(u32x4*)(YE + (size_t)row * D + c0) = w; }
        }
    }
};
struct EpiMoe {
    static constexpr bool PERM = true;
    EpiUp up; EpiDown dn;
    __device__ __forceinline__ void operator()(const f32x4 (&acc)[2][2][4][2], const pg8::Unit& u, int wr, int wc, int fr, int fq) const {
        if ((u.e & 32) == 0) up(acc, u, wr, wc, fr, fq); else dn(acc, u, wr, wc, fr, fq);
    }
};
__device__ void phase_moe(const Params& p, unsigned char* lds) {
    int* ps = (int*)(lds + LDS_PS);
    compute_pstart(p, lds);
    const volatile unsigned* xs = (const volatile unsigned*)(lds + LDS_BARW);
    pg8::MoeSched2 Sm; Sm.init(p.ws, ps, (int)xs[0], (int)xs[2], (int)xs[3]);
    EpiMoe E{EpiUp{(bf16_t*)(p.ws + WS_ACT), p.b_gate_up}, EpiDown{(bf16_t*)(p.ws + WS_YE), p.b_down}};
    pg8::gemm_phase<EpiMoe, pg8::MoeSched2>((LAS unsigned char*)lds, D, Sm, E);
}
__device__ void phase_moe_down(const Params& p, unsigned char* lds) {
    int* ps = (int*)(lds + LDS_PS);
    compute_pstart(p, lds);
    pg8::MoeSched<false> Sm; Sm.init(p.ws + WS_ACT, p.ws + WS_WDT, DFF, 4, 1024, ps, nullptr);
    EpiDown E{(bf16_t*)(p.ws + WS_YE), p.b_down};
    pg8::gemm_phase<EpiDown, pg8::MoeSched<false>>((LAS unsigned char*)lds, DFF, Sm, E);
}

__device__ void phase_combine(const Params& p, unsigned char* lds) {
    const int tid = threadIdx.x, lane = tid & 63, wave = tid >> 6;
    unsigned char* ws = p.ws;
    const float* mod = (const float*)(ws + WS_MOD);
    const bf16_t* YE = (const bf16_t*)(ws + WS_YE);
    const bf16_t* X1 = (const bf16_t*)(ws + WS_X1);
    const int* TOPI = (const int*)(ws + WS_TOPI); const int* POS = (const int*)(ws + WS_POS); const float* GATE = (const float*)(ws + WS_GATE);
    compute_pstart(p, lds);
    const int* ps = (const int*)(lds + LDS_PS);
    for (int m0 = (blockIdx.x * NW + wave) * 2; m0 < T; m0 += gridDim.x * NW * 2) {
        const int4 te0 = *(const int4*)(TOPI + m0 * 4), te1 = *(const int4*)(TOPI + m0 * 4 + 4), tp0 = *(const int4*)(POS + m0 * 4), tp1 = *(const int4*)(POS + m0 * 4 + 4);
        const float4 gk0 = *(const float4*)(GATE + m0 * 4), gk1 = *(const float4*)(GATE + m0 * 4 + 4);
        const int slot[2][4] = {{ps[te0.x] + tp0.x, ps[te0.y] + tp0.y, ps[te0.z] + tp0.z, ps[te0.w] + tp0.w}, {ps[te1.x] + tp1.x, ps[te1.y] + tp1.y, ps[te1.z] + tp1.z, ps[te1.w] + tp1.w}};
        const float gk[2][4] = {{gk0.x, gk0.y, gk0.z, gk0.w}, {gk1.x, gk1.y, gk1.z, gk1.w}};
        uint2 u[2][4][4]; float4 x1[2][4];
#pragma unroll
        for (int q = 0; q < 2; ++q) {
#pragma unroll
            for (int k = 0; k < 4; ++k) { const uint2* yr = (const uint2*)(YE + (size_t)slot[q][k] * D) + lane;
#pragma unroll
                for (int j = 0; j < 4; ++j) u[q][k][j] = ntload2(yr + 64 * j); }
            const uint2* xr = (const uint2*)(X1 + (size_t)(m0 + q) * D) + lane;
#pragma unroll
            for (int j = 0; j < 4; ++j) { const uint2 w = ntload2(xr + 64 * j);
                x1[q][j] = make_float4(bf2f((unsigned short)(w.x & 0xffff)), bf2f((unsigned short)(w.x >> 16)), bf2f((unsigned short)(w.y & 0xffff)), bf2f((unsigned short)(w.y >> 16))); }
        }
#pragma unroll
        for (int q = 0; q < 2; ++q) {
            const int m = m0 + q, b = m >> 13;
            float4 y[4];
#pragma unroll
            for (int j = 0; j < 4; ++j) { y[j] = make_float4(0.f, 0.f, 0.f, 0.f);
#pragma unroll
                for (int k = 0; k < 4; ++k) { const uint2 w = u[q][k][j]; const float g = gk[q][k];
                    y[j].x += g * bf2f((unsigned short)(w.x & 0xffff)); y[j].y += g * bf2f((unsigned short)(w.x >> 16));
                    y[j].z += g * bf2f((unsigned short)(w.y & 0xffff)); y[j].w += g * bf2f((unsigned short)(w.y >> 16)); } }
            float ss = 0.f;
#pragma unroll
            for (int j = 0; j < 4; ++j) ss += y[j].x * y[j].x + y[j].y * y[j].y + y[j].z * y[j].z + y[j].w * y[j].w;
            const float rstd = rsqrtf(wave_sum(ss) * (1.f / D) + EPS);
#pragma unroll
            for (int j = 0; j < 4; ++j) { const int c = 4 * lane + 256 * j;
                const float4 g = *(const float4*)(p.g_post_ffn + c), gt = *(const float4*)(mod + b * 6144 + 5120 + c);
                float4 o;
                o.x = x1[q][j].x + gt.x * (y[j].x * rstd * g.x); o.y = x1[q][j].y + gt.y * (y[j].y * rstd * g.y);
                o.z = x1[q][j].z + gt.z * (y[j].z * rstd * g.z); o.w = x1[q][j].w + gt.w * (y[j].w * rstd * g.w);
                ntstore4((float4*)(p.out + (size_t)m * D + c), o); }
        }
    }
}

#define XB_TMO      128
#define XB_XCNT(j)  (256  + 64 * (j))
#define XB_XSUB(j)  (1280 + 64 * (j))
#define XB_XGEN(j)  (2304 + 64 * (j))
#define XB_TOP      3328
#define XB_TOPGEN   3392
#define XCD_BAR_WORDS 3456
#define XB_SPIN_CAP (1u << 18)
__device__ __forceinline__ unsigned xb_ld(unsigned* p)              { return __hip_atomic_load(p, __ATOMIC_RELAXED, __HIP_MEMORY_SCOPE_AGENT); }
__device__ __forceinline__ unsigned xb_add(unsigned* p, unsigned v) { return __hip_atomic_fetch_add(p, v, __ATOMIC_RELAXED, __HIP_MEMORY_SCOPE_AGENT); }
__device__ __forceinline__ unsigned xb_xcc_id() { return (unsigned)__builtin_amdgcn_s_getreg((3 << 11) | 20) & 0xFu; }
#define XB_SPIN(cond, bar) do { unsigned _sp = 0; while (cond) { __builtin_amdgcn_s_sleep(1); \
    if ((++_sp & 255u) == 0u) { if (xb_ld(&(bar)[XB_TMO])) break; if (_sp > XB_SPIN_CAP) { atomicAdd(&(bar)[XB_TMO], 1u); break; } } } } while (0)
struct XcdBarrier { unsigned* bar; unsigned x; volatile LAS unsigned* st; };
__device__ __forceinline__ XcdBarrier xcd_barrier_post(unsigned* bar, volatile LAS unsigned* st) {
    XcdBarrier b; b.bar = bar; b.x = xb_xcc_id(); b.st = st;
    if (threadIdx.x == 0) st[2] = xb_add(&bar[XB_XCNT(b.x)], 1u);
    return b;
}
__device__ __forceinline__ void xcd_barrier_complete(unsigned* bar, unsigned x, unsigned& nloc, unsigned& nx, unsigned& base) {
    const unsigned G = gridDim.x * gridDim.y * gridDim.z;
    unsigned sum, cnt, mine, sp = 0u;
    for (;;) {
        sum = 0u; cnt = 0u; mine = 0u; base = 0u;
#pragma unroll
        for (unsigned j = 0; j < 16; ++j) { const unsigned c = xb_ld(&bar[XB_XCNT(j)]); sum += c; cnt += (c > 0u) ? 1u : 0u; mine = (j == x) ? c : mine; base += (j < x) ? c : 0u; }
        if (sum == G) break;
        __builtin_amdgcn_s_sleep(1);
        if ((++sp & 255u) == 0u) { if (xb_ld(&bar[XB_TMO])) break; if (sp > XB_SPIN_CAP) { atomicAdd(&bar[XB_TMO], 1u); break; } }
    }
    nloc = mine > 0u ? mine : 1u; nx = cnt > 0u ? cnt : 1u;
}
__device__ __forceinline__ void xcd_barrier(const XcdBarrier& b) {
    asm volatile("s_waitcnt vmcnt(0)" ::: "memory");
    __syncthreads();
    if (threadIdx.x == 0) {
        unsigned* bar = b.bar;
        __builtin_amdgcn_s_waitcnt(0);
        unsigned nloc = b.st[0], nx = b.st[1];
        if (nloc == 0u) { unsigned base; xcd_barrier_complete(bar, b.x, nloc, nx, base); b.st[0] = nloc; b.st[1] = nx; b.st[3] = base; }
        const unsigned old = xb_add(&bar[XB_XSUB(b.x)], 1u);
        const unsigned gen = old / nloc;
        if (old + 1u == (gen + 1u) * nloc) {
            __builtin_amdgcn_fence(__ATOMIC_RELEASE, "agent");
            asm volatile("s_waitcnt vmcnt(0)" ::: "memory");
            const unsigned og = xb_add(&bar[XB_TOP], 1u);
            const unsigned tg = og / nx;
            if (og + 1u == (tg + 1u) * nx) xb_add(&bar[XB_TOPGEN], 1u);
            else XB_SPIN(xb_ld(&bar[XB_TOPGEN]) == tg, bar);
            __builtin_amdgcn_fence(__ATOMIC_ACQUIRE, "agent");
            xb_add(&bar[XB_XGEN(b.x)], 1u);
            asm volatile("s_waitcnt vmcnt(0)" ::: "memory");
        } else {
            XB_SPIN(xb_ld(&bar[XB_XGEN(b.x)]) == gen, bar);
            __builtin_amdgcn_fence(__ATOMIC_ACQUIRE, "agent");
            asm volatile("s_waitcnt vmcnt(0)" ::: "memory");
        }
    }
    __syncthreads();
}

__global__ void __launch_bounds__(NTHREADS, 2) fwd_kernel(Params p) {
    extern __shared__ __attribute__((aligned(16))) unsigned char lds[];
    const int lo = p.ph_lo, hi = p.ph_hi;
    volatile LAS unsigned* st = (volatile LAS unsigned*)(lds + LDS_BARW);
    if (threadIdx.x == 0) { st[0] = 0u; st[1] = 0u; }
    __syncthreads();
    XcdBarrier bar; bar.bar = (unsigned*)(p.ws + WS_CTL); bar.x = 0; bar.st = st;
    if (hi - lo > 1) bar = xcd_barrier_post((unsigned*)(p.ws + WS_CTL), st);
#ifndef PROBE_DUP
#define PROBE_DUP -1
#endif
#define PHASE(k, call) if (lo <= (k) && (k) < hi) { const int nrep = ((k) == PROBE_DUP) ? hi - 9 : 1; for (int rep = 0; rep < nrep; ++rep) { const bool dry = rep > 0; (void)dry; call; if (rep + 1 < nrep) __syncthreads(); } if ((k) + 1 < hi) xcd_barrier(bar); }
    PHASE(0, { phase_prep(p, lds); phase_prenorm(p); })
    PHASE(2, phase_gemm_in(p, lds))
    PHASE(3, { vtrans_items(p, lds); gla1_items(p, lds); })
    PHASE(4, { gla2_scan(p); phase_attn(p, lds); })
    PHASE(5, gla3_items(p, lds))
    PHASE(6, phase_gemm_out(p, lds))
    PHASE(7, phase_postmix(p, lds, dry))
    PHASE(8, phase_moe(p, lds))
    PHASE(10, phase_combine(p, lds))
#undef PHASE
}

extern "C" void kernel_launch(void* const* d_in, const int* in_sizes, int n_in, void* d_out, int out_size, void* d_ws, size_t ws_size, hipStream_t stream) {
    static int grid_blocks = 0;
    if (grid_blocks == 0) {
        if (n_in != 19 || out_size != T * D || ws_size < WS_END) { fprintf(stderr, "kernel_launch: unexpected shapes (n_in %d out %d ws %zu need %zu)\n", n_in, out_size, ws_size, (size_t)WS_END); grid_blocks = -1; return; }
        int dev = 0, cus = 0, per_cu = 0;
        (void)hipGetDevice(&dev);
        (void)hipDeviceGetAttribute(&cus, hipDeviceAttributeMultiprocessorCount, dev);
        if (hipFuncSetAttribute((const void*)fwd_kernel, hipFuncAttributeMaxDynamicSharedMemorySize, LDS_BYTES) != hipSuccess) { fprintf(stderr, "kernel_launch: hipFuncSetAttribute failed\n"); grid_blocks = -1; return; }
        (void)hipOccupancyMaxActiveBlocksPerMultiprocessor(&per_cu, fwd_kernel, NTHREADS, LDS_BYTES);
        if (per_cu < 1) { fprintf(stderr, "kernel_launch: occupancy query reports %d blocks per CU\n", per_cu); per_cu = 1; }
        grid_blocks = cus;
        (void)hipGetLastError();
    }
    if (grid_blocks < 0) return;
    (void)hipMemsetAsync((char*)d_ws + WS_CTL, 0, CTL_BYTES, stream);
    Params p{};
    p.x = (const float*)d_in[0]; p.c = (const float*)d_in[1]; p.w_mod = (const float*)d_in[2]; p.b_mod = (const float*)d_in[3];
    p.g_pre_mix = (const float*)d_in[4]; p.w_in = (const float*)d_in[5]; p.w_gate_lr = (const float*)d_in[6]; p.b_gate = (const float*)d_in[7];
    p.g_gla = (const float*)d_in[8]; p.w_out = (const float*)d_in[9]; p.g_post_mix = (const float*)d_in[10]; p.g_pre_ffn = (const float*)d_in[11];
    p.router_w = (const float*)d_in[12]; p.router_b = (const float*)d_in[13]; p.w_gate_up = (const float*)d_in[14]; p.b_gate_up = (const float*)d_in[15];
    p.w_down = (const float*)d_in[16]; p.b_down = (const float*)d_in[17]; p.g_post_ffn = (const float*)d_in[18];
    p.out = (float*)d_out; p.ws = (unsigned char*)d_ws;
    for (int d = 0; d < 32; ++d) p.inv_freq[d] = powf(10000.0f, -(float)d / 32.0f);
#if ONE_LAUNCH
    p.ph_lo = 0; p.ph_hi = NPHASE;
    void* args[] = {&p};
    hipError_t e = hipLaunchCooperativeKernel((void*)fwd_kernel, dim3(grid_blocks), dim3(NTHREADS), args, LDS_BYTES, stream);
    if (e != hipSuccess) fprintf(stderr, "cooperative launch failed: %s (grid %d)\n", hipGetErrorString(e), grid_blocks);
#else
    for (int k = 0; k < NPHASE; ++k) { p.ph_lo = k; p.ph_hi = k + 1; hipLaunchKernelGGL(fwd_kernel, dim3(grid_blocks), dim3(NTHREADS), LDS_BYTES, stream, p); }
#endif
}
```

```cpp
#include <hip/hip_runtime.h>
#include <cstdio>
#include <cstdint>
#include <cmath>

#ifndef ONE_LAUNCH
#define ONE_LAUNCH 1
#endif

typedef unsigned short bf16_t;
typedef short bf16x8 __attribute__((ext_vector_type(8)));
typedef float f32x4 __attribute__((ext_vector_type(4)));
typedef unsigned u32x4 __attribute__((ext_vector_type(4)));
#define LAS __attribute__((address_space(3)))

constexpr int T = 16384, D = 1024, S = 8192;
constexpr int DIN = 3088, DINP = 3104;
constexpr int NE = 32, DFF = 1024;
constexpr int PMAX = 65536 + NE * 256;
constexpr int NTHREADS = 512, NW = 8;
constexpr int LDS_STAGE = 131072;
constexpr int LDS_PS = LDS_STAGE;
constexpr int LDS_BARW = LDS_STAGE + 256;
constexpr int LDS_CNT = LDS_STAGE + 512;
constexpr int LDS_TOKB = LDS_STAGE + 1024;
constexpr int LDS_BYTES = LDS_STAGE + 4096;
constexpr int NPHASE = 11;
constexpr float EPS = 1e-6f;
constexpr float LOG2E = 1.4426950408889634f;

constexpr size_t al(size_t x) { return (x + 255) & ~(size_t)255; }
constexpr size_t WS_CTL   = 0;
constexpr size_t CTL_BYTES = 65536;
constexpr size_t WS_MOD   = WS_CTL + CTL_BYTES;
constexpr size_t WS_ROPE  = al(WS_MOD + 2 * 6144 * 4);
constexpr size_t WS_WINT  = al(WS_ROPE + (size_t)S * 32 * 2 * 4);
constexpr size_t WS_WOUTT = al(WS_WINT + (size_t)DINP * D * 2);
constexpr size_t WS_WGUT  = al(WS_WOUTT + (size_t)D * D * 2);
constexpr size_t WS_WDT   = al(WS_WGUT + (size_t)NE * 2048 * D * 2);
constexpr size_t WS_H     = al(WS_WDT + (size_t)NE * D * DFF * 2);
constexpr size_t WS_QA    = al(WS_H + (size_t)T * D * 2);
constexpr size_t WS_KA    = al(WS_QA + (size_t)T * 512 * 2);
constexpr size_t WS_VA    = al(WS_KA + (size_t)T * 512 * 2);
constexpr size_t WS_VB    = al(WS_VA + (size_t)T * 512 * 2);
constexpr size_t WS_QG    = al(WS_VB + (size_t)T * 512 * 2);
constexpr size_t WS_KG    = al(WS_QG + (size_t)T * 256 * 2);
constexpr size_t WS_VG    = al(WS_KG + (size_t)T * 256 * 2);
constexpr size_t WS_RG    = al(WS_VG + (size_t)T * 512 * 2);
constexpr size_t WS_GLR   = al(WS_RG + (size_t)T * 512 * 2);
constexpr size_t WS_UT    = al(WS_GLR + (size_t)T * 16 * 4);
constexpr size_t WS_AG    = al(WS_UT + (size_t)1024 * 128 * 64 * 4);
constexpr size_t WS_SPT   = al(WS_AG + (size_t)1024 * 64 * 4);
constexpr size_t WS_CAT   = al(WS_SPT + (size_t)1024 * 128 * 64 * 2);
constexpr size_t WS_TOPI  = al(WS_CAT + (size_t)T * D * 2);
constexpr size_t WS_GATE  = al(WS_TOPI + (size_t)T * 4 * 4);
constexpr size_t WS_POS   = al(WS_GATE + (size_t)T * 4 * 4);
constexpr size_t WS_SLOT  = al(WS_POS + (size_t)T * 4 * 4);
constexpr size_t WS_TOK   = al(WS_SLOT + (size_t)T * 4 * 4);
constexpr size_t WS_ACT   = al(WS_TOK + (size_t)NE * T * 4);
constexpr size_t WS_YMIX  = WS_ACT;
constexpr size_t WS_X1    = WS_UT;
constexpr size_t WS_YE    = al(WS_ACT + (size_t)PMAX * DFF * 2);
constexpr size_t WS_IDT   = al(WS_YE + (size_t)PMAX * D * 2);
constexpr size_t WS_END   = al(WS_IDT + (size_t)PMAX * 4);
static_assert((size_t)T * D * 4 <= (size_t)PMAX * DFF * 2, "YMIX alias fits in ACT");
static_assert(WS_X1 + (size_t)T * D * 2 <= WS_AG, "X1 alias fits in UT");
constexpr int CW_CNT = 4096;
constexpr int CW_UPCNT = 4352;
constexpr int CW_MODCNT = 4224;

struct Params {
    const float *x, *c, *w_mod, *b_mod, *g_pre_mix, *w_in, *w_gate_lr, *b_gate, *g_gla, *w_out, *g_post_mix, *g_pre_ffn,
                *router_w, *router_b, *w_gate_up, *b_gate_up, *w_down, *b_down, *g_post_ffn;
    float* out; unsigned char* ws;
    int ph_lo, ph_hi;
    float inv_freq[32];
};

__device__ __forceinline__ unsigned f2bf(float f) { unsigned u = __builtin_bit_cast(unsigned, f); return (u + 0x7fffu + ((u >> 16) & 1u)) >> 16; }
typedef float f32x2_t __attribute__((ext_vector_type(2))); typedef __bf16 bf16x2_t __attribute__((ext_vector_type(2)));
__device__ __forceinline__ unsigned pk2(float lo, float hi) { f32x2_t v = {lo, hi}; bf16x2_t b = __builtin_convertvector(v, bf16x2_t); return __builtin_bit_cast(unsigned, b); }
__device__ __forceinline__ float bf2f(unsigned short b) { return __builtin_bit_cast(float, (unsigned)b << 16); }
__device__ __forceinline__ float4 ntload4(const float4* p) { const f32x4 t = __builtin_nontemporal_load((const f32x4*)p); return make_float4(t[0], t[1], t[2], t[3]); }
__device__ __forceinline__ uint2 ntload2(const uint2* p) { typedef unsigned u32x2 __attribute__((ext_vector_type(2))); const u32x2 t = __builtin_nontemporal_load((const u32x2*)p); return make_uint2(t[0], t[1]); }
__device__ __forceinline__ void ntstore4(float4* p, float4 v) { const f32x4 t = {v.x, v.y, v.z, v.w}; __builtin_nontemporal_store(t, (f32x4*)p); }
__device__ __forceinline__ void ntstore2(uint2* p, uint2 v) { typedef unsigned u32x2 __attribute__((ext_vector_type(2))); const u32x2 t = {v.x, v.y}; __builtin_nontemporal_store(t, (u32x2*)p); }
__device__ __forceinline__ void ntstore4u(uint4* p, uint4 v) { const u32x4 t = {v.x, v.y, v.z, v.w}; __builtin_nontemporal_store(t, (u32x4*)p); }
__device__ __forceinline__ float wave_sum(float v) {
#pragma unroll
    for (int o = 1; o < 64; o <<= 1) v += __shfl_xor(v, o);
    return v;
}
__device__ __forceinline__ float fexp2(float x) { return __builtin_amdgcn_exp2f(x); }
__device__ __forceinline__ float fexp(float x) { return __builtin_amdgcn_exp2f(x * LOG2E); }
__device__ __forceinline__ float flog(float x) { return __builtin_amdgcn_logf(x) * 0.6931471805599453f; }
__device__ __forceinline__ float fsilu(float x) { return x / (1.f + fexp(-x)); }

#define GAS __attribute__((address_space(1)))
namespace pg8 {
constexpr int BM = 256, BK = 64, HALF = 128, HTB = HALF * BK * 2, NXCD = 8, WGM = 8;
__host__ __device__ __forceinline__ int lds_byte(int r, int c) { const int st = (r >> 4) * 2 + (c >> 5), rr = r & 15, cc = c & 31, ob = rr * 64 + cc * 2; return st * 1024 + (ob ^ (((ob >> 9) & 1) << 5)); }
__host__ __device__ __forceinline__ void stage_rc(int b, int& R, int& C) { const int st = b / 1024, sb = b % 1024, swz = sb ^ (((sb >> 9) & 1) << 5); R = (st >> 1) * 16 + swz / 64; C = (st & 1) * 32 + (swz % 64) / 2; }
__host__ __device__ __forceinline__ int perm32(int rho) { const int n = rho >> 4, i = rho & 15; return 8 * (i >> 2) + 4 * n + (i & 3); }

struct Unit { const char* A; const char* B; unsigned ao[2][2]; int row0, pn, e, nvalid, tb0; };

__device__ __forceinline__ int xcd_remap(int wgid, int nwg) { const int q = nwg / NXCD, r = nwg % NXCD, xcd = wgid % NXCD, off = wgid / NXCD; return (xcd < r ? xcd * (q + 1) : r * (q + 1) + (xcd - r) * q) + off; }
__device__ __forceinline__ const char* uptr(const char* p) {
    const unsigned long long v = (unsigned long long)p;
    const unsigned lo = __builtin_amdgcn_readfirstlane((unsigned)v), hi = __builtin_amdgcn_readfirstlane((unsigned)(v >> 32));
    return (const char*)(((unsigned long long)hi << 32) | lo);
}

template <class Epi, class Sched>
__device__ __forceinline__ void gemm_phase(LAS unsigned char* lds, const int K, const Sched& S, const Epi& E) {
    constexpr bool GATHER = Sched::GATHER;
    const int tid = threadIdx.x, wid = __builtin_amdgcn_readfirstlane(tid >> 6), lane = tid & 63, wr = wid >> 2, wc = wid & 3, fr = lane & 15, fq = lane >> 4;
    const int nt = K / BK;
    unsigned voffA[2], voffB[2];
#pragma unroll
    for (int i = 0; i < 2; ++i) { int R, C; stage_rc(tid * 16 + i * 8192, R, C); const int Rb = Epi::PERM ? ((R & ~31) + perm32(R & 31)) : R;
        voffA[i] = (unsigned)(R * K + C) * 2u; voffB[i] = (unsigned)(Rb * K + C) * 2u; }
    const size_t kstep = (size_t)(BK * 2);
    const size_t hstep = (size_t)HALF * K * 2;
    const unsigned ldsw = (unsigned)wid * 1024u;
    const int aoff = lds_byte(wr * 64 + fr, fq * 8), boff = lds_byte(wc * 32 + fr, fq * 8);
#define PG8_SA(b, h) (((b) * 2 + (h)) * HTB)
#define PG8_SB(b, h) ((4 + (b) * 2 + (h)) * HTB)
#define PG8_STAGE(bufoff, gbase, voff) do { _Pragma("unroll") for (int _i = 0; _i < 2; ++_i) \
        __builtin_amdgcn_global_load_lds((const unsigned*)((const char*)(gbase) + (voff)[_i]), (LAS unsigned*)(lds + (bufoff) + ldsw + _i * 8192), 16, 0, 0); } while (0)
#define PG8_STAGE_A(bufoff, ap, ao, h) do { if constexpr (GATHER) PG8_STAGE(bufoff, ap, (ao)[h]); else PG8_STAGE(bufoff, (ap) + (size_t)(h) * hstep, voffA); } while (0)
#define PG8_LDA(dst, b, h) do { _Pragma("unroll") for (int m = 0; m < 4; ++m) _Pragma("unroll") for (int k = 0; k < 2; ++k) dst[m][k] = *(const LAS bf16x8*)(lds + PG8_SA(b, h) + aoff + m * 2048 + k * 1024); } while (0)
#define PG8_LDB(dst, b, h) do { _Pragma("unroll") for (int n = 0; n < 2; ++n) _Pragma("unroll") for (int k = 0; k < 2; ++k) dst[n][k] = *(const LAS bf16x8*)(lds + PG8_SB(b, h) + boff + n * 2048 + k * 1024); } while (0)
#define PG8_MMA(ai, bj, At, Bt) do { __builtin_amdgcn_s_setprio(1); _Pragma("unroll") for (int m = 0; m < 4; ++m) _Pragma("unroll") for (int n = 0; n < 2; ++n) _Pragma("unroll") for (int k = 0; k < 2; ++k) \
        acc[ai][bj][m][n] = __builtin_amdgcn_mfma_f32_16x16x32_bf16(Bt[n][k], At[m][k], acc[ai][bj][m][n], 0, 0, 0); __builtin_amdgcn_s_setprio(0); } while (0)
#define PG8_UCOPY(d, s_) do { (d).A = (s_).A; (d).B = (s_).B; (d).row0 = (s_).row0; (d).pn = (s_).pn; (d).e = (s_).e; (d).nvalid = (s_).nvalid; (d).tb0 = (s_).tb0; } while (0)
#define PG8_WAIT_V(n) asm volatile("s_waitcnt vmcnt(" #n ")" ::: "memory")
#define PG8_WAIT_L(n) asm volatile("s_waitcnt lgkmcnt(" #n ")" ::: "memory")
#define PG8_BAR __builtin_amdgcn_s_barrier()
#define PG8_SCHED __builtin_amdgcn_sched_barrier(0)
    Unit cur, nxt; int ui = 0;
    int pend = -1;
    if (!S.next(0, cur)) return;
    if constexpr (GATHER) S.first_rows(cur);
    f32x4 acc[2][2][4][2];
#pragma unroll
    for (int a = 0; a < 2; ++a)
#pragma unroll
        for (int b = 0; b < 2; ++b)
#pragma unroll
            for (int m = 0; m < 4; ++m)
#pragma unroll
                for (int n = 0; n < 2; ++n) acc[a][b][m][n] = (f32x4){0.f, 0.f, 0.f, 0.f};
    bf16x8 At[4][2], B0[2][2], B1[2][2];
#ifndef PG8_SP2
#define PG8_SP2 1
#endif
#if PG8_SP2
    PG8_STAGE(PG8_SB(0, 0), cur.B, voffB); PG8_STAGE(PG8_SB(0, 1), cur.B + hstep, voffB); PG8_STAGE_A(PG8_SA(0, 0), cur.A, cur.ao, 0); PG8_STAGE_A(PG8_SA(0, 1), cur.A, cur.ao, 1);
    if (wr == 1) PG8_BAR;
    PG8_WAIT_V(2); PG8_BAR;
#else
    PG8_STAGE(PG8_SB(0, 0), cur.B, voffB); PG8_STAGE_A(PG8_SA(0, 0), cur.A, cur.ao, 0); PG8_STAGE(PG8_SB(0, 1), cur.B + hstep, voffB); PG8_STAGE_A(PG8_SA(0, 1), cur.A, cur.ao, 1);
    if (wr == 1) PG8_BAR;
    PG8_WAIT_V(4); PG8_BAR;
#endif
    PG8_STAGE(PG8_SB(1, 0), cur.B + kstep, voffB); PG8_STAGE_A(PG8_SA(1, 0), cur.A + kstep, cur.ao, 0); PG8_STAGE(PG8_SB(1, 1), cur.B + hstep + kstep, voffB);
    PG8_WAIT_V(6); PG8_BAR;
    for (;;) {
        const bool has_next = S.next(ui + 1, nxt);
        if constexpr (GATHER) { if (has_next && wid < 4) S.prefetch_rows(nxt, (LAS unsigned*)(lds + LDS_TOKB + ((ui + 1) & 1) * 1024 + wid * 256), wid, lane); }
        if constexpr (Sched::HOOKS) { if (has_next) S.poll(nxt, (LAS unsigned*)(lds + LDS_BARW + 32 + wid * 4), lane); }
        if (!has_next) { PG8_UCOPY(nxt, cur); }
        for (int t = 0; t < nt; t += 2) {
            const bool last = (t == nt - 2);
            if constexpr (Sched::HOOKS) {
                if (t == 2 && pend >= 0) { S.publish(pend, lane); pend = -1; }
                if (last && has_next) S.a_ready(nxt, (const LAS unsigned*)(lds + LDS_BARW + 32 + wid * 4));
            }
            const char* a1 = cur.A + (size_t)(t + 1) * kstep;
            const char* a2 = last ? nxt.A : cur.A + (size_t)(t + 2) * kstep; const char* b2 = last ? nxt.B : cur.B + (size_t)(t + 2) * kstep;
            const char* a3 = a2 + kstep; const char* b3 = b2 + kstep;
            unsigned o2[2][2];
            if constexpr (GATHER) {
                const LAS int* tb = (const LAS int*)(lds + LDS_TOKB + ((ui + 1) & 1) * 1024);
#pragma unroll
                for (int q = 0; q < 2; ++q) { int R, C; stage_rc(tid * 16 + q * 8192, R, C);
#pragma unroll
                    for (int h = 0; h < 2; ++h) { const int i = h * HALF + R; const int tk = i < nxt.nvalid ? tb[i] : 0; o2[h][q] = (last && has_next) ? (unsigned)(tk * K + C) * 2u : cur.ao[h][q]; } }
            }
#if !PG8_SP2
            PG8_LDB(B0, 0, 0); PG8_SCHED; PG8_LDA(At, 0, 0); PG8_STAGE_A(PG8_SA(1, 1), a1, cur.ao, 1);
            PG8_WAIT_L(8); PG8_BAR; PG8_WAIT_L(0); PG8_MMA(0, 0, At, B0); PG8_BAR; PG8_SCHED;
            PG8_LDB(B1, 0, 1); PG8_STAGE(PG8_SB(0, 0), b2, voffB);
            PG8_BAR; PG8_WAIT_L(0); PG8_MMA(0, 1, At, B1); PG8_BAR;
            PG8_LDA(At, 0, 1); PG8_STAGE_A(PG8_SA(0, 0), a2, o2, 0);
            PG8_BAR; PG8_WAIT_L(0); PG8_MMA(1, 0, At, B0); PG8_BAR; PG8_SCHED;
            PG8_STAGE(PG8_SB(0, 1), b2 + hstep, voffB);
            PG8_WAIT_V(6); PG8_BAR; PG8_MMA(1, 1, At, B1); PG8_BAR;
            PG8_LDB(B0, 1, 0); PG8_SCHED; PG8_LDA(At, 1, 0); PG8_STAGE_A(PG8_SA(0, 1), a2, o2, 1);
            PG8_WAIT_L(8); PG8_BAR; PG8_WAIT_L(0); PG8_MMA(0, 0, At, B0); PG8_BAR; PG8_SCHED;
            PG8_LDB(B1, 1, 1); PG8_STAGE(PG8_SB(1, 0), b3, voffB);
            PG8_BAR; PG8_WAIT_L(0); PG8_MMA(0, 1, At, B1); PG8_BAR;
            PG8_LDA(At, 1, 1); PG8_STAGE_A(PG8_SA(1, 0), a3, o2, 0);
            PG8_BAR; PG8_WAIT_L(0); PG8_MMA(1, 0, At, B0); PG8_BAR; PG8_SCHED;
            PG8_STAGE(PG8_SB(1, 1), b3 + hstep, voffB);
            PG8_WAIT_V(6); PG8_BAR; PG8_MMA(1, 1, At, B1); PG8_BAR;
#else
            PG8_LDB(B0, 0, 0); PG8_LDB(B1, 0, 1); PG8_SCHED; PG8_LDA(At, 0, 0); PG8_STAGE_A(PG8_SA(1, 1), a1, cur.ao, 1);
            PG8_WAIT_V(8); PG8_WAIT_L(0); PG8_BAR; PG8_MMA(0, 0, At, B0); PG8_MMA(0, 1, At, B1); PG8_BAR; PG8_SCHED;
            PG8_LDA(At, 0, 1); PG8_STAGE(PG8_SB(0, 0), b2, voffB); PG8_STAGE(PG8_SB(0, 1), b2 + hstep, voffB); PG8_STAGE_A(PG8_SA(0, 0), a2, o2, 0);
            PG8_WAIT_V(8); PG8_WAIT_L(0); PG8_BAR; PG8_MMA(1, 0, At, B0); PG8_MMA(1, 1, At, B1); PG8_BAR; PG8_SCHED;
            PG8_LDB(B0, 1, 0); PG8_LDB(B1, 1, 1); PG8_SCHED; PG8_LDA(At, 1, 0); PG8_STAGE_A(PG8_SA(0, 1), a2, o2, 1);
            PG8_WAIT_V(8); PG8_WAIT_L(0); PG8_BAR; PG8_MMA(0, 0, At, B0); PG8_MMA(0, 1, At, B1); PG8_BAR; PG8_SCHED;
            PG8_LDA(At, 1, 1); PG8_STAGE(PG8_SB(1, 0), b3, voffB); PG8_STAGE(PG8_SB(1, 1), b3 + hstep, voffB); PG8_STAGE_A(PG8_SA(1, 0), a3, o2, 0);
            PG8_WAIT_V(8); PG8_WAIT_L(0); PG8_BAR; PG8_MMA(1, 0, At, B0); PG8_MMA(1, 1, At, B1); PG8_BAR; PG8_SCHED;
#endif
        }
        if (wr == 0) PG8_BAR;
        E(acc, cur, wr, wc, fr, fq);
        if constexpr (Sched::HOOKS) pend = S.pub_tile(cur);
        if (!has_next) break;
#pragma unroll
        for (int a = 0; a < 2; ++a)
#pragma unroll
            for (int b = 0; b < 2; ++b)
#pragma unroll
                for (int m = 0; m < 4; ++m)
#pragma unroll
                    for (int n = 0; n < 2; ++n) acc[a][b][m][n] = (f32x4){0.f, 0.f, 0.f, 0.f};
        PG8_UCOPY(cur, nxt); ++ui;
        if constexpr (GATHER) {
            const LAS int* tb = (const LAS int*)(lds + LDS_TOKB + (ui & 1) * 1024);
#pragma unroll
            for (int q = 0; q < 2; ++q) { int R, C; stage_rc(tid * 16 + q * 8192, R, C);
#pragma unroll
                for (int h = 0; h < 2; ++h) { const int i = h * HALF + R; const int tk = i < cur.nvalid ? tb[i] : 0; cur.ao[h][q] = (unsigned)(tk * K + C) * 2u; } }
        }
        if (wr == 1) PG8_BAR;
    }
    PG8_WAIT_V(0);
    if constexpr (Sched::HOOKS) { if (pend >= 0) S.publish(pend, lane); }
    PG8_BAR;
#undef PG8_SA
#undef PG8_SB
#undef PG8_STAGE
#undef PG8_STAGE_A
#undef PG8_LDA
#undef PG8_LDB
#undef PG8_MMA
#undef PG8_WAIT_V
#undef PG8_UCOPY
#undef PG8_WAIT_L
#undef PG8_BAR
#undef PG8_SCHED
}

struct DenseSched {
    static constexpr bool GATHER = false, HOOKS = false;
    const char* A; const char* Bt; int K, nM, nN, nwg, G, c;
    __device__ __forceinline__ void init(const void* A_, const void* Bt_, int M, int N, int K_) {
        A = uptr((const char*)A_); Bt = uptr((const char*)Bt_); K = K_; nM = M / BM; nN = N / BM; nwg = nM * nN; G = gridDim.x; c = blockIdx.x;
    }
    __device__ __forceinline__ bool next(int i, Unit& u) const {
        const long L = (long)i * G + c; if (L >= nwg) return false;
        const int wgid = xcd_remap((int)L, nwg);
        const int nig = WGM * nN, gid = wgid / nig, fm = gid * WGM, gsz = (nM - fm) < WGM ? (nM - fm) : WGM;
        const int pm = fm + ((wgid % nig) % gsz), pn = (wgid % nig) / gsz;
        u.A = A + (size_t)pm * BM * K * 2; u.B = Bt + (size_t)pn * BM * K * 2; u.row0 = pm * BM; u.pn = pn; u.e = 0; u.nvalid = BM; u.tb0 = 0;
        return true;
    }
};
template <bool GATHER_>
struct MoeSched {
    static constexpr bool GATHER = GATHER_, HOOKS = false;
    const char* A; const char* W; int K, nN, rows_per_e, nwg, G, c; const int* ps; const int* cn; const int* tok;
    __device__ __forceinline__ void init(const void* A_, const void* W_, int K_, int nN_, int rows_per_e_, const int* ps_, const int* tok_) {
        A = uptr((const char*)A_); W = uptr((const char*)W_); K = K_; nN = nN_; rows_per_e = rows_per_e_; ps = ps_; cn = ps_ + (LDS_CNT - LDS_PS) / 4; tok = (const int*)uptr((const char*)tok_); G = gridDim.x; c = blockIdx.x;
        nwg = __builtin_amdgcn_readfirstlane((ps[NE] >> 8) * nN);
    }
    __device__ __forceinline__ bool next(int i, Unit& u) const {
        const long L = (long)i * G + c; if (L >= nwg) return false;
        const int wgid = xcd_remap((int)L, nwg);
        const int rt = wgid / nN, pn = wgid % nN, slot0 = rt * BM;
        int e = 0;
        for (int q = 1; q < NE; ++q) e = (ps[q] <= slot0) ? q : e;
        e = __builtin_amdgcn_readfirstlane(e);
        u.B = W + ((size_t)e * rows_per_e + (size_t)pn * BM) * K * 2; u.row0 = slot0; u.pn = pn; u.e = e;
        const int pos0 = __builtin_amdgcn_readfirstlane(slot0 - ps[e]);
        u.nvalid = __builtin_amdgcn_readfirstlane(cn[e]) - pos0; u.tb0 = e * T + pos0;
        if constexpr (GATHER) u.A = A; else u.A = A + (size_t)slot0 * K * 2;
        return true;
    }
    __device__ __forceinline__ void first_rows(Unit& u) const {
#pragma unroll
        for (int q = 0; q < 2; ++q) { int R, C; stage_rc(threadIdx.x * 16 + q * 8192, R, C);
#pragma unroll
            for (int h = 0; h < 2; ++h) { const int i = h * HALF + R; const int tk = i < u.nvalid ? tok[u.tb0 + i] : 0; u.ao[h][q] = (unsigned)(tk * K + C) * 2u; } }
    }
    __device__ __forceinline__ void prefetch_rows(const Unit& u, LAS unsigned* dst, int wid, int lane) const {
        __builtin_amdgcn_global_load_lds((const unsigned*)(tok + u.tb0 + wid * 64 + lane), dst, 4, 0, 0);
    }
};
struct MoeSched2 {
    static constexpr bool GATHER = true, HOOKS = true;
    const char* ws; int K, nU, nDl, nwg, G, c, rt0, nexp; const int* ps; const int* cn; const int* tok; const LAS int* imp; GAS int* upcnt;
    __device__ __forceinline__ void init(unsigned char* ws_, const int* ps_, int nloc, int rank, const LAS int* ms) {
        ws = uptr((const char*)ws_); K = D; ps = ps_; cn = ps_ + (LDS_CNT - LDS_PS) / 4; tok = (const int*)(ws + WS_TOK); upcnt = (GAS int*)(ws + WS_CTL) + CW_UPCNT;
        G = __builtin_amdgcn_readfirstlane(nloc); c = __builtin_amdgcn_readfirstlane(rank);
        rt0 = __builtin_amdgcn_readfirstlane(ms[0]); const int nt_ = __builtin_amdgcn_readfirstlane(ms[1]); nexp = __builtin_amdgcn_readfirstlane(ms[2]); const int nimp = __builtin_amdgcn_readfirstlane(ms[3]); imp = ms + 8;
        nU = nt_ * 8; nDl = (nt_ - nexp) * 4; nwg = nU + nDl + nimp * 4;
    }
    __device__ __forceinline__ bool next(int i, Unit& u) const {
        const int L = i * G + c; if (L >= nwg) return false;
        const bool dn = L >= nU;
        int rt, pn, sh = 0;
        if (!dn) { rt = rt0 + (L >> 3); pn = L & 7; sh = (L >> 3) < nexp ? 64 : 0; }
        else if (L < nU + nDl) { const int d = L - nU; rt = rt0 + nexp + (d >> 2); pn = d & 3; }
        else { const int d = L - nU - nDl; rt = __builtin_amdgcn_readfirstlane(imp[d >> 2]); pn = d & 3; sh = 64; }
        const int slot0 = rt * BM;
        int e = 0;
        for (int q = 1; q < NE; ++q) e = (ps[q] <= slot0) ? q : e;
        e = __builtin_amdgcn_readfirstlane(e);
        u.row0 = slot0; u.pn = pn;
        const int pos0 = __builtin_amdgcn_readfirstlane(slot0 - ps[e]);
        if (dn) { u.B = ws + WS_WDT + ((size_t)e * 1024 + (size_t)pn * BM) * (size_t)(D * 2); u.A = ws + WS_ACT; u.e = e | 32 | sh; u.nvalid = BM; u.tb0 = (int)((WS_IDT - WS_TOK) / 4) + slot0; }
        else    { u.B = ws + WS_WGUT + ((size_t)e * 2048 + (size_t)pn * BM) * (size_t)(D * 2); u.A = ws + WS_H; u.e = e | sh; u.nvalid = __builtin_amdgcn_readfirstlane(cn[e]) - pos0; u.tb0 = e * T + pos0; }
        return true;
    }
    __device__ __forceinline__ void first_rows(Unit& u) const {
#pragma unroll
        for (int q = 0; q < 2; ++q) { int R, C; stage_rc(threadIdx.x * 16 + q * 8192, R, C);
#pragma unroll
            for (int h = 0; h < 2; ++h) { const int i = h * HALF + R; const int tk = i < u.nvalid ? tok[u.tb0 + i] : 0; u.ao[h][q] = (unsigned)(tk * K + C) * 2u; } }
    }
    __device__ __forceinline__ void prefetch_rows(const Unit& u, LAS unsigned* dst, int wid, int lane) const {
        __builtin_amdgcn_global_load_lds((const unsigned*)(tok + u.tb0 + wid * 64 + lane), dst, 4, 0, 0);
    }
    __device__ __forceinline__ void poll(const Unit& u, LAS unsigned* w, int lane) const {
        if ((u.e & 32) && lane == 0) __builtin_amdgcn_global_load_lds((const GAS unsigned*)(upcnt + (u.row0 >> 8)), w, 4, 0, 16  );
    }
    __device__ __forceinline__ void a_ready(const Unit& u, const LAS unsigned* w) const {
        if (u.e & 32) {
            const int rdy = __builtin_amdgcn_readfirstlane((int)*w);
            if (rdy < 64) { const GAS int* cp = upcnt + (u.row0 >> 8); int spins = 0;
                while (__hip_atomic_load(cp, __ATOMIC_RELAXED, __HIP_MEMORY_SCOPE_AGENT) < 64 && ++spins < (1 << 22)) __builtin_amdgcn_s_sleep(4); }
            if (u.e & 64) asm volatile("buffer_inv sc1" ::: "memory");
            else asm volatile("" ::: "memory");
        }
    }
    __device__ __forceinline__ int pub_tile(const Unit& u) const { return (u.e & 32) ? -1 : (u.row0 >> 8); }
    __device__ __forceinline__ void publish(int rt, int lane) const { if (lane == 0) __hip_atomic_fetch_add(upcnt + rt, 1, __ATOMIC_RELAXED, __HIP_MEMORY_SCOPE_AGENT); }
};
}

__device__ __forceinline__ int win_row(int oc) {
    if (oc >= 1024) return oc;
    const int base = oc & ~511, o = oc & 511;
    return base + 32 * ((o >> 6) * 2 + ((o & 31) >> 4)) + 8 * ((o & 15) >> 2) + 4 * ((o >> 5) & 1) + (o & 3);
}
__device__ __forceinline__ int wgu_row(int oc) { const int jj = oc >> 1, il = oc & 1; return 32 * (jj >> 4) + 8 * ((jj & 15) >> 2) + 4 * il + (jj & 3); }

struct CvtItem { const float* W; bf16_t* WT; int ldw, nvalid, K, k0, n0, map; };
__device__ __forceinline__ void cvt_load(const CvtItem& it, int lane, float4 (&v)[8]) {
    const int col = it.n0 + (lane & 7) * 4;
    const float* src = it.W + (size_t)(it.k0 + (lane >> 3)) * it.ldw + col;
#pragma unroll
    for (int i = 0; i < 8; ++i) { const f32x4 t = (col < it.nvalid) ? __builtin_nontemporal_load((const f32x4*)(src + (size_t)(8 * i) * it.ldw)) : (f32x4){0.f, 0.f, 0.f, 0.f};
        v[i] = make_float4(t[0], t[1], t[2], t[3]); }
}
__device__ __forceinline__ void cvt_store(const CvtItem& it, int lane, const float4 (&v)[8], float* scr) {
    const int r8 = lane >> 3, c4 = (lane & 7) * 4;
#pragma unroll
    for (int i = 0; i < 8; ++i) { float* d = scr + (8 * i + r8) * 33 + c4; d[0] = v[i].x; d[1] = v[i].y; d[2] = v[i].z; d[3] = v[i].w; }
    asm volatile("s_waitcnt lgkmcnt(0)" ::: "memory");
    const int c = lane & 7;
#pragma unroll
    for (int j = 0; j < 4; ++j) { const int n = (lane >> 3) + 8 * j; const float* s = scr + (8 * c) * 33 + n;
        uint4 o; o.x = pk2(s[0 * 33], s[1 * 33]); o.y = pk2(s[2 * 33], s[3 * 33]); o.z = pk2(s[4 * 33], s[5 * 33]); o.w = pk2(s[6 * 33], s[7 * 33]);
        const int oc = it.n0 + n;
        const int orow = it.map == 1 ? win_row(oc) : (it.map == 2 ? wgu_row(oc) : oc);
        ntstore4u((uint4*)(it.WT + (size_t)orow * it.K + it.k0 + 8 * c), o); }
    asm volatile("s_waitcnt lgkmcnt(0)" ::: "memory");
}
__device__ void phase_prep(const Params& p, unsigned char* lds) {
    const int tid = threadIdx.x, lane = tid & 63, wave = tid >> 6;
    unsigned char* ws = p.ws;
    for (int i = blockIdx.x * NTHREADS + tid; i < PMAX; i += gridDim.x * NTHREADS) ((int*)(ws + WS_IDT))[i] = i;
    if ((int)blockIdx.x < 192) {
        float* sl = (float*)lds;
        float* red = sl + 2048;
        for (int i = tid; i < 2048; i += NTHREADS) sl[i] = fsilu(p.c[i]);
        __syncthreads();
        for (int it = blockIdx.x; it < 192; it += gridDim.x) {
            const int col = it * 32 + (tid & 31), kg = tid >> 5;
            float a0 = 0.f, a1 = 0.f;
#pragma unroll 8
            for (int kk = 0; kk < 64; ++kk) { const int k = kg * 64 + kk; const float w = __builtin_nontemporal_load(p.w_mod + (size_t)k * 6144 + col); a0 += sl[k] * w; a1 += sl[1024 + k] * w; }
            red[(kg * 32 + (tid & 31)) * 2 + 0] = a0; red[(kg * 32 + (tid & 31)) * 2 + 1] = a1;
            __syncthreads();
            if (tid < 64) { const int b = tid >> 5, cg_ = tid & 31; float s = 0.f;
#pragma unroll
                for (int g = 0; g < 16; ++g) s += red[(g * 32 + cg_) * 2 + b];
                const int cc = it * 32 + cg_;
                __hip_atomic_store((float*)(ws + WS_MOD) + b * 6144 + cc, s + p.b_mod[cc], __ATOMIC_RELAXED, __HIP_MEMORY_SCOPE_AGENT);
                asm volatile("s_waitcnt vmcnt(0)" ::: "memory"); }
            __syncthreads();
            if (tid == 0) __hip_atomic_fetch_add((unsigned*)(ws + WS_CTL) + CW_MODCNT, 1u, __ATOMIC_RELAXED, __HIP_MEMORY_SCOPE_AGENT);
        }
    }
    __syncthreads();
    {
        float2* rope = (float2*)(ws + WS_ROPE);
        for (int i = blockIdx.x * NTHREADS + tid; i < S * 32; i += gridDim.x * NTHREADS) {
            const int pos = i >> 5, d = i & 31;
            const float angf = (float)pos * p.inv_freq[d];
            const double ang = (double)angf;
            const double TWO_PI = 6.283185307179586476925286766559, HALF_PI = 1.5707963267948966192313216916398;
            const double n = __builtin_rint(ang / TWO_PI);
            const double rr = ang - n * TWO_PI;
            const double q = __builtin_rint(rr / HALF_PI);
            const double y = rr - q * HALF_PI;
            const double y2 = y * y;
            const double sy = y * (1.0 + y2 * (-1.0 / 6 + y2 * (1.0 / 120 + y2 * (-1.0 / 5040 + y2 * (1.0 / 362880 + y2 * (-1.0 / 39916800 + y2 * (1.0 / 6227020800.0)))))));
            const double cy = 1.0 + y2 * (-0.5 + y2 * (1.0 / 24 + y2 * (-1.0 / 720 + y2 * (1.0 / 40320 + y2 * (-1.0 / 3628800 + y2 * (1.0 / 479001600.0))))));
            const int qi = ((int)q) & 3;
            double cs, sn;
            if (qi == 0) { cs = cy; sn = sy; } else if (qi == 1) { cs = -sy; sn = cy; } else if (qi == 2) { cs = -cy; sn = -sy; } else { cs = sy; sn = -cy; }
            rope[i] = make_float2((float)cs, (float)sn);
        }
    }
    {
        float* scr = (float*)(lds + wave * 8448);
        const int gw = blockIdx.x * NW + wave, ngw = gridDim.x * NW;
        constexpr int I_IN = 16 * 97, I_OUT = 16 * 32, I_GU = 16 * 64, I_DN = 16 * 32;
        constexpr int NITEMS = I_IN + I_OUT + NE * I_GU + NE * I_DN;
        auto decode = [&](int r, CvtItem& it) {
            if (r < I_IN) { it.W = p.w_in; it.WT = (bf16_t*)(ws + WS_WINT); it.ldw = DIN; it.nvalid = DIN; it.K = D; it.k0 = (r / 97) * 64; it.n0 = (r % 97) * 32; it.map = 1; return; }
            r -= I_IN;
            if (r < I_OUT) { it.W = p.w_out; it.WT = (bf16_t*)(ws + WS_WOUTT); it.ldw = D; it.nvalid = D; it.K = D; it.k0 = (r / 32) * 64; it.n0 = (r % 32) * 32; it.map = 0; return; }
            r -= I_OUT;
            if (r < NE * I_GU) { const int e = r / I_GU, q = r % I_GU;
                it.W = p.w_gate_up + (size_t)e * D * 2048; it.WT = (bf16_t*)(ws + WS_WGUT) + (size_t)e * 2048 * D; it.ldw = 2048; it.nvalid = 2048; it.K = D; it.k0 = (q / 64) * 64; it.n0 = (q % 64) * 32; it.map = 2; return; }
            r -= NE * I_GU;
            { const int e = r / I_DN, q = r % I_DN;
                it.W = p.w_down + (size_t)e * DFF * D; it.WT = (bf16_t*)(ws + WS_WDT) + (size_t)e * D * DFF; it.ldw = D; it.nvalid = D; it.K = DFF; it.k0 = (q / 32) * 64; it.n0 = (q % 32) * 32; it.map = 0; }
        };
        if (gw < NITEMS) {
            CvtItem cur, nxt; float4 vc[8], vn[8];
            decode(gw, cur); cvt_load(cur, lane, vc);
            for (int r = gw; r < NITEMS; r += ngw) {
                const bool more = r + ngw < NITEMS;
                if (more) { decode(r + ngw, nxt); cvt_load(nxt, lane, vn); }
                cvt_store(cur, lane, vc, scr);
                if (more) { cur = nxt;
#pragma unroll
                    for (int i = 0; i < 8; ++i) vc[i] = vn[i]; }
            }
        }
    }
}

__device__ void phase_prenorm(const Params& p) {
    const int tid = threadIdx.x, lane = tid & 63, wave = tid >> 6;
    if (tid == 0) {
        unsigned* cnt = (unsigned*)(p.ws + WS_CTL) + CW_MODCNT; unsigned sp = 0;
        while (__hip_atomic_load(cnt, __ATOMIC_RELAXED, __HIP_MEMORY_SCOPE_AGENT) < 192u) { __builtin_amdgcn_s_sleep(2); if (++sp > (1u << 20)) break; }
        __builtin_amdgcn_fence(__ATOMIC_ACQUIRE, "agent");
        asm volatile("s_waitcnt vmcnt(0)" ::: "memory");
    }
    __syncthreads();
    const float* mod = (const float*)(p.ws + WS_MOD);
    bf16_t* H = (bf16_t*)(p.ws + WS_H);
    for (int m0 = (blockIdx.x * NW + wave) * 2; m0 < T; m0 += gridDim.x * NW * 2) {
        float4 v[2][4];
#pragma unroll
        for (int q = 0; q < 2; ++q) { const float4* xr = (const float4*)(p.x + (size_t)(m0 + q) * D) + lane;
#pragma unroll
            for (int j = 0; j < 4; ++j) v[q][j] = ntload4(xr + 64 * j); }
#pragma unroll
        for (int q = 0; q < 2; ++q) {
            const int m = m0 + q, b = m >> 13;
            float ss = 0.f;
#pragma unroll
            for (int j = 0; j < 4; ++j) ss += v[q][j].x * v[q][j].x + v[q][j].y * v[q][j].y + v[q][j].z * v[q][j].z + v[q][j].w * v[q][j].w;
            const float rstd = rsqrtf(wave_sum(ss) * (1.f / D) + EPS);
#pragma unroll
            for (int j = 0; j < 4; ++j) { const int c = 4 * lane + 256 * j;
                const float4 g = *(const float4*)(p.g_pre_mix + c), sh = *(const float4*)(mod + b * 6144 + c), sc = *(const float4*)(mod + b * 6144 + 1024 + c);
                const float h0 = v[q][j].x * rstd * g.x * (1.f + sc.x) + sh.x, h1 = v[q][j].y * rstd * g.y * (1.f + sc.y) + sh.y;
                const float h2 = v[q][j].z * rstd * g.z * (1.f + sc.z) + sh.z, h3 = v[q][j].w * rstd * g.w * (1.f + sc.w) + sh.w;
                uint2 o; o.x = pk2(h0, h1); o.y = pk2(h2, h3);
                *(uint2*)(H + (size_t)m * D + c) = o; }
        }
    }
}

struct EpiIn {
    static constexpr bool PERM = true;
    unsigned char* ws;
    __device__ __forceinline__ void operator()(const f32x4 (&acc)[2][2][4][2], const pg8::Unit& u, int wr, int wc, int fr, int fq) const {
        const int cbase = u.pn * 256;
        if (cbase < 1024) {
            const bool isq = cbase < 512;
            bf16_t* dst = (bf16_t*)(ws + (isq ? WS_QA : WS_KA));
            const float2* rope = (const float2*)(ws + WS_ROPE);
            const float scl = isq ? 0.125f * LOG2E : 1.f;
#pragma unroll
            for (int bj = 0; bj < 2; ++bj) {
                const int grp = ((cbase & 511) >> 5) + 4 * bj + wc, head = grp >> 1, dl = (grp & 1) * 16 + 4 * fq;
#pragma unroll
                for (int ai = 0; ai < 2; ++ai)
#pragma unroll
                    for (int m = 0; m < 4; ++m) { const int row = u.row0 + 128 * ai + 64 * wr + 16 * m + fr, pos = row & (S - 1);
                        const float4 c01 = *(const float4*)(rope + pos * 32 + dl), c23 = *(const float4*)(rope + pos * 32 + dl + 2);
                        const f32x4 x1 = acc[ai][bj][m][0], x2 = acc[ai][bj][m][1];
                        uint2 lo, hi;
                        lo.x = pk2((x1[0] * c01.x - x2[0] * c01.y) * scl, (x1[1] * c01.z - x2[1] * c01.w) * scl);
                        lo.y = pk2((x1[2] * c23.x - x2[2] * c23.y) * scl, (x1[3] * c23.z - x2[3] * c23.w) * scl);
                        hi.x = pk2((x2[0] * c01.x + x1[0] * c01.y) * scl, (x2[1] * c01.z + x1[1] * c01.w) * scl);
                        hi.y = pk2((x2[2] * c23.x + x1[2] * c23.y) * scl, (x2[3] * c23.z + x1[3] * c23.w) * scl);
                        const int bh = (row >> 13) * 8 + head;
                        bf16_t* o = dst + ((size_t)(bh * S + (pos & 15) * 512 + (pos >> 4)) * 64 + dl); *(uint2*)o = lo; *(uint2*)(o + 32) = hi; }
            }
        } else {
            bf16_t* dst; int ldc, cb;
            if (cbase < 1536) { dst = (bf16_t*)(ws + WS_VA); ldc = 512; cb = cbase - 1024; }
            else if (cbase < 1792) { dst = (bf16_t*)(ws + WS_QG); ldc = 256; cb = cbase - 1536; }
            else if (cbase < 2048) { dst = (bf16_t*)(ws + WS_KG); ldc = 256; cb = cbase - 1792; }
            else if (cbase < 2560) { dst = (bf16_t*)(ws + WS_VG); ldc = 512; cb = cbase - 2048; }
            else { dst = (bf16_t*)(ws + WS_RG); ldc = 512; cb = cbase - 2560; }
#pragma unroll
            for (int ai = 0; ai < 2; ++ai)
#pragma unroll
                for (int m = 0; m < 4; ++m) { const int row = u.row0 + 128 * ai + 64 * wr + 16 * m + fr;
#pragma unroll
                    for (int bj = 0; bj < 2; ++bj) { const f32x4 v0 = acc[ai][bj][m][0], v1 = acc[ai][bj][m][1];
                        u32x4 w; w.x = pk2(v0[0], v0[1]); w.y = pk2(v0[2], v0[3]); w.z = pk2(v1[0], v1[1]); w.w = pk2(v1[2], v1[3]);
                        *(u32x4*)(dst + (size_t)row * ldc + cb + 128 * bj + 32 * wc + 8 * fq) = w; } }
        }
    }
};

__device__ void phase_gemm_in(const Params& p, unsigned char* lds) {
    unsigned char* ws = p.ws;
    {
        pg8::DenseSched Sd; Sd.init(ws + WS_H, ws + WS_WINT, T, 3072, D);
        EpiIn E{ws};
        pg8::gemm_phase<EpiIn, pg8::DenseSched>((LAS unsigned char*)lds, D, Sd, E);
    }
    const int tid = threadIdx.x, lane = tid & 63, wave = tid >> 6, fr = lane & 15, fq = lane >> 4;
    const bf16_t* H = (const bf16_t*)(ws + WS_H); const bf16_t* Wl = (const bf16_t*)(ws + WS_WINT) + (size_t)3072 * D;
    float* glr = (float*)(ws + WS_GLR);
    float* part = (float*)lds;
    for (int item = blockIdx.x; item < T / 64; item += gridDim.x) {
        const int mt = wave & 3, kh = wave >> 2, r0 = item * 64 + mt * 16;
        f32x4 a = (f32x4){0.f, 0.f, 0.f, 0.f};
        const bf16_t* ap = H + (size_t)(r0 + fr) * D + kh * 512 + fq * 8;
        const bf16_t* bp = Wl + (size_t)fr * D + kh * 512 + fq * 8;
#pragma unroll 4
        for (int ks = 0; ks < 16; ++ks) a = __builtin_amdgcn_mfma_f32_16x16x32_bf16(*(const bf16x8*)(ap + ks * 32), *(const bf16x8*)(bp + ks * 32), a, 0, 0, 0);
        __syncthreads();
        if (kh == 1) {
#pragma unroll
            for (int j = 0; j < 4; ++j) part[(mt * 16 + 4 * fq + j) * 16 + fr] = a[j];
        }
        __syncthreads();
        if (kh == 0) {
#pragma unroll
            for (int j = 0; j < 4; ++j) glr[(size_t)(r0 + 4 * fq + j) * 16 + fr] = a[j] + part[(mt * 16 + 4 * fq + j) * 16 + fr];
        }
    }
    __syncthreads();
}

__device__ void vtrans_items(const Params& p, unsigned char* lds) {
    const int tid = threadIdx.x;
    unsigned char* ws = p.ws;
    const bf16_t* VA = (const bf16_t*)(ws + WS_VA);
    bf16_t* vb = (bf16_t*)(ws + WS_VB);
    constexpr int VS = 72;
    bf16_t* tile = (bf16_t*)lds;
    for (int item = blockIdx.x; item < 512; item += gridDim.x) {
        const int bh = item >> 5, blk = item & 31, b = bh >> 3, h = bh & 7, pos0 = blk * 256;
        { const int tok = tid >> 1, hf = tid & 1;
          const uint4* src = (const uint4*)(VA + (size_t)(b * S + pos0 + tok) * 512 + h * 64 + hf * 32);
          uint4 v0 = src[0], v1 = src[1], v2 = src[2], v3 = src[3];
          uint4* d = (uint4*)(tile + tok * VS + hf * 32);
          d[0] = v0; d[1] = v1; d[2] = v2; d[3] = v3; }
        __syncthreads();
        const int dv = tid >> 3, l8 = tid & 7;
#pragma unroll
        for (int cc = 0; cc < 2; ++cc) { const int cls = 2 * l8 + cc;
#pragma unroll
            for (int hh = 0; hh < 2; ++hh) { unsigned w[4];
#pragma unroll
                for (int i = 0; i < 4; ++i) w[i] = (unsigned)tile[(16 * (hh * 8 + 2 * i) + cls) * VS + dv] | ((unsigned)tile[(16 * (hh * 8 + 2 * i + 1) + cls) * VS + dv] << 16);
                const int blkidx = (bh * S + cls * 512 + 16 * blk + hh * 8) >> 3;
                *(uint4*)(vb + ((size_t)blkidx * 64 + dv) * 8) = make_uint4(w[0], w[1], w[2], w[3]); } }
        __syncthreads();
    }
}

struct AttnFrag { bf16x8 ka[4], vf[4]; };
__device__ __forceinline__ void attn_load(AttnFrag& f, const bf16_t* kp, const bf16_t* vp) {
    f.ka[0] = *(const bf16x8*)kp; f.ka[1] = *(const bf16x8*)(kp + 32); f.ka[2] = *(const bf16x8*)(kp + 256); f.ka[3] = *(const bf16x8*)(kp + 288);
#pragma unroll
    for (int n = 0; n < 4; ++n) f.vf[n] = *(const bf16x8*)(vp + n * 128);
}
struct AttnState { float m, l; f32x4 o[4]; bf16x8 q0, q1; };
__device__ __forceinline__ float max2a(float a, float b) { float r; asm("v_max_f32_e32 %0, %1, %2" : "=v"(r) : "v"(a), "v"(b)); return r; }
__device__ __forceinline__ float max3a(float a, float b, float c) { float r; asm("v_max3_f32 %0, %1, %2, %3" : "=v"(r) : "v"(a), "v"(b), "v"(c)); return r; }
__device__ __forceinline__ float rowmax4(float x) {
    const unsigned u = __builtin_bit_cast(unsigned, x);
    const auto a = __builtin_amdgcn_permlane16_swap(u, u, false, false);
    const float y = fmaxf(__builtin_bit_cast(float, a[0]), __builtin_bit_cast(float, a[1]));
    const unsigned v = __builtin_bit_cast(unsigned, y);
    const auto b = __builtin_amdgcn_permlane32_swap(v, v, false, false);
    return fmaxf(__builtin_bit_cast(float, b[0]), __builtin_bit_cast(float, b[1]));
}
template <bool FIRST>
__device__ __forceinline__ float attn_scores(const AttnFrag& f, const AttnState& t, const int d0, const int js, float (&sv)[8]) {
    const float nm = FIRST ? 0.f : -t.m;
    f32x4 st0 = (f32x4){nm, nm, nm, nm}, st1 = (f32x4){nm, nm, nm, nm};
    st0 = __builtin_amdgcn_mfma_f32_16x16x32_bf16(f.ka[0], t.q0, st0, 0, 0, 0);
    st0 = __builtin_amdgcn_mfma_f32_16x16x32_bf16(f.ka[1], t.q1, st0, 0, 0, 0);
    st1 = __builtin_amdgcn_mfma_f32_16x16x32_bf16(f.ka[2], t.q0, st1, 0, 0, 0);
    st1 = __builtin_amdgcn_mfma_f32_16x16x32_bf16(f.ka[3], t.q1, st1, 0, 0, 0);
#pragma unroll
    for (int j = 0; j < 8; ++j) { const bool vd = (unsigned)(d0 - (j << js)) <= 128u; const float x = (j < 4) ? st0[j] : st1[j - 4]; sv[j] = vd ? x : -3.0e38f; }
    float mx = max3a(max3a(sv[0], sv[1], sv[2]), max3a(sv[3], sv[4], sv[5]), max2a(sv[6], sv[7]));
    return rowmax4(mx);
}
__device__ __forceinline__ void attn_grow(AttnState& t, float (&sv)[8], const float mx) {
    const float gr = fmaxf(mx, 0.f), alpha = fexp2(-gr);
    t.m += gr;
#pragma unroll
    for (int j = 0; j < 8; ++j) sv[j] -= gr;
    t.l = t.l * alpha;
#pragma unroll
    for (int n = 0; n < 4; ++n) t.o[n] = t.o[n] * alpha;
}
__device__ __forceinline__ void attn_pv(const AttnFrag& f, AttnState& t, const float (&sv)[8]) {
    float pj[8];
#pragma unroll
    for (int j = 0; j < 8; ++j) pj[j] = fexp2(sv[j]);
    t.l += ((pj[0] + pj[1]) + (pj[2] + pj[3])) + ((pj[4] + pj[5]) + (pj[6] + pj[7]));
    u32x4 pw; pw.x = pk2(pj[0], pj[1]); pw.y = pk2(pj[2], pj[3]); pw.z = pk2(pj[4], pj[5]); pw.w = pk2(pj[6], pj[7]);
    const bf16x8 pf = __builtin_bit_cast(bf16x8, pw);
#pragma unroll
    for (int n = 0; n < 4; ++n) t.o[n] = __builtin_amdgcn_mfma_f32_16x16x32_bf16(f.vf[n], pf, t.o[n], 0, 0, 0);
}
template <bool FIRST>
__device__ __forceinline__ void attn_math2(const AttnFrag& fa, const AttnFrag& fb, AttnState& ta, AttnState& tb, const int d0a, const int d0b, const int js) {
    float sa[8], sb[8];
    const float mxa = attn_scores<FIRST>(fa, ta, d0a, js, sa), mxb = attn_scores<FIRST>(fb, tb, d0b, js, sb);
    if (FIRST) {
        ta.m = mxa; tb.m = mxb;
#pragma unroll
        for (int j = 0; j < 8; ++j) { sa[j] -= mxa; sb[j] -= mxb; }
    } else if (__any(fmaxf(mxa, mxb) > 8.f)) {
        attn_grow(ta, sa, mxa); attn_grow(tb, sb, mxb);
    }
    attn_pv(fa, ta, sa); attn_pv(fb, tb, sb);
}
__device__ void phase_attn(const Params& p, unsigned char* lds) {
    const int tid = threadIdx.x, lane = tid & 63, wave = tid >> 6, qi = lane & 15, g = lane >> 4, gp = qi >> 2, jj = qi & 3;
    unsigned char* ws = p.ws;
    const bf16_t* QA = (const bf16_t*)(ws + WS_QA);
    bf16_t* CAT = (bf16_t*)(ws + WS_CAT);
    const bf16_t* K = (const bf16_t*)(ws + WS_KA); const bf16_t* V = (const bf16_t*)(ws + WS_VB);
    constexpr int LV = 49152;
    constexpr int CLS8 = 8 * 512 * 64;
    const int nwg = gridDim.x, xg = blockIdx.x & 7, xl = blockIdx.x >> 3;
    const bool xord = (nwg & 7) == 0;
    const int k0 = xord ? xl : (int)blockIdx.x, kst = xord ? (nwg >> 3) : nwg, kend = xord ? 64 : 512;
    for (int k = k0; k < kend; k += kst) {
        const int idd = xord ? ((xg + 8 * (k >> 5)) << 5) + (k & 31) : k;
        const int bh = idd >> 5, blk = idd & 31, r = wave, b = bh >> 3, h = bh & 7;
        const int tq = 256 * blk + r + 16 * qi, rho4 = r & 3;
        __syncthreads();
        uint4 pre[12];
#pragma unroll
        for (int i = 0; i < 6; ++i) { const int pid = tid + 512 * i, row = pid >> 3, cls = row / 24, il = row - cls * 24;
            pre[i] = *(const uint4*)(K + ((bh * S + cls * 512 + 16 * blk - 8 + il) * 64 + (pid & 7) * 8)); }
#pragma unroll
        for (int i = 0; i < 6; ++i) { const int vp = tid + 512 * i, b3 = vp >> 6, cls = b3 / 3, bl = b3 - cls * 3;
            pre[6 + i] = *(const uint4*)(V + ((((bh * S + cls * 512 + 16 * blk - 8) >> 3) + bl) * 512 + (vp & 63) * 8)); }
        const int ks16 = ((16 * blk) & ~31) - 128;
        const int c16 = ks16 < 0 ? ((-ks16) >> 5) : 0;
        const int kb16 = (bh * S + r * 512 + ks16 + 8 * gp + jj) * 64 + 8 * g, vb16 = (((bh * S + r * 512 + ks16) >> 3) + g) * 512 + qi * 8;
        const int dq16 = 16 * blk + qi - (ks16 + 8 * g);
        const int c4 = blk == 0 ? 4 : (blk == 1 ? 2 : 0);
        const int kb4 = (bh * S + (rho4 + 4 * gp) * 512 + 16 * blk - 32 + jj) * 64 + 8 * g, vb4 = ((bh * S + (rho4 + 4 * g) * 512 + 16 * blk - 32) >> 3) * 512 + qi * 8;
        const int dq4 = 4 * qi + 128 + (r >> 2) - g;
        AttnFrag fxa, fxb, fya;
        attn_load(fxa, K + (kb16 + 4 * 2048), V + (vb16 + 4 * 2048)); attn_load(fxb, K + (kb16 + 4 * 2048 + CLS8), V + (vb16 + 4 * 2048 + CLS8));
        attn_load(fya, K + kb4, V + vb4);
        AttnState ta, tb;
        { const bf16_t* qrow = QA + ((size_t)(bh * S + r * 512 + 16 * blk + qi) * 64 + 8 * g);
          ta.q0 = *(const bf16x8*)qrow; ta.q1 = *(const bf16x8*)(qrow + 32); tb.q0 = *(const bf16x8*)(qrow + CLS8); tb.q1 = *(const bf16x8*)(qrow + CLS8 + 32); }
        ta.m = 0.f; tb.m = 0.f; ta.l = 0.f; tb.l = 0.f;
#pragma unroll
        for (int n = 0; n < 4; ++n) { ta.o[n] = (f32x4){0.f, 0.f, 0.f, 0.f}; tb.o[n] = ta.o[n]; }
        attn_math2<true>(fxa, fxb, ta, tb, dq16 - 128, dq16 - 128, 0);
        {
            const int m0 = c4 <= 0 ? 0 : (1 << 20), m1 = c4 <= 1 ? 0 : (1 << 20), m2 = c4 <= 2 ? 0 : (1 << 20);
            attn_load(fxa, K + (kb4 + 1 * 512), V + (vb4 + 1 * 512));
            attn_math2<false>(fya, fya, ta, tb, dq4 - m0, dq4 + 2 - m0, 2);
            attn_load(fya, K + (kb4 + 2 * 512), V + (vb4 + 2 * 512));
            attn_math2<false>(fxa, fxa, ta, tb, dq4 - 32 - m1, dq4 + 2 - 32 - m1, 2);
            attn_math2<false>(fya, fya, ta, tb, dq4 - 64 - m2, dq4 + 2 - 64 - m2, 2);
        }
#pragma unroll
        for (int i = 0; i < 12; ++i) *(uint4*)(lds + (tid + 512 * i) * 16) = pre[i];
        __syncthreads();
        {
            const int d1 = 16 * qi + 128 + r - g;
            const unsigned char* kl = lds + (gp * 24 + jj) * 128 + g * 16;
            const unsigned char* vl = lds + LV + g * 3072 + qi * 16;
            int c1 = (blk == 0 ? 4 : 0);
            const unsigned char* kl4 = lds + ((rho4 + 4 * gp) * 24 + jj) * 128 + g * 16;
            const unsigned char* vl4 = lds + LV + (rho4 + 4 * g) * 3072 + qi * 16;
            const int c4l = c4 > 3 ? c4 : 3;
#define ATTN_D1_CHUNK() do { const int w = c1 >> 2, q = c1 & 3; const unsigned char* kq = kl + q * 12288 + w * 1024; const unsigned char* vq = vl + q * 12288 + w * 1024; \
                fya.ka[0] = *(const bf16x8*)kq; fya.ka[1] = *(const bf16x8*)(kq + 64); fya.ka[2] = *(const bf16x8*)(kq + 512); fya.ka[3] = *(const bf16x8*)(kq + 576); \
                _Pragma("unroll") for (int n = 0; n < 4; ++n) fya.vf[n] = *(const bf16x8*)(vq + n * 256); \
                attn_math2<false>(fya, fya, ta, tb, d1 - 128 * w - 4 * q, d1 + 8 - 128 * w - 4 * q, 4); ++c1; } while (0)
#define ATTN_D4_CHUNK(w4) do { const unsigned char* kq = kl4 + ((w4) - 3) * 1024; const unsigned char* vq = vl4 + ((w4) - 3) * 1024; \
                fya.ka[0] = *(const bf16x8*)kq; fya.ka[1] = *(const bf16x8*)(kq + 64); fya.ka[2] = *(const bf16x8*)(kq + 512); fya.ka[3] = *(const bf16x8*)(kq + 576); \
                _Pragma("unroll") for (int n = 0; n < 4; ++n) fya.vf[n] = *(const bf16x8*)(vq + n * 256); \
                attn_math2<false>(fya, fya, ta, tb, dq4 - 32 * (w4), dq4 + 2 - 32 * (w4), 2); } while (0)
            for (int cc = c16; cc < 4; ++cc) {
                attn_load(fxa, K + (kb16 + cc * 2048), V + (vb16 + cc * 2048)); attn_load(fxb, K + (kb16 + cc * 2048 + CLS8), V + (vb16 + cc * 2048 + CLS8));
                for (int q3 = 0; q3 < 3 && c1 < 12; ++q3) ATTN_D1_CHUNK();
                if (3 + (cc - c16) >= c4l && 3 + (cc - c16) < 6) ATTN_D4_CHUNK(3 + (cc - c16));
                attn_math2<false>(fxa, fxb, ta, tb, dq16 - 32 * cc, dq16 - 32 * cc, 0);
            }
            while (c1 < 12) ATTN_D1_CHUNK();
            for (int w4 = (4 - c16 < 3 ? 3 + (4 - c16) : 6); w4 < 6; ++w4) { if (w4 >= c4l) ATTN_D4_CHUNK(w4); }
#undef ATTN_D1_CHUNK
#undef ATTN_D4_CHUNK
        }
        {
            float la = ta.l, lb = tb.l;
            la += __shfl_xor(la, 16); la += __shfl_xor(la, 32); lb += __shfl_xor(lb, 16); lb += __shfl_xor(lb, 32);
            const float ia = 1.f / la, ib = 1.f / lb;
            bf16_t* orow = CAT + (size_t)(b * S + tq) * D + h * 64 + 4 * g;
#pragma unroll
            for (int n = 0; n < 4; ++n) { uint2 ov; ov.x = pk2(ta.o[n][0] * ia, ta.o[n][1] * ia); ov.y = pk2(ta.o[n][2] * ia, ta.o[n][3] * ia); *(uint2*)(orow + 16 * n) = ov;
                uint2 ow; ow.x = pk2(tb.o[n][0] * ib, tb.o[n][1] * ib); ow.y = pk2(tb.o[n][2] * ib, tb.o[n][3] * ib); *(uint2*)(orow + 8 * D + 16 * n) = ow; }
        }
    }
}

constexpr int TS = 72;
constexpr int GL_LA = 0, GL_A1 = 16640, GL_A2 = GL_A1 + 64 * TS * 2, GL_VT = GL_A2 + 64 * TS * 2, GL_ATT = GL_VT + 128 * TS * 2;
static_assert(GL_ATT + 64 * TS * 2 <= 65536, "gla lds");

struct GlaIn { uint4 kr0, kr1, qr0, qr1, vr[4]; float4 gl; };
template <int MODE>
__device__ __forceinline__ void gla_fetch(const Params& p, int item, int tid, GlaIn& in) {
    unsigned char* ws = p.ws;
    const int bh4 = item >> 7, n = item & 127, b = bh4 >> 2, hh = bh4 & 3;
    const int t0 = b * S + n * 64;
    const int c = tid >> 2, d0 = (tid & 3) * 16, e0 = (tid & 3) * 32;
    const bf16_t* kp = (const bf16_t*)(ws + WS_KG) + (size_t)(t0 + c) * 256 + hh * 64 + d0;
    in.kr0 = *(const uint4*)kp; in.kr1 = *(const uint4*)(kp + 8);
    const bf16_t* qp = (const bf16_t*)(ws + WS_QG) + (size_t)(t0 + c) * 256 + hh * 64 + d0;
    in.qr0 = make_uint4(0, 0, 0, 0); in.qr1 = make_uint4(0, 0, 0, 0);
    if (MODE == 1) { in.qr0 = *(const uint4*)qp; in.qr1 = *(const uint4*)(qp + 8); }
    const bf16_t* vp = (const bf16_t*)(ws + WS_VG) + (size_t)(t0 + c) * 512 + hh * 128 + e0;
#pragma unroll
    for (int q = 0; q < 4; ++q) in.vr[q] = *(const uint4*)(vp + 8 * q);
    in.gl = *(const float4*)((const float*)(ws + WS_GLR) + (size_t)t0 * 16 + tid * 4);
}
template <int MODE>
__device__ __forceinline__ void gla_prep(const Params& p, unsigned char* lds, int item, int tid, const GlaIn& in) {
    const int bh4 = item >> 7, hh = bh4 & 3;
    float* LA = (float*)(lds + GL_LA);
    bf16_t* A1 = (bf16_t*)(lds + GL_A1); bf16_t* A2 = (bf16_t*)(lds + GL_A2); bf16_t* VTl = (bf16_t*)(lds + GL_VT);
    const int c = tid >> 2, d0 = (tid & 3) * 16, e0 = (tid & 3) * 32;
    const uint4 kr0 = in.kr0, kr1 = in.kr1, qr0 = in.qr0, qr1 = in.qr1;
    float* GLRL = (float*)(lds + GL_ATT + 1024);
    *(float4*)(GLRL + tid * 4) = in.gl;
    __syncthreads();
    {
        const int dd = tid & 63, cgp = tid >> 6;
        float w[16];
#pragma unroll
        for (int r = 0; r < 16; ++r) w[r] = p.w_gate_lr[r * 256 + hh * 64 + dd];
        const float bias = p.b_gate[hh * 64 + dd];
        float pre[16]; float run = 0.f;
#pragma unroll
        for (int i = 0; i < 16; ++i) {
            const float4* gp = (const float4*)(GLRL + (cgp * 16 + i) * 16);
            const float4 g0 = gp[0], g1 = gp[1], g2 = gp[2], g3 = gp[3];
            float z = bias;
            z += g0.x * w[0] + g0.y * w[1] + g0.z * w[2] + g0.w * w[3];
            z += g1.x * w[4] + g1.y * w[5] + g1.z * w[6] + g1.w * w[7];
            z += g2.x * w[8] + g2.y * w[9] + g2.z * w[10] + g2.w * w[11];
            z += g3.x * w[12] + g3.y * w[13] + g3.z * w[14] + g3.w * w[15];
            const float ls = fminf(z, 0.f) - flog(1.f + fexp(-fabsf(z)));
            run += ls * (1.f / 16.f); pre[i] = run;
        }
        float* tot = (float*)(lds + GL_ATT);
        tot[cgp * 64 + dd] = run;
        __syncthreads();
        float off = 0.f;
#pragma unroll
        for (int gq = 0; gq < 3; ++gq) off += (gq < cgp) ? tot[gq * 64 + dd] : 0.f;
#pragma unroll
        for (int i = 0; i < 16; ++i) LA[(cgp * 16 + i) * 65 + dd] = pre[i] + off;
    }
    __syncthreads();
    {
        unsigned kw[8] = {kr0.x, kr0.y, kr0.z, kr0.w, kr1.x, kr1.y, kr1.z, kr1.w};
        if (MODE == 0) {
#pragma unroll
            for (int i = 0; i < 16; ++i) { const int dd = d0 + i; const float kv = bf2f((unsigned short)((kw[i >> 1] >> ((i & 1) * 16)) & 0xffff));
                const float f = fexp(LA[63 * 65 + dd] - LA[c * 65 + dd]);
                A1[dd * TS + c] = (bf16_t)f2bf(kv * f); }
        } else {
            unsigned qw[8] = {qr0.x, qr0.y, qr0.z, qr0.w, qr1.x, qr1.y, qr1.z, qr1.w};
            unsigned oq[8], ok[8];
#pragma unroll
            for (int i = 0; i < 8; ++i) {
                const float bb0 = LA[c * 65 + d0 + 2 * i], bb1 = LA[c * 65 + d0 + 2 * i + 1];
                const float q0 = bf2f((unsigned short)(qw[i] & 0xffff)), q1 = bf2f((unsigned short)(qw[i] >> 16));
                const float k0 = bf2f((unsigned short)(kw[i] & 0xffff)), k1 = bf2f((unsigned short)(kw[i] >> 16));
                oq[i] = pk2(q0 * 0.125f * fexp(bb0), q1 * 0.125f * fexp(bb1));
                ok[i] = pk2(k0 * fexp(-bb0), k1 * fexp(-bb1));
            }
            *(uint4*)(A1 + c * TS + d0) = make_uint4(oq[0], oq[1], oq[2], oq[3]); *(uint4*)(A1 + c * TS + d0 + 8) = make_uint4(oq[4], oq[5], oq[6], oq[7]);
            *(uint4*)(A2 + c * TS + d0) = make_uint4(ok[0], ok[1], ok[2], ok[3]); *(uint4*)(A2 + c * TS + d0 + 8) = make_uint4(ok[4], ok[5], ok[6], ok[7]);
        }
#pragma unroll
        for (int q = 0; q < 4; ++q) { const unsigned vw[4] = {in.vr[q].x, in.vr[q].y, in.vr[q].z, in.vr[q].w};
#pragma unroll
            for (int i = 0; i < 4; ++i) { VTl[(e0 + 8 * q + 2 * i) * TS + c] = (bf16_t)(vw[i] & 0xffff); VTl[(e0 + 8 * q + 2 * i + 1) * TS + c] = (bf16_t)(vw[i] >> 16); } }
    }
    __syncthreads();
}

__device__ void gla1_items(const Params& p, unsigned char* lds0) {
    const int half = threadIdx.x >> 8, tid = threadIdx.x & 255, lane = tid & 63, w = tid >> 6, fr = lane & 15, fq = lane >> 4;
    unsigned char* lds = lds0 + half * 65536;
    float* UT = (float*)(p.ws + WS_UT); float* AG = (float*)(p.ws + WS_AG);
    const float* LA = (const float*)(lds + GL_LA);
    const bf16_t* A1 = (const bf16_t*)(lds + GL_A1); const bf16_t* VTl = (const bf16_t*)(lds + GL_VT);
    GlaIn cur, nxt;
    if ((int)blockIdx.x < 512) gla_fetch<0>(p, 2 * blockIdx.x + half, tid, cur);
    for (int it = blockIdx.x; it < 512; it += gridDim.x) {
        const int item = 2 * it + half;
        const bool more = it + (int)gridDim.x < 512;
        if (more) gla_fetch<0>(p, 2 * (it + gridDim.x) + half, tid, nxt);
        gla_prep<0>(p, lds, item, tid, cur);
        f32x4 acc[8];
#pragma unroll
        for (int n = 0; n < 8; ++n) acc[n] = (f32x4){0.f, 0.f, 0.f, 0.f};
#pragma unroll
        for (int ks = 0; ks < 2; ++ks) {
            const bf16x8 af = *(const bf16x8*)(A1 + (16 * w + fr) * TS + ks * 32 + fq * 8);
#pragma unroll
            for (int n = 0; n < 8; ++n) { const bf16x8 bfr = *(const bf16x8*)(VTl + (16 * n + fr) * TS + ks * 32 + fq * 8);
                acc[n] = __builtin_amdgcn_mfma_f32_16x16x32_bf16(af, bfr, acc[n], 0, 0, 0); }
        }
#pragma unroll
        for (int n = 0; n < 8; ++n) *(f32x4*)(UT + ((size_t)item * 128 + 16 * n + fr) * 64 + 16 * w + 4 * fq) = acc[n];
        if (tid < 64) AG[item * 64 + tid] = fexp(LA[63 * 65 + tid]);
        __syncthreads();
        if (more) cur = nxt;
    }
}
__device__ void gla2_scan(const Params& p) {
    const float* UT = (const float*)(p.ws + WS_UT); const float* AG = (const float*)(p.ws + WS_AG);
    bf16_t* SPT = (bf16_t*)(p.ws + WS_SPT);
    for (int rec = blockIdx.x * NTHREADS + threadIdx.x; rec < 65536; rec += gridDim.x * NTHREADS) {
        const int bh4 = rec >> 13, e = (rec >> 6) & 127, dd = rec & 63;
        float st = 0.f;
        for (int n0 = 0; n0 < 128; n0 += 32) {
            float av[32], uv[32];
#pragma unroll
            for (int q = 0; q < 32; ++q) { const int item = bh4 * 128 + n0 + q; av[q] = AG[item * 64 + dd]; uv[q] = UT[((size_t)item * 128 + e) * 64 + dd]; }
#pragma unroll
            for (int q = 0; q < 32; ++q) { const int item = bh4 * 128 + n0 + q; SPT[((size_t)item * 128 + e) * 64 + dd] = (bf16_t)f2bf(st); st = av[q] * st + uv[q]; }
        }
    }
}
__device__ void gla3_items(const Params& p, unsigned char* lds0) {
    const int half = threadIdx.x >> 8, tid = threadIdx.x & 255, lane = tid & 63, w = tid >> 6, fr = lane & 15, fq = lane >> 4;
    unsigned char* lds = lds0 + half * 65536;
    unsigned char* ws = p.ws;
    const bf16_t* SPT = (const bf16_t*)(ws + WS_SPT); const bf16_t* RG = (const bf16_t*)(ws + WS_RG);
    bf16_t* CAT = (bf16_t*)(ws + WS_CAT);
    const bf16_t* A1 = (const bf16_t*)(lds + GL_A1); const bf16_t* A2 = (const bf16_t*)(lds + GL_A2); const bf16_t* VTl = (const bf16_t*)(lds + GL_VT);
    bf16_t* ATT = (bf16_t*)(lds + GL_ATT);
    GlaIn cur, nxt;
    if ((int)blockIdx.x < 512) gla_fetch<1>(p, 2 * blockIdx.x + half, tid, cur);
    for (int it = blockIdx.x; it < 512; it += gridDim.x) {
        const int item = 2 * it + half;
        const bool more = it + (int)gridDim.x < 512;
        const int bh4 = item >> 7, n_ = item & 127, b = bh4 >> 2, hh = bh4 & 3;
        const int t0 = b * S + n_ * 64;
        bf16x8 sf[8][2]; uint2 rw[8];
#pragma unroll
        for (int n = 0; n < 8; ++n) { const bf16_t* sp = SPT + ((size_t)item * 128 + 16 * n + fr) * 64 + fq * 8; sf[n][0] = *(const bf16x8*)sp; sf[n][1] = *(const bf16x8*)(sp + 32);
            rw[n] = *(const uint2*)(RG + (size_t)(t0 + 16 * w + fr) * 512 + hh * 128 + 16 * n + 4 * fq); }
        if (more) gla_fetch<1>(p, 2 * (it + gridDim.x) + half, tid, nxt);
        gla_prep<1>(p, lds, item, tid, cur);
        const bf16x8 aq0 = *(const bf16x8*)(A1 + (16 * w + fr) * TS + fq * 8), aq1 = *(const bf16x8*)(A1 + (16 * w + fr) * TS + 32 + fq * 8);
#pragma unroll
        for (int np = 0; np < 4; ++np) {
            f32x4 a = (f32x4){0.f, 0.f, 0.f, 0.f};
            if (np <= w) {
                const bf16x8 b0 = *(const bf16x8*)(A2 + (16 * np + fr) * TS + fq * 8), b1 = *(const bf16x8*)(A2 + (16 * np + fr) * TS + 32 + fq * 8);
                a = __builtin_amdgcn_mfma_f32_16x16x32_bf16(aq0, b0, a, 0, 0, 0);
                a = __builtin_amdgcn_mfma_f32_16x16x32_bf16(aq1, b1, a, 0, 0, 0);
            }
#pragma unroll
            for (int j = 0; j < 4; ++j) { const int c = 16 * w + 4 * fq + j, cp = 16 * np + fr; ATT[c * TS + cp] = (bf16_t)f2bf(cp <= c ? a[j] : 0.f); }
        }
        __syncthreads();
        const bf16x8 at0 = *(const bf16x8*)(ATT + (16 * w + fr) * TS + fq * 8), at1 = *(const bf16x8*)(ATT + (16 * w + fr) * TS + 32 + fq * 8);
        f32x4 acc[8];
#pragma unroll
        for (int n = 0; n < 8; ++n) {
            acc[n] = (f32x4){0.f, 0.f, 0.f, 0.f};
            const bf16x8 v0 = *(const bf16x8*)(VTl + (16 * n + fr) * TS + fq * 8), v1 = *(const bf16x8*)(VTl + (16 * n + fr) * TS + 32 + fq * 8);
            const bf16x8 s0 = sf[n][0], s1 = sf[n][1];
            acc[n] = __builtin_amdgcn_mfma_f32_16x16x32_bf16(v0, at0, acc[n], 0, 0, 0);
            acc[n] = __builtin_amdgcn_mfma_f32_16x16x32_bf16(v1, at1, acc[n], 0, 0, 0);
            acc[n] = __builtin_amdgcn_mfma_f32_16x16x32_bf16(s0, aq0, acc[n], 0, 0, 0);
            acc[n] = __builtin_amdgcn_mfma_f32_16x16x32_bf16(s1, aq1, acc[n], 0, 0, 0);
        }
        {
            float ss = 0.f;
#pragma unroll
            for (int n = 0; n < 8; ++n) ss += acc[n][0] * acc[n][0] + acc[n][1] * acc[n][1] + acc[n][2] * acc[n][2] + acc[n][3] * acc[n][3];
            ss += __shfl_xor(ss, 16); ss += __shfl_xor(ss, 32);
            const float rstd = rsqrtf(ss * (1.f / 128.f) + EPS);
            const int t = t0 + 16 * w + fr;
#pragma unroll
            for (int n = 0; n < 8; ++n) { const int e = 16 * n + 4 * fq;
                const float4 gg = *(const float4*)(p.g_gla + e);
                const float r0 = bf2f((unsigned short)(rw[n].x & 0xffff)), r1 = bf2f((unsigned short)(rw[n].x >> 16)), r2 = bf2f((unsigned short)(rw[n].y & 0xffff)), r3 = bf2f((unsigned short)(rw[n].y >> 16));
                uint2 ov; ov.x = pk2(acc[n][0] * rstd * gg.x * fsilu(r0), acc[n][1] * rstd * gg.y * fsilu(r1)); ov.y = pk2(acc[n][2] * rstd * gg.z * fsilu(r2), acc[n][3] * rstd * gg.w * fsilu(r3));
                *(uint2*)(CAT + (size_t)t * D + 512 + hh * 128 + e) = ov; }
        }
        __syncthreads();
        if (more) cur = nxt;
    }
}

struct EpiBf16Plain {
    static constexpr bool PERM = true;
    bf16_t* C; int ldc;
    __device__ __forceinline__ void operator()(const f32x4 (&acc)[2][2][4][2], const pg8::Unit& u, int wr, int wc, int fr, int fq) const {
#pragma unroll
        for (int ai = 0; ai < 2; ++ai)
#pragma unroll
            for (int m = 0; m < 4; ++m) { const int row = u.row0 + 128 * ai + 64 * wr + 16 * m + fr;
#pragma unroll
                for (int bj = 0; bj < 2; ++bj) { const f32x4 v0 = acc[ai][bj][m][0], v1 = acc[ai][bj][m][1];
                    u32x4 w; w.x = pk2(v0[0], v0[1]); w.y = pk2(v0[2], v0[3]); w.z = pk2(v1[0], v1[1]); w.w = pk2(v1[2], v1[3]);
                    *(u32x4*)(C + (size_t)row * ldc + 256 * u.pn + 128 * bj + 32 * wc + 8 * fq) = w; } }
    }
};
__device__ void phase_gemm_out(const Params& p, unsigned char* lds) {
    pg8::DenseSched Sd; Sd.init(p.ws + WS_CAT, p.ws + WS_WOUTT, T, D, D);
    EpiBf16Plain E{(bf16_t*)(p.ws + WS_YMIX), D};
    pg8::gemm_phase<EpiBf16Plain, pg8::DenseSched>((LAS unsigned char*)lds, D, Sd, E);
}

constexpr int HS_STRIDE = 1028;
__device__ void phase_postmix(const Params& p, unsigned char* lds, const bool dry) {
    const int tid = threadIdx.x, lane = tid & 63, wave = tid >> 6;
    unsigned char* ws = p.ws;
    const float* mod = (const float*)(ws + WS_MOD);
    const bf16_t* Y = (const bf16_t*)(ws + WS_YMIX);
    bf16_t* H = (bf16_t*)(ws + WS_H);
    bf16_t* X1 = (bf16_t*)(ws + WS_X1);
    float* hs = (float*)lds;
    float* part = (float*)(lds + 66048);
    float* lg = (float*)(lds + 66048 + 16384);
    float* tvs = lg + 512;
    int* tis = (int*)(tvs + 64);
    constexpr int MAXG = 8;
    int* sel_e = tis + 64;
    float* sel_g = (float*)(sel_e + MAXG * 64);
    int* lrank = (int*)(sel_g + MAXG * 64);
    int* lcnt = lrank + MAXG * 64;
    int* lbase = lcnt + 32;
    int* CNT = (int*)(ws + WS_CTL) + CW_CNT;
    float wb0[32], wb1[32];
    { const float* wp = p.router_w + (size_t)(128 * wave + (lane >> 4)) * 32 + (lane & 15);
#pragma unroll
      for (int ks = 0; ks < 32; ++ks) { wb0[ks] = wp[(size_t)(4 * ks) * 32]; wb1[ks] = wp[(size_t)(4 * ks) * 32 + 16]; } }
    if (tid < 32) lcnt[tid] = 0;
    int gl = 0, grp0 = blockIdx.x;
    uint2 yw[2][4]; float4 xv[2][4];
    if ((int)blockIdx.x < T / 16) {
#pragma unroll
        for (int i = 0; i < 2; ++i) { const int m = blockIdx.x * 16 + wave * 2 + i;
            const uint2* yr = (const uint2*)(Y + (size_t)m * D) + lane; const float4* xr = (const float4*)(p.x + (size_t)m * D) + lane;
#pragma unroll
            for (int j = 0; j < 4; ++j) { yw[i][j] = ntload2(yr + 64 * j); xv[i][j] = ntload4(xr + 64 * j); } }
    }
    for (int grp = blockIdx.x; grp < T / 16; grp += gridDim.x) {
        const int m0 = grp * 16;
#pragma unroll
        for (int i = 0; i < 2; ++i) {
            const int rl = wave * 2 + i, m = m0 + rl, b = m >> 13;
            float4 yv[4]; float ss = 0.f;
#pragma unroll
            for (int j = 0; j < 4; ++j) { const uint2 w = yw[i][j];
                yv[j] = make_float4(bf2f((unsigned short)(w.x & 0xffff)), bf2f((unsigned short)(w.x >> 16)), bf2f((unsigned short)(w.y & 0xffff)), bf2f((unsigned short)(w.y >> 16)));
                ss += yv[j].x * yv[j].x + yv[j].y * yv[j].y + yv[j].z * yv[j].z + yv[j].w * yv[j].w; }
            const float rstd1 = rsqrtf(wave_sum(ss) * (1.f / D) + EPS);
            float4 x1[4]; float ss2 = 0.f;
#pragma unroll
            for (int j = 0; j < 4; ++j) { const int c = 4 * lane + 256 * j;
                const float4 xq = xv[i][j], g = *(const float4*)(p.g_post_mix + c), gt = *(const float4*)(mod + b * 6144 + 2048 + c);
                x1[j].x = xq.x + gt.x * (yv[j].x * rstd1 * g.x); x1[j].y = xq.y + gt.y * (yv[j].y * rstd1 * g.y);
                x1[j].z = xq.z + gt.z * (yv[j].z * rstd1 * g.z); x1[j].w = xq.w + gt.w * (yv[j].w * rstd1 * g.w);
                ss2 += x1[j].x * x1[j].x + x1[j].y * x1[j].y + x1[j].z * x1[j].z + x1[j].w * x1[j].w;
                { uint2 xo; xo.x = pk2(x1[j].x, x1[j].y); xo.y = pk2(x1[j].z, x1[j].w); ntstore2((uint2*)(X1 + (size_t)m * D + c), xo); } }
            const float rstd2 = rsqrtf(wave_sum(ss2) * (1.f / D) + EPS);
#pragma unroll
            for (int j = 0; j < 4; ++j) { const int c = 4 * lane + 256 * j;
                const float4 g = *(const float4*)(p.g_pre_ffn + c), sh = *(const float4*)(mod + b * 6144 + 3072 + c), sc = *(const float4*)(mod + b * 6144 + 4096 + c);
                float4 h;
                h.x = x1[j].x * rstd2 * g.x * (1.f + sc.x) + sh.x; h.y = x1[j].y * rstd2 * g.y * (1.f + sc.y) + sh.y;
                h.z = x1[j].z * rstd2 * g.z * (1.f + sc.z) + sh.z; h.w = x1[j].w * rstd2 * g.w * (1.f + sc.w) + sh.w;
                uint2 o; o.x = pk2(h.x, h.y); o.y = pk2(h.z, h.w);
                *(uint2*)(H + (size_t)m * D + c) = o;
                *(float4*)(hs + rl * HS_STRIDE + c) = h; }
        }
        if (grp + (int)gridDim.x < T / 16) {
#pragma unroll
            for (int i = 0; i < 2; ++i) { const int m = (grp + gridDim.x) * 16 + wave * 2 + i;
                const uint2* yr = (const uint2*)(Y + (size_t)m * D) + lane; const float4* xr = (const float4*)(p.x + (size_t)m * D) + lane;
#pragma unroll
                for (int j = 0; j < 4; ++j) { yw[i][j] = ntload2(yr + 64 * j); xv[i][j] = ntload4(xr + 64 * j); } }
        }
        __syncthreads();
        f32x4 a0 = (f32x4){0.f, 0.f, 0.f, 0.f}, a1 = (f32x4){0.f, 0.f, 0.f, 0.f};
        {
            const float* hp = hs + (lane & 15) * HS_STRIDE + 128 * wave + (lane >> 4);
#pragma unroll
            for (int ks = 0; ks < 32; ++ks) {
                const float av = hp[4 * ks];
                a0 = __builtin_amdgcn_mfma_f32_16x16x4f32(av, wb0[ks], a0, 0, 0, 0);
                a1 = __builtin_amdgcn_mfma_f32_16x16x4f32(av, wb1[ks], a1, 0, 0, 0);
            }
        }
        {
            const int fr = lane & 15, fq = lane >> 4;
#pragma unroll
            for (int j = 0; j < 4; ++j) { part[(wave * 16 + 4 * fq + j) * 32 + fr] = a0[j]; part[(wave * 16 + 4 * fq + j) * 32 + 16 + fr] = a1[j]; }
        }
        __syncthreads();
        { const int e = tid & 31; float s = p.router_b[e];
#pragma unroll
          for (int w8 = 0; w8 < 8; ++w8) s += part[w8 * 512 + tid];
          lg[tid] = s; }
        __syncthreads();
        {
            const int row = tid >> 5, e = tid & 31; const float v = lg[tid]; int rank = 0;
#pragma unroll
            for (int q = 0; q < 32; ++q) { const float u = lg[row * 32 + q]; rank += (u > v || (u == v && q < e)) ? 1 : 0; }
            if (rank < 4) { tvs[row * 4 + rank] = v; tis[row * 4 + rank] = e; }
        }
        __syncthreads();
        if (tid < 64) { const int row = tid >> 2, k = tid & 3;
            const float t0 = tvs[row * 4], e1 = fexp(tvs[row * 4 + 1] - t0), e2 = fexp(tvs[row * 4 + 2] - t0), e3 = fexp(tvs[row * 4 + 3] - t0);
            const float inv = 1.f / (1.f + e1 + e2 + e3);
            const float ek = k == 0 ? 1.f : (k == 1 ? e1 : (k == 2 ? e2 : e3));
            const int e = tis[tid];
            sel_e[gl * 64 + tid] = e; sel_g[gl * 64 + tid] = ek * inv;
            lrank[gl * 64 + tid] = atomicAdd(&lcnt[e], 1); }
        ++gl;
        const bool lastg = grp + (int)gridDim.x >= T / 16;
        if (gl == MAXG || lastg) {
            __syncthreads();
            if (tid < 32) { const int c = lcnt[tid]; lbase[tid] = (c > 0 && !dry) ? atomicAdd(&CNT[tid], c) : 0; }
            __syncthreads();
            if (!dry) for (int i = tid; i < gl * 64; i += NTHREADS) { const int gq = i >> 6, a = (grp0 + gq * (int)gridDim.x) * 64 + (i & 63); const int e = sel_e[i];
                const int pos = lbase[e] + lrank[i];
                ((int*)(ws + WS_TOPI))[a] = e; ((float*)(ws + WS_GATE))[a] = sel_g[i]; ((int*)(ws + WS_POS))[a] = pos; ((int*)(ws + WS_TOK))[e * T + pos] = a >> 2; }
            __syncthreads();
            if (tid < 32) lcnt[tid] = 0;
            gl = 0; grp0 = grp + gridDim.x;
        }
        __syncthreads();
    }
}

__device__ __forceinline__ void compute_pstart(const Params& p, unsigned char* lds) {
    int* ps = (int*)(lds + LDS_PS); int* cn = (int*)(lds + LDS_CNT);
    if (threadIdx.x < 64) {
        const int lane = threadIdx.x;
        const int* CNT = (const int*)(p.ws + WS_CTL) + CW_CNT;
        const int c = lane < NE ? __hip_atomic_load(&CNT[lane], __ATOMIC_RELAXED, __HIP_MEMORY_SCOPE_AGENT) : 0;
        int incl = (c + 255) & ~255;
#pragma unroll
        for (int o = 1; o < 32; o <<= 1) { const int t = __shfl_up(incl, o); if (lane >= o) incl += t; }
        if (lane < NE) { ps[lane + 1] = incl; cn[lane] = c; }
        if (lane == 0) ps[0] = 0;
    }
    __syncthreads();
}

struct EpiUp {
    static constexpr bool PERM = true;
    bf16_t* ACT; const float* bgu;
    __device__ __forceinline__ void operator()(const f32x4 (&acc)[2][2][4][2], const pg8::Unit& u, int wr, int wc, int fr, int fq) const {
#pragma unroll
        for (int bj = 0; bj < 2; ++bj) {
            const int grp = 8 * u.pn + 4 * bj + wc, jc = 16 * grp + 4 * fq;
            const float* bp = bgu + (size_t)(u.e & 31) * 2048 + 2 * jc;
            const float4 b01 = *(const float4*)bp, b23 = *(const float4*)(bp + 4);
            const float bg[4] = {b01.x, b01.z, b23.x, b23.z}, bl[4] = {b01.y, b01.w, b23.y, b23.w};
#pragma unroll
            for (int ai = 0; ai < 2; ++ai)
#pragma unroll
                for (int m = 0; m < 4; ++m) { const int row = u.row0 + 128 * ai + 64 * wr + 16 * m + fr;
                    float a[4];
#pragma unroll
                    for (int j = 0; j < 4; ++j) { float gl = acc[ai][bj][m][0][j] + bg[j], ln = acc[ai][bj][m][1][j] + bl[j];
                        gl = fminf(gl, 7.f); ln = fminf(fmaxf(ln, -7.f), 7.f);
                        a[j] = gl / (1.f + fexp(-1.702f * gl)) * (ln + 1.f); }
                    uint2 o; o.x = pk2(a[0], a[1]); o.y = pk2(a[2], a[3]);
                    if (u.e & 64) __hip_atomic_store((unsigned long long*)(ACT + (size_t)row * DFF + jc), (unsigned long long)o.x | ((unsigned long long)o.y << 32), __ATOMIC_RELAXED, __HIP_MEMORY_SCOPE_AGENT);
                    else *(uint2*)(ACT + (size_t)row * DFF + jc) = o; }
        }
    }
};
__device__ void phase_moe_up(const Params& p, unsigned char* lds) {
    int* ps = (int*)(lds + LDS_PS);
    compute_pstart(p, lds);
    pg8::MoeSched<true> Sm; Sm.init(p.ws + WS_H, p.ws + WS_WGUT, D, 8, 2048, ps, (const int*)(p.ws + WS_TOK));
    EpiUp E{(bf16_t*)(p.ws + WS_ACT), p.b_gate_up};
    pg8::gemm_phase<EpiUp, pg8::MoeSched<true>>((LAS unsigned char*)lds, D, Sm, E);
}

struct EpiDown {
    static constexpr bool PERM = true;
    bf16_t* YE; const float* bd;
    __device__ __forceinline__ void operator()(const f32x4 (&acc)[2][2][4][2], const pg8::Unit& u, int wr, int wc, int fr, int fq) const {
#pragma unroll
        for (int bj = 0; bj < 2; ++bj) {
            const int c0 = 256 * u.pn + 128 * bj + 32 * wc + 8 * fq;
            const float* bp = bd + (size_t)(u.e & 31) * D + c0;
            const float4 b0 = *(const float4*)bp, b1 = *(const float4*)(bp + 4);
#pragma unroll
            for (int ai = 0; ai < 2; ++ai)
#pragma unroll
                for (int m = 0; m < 4; ++m) { const int row = u.row0 + 128 * ai + 64 * wr + 16 * m + fr;
                    const f32x4 v0 = acc[ai][bj][m][0], v1 = acc[ai][bj][m][1];
                    u32x4 w; w.x = pk2(v0[0] + b0.x, v0[1] + b0.y); w.y = pk2(v0[2] + b0.z, v0[3] + b0.w); w.z = pk2(v1[0] + b1.x, v1[1] + b1.y); w.w = pk2(v1[2] + b1.z, v1[3] + b1.w);
                    *(u32x4*)(YE + (size_t)row * D + c0) = w; }
        }
    }
};
struct EpiMoe {
    static constexpr bool PERM = true;
    EpiUp up; EpiDown dn;
    __device__ __forceinline__ void operator()(const f32x4 (&acc)[2][2][4][2], const pg8::Unit& u, int wr, int wc, int fr, int fq) const {
        if ((u.e & 32) == 0) up(acc, u, wr, wc, fr, fq); else dn(acc, u, wr, wc, fr, fq);
    }
};
__device__ void phase_moe(const Params& p, unsigned char* lds) {
    int* ps = (int*)(lds + LDS_PS);
    compute_pstart(p, lds);
    const volatile unsigned* xs = (const volatile unsigned*)(lds + LDS_BARW);
    LAS int* ms = (LAS int*)(lds + LDS_BARW + 128);
    if (threadIdx.x == 0) {
        const int gt = gridDim.x, RT = ps[NE] >> 8, R = (12 * RT + gt - 1) / gt, x = (int)xs[4];
        int totE = 0, totF = 0, base = 0;
        for (int j = 0; j < 16; ++j) { const int cj = (int)xs[16 + j]; if (cj == 0) continue;
            const int tiles = RT * (base + cj) / gt - RT * base / gt, cap = R * cj, un = 12 * tiles;
            totE += un > cap ? min(tiles, (un - cap + 3) / 4) : 0; totF += un <= cap ? (cap - un) / 4 : 0; base += cj; }
        const int E = min(min(totE, totF), 24);
        int ge = 0, gf = 0; base = 0;
        LAS int* tmp = (LAS int*)lds;
        ms[2] = 0; ms[3] = 0;
        for (int j = 0; j < 16; ++j) { const int cj = (int)xs[16 + j]; if (cj == 0) continue;
            const int t0j = RT * base / gt, tiles = RT * (base + cj) / gt - t0j, cap = R * cj, un = 12 * tiles;
            const int ej = un > cap ? min(tiles, (un - cap + 3) / 4) : 0, fj = un <= cap ? (cap - un) / 4 : 0;
            const int eff = max(0, min(ej, E - ge));
            for (int k = 0; k < eff; ++k) tmp[ge + k] = t0j + k;
            if (j == x) { ms[0] = t0j; ms[1] = tiles; ms[2] = eff; ms[4] = min(gf, E); ms[3] = min(gf + fj, E) - min(gf, E); }
            ge += ej; gf += fj; base += cj; }
        for (int k = 0; k < ms[3]; ++k) ms[8 + k] = tmp[ms[4] + k];
    }
    __syncthreads();
    pg8::MoeSched2 Sm; Sm.init(p.ws, ps, (int)xs[0], (int)xs[2], ms);
    EpiMoe E{EpiUp{(bf16_t*)(p.ws + WS_ACT), p.b_gate_up}, EpiDown{(bf16_t*)(p.ws + WS_YE), p.b_down}};
    pg8::gemm_phase<EpiMoe, pg8::MoeSched2>((LAS unsigned char*)lds, D, Sm, E);
}
__device__ void phase_moe_down(const Params& p, unsigned char* lds) {
    int* ps = (int*)(lds + LDS_PS);
    compute_pstart(p, lds);
    pg8::MoeSched<false> Sm; Sm.init(p.ws + WS_ACT, p.ws + WS_WDT, DFF, 4, 1024, ps, nullptr);
    EpiDown E{(bf16_t*)(p.ws + WS_YE), p.b_down};
    pg8::gemm_phase<EpiDown, pg8::MoeSched<false>>((LAS unsigned char*)lds, DFF, Sm, E);
}

__device__ void phase_combine(const Params& p, unsigned char* lds) {
    const int tid = threadIdx.x, lane = tid & 63, wave = tid >> 6;
    unsigned char* ws = p.ws;
    const float* mod = (const float*)(ws + WS_MOD);
    const bf16_t* YE = (const bf16_t*)(ws + WS_YE);
    const bf16_t* X1 = (const bf16_t*)(ws + WS_X1);
    const int* TOPI = (const int*)(ws + WS_TOPI); const int* POS = (const int*)(ws + WS_POS); const float* GATE = (const float*)(ws + WS_GATE);
    compute_pstart(p, lds);
    const int* ps = (const int*)(lds + LDS_PS);
    for (int m0 = (blockIdx.x * NW + wave) * 2; m0 < T; m0 += gridDim.x * NW * 2) {
        const int4 te0 = *(const int4*)(TOPI + m0 * 4), te1 = *(const int4*)(TOPI + m0 * 4 + 4), tp0 = *(const int4*)(POS + m0 * 4), tp1 = *(const int4*)(POS + m0 * 4 + 4);
        const float4 gk0 = *(const float4*)(GATE + m0 * 4), gk1 = *(const float4*)(GATE + m0 * 4 + 4);
        const int slot[2][4] = {{ps[te0.x] + tp0.x, ps[te0.y] + tp0.y, ps[te0.z] + tp0.z, ps[te0.w] + tp0.w}, {ps[te1.x] + tp1.x, ps[te1.y] + tp1.y, ps[te1.z] + tp1.z, ps[te1.w] + tp1.w}};
        const float gk[2][4] = {{gk0.x, gk0.y, gk0.z, gk0.w}, {gk1.x, gk1.y, gk1.z, gk1.w}};
        uint2 u[2][4][4]; float4 x1[2][4];
#pragma unroll
        for (int q = 0; q < 2; ++q) {
#pragma unroll
            for (int k = 0; k < 4; ++k) { const uint2* yr = (const uint2*)(YE + (size_t)slot[q][k] * D) + lane;
#pragma unroll
                for (int j = 0; j < 4; ++j) u[q][k][j] = ntload2(yr + 64 * j); }
            const uint2* xr = (const uint2*)(X1 + (size_t)(m0 + q) * D) + lane;
#pragma unroll
            for (int j = 0; j < 4; ++j) { const uint2 w = ntload2(xr + 64 * j);
                x1[q][j] = make_float4(bf2f((unsigned short)(w.x & 0xffff)), bf2f((unsigned short)(w.x >> 16)), bf2f((unsigned short)(w.y & 0xffff)), bf2f((unsigned short)(w.y >> 16))); }
        }
#pragma unroll
        for (int q = 0; q < 2; ++q) {
            const int m = m0 + q, b = m >> 13;
            float4 y[4];
#pragma unroll
            for (int j = 0; j < 4; ++j) { y[j] = make_float4(0.f, 0.f, 0.f, 0.f);
#pragma unroll
                for (int k = 0; k < 4; ++k) { const uint2 w = u[q][k][j]; const float g = gk[q][k];
                    y[j].x += g * bf2f((unsigned short)(w.x & 0xffff)); y[j].y += g * bf2f((unsigned short)(w.x >> 16));
                    y[j].z += g * bf2f((unsigned short)(w.y & 0xffff)); y[j].w += g * bf2f((unsigned short)(w.y >> 16)); } }
            float ss = 0.f;
#pragma unroll
            for (int j = 0; j < 4; ++j) ss += y[j].x * y[j].x + y[j].y * y[j].y + y[j].z * y[j].z + y[j].w * y[j].w;
            const float rstd = rsqrtf(wave_sum(ss) * (1.f / D) + EPS);
#pragma unroll
            for (int j = 0; j < 4; ++j) { const int c = 4 * lane + 256 * j;
                const float4 g = *(const float4*)(p.g_post_ffn + c), gt = *(const float4*)(mod + b * 6144 + 5120 + c);
                float4 o;
                o.x = x1[q][j].x + gt.x * (y[j].x * rstd * g.x); o.y = x1[q][j].y + gt.y * (y[j].y * rstd * g.y);
                o.z = x1[q][j].z + gt.z * (y[j].z * rstd * g.z); o.w = x1[q][j].w + gt.w * (y[j].w * rstd * g.w);
                ntstore4((float4*)(p.out + (size_t)m * D + c), o); }
        }
    }
}

#define XB_TMO      128
#define XB_XCNT(j)  (256  + 64 * (j))
#define XB_XSUB(j)  (1280 + 64 * (j))
#define XB_XGEN(j)  (2304 + 64 * (j))
#define XB_TOP      3328
#define XB_TOPGEN   3392
#define XCD_BAR_WORDS 3456
#define XB_SPIN_CAP (1u << 18)
__device__ __forceinline__ unsigned xb_ld(unsigned* p)              { return __hip_atomic_load(p, __ATOMIC_RELAXED, __HIP_MEMORY_SCOPE_AGENT); }
__device__ __forceinline__ unsigned xb_add(unsigned* p, unsigned v) { return __hip_atomic_fetch_add(p, v, __ATOMIC_RELAXED, __HIP_MEMORY_SCOPE_AGENT); }
__device__ __forceinline__ unsigned xb_xcc_id() { return (unsigned)__builtin_amdgcn_s_getreg((3 << 11) | 20) & 0xFu; }
#define XB_SPIN(cond, bar) do { unsigned _sp = 0; while (cond) { __builtin_amdgcn_s_sleep(1); \
    if ((++_sp & 255u) == 0u) { if (xb_ld(&(bar)[XB_TMO])) break; if (_sp > XB_SPIN_CAP) { atomicAdd(&(bar)[XB_TMO], 1u); break; } } } } while (0)
struct XcdBarrier { unsigned* bar; unsigned x; volatile LAS unsigned* st; };
__device__ __forceinline__ XcdBarrier xcd_barrier_post(unsigned* bar, volatile LAS unsigned* st) {
    XcdBarrier b; b.bar = bar; b.x = xb_xcc_id(); b.st = st;
    if (threadIdx.x == 0) st[2] = xb_add(&bar[XB_XCNT(b.x)], 1u);
    return b;
}
__device__ __forceinline__ void xcd_barrier_complete(unsigned* bar, unsigned x, unsigned& nloc, unsigned& nx, unsigned& base) {
    const unsigned G = gridDim.x * gridDim.y * gridDim.z;
    unsigned sum, cnt, mine, sp = 0u;
    for (;;) {
        sum = 0u; cnt = 0u; mine = 0u; base = 0u;
#pragma unroll
        for (unsigned j = 0; j < 16; ++j) { const unsigned c = xb_ld(&bar[XB_XCNT(j)]); sum += c; cnt += (c > 0u) ? 1u : 0u; mine = (j == x) ? c : mine; base += (j < x) ? c : 0u; }
        if (sum == G) break;
        __builtin_amdgcn_s_sleep(1);
        if ((++sp & 255u) == 0u) { if (xb_ld(&bar[XB_TMO])) break; if (sp > XB_SPIN_CAP) { atomicAdd(&bar[XB_TMO], 1u); break; } }
    }
    nloc = mine > 0u ? mine : 1u; nx = cnt > 0u ? cnt : 1u;
}
__device__ __forceinline__ void xcd_barrier(const XcdBarrier& b) {
    asm volatile("s_waitcnt vmcnt(0)" ::: "memory");
    __syncthreads();
    if (threadIdx.x == 0) {
        unsigned* bar = b.bar;
        __builtin_amdgcn_s_waitcnt(0);
        unsigned nloc = b.st[0], nx = b.st[1];
        if (nloc == 0u) { unsigned base; xcd_barrier_complete(bar, b.x, nloc, nx, base); b.st[0] = nloc; b.st[1] = nx; b.st[3] = base; b.st[4] = b.x;
            for (unsigned j = 0; j < 16; ++j) b.st[16 + j] = xb_ld(&bar[XB_XCNT(j)]); }
        const unsigned old = xb_add(&bar[XB_XSUB(b.x)], 1u);
        const unsigned gen = old / nloc;
        if (old + 1u == (gen + 1u) * nloc) {
            __builtin_amdgcn_fence(__ATOMIC_RELEASE, "agent");
            asm volatile("s_waitcnt vmcnt(0)" ::: "memory");
            const unsigned og = xb_add(&bar[XB_TOP], 1u);
            const unsigned tg = og / nx;
            if (og + 1u == (tg + 1u) * nx) xb_add(&bar[XB_TOPGEN], 1u);
            else XB_SPIN(xb_ld(&bar[XB_TOPGEN]) == tg, bar);
            __builtin_amdgcn_fence(__ATOMIC_ACQUIRE, "agent");
            xb_add(&bar[XB_XGEN(b.x)], 1u);
            asm volatile("s_waitcnt vmcnt(0)" ::: "memory");
        } else {
            XB_SPIN(xb_ld(&bar[XB_XGEN(b.x)]) == gen, bar);
            __builtin_amdgcn_fence(__ATOMIC_ACQUIRE, "agent");
            asm volatile("s_waitcnt vmcnt(0)" ::: "memory");
        }
    }
    __syncthreads();
}

__global__ void __launch_bounds__(NTHREADS, 2) fwd_kernel(Params p) {
    extern __shared__ __attribute__((aligned(16))) unsigned char lds[];
    const int lo = p.ph_lo, hi = p.ph_hi;
    volatile LAS unsigned* st = (volatile LAS unsigned*)(lds + LDS_BARW);
    if (threadIdx.x == 0) { st[0] = 0u; st[1] = 0u; }
    __syncthreads();
    XcdBarrier bar; bar.bar = (unsigned*)(p.ws + WS_CTL); bar.x = 0; bar.st = st;
    if (hi - lo > 1) bar = xcd_barrier_post((unsigned*)(p.ws + WS_CTL), st);
#ifndef PROBE_DUP
#define PROBE_DUP -1
#endif
#define PHASE(k, call) if (lo <= (k) && (k) < hi) { const int nrep = ((k) == PROBE_DUP) ? hi - 9 : 1; for (int rep = 0; rep < nrep; ++rep) { const bool dry = rep > 0; (void)dry; call; if (rep + 1 < nrep) __syncthreads(); } if ((k) + 1 < hi) xcd_barrier(bar); }
    PHASE(0, { phase_prep(p, lds); phase_prenorm(p); })
    PHASE(2, phase_gemm_in(p, lds))
    PHASE(3, { vtrans_items(p, lds); gla1_items(p, lds); })
    PHASE(4, { gla2_scan(p); phase_attn(p, lds); })
    PHASE(5, gla3_items(p, lds))
    PHASE(6, phase_gemm_out(p, lds))
    PHASE(7, phase_postmix(p, lds, dry))
    PHASE(8, phase_moe(p, lds))
    PHASE(10, phase_combine(p, lds))
#undef PHASE
}

extern "C" void kernel_launch(void* const* d_in, const int* in_sizes, int n_in, void* d_out, int out_size, void* d_ws, size_t ws_size, hipStream_t stream) {
    static int grid_blocks = 0;
    if (grid_blocks == 0) {
        if (n_in != 19 || out_size != T * D || ws_size < WS_END) { fprintf(stderr, "kernel_launch: unexpected shapes (n_in %d out %d ws %zu need %zu)\n", n_in, out_size, ws_size, (size_t)WS_END); grid_blocks = -1; return; }
        int dev = 0, cus = 0, per_cu = 0;
        (void)hipGetDevice(&dev);
        (void)hipDeviceGetAttribute(&cus, hipDeviceAttributeMultiprocessorCount, dev);
        if (hipFuncSetAttribute((const void*)fwd_kernel, hipFuncAttributeMaxDynamicSharedMemorySize, LDS_BYTES) != hipSuccess) { fprintf(stderr, "kernel_launch: hipFuncSetAttribute failed\n"); grid_blocks = -1; return; }
        (void)hipOccupancyMaxActiveBlocksPerMultiprocessor(&per_cu, fwd_kernel, NTHREADS, LDS_BYTES);
        if (per_cu < 1) { fprintf(stderr, "kernel_launch: occupancy query reports %d blocks per CU\n", per_cu); per_cu = 1; }
        grid_blocks = cus;
        (void)hipGetLastError();
    }
    if (grid_blocks < 0) return;
    (void)hipMemsetAsync((char*)d_ws + WS_CTL, 0, CTL_BYTES, stream);
    Params p{};
    p.x = (const float*)d_in[0]; p.c = (const float*)d_in[1]; p.w_mod = (const float*)d_in[2]; p.b_mod = (const float*)d_in[3];
    p.g_pre_mix = (const float*)d_in[4]; p.w_in = (const float*)d_in[5]; p.w_gate_lr = (const float*)d_in[6]; p.b_gate = (const float*)d_in[7];
    p.g_gla = (const float*)d_in[8]; p.w_out = (const float*)d_in[9]; p.g_post_mix = (const float*)d_in[10]; p.g_pre_ffn = (const float*)d_in[11];
    p.router_w = (const float*)d_in[12]; p.router_b = (const float*)d_in[13]; p.w_gate_up = (const float*)d_in[14]; p.b_gate_up = (const float*)d_in[15];
    p.w_down = (const float*)d_in[16]; p.b_down = (const float*)d_in[17]; p.g_post_ffn = (const float*)d_in[18];
    p.out = (float*)d_out; p.ws = (unsigned char*)d_ws;
    for (int d = 0; d < 32; ++d) p.inv_freq[d] = powf(10000.0f, -(float)d / 32.0f);
#if ONE_LAUNCH
    p.ph_lo = 0; p.ph_hi = NPHASE;
    void* args[] = {&p};
    hipError_t e = hipLaunchCooperativeKernel((void*)fwd_kernel, dim3(grid_blocks), dim3(NTHREADS), args, LDS_BYTES, stream);
    if (e != hipSuccess) fprintf(stderr, "cooperative launch failed: %s (grid %d)\n", hipGetErrorString(e), grid_blocks);
#else
    for (int k = 0; k < NPHASE; ++k) { p.ph_lo = k; p.ph_hi = k + 1; hipLaunchKernelGGL(fwd_kernel, dim3(grid_blocks), dim3(NTHREADS), LDS_BYTES, stream, p); }
#endif
}
```

```cpp
#include <hip/hip_runtime.h>
#include <cstdio>
#include <cstdint>
#include <cmath>

#ifndef ONE_LAUNCH
#define ONE_LAUNCH 1
#endif

typedef unsigned short bf16_t;
typedef short bf16x8 __attribute__((ext_vector_type(8)));
typedef float f32x4 __attribute__((ext_vector_type(4)));
typedef unsigned u32x4 __attribute__((ext_vector_type(4)));
#define LAS __attribute__((address_space(3)))

constexpr int T = 16384, D = 1024, S = 8192;
constexpr int DIN = 3088, DINP = 3104;
constexpr int NE = 32, DFF = 1024;
constexpr int PMAX = 65536 + NE * 256;
constexpr int NTHREADS = 512, NW = 8;
constexpr int LDS_STAGE = 131072;
constexpr int LDS_PS = LDS_STAGE;
constexpr int LDS_BARW = LDS_STAGE + 256;
constexpr int LDS_CNT = LDS_STAGE + 512;
constexpr int LDS_TOKB = LDS_STAGE + 1024;
constexpr int LDS_BYTES = LDS_STAGE + 4096;
constexpr int NPHASE = 11;
constexpr float EPS = 1e-6f;
constexpr float LOG2E = 1.4426950408889634f;

constexpr size_t al(size_t x) { return (x + 255) & ~(size_t)255; }
constexpr size_t WS_CTL   = 0;
constexpr size_t CTL_BYTES = 65536;
constexpr size_t WS_MOD   = WS_CTL + CTL_BYTES;
constexpr size_t WS_ROPE  = al(WS_MOD + 2 * 6144 * 4);
constexpr size_t WS_WINT  = al(WS_ROPE + (size_t)S * 32 * 2 * 4);
constexpr size_t WS_WOUTT = al(WS_WINT + (size_t)DINP * D * 2);
constexpr size_t WS_WGUT  = al(WS_WOUTT + (size_t)D * D * 2);
constexpr size_t WS_WDT   = al(WS_WGUT + (size_t)NE * 2048 * D * 2);
constexpr size_t WS_H     = al(WS_WDT + (size_t)NE * D * DFF * 2);
constexpr size_t WS_QA    = al(WS_H + (size_t)T * D * 2);
constexpr size_t WS_KA    = al(WS_QA + (size_t)T * 512 * 2);
constexpr size_t WS_VA    = al(WS_KA + (size_t)T * 512 * 2);
constexpr size_t WS_VB    = al(WS_VA + (size_t)T * 512 * 2);
constexpr size_t WS_QG    = al(WS_VB + (size_t)T * 512 * 2);
constexpr size_t WS_KG    = al(WS_QG + (size_t)T * 256 * 2);
constexpr size_t WS_VG    = al(WS_KG + (size_t)T * 256 * 2);
constexpr size_t WS_RG    = al(WS_VG + (size_t)T * 512 * 2);
constexpr size_t WS_GLR   = al(WS_RG + (size_t)T * 512 * 2);
constexpr size_t WS_UT    = al(WS_GLR + (size_t)T * 16 * 4);
constexpr size_t WS_AG    = al(WS_UT + (size_t)1024 * 128 * 64 * 4);
constexpr size_t WS_SPT   = al(WS_AG + (size_t)1024 * 64 * 4);
constexpr size_t WS_CAT   = al(WS_SPT + (size_t)1024 * 128 * 64 * 2);
constexpr size_t WS_TOPI  = al(WS_CAT + (size_t)T * D * 2);
constexpr size_t WS_GATE  = al(WS_TOPI + (size_t)T * 4 * 4);
constexpr size_t WS_POS   = al(WS_GATE + (size_t)T * 4 * 4);
constexpr size_t WS_SLOT  = al(WS_POS + (size_t)T * 4 * 4);
constexpr size_t WS_TOK   = al(WS_SLOT + (size_t)T * 4 * 4);
constexpr size_t WS_ACT   = al(WS_TOK + (size_t)NE * T * 4);
constexpr size_t WS_YMIX  = WS_ACT;
constexpr size_t WS_X1    = WS_UT;
constexpr size_t WS_YE    = al(WS_ACT + (size_t)PMAX * DFF * 2);
constexpr size_t WS_IDT   = al(WS_YE + (size_t)PMAX * D * 2);
constexpr size_t WS_END   = al(WS_IDT + (size_t)PMAX * 4);
static_assert((size_t)T * D * 4 <= (size_t)PMAX * DFF * 2, "YMIX alias fits in ACT");
static_assert(WS_X1 + (size_t)T * D * 2 <= WS_AG, "X1 alias fits in UT");
constexpr int CW_CNT = 4096;
constexpr int CW_UPCNT = 4352;
constexpr int CW_MODCNT = 4224;

struct Params {
    const float *x, *c, *w_mod, *b_mod, *g_pre_mix, *w_in, *w_gate_lr, *b_gate, *g_gla, *w_out, *g_post_mix, *g_pre_ffn,
                *router_w, *router_b, *w_gate_up, *b_gate_up, *w_down, *b_down, *g_post_ffn;
    float* out; unsigned char* ws;
    int ph_lo, ph_hi;
    float inv_freq[32];
};

__device__ __forceinline__ unsigned f2bf(float f) { unsigned u = __builtin_bit_cast(unsigned, f); return (u + 0x7fffu + ((u >> 16) & 1u)) >> 16; }
typedef float f32x2_t __attribute__((ext_vector_type(2))); typedef __bf16 bf16x2_t __attribute__((ext_vector_type(2)));
__device__ __forceinline__ unsigned pk2(float lo, float hi) { f32x2_t v = {lo, hi}; bf16x2_t b = __builtin_convertvector(v, bf16x2_t); return __builtin_bit_cast(unsigned, b); }
__device__ __forceinline__ float bf2f(unsigned short b) { return __builtin_bit_cast(float, (unsigned)b << 16); }
__device__ __forceinline__ float4 ntload4(const float4* p) { const f32x4 t = __builtin_nontemporal_load((const f32x4*)p); return make_float4(t[0], t[1], t[2], t[3]); }
__device__ __forceinline__ uint2 ntload2(const uint2* p) { typedef unsigned u32x2 __attribute__((ext_vector_type(2))); const u32x2 t = __builtin_nontemporal_load((const u32x2*)p); return make_uint2(t[0], t[1]); }
__device__ __forceinline__ void ntstore4(float4* p, float4 v) { const f32x4 t = {v.x, v.y, v.z, v.w}; __builtin_nontemporal_store(t, (f32x4*)p); }
__device__ __forceinline__ void ntstore2(uint2* p, uint2 v) { typedef unsigned u32x2 __attribute__((ext_vector_type(2))); const u32x2 t = {v.x, v.y}; __builtin_nontemporal_store(t, (u32x2*)p); }
__device__ __forceinline__ void ntstore4u(uint4* p, uint4 v) { const u32x4 t = {v.x, v.y, v.z, v.w}; __builtin_nontemporal_store(t, (u32x4*)p); }
__device__ __forceinline__ float wave_sum(float v) {
#pragma unroll
    for (int o = 1; o < 64; o <<= 1) v += __shfl_xor(v, o);
    return v;
}
__device__ __forceinline__ float fexp2(float x) { return __builtin_amdgcn_exp2f(x); }
__device__ __forceinline__ float fexp(float x) { return __builtin_amdgcn_exp2f(x * LOG2E); }
__device__ __forceinline__ float flog(float x) { return __builtin_amdgcn_logf(x) * 0.6931471805599453f; }
__device__ __forceinline__ float fsilu(float x) { return x / (1.f + fexp(-x)); }

#define GAS __attribute__((address_space(1)))
namespace pg8 {
constexpr int BM = 256, BK = 64, HALF = 128, HTB = HALF * BK * 2, NXCD = 8, WGM = 8;
__host__ __device__ __forceinline__ int lds_byte(int r, int c) { const int st = (r >> 4) * 2 + (c >> 5), rr = r & 15, cc = c & 31, ob = rr * 64 + cc * 2; return st * 1024 + (ob ^ (((ob >> 9) & 1) << 5)); }
__host__ __device__ __forceinline__ void stage_rc(int b, int& R, int& C) { const int st = b / 1024, sb = b % 1024, swz = sb ^ (((sb >> 9) & 1) << 5); R = (st >> 1) * 16 + swz / 64; C = (st & 1) * 32 + (swz % 64) / 2; }
__host__ __device__ __forceinline__ int perm32(int rho) { const int n = rho >> 4, i = rho & 15; return 8 * (i >> 2) + 4 * n + (i & 3); }

struct Unit { const char* A; const char* B; unsigned ao[2][2]; int row0, pn, e, nvalid, tb0; };

__device__ __forceinline__ int xcd_remap(int wgid, int nwg) { const int q = nwg / NXCD, r = nwg % NXCD, xcd = wgid % NXCD, off = wgid / NXCD; return (xcd < r ? xcd * (q + 1) : r * (q + 1) + (xcd - r) * q) + off; }
__device__ __forceinline__ const char* uptr(const char* p) {
    const unsigned long long v = (unsigned long long)p;
    const unsigned lo = __builtin_amdgcn_readfirstlane((unsigned)v), hi = __builtin_amdgcn_readfirstlane((unsigned)(v >> 32));
    return (const char*)(((unsigned long long)hi << 32) | lo);
}

template <class Epi, class Sched>
__device__ __forceinline__ void gemm_phase(LAS unsigned char* lds, const int K, const Sched& S, const Epi& E) {
    constexpr bool GATHER = Sched::GATHER;
    const int tid = threadIdx.x, wid = __builtin_amdgcn_readfirstlane(tid >> 6), lane = tid & 63, wr = wid >> 2, wc = wid & 3, fr = lane & 15, fq = lane >> 4;
    const int nt = K / BK;
    unsigned voffA[2], voffB[2];
#pragma unroll
    for (int i = 0; i < 2; ++i) { int R, C; stage_rc(tid * 16 + i * 8192, R, C); const int Rb = Epi::PERM ? ((R & ~31) + perm32(R & 31)) : R;
        voffA[i] = (unsigned)(R * K + C) * 2u; voffB[i] = (unsigned)(Rb * K + C) * 2u; }
    const size_t kstep = (size_t)(BK * 2);
    const size_t hstep = (size_t)HALF * K * 2;
    const unsigned ldsw = (unsigned)wid * 1024u;
    const int aoff = lds_byte(wr * 64 + fr, fq * 8), boff = lds_byte(wc * 32 + fr, fq * 8);
#define PG8_SA(b, h) (((b) * 2 + (h)) * HTB)
#define PG8_SB(b, h) ((4 + (b) * 2 + (h)) * HTB)
#define PG8_STAGE(bufoff, gbase, voff) do { _Pragma("unroll") for (int _i = 0; _i < 2; ++_i) \
        __builtin_amdgcn_global_load_lds((const unsigned*)((const char*)(gbase) + (voff)[_i]), (LAS unsigned*)(lds + (bufoff) + ldsw + _i * 8192), 16, 0, 0); } while (0)
#define PG8_STAGE_A(bufoff, ap, ao, h) do { if constexpr (GATHER) PG8_STAGE(bufoff, ap, (ao)[h]); else PG8_STAGE(bufoff, (ap) + (size_t)(h) * hstep, voffA); } while (0)
#define PG8_LDA(dst, b, h) do { _Pragma("unroll") for (int m = 0; m < 4; ++m) _Pragma("unroll") for (int k = 0; k < 2; ++k) dst[m][k] = *(const LAS bf16x8*)(lds + PG8_SA(b, h) + aoff + m * 2048 + k * 1024); } while (0)
#define PG8_LDB(dst, b, h) do { _Pragma("unroll") for (int n = 0; n < 2; ++n) _Pragma("unroll") for (int k = 0; k < 2; ++k) dst[n][k] = *(const LAS bf16x8*)(lds + PG8_SB(b, h) + boff + n * 2048 + k * 1024); } while (0)
#define PG8_MMA(ai, bj, At, Bt) do { __builtin_amdgcn_s_setprio(1); _Pragma("unroll") for (int m = 0; m < 4; ++m) _Pragma("unroll") for (int n = 0; n < 2; ++n) _Pragma("unroll") for (int k = 0; k < 2; ++k) \
        acc[ai][bj][m][n] = __builtin_amdgcn_mfma_f32_16x16x32_bf16(Bt[n][k], At[m][k], acc[ai][bj][m][n], 0, 0, 0); __builtin_amdgcn_s_setprio(0); } while (0)
#define PG8_UCOPY(d, s_) do { (d).A = (s_).A; (d).B = (s_).B; (d).row0 = (s_).row0; (d).pn = (s_).pn; (d).e = (s_).e; (d).nvalid = (s_).nvalid; (d).tb0 = (s_).tb0; } while (0)
#define PG8_WAIT_V(n) asm volatile("s_waitcnt vmcnt(" #n ")" ::: "memory")
#define PG8_WAIT_L(n) asm volatile("s_waitcnt lgkmcnt(" #n ")" ::: "memory")
#define PG8_BAR __builtin_amdgcn_s_barrier()
#define PG8_SCHED __builtin_amdgcn_sched_barrier(0)
    Unit cur, nxt; int ui = 0;
    int pend = -1;
    if (!S.next(0, cur)) return;
    if constexpr (GATHER) S.first_rows(cur);
    f32x4 acc[2][2][4][2];
#pragma unroll
    for (int a = 0; a < 2; ++a)
#pragma unroll
        for (int b = 0; b < 2; ++b)
#pragma unroll
            for (int m = 0; m < 4; ++m)
#pragma unroll
                for (int n = 0; n < 2; ++n) acc[a][b][m][n] = (f32x4){0.f, 0.f, 0.f, 0.f};
    bf16x8 At[4][2], B0[2][2], B1[2][2];
#ifndef PG8_SP2
#define PG8_SP2 1
#endif
#if PG8_SP2
    PG8_STAGE(PG8_SB(0, 0), cur.B, voffB); PG8_STAGE(PG8_SB(0, 1), cur.B + hstep, voffB); PG8_STAGE_A(PG8_SA(0, 0), cur.A, cur.ao, 0); PG8_STAGE_A(PG8_SA(0, 1), cur.A, cur.ao, 1);
    if (wr == 1) PG8_BAR;
    PG8_WAIT_V(2); PG8_BAR;
#else
    PG8_STAGE(PG8_SB(0, 0), cur.B, voffB); PG8_STAGE_A(PG8_SA(0, 0), cur.A, cur.ao, 0); PG8_STAGE(PG8_SB(0, 1), cur.B + hstep, voffB); PG8_STAGE_A(PG8_SA(0, 1), cur.A, cur.ao, 1);
    if (wr == 1) PG8_BAR;
    PG8_WAIT_V(4); PG8_BAR;
#endif
    PG8_STAGE(PG8_SB(1, 0), cur.B + kstep, voffB); PG8_STAGE_A(PG8_SA(1, 0), cur.A + kstep, cur.ao, 0); PG8_STAGE(PG8_SB(1, 1), cur.B + hstep + kstep, voffB);
    PG8_WAIT_V(6); PG8_BAR;
    for (;;) {
        const bool has_next = S.next(ui + 1, nxt);
        if constexpr (GATHER) { if (has_next && wid < 4) S.prefetch_rows(nxt, (LAS unsigned*)(lds + LDS_TOKB + ((ui + 1) & 1) * 1024 + wid * 256), wid, lane); }
        if constexpr (Sched::HOOKS) { if (has_next) S.poll(nxt, (LAS unsigned*)(lds + LDS_BARW + 32 + wid * 4), lane); }
        if (!has_next) { PG8_UCOPY(nxt, cur); }
        for (int t = 0; t < nt; t += 2) {
            const bool last = (t == nt - 2);
            if constexpr (Sched::HOOKS) {
                if (t == 2 && pend >= 0) { S.publish(pend, lane); pend = -1; }
                if (last && has_next) S.a_ready(nxt, (const LAS unsigned*)(lds + LDS_BARW + 32 + wid * 4));
            }
            const char* a1 = cur.A + (size_t)(t + 1) * kstep;
            const char* a2 = last ? nxt.A : cur.A + (size_t)(t + 2) * kstep; const char* b2 = last ? nxt.B : cur.B + (size_t)(t + 2) * kstep;
            const char* a3 = a2 + kstep; const char* b3 = b2 + kstep;
            unsigned o2[2][2];
            if constexpr (GATHER) {
                const LAS int* tb = (const LAS int*)(lds + LDS_TOKB + ((ui + 1) & 1) * 1024);
#pragma unroll
                for (int q = 0; q < 2; ++q) { int R, C; stage_rc(tid * 16 + q * 8192, R, C);
#pragma unroll
                    for (int h = 0; h < 2; ++h) { const int i = h * HALF + R; const int tk = i < nxt.nvalid ? tb[i] : 0; o2[h][q] = (last && has_next) ? (unsigned)(tk * K + C) * 2u : cur.ao[h][q]; } }
            }
#if !PG8_SP2
            PG8_LDB(B0, 0, 0); PG8_SCHED; PG8_LDA(At, 0, 0); PG8_STAGE_A(PG8_SA(1, 1), a1, cur.ao, 1);
            PG8_WAIT_L(8); PG8_BAR; PG8_WAIT_L(0); PG8_MMA(0, 0, At, B0); PG8_BAR; PG8_SCHED;
            PG8_LDB(B1, 0, 1); PG8_STAGE(PG8_SB(0, 0), b2, voffB);
            PG8_BAR; PG8_WAIT_L(0); PG8_MMA(0, 1, At, B1); PG8_BAR;
            PG8_LDA(At, 0, 1); PG8_STAGE_A(PG8_SA(0, 0), a2, o2, 0);
            PG8_BAR; PG8_WAIT_L(0); PG8_MMA(1, 0, At, B0); PG8_BAR; PG8_SCHED;
            PG8_STAGE(PG8_SB(0, 1), b2 + hstep, voffB);
            PG8_WAIT_V(6); PG8_BAR; PG8_MMA(1, 1, At, B1); PG8_BAR;
            PG8_LDB(B0, 1, 0); PG8_SCHED; PG8_LDA(At, 1, 0); PG8_STAGE_A(PG8_SA(0, 1), a2, o2, 1);
            PG8_WAIT_L(8); PG8_BAR; PG8_WAIT_L(0); PG8_MMA(0, 0, At, B0); PG8_BAR; PG8_SCHED;
            PG8_LDB(B1, 1, 1); PG8_STAGE(PG8_SB(1, 0), b3, voffB);
            PG8_BAR; PG8_WAIT_L(0); PG8_MMA(0, 1, At, B1); PG8_BAR;
            PG8_LDA(At, 1, 1); PG8_STAGE_A(PG8_SA(1, 0), a3, o2, 0);
            PG8_BAR; PG8_WAIT_L(0); PG8_MMA(1, 0, At, B0); PG8_BAR; PG8_SCHED;
            PG8_STAGE(PG8_SB(1, 1), b3 + hstep, voffB);
            PG8_WAIT_V(6); PG8_BAR; PG8_MMA(1, 1, At, B1); PG8_BAR;
#else
            PG8_LDB(B0, 0, 0); PG8_LDB(B1, 0, 1); PG8_SCHED; PG8_LDA(At, 0, 0); PG8_STAGE_A(PG8_SA(1, 1), a1, cur.ao, 1);
            PG8_WAIT_V(8); PG8_WAIT_L(0); PG8_BAR; PG8_MMA(0, 0, At, B0); PG8_MMA(0, 1, At, B1); PG8_BAR; PG8_SCHED;
            PG8_LDA(At, 0, 1); PG8_STAGE(PG8_SB(0, 0), b2, voffB); PG8_STAGE(PG8_SB(0, 1), b2 + hstep, voffB); PG8_STAGE_A(PG8_SA(0, 0), a2, o2, 0);
            PG8_WAIT_V(8); PG8_WAIT_L(0); PG8_BAR; PG8_MMA(1, 0, At, B0); PG8_MMA(1, 1, At, B1); PG8_BAR; PG8_SCHED;
            PG8_LDB(B0, 1, 0); PG8_LDB(B1, 1, 1); PG8_SCHED; PG8_LDA(At, 1, 0); PG8_STAGE_A(PG8_SA(0, 1), a2, o2, 1);
            PG8_WAIT_V(8); PG8_WAIT_L(0); PG8_BAR; PG8_MMA(0, 0, At, B0); PG8_MMA(0, 1, At, B1); PG8_BAR; PG8_SCHED;
            PG8_LDA(At, 1, 1); PG8_STAGE(PG8_SB(1, 0), b3, voffB); PG8_STAGE(PG8_SB(1, 1), b3 + hstep, voffB); PG8_STAGE_A(PG8_SA(1, 0), a3, o2, 0);
            PG8_WAIT_V(8); PG8_WAIT_L(0); PG8_BAR; PG8_MMA(1, 0, At, B0); PG8_MMA(1, 1, At, B1); PG8_BAR; PG8_SCHED;
#endif
        }
        if (wr == 0) PG8_BAR;
        E(acc, cur, wr, wc, fr, fq);
        if constexpr (Sched::HOOKS) pend = S.pub_tile(cur);
        if (!has_next) break;
#pragma unroll
        for (int a = 0; a < 2; ++a)
#pragma unroll
            for (int b = 0; b < 2; ++b)
#pragma unroll
                for (int m = 0; m < 4; ++m)
#pragma unroll
                    for (int n = 0; n < 2; ++n) acc[a][b][m][n] = (f32x4){0.f, 0.f, 0.f, 0.f};
        PG8_UCOPY(cur, nxt); ++ui;
        if constexpr (GATHER) {
            const LAS int* tb = (const LAS int*)(lds + LDS_TOKB + (ui & 1) * 1024);
#pragma unroll
            for (int q = 0; q < 2; ++q) { int R, C; stage_rc(tid * 16 + q * 8192, R, C);
#pragma unroll
                for (int h = 0; h < 2; ++h) { const int i = h * HALF + R; const int tk = i < cur.nvalid ? tb[i] : 0; cur.ao[h][q] = (unsigned)(tk * K + C) * 2u; } }
        }
        if (wr == 1) PG8_BAR;
    }
    PG8_WAIT_V(0);
    if constexpr (Sched::HOOKS) { if (pend >= 0) S.publish(pend, lane); }
    PG8_BAR;
#undef PG8_SA
#undef PG8_SB
#undef PG8_STAGE
#undef PG8_STAGE_A
#undef PG8_LDA
#undef PG8_LDB
#undef PG8_MMA
#undef PG8_WAIT_V
#undef PG8_UCOPY
#undef PG8_WAIT_L
#undef PG8_BAR
#undef PG8_SCHED
}

struct DenseSched {
    static constexpr bool GATHER = false, HOOKS = false;
    const char* A; const char* Bt; int K, nM, nN, nwg, G, c;
    __device__ __forceinline__ void init(const void* A_, const void* Bt_, int M, int N, int K_) {
        A = uptr((const char*)A_); Bt = uptr((const char*)Bt_); K = K_; nM = M / BM; nN = N / BM; nwg = nM * nN; G = gridDim.x; c = blockIdx.x;
    }
    __device__ __forceinline__ bool next(int i, Unit& u) const {
        const long L = (long)i * G + c; if (L >= nwg) return false;
        const int wgid = xcd_remap((int)L, nwg);
        const int nig = WGM * nN, gid = wgid / nig, fm = gid * WGM, gsz = (nM - fm) < WGM ? (nM - fm) : WGM;
        const int pm = fm + ((wgid % nig) % gsz), pn = (wgid % nig) / gsz;
        u.A = A + (size_t)pm * BM * K * 2; u.B = Bt + (size_t)pn * BM * K * 2; u.row0 = pm * BM; u.pn = pn; u.e = 0; u.nvalid = BM; u.tb0 = 0;
        return true;
    }
};
template <bool GATHER_>
struct MoeSched {
    static constexpr bool GATHER = GATHER_, HOOKS = false;
    const char* A; const char* W; int K, nN, rows_per_e, nwg, G, c; const int* ps; const int* cn; const int* tok;
    __device__ __forceinline__ void init(const void* A_, const void* W_, int K_, int nN_, int rows_per_e_, const int* ps_, const int* tok_) {
        A = uptr((const char*)A_); W = uptr((const char*)W_); K = K_; nN = nN_; rows_per_e = rows_per_e_; ps = ps_; cn = ps_ + (LDS_CNT - LDS_PS) / 4; tok = (const int*)uptr((const char*)tok_); G = gridDim.x; c = blockIdx.x;
        nwg = __builtin_amdgcn_readfirstlane((ps[NE] >> 8) * nN);
    }
    __device__ __forceinline__ bool next(int i, Unit& u) const {
        const long L = (long)i * G + c; if (L >= nwg) return false;
        const int wgid = xcd_remap((int)L, nwg);
        const int rt = wgid / nN, pn = wgid % nN, slot0 = rt * BM;
        int e = 0;
        for (int q = 1; q < NE; ++q) e = (ps[q] <= slot0) ? q : e;
        e = __builtin_amdgcn_readfirstlane(e);
        u.B = W + ((size_t)e * rows_per_e + (size_t)pn * BM) * K * 2; u.row0 = slot0; u.pn = pn; u.e = e;
        const int pos0 = __builtin_amdgcn_readfirstlane(slot0 - ps[e]);
        u.nvalid = __builtin_amdgcn_readfirstlane(cn[e]) - pos0; u.tb0 = e * T + pos0;
        if constexpr (GATHER) u.A = A; else u.A = A + (size_t)slot0 * K * 2;
        return true;
    }
    __device__ __forceinline__ void first_rows(Unit& u) const {
#pragma unroll
        for (int q = 0; q < 2; ++q) { int R, C; stage_rc(threadIdx.x * 16 + q * 8192, R, C);
#pragma unroll
            for (int h = 0; h < 2; ++h) { const int i = h * HALF + R; const int tk = i < u.nvalid ? tok[u.tb0 + i] : 0; u.ao[h][q] = (unsigned)(tk * K + C) * 2u; } }
    }
    __device__ __forceinline__ void prefetch_rows(const Unit& u, LAS unsigned* dst, int wid, int lane) const {
        __builtin_amdgcn_global_load_lds((const unsigned*)(tok + u.tb0 + wid * 64 + lane), dst, 4, 0, 0);
    }
};
struct MoeSched2 {
    static constexpr bool GATHER = true, HOOKS = true;
    const char* ws; int K, nU, nDl, nwg, G, c, rt0, nexp; const int* ps; const int* cn; const int* tok; const LAS int* imp; GAS int* upcnt;
    __device__ __forceinline__ void init(unsigned char* ws_, const int* ps_, int nloc, int rank, const LAS int* ms) {
        ws = uptr((const char*)ws_); K = D; ps = ps_; cn = ps_ + (LDS_CNT - LDS_PS) / 4; tok = (const int*)(ws + WS_TOK); upcnt = (GAS int*)(ws + WS_CTL) + CW_UPCNT;
        G = __builtin_amdgcn_readfirstlane(nloc); c = __builtin_amdgcn_readfirstlane(rank);
        rt0 = __builtin_amdgcn_readfirstlane(ms[0]); const int nt_ = __builtin_amdgcn_readfirstlane(ms[1]); nexp = __builtin_amdgcn_readfirstlane(ms[2]); const int nimp = __builtin_amdgcn_readfirstlane(ms[3]); imp = ms + 8;
        nU = nt_ * 8; nDl = (nt_ - nexp) * 4; nwg = nU + nDl + nimp * 4;
    }
    __device__ __forceinline__ bool next(int i, Unit& u) const {
        const int L = i * G + c; if (L >= nwg) return false;
        const bool dn = L >= nU;
        int rt, pn, sh = 0;
        if (!dn) { rt = rt0 + (L >> 3); pn = L & 7; sh = (L >> 3) < nexp ? 64 : 0; }
        else if (L >= nwg - nDl) { const int d = L - (nwg - nDl); rt = rt0 + nexp + (d >> 2); pn = d & 3; }
        else { const int d = L - nU; rt = __builtin_amdgcn_readfirstlane(imp[d >> 2]); pn = d & 3; sh = 64; }
        const int slot0 = rt * BM;
        int e = 0;
        for (int q = 1; q < NE; ++q) e = (ps[q] <= slot0) ? q : e;
        e = __builtin_amdgcn_readfirstlane(e);
        u.row0 = slot0; u.pn = pn;
        const int pos0 = __builtin_amdgcn_readfirstlane(slot0 - ps[e]);
        if (dn) { u.B = ws + WS_WDT + ((size_t)e * 1024 + (size_t)pn * BM) * (size_t)(D * 2); u.A = ws + WS_ACT; u.e = e | 32 | sh; u.nvalid = BM; u.tb0 = (int)((WS_IDT - WS_TOK) / 4) + slot0; }
        else    { u.B = ws + WS_WGUT + ((size_t)e * 2048 + (size_t)pn * BM) * (size_t)(D * 2); u.A = ws + WS_H; u.e = e | sh; u.nvalid = __builtin_amdgcn_readfirstlane(cn[e]) - pos0; u.tb0 = e * T + pos0; }
        return true;
    }
    __device__ __forceinline__ void first_rows(Unit& u) const {
#pragma unroll
        for (int q = 0; q < 2; ++q) { int R, C; stage_rc(threadIdx.x * 16 + q * 8192, R, C);
#pragma unroll
            for (int h = 0; h < 2; ++h) { const int i = h * HALF + R; const int tk = i < u.nvalid ? tok[u.tb0 + i] : 0; u.ao[h][q] = (unsigned)(tk * K + C) * 2u; } }
    }
    __device__ __forceinline__ void prefetch_rows(const Unit& u, LAS unsigned* dst, int wid, int lane) const {
        __builtin_amdgcn_global_load_lds((const unsigned*)(tok + u.tb0 + wid * 64 + lane), dst, 4, 0, 0);
    }
    __device__ __forceinline__ void poll(const Unit& u, LAS unsigned* w, int lane) const {
        if ((u.e & 32) && lane == 0) __builtin_amdgcn_global_load_lds((const GAS unsigned*)(upcnt + (u.row0 >> 8)), w, 4, 0, 16  );
    }
    __device__ __forceinline__ void a_ready(const Unit& u, const LAS unsigned* w) const {
        if (u.e & 32) {
            const int rdy = __builtin_amdgcn_readfirstlane((int)*w);
            if (rdy < 64) { const GAS int* cp = upcnt + (u.row0 >> 8); int spins = 0;
                while (__hip_atomic_load(cp, __ATOMIC_RELAXED, __HIP_MEMORY_SCOPE_AGENT) < 64 && ++spins < (1 << 22)) __builtin_amdgcn_s_sleep(4); }
            if (u.e & 64) asm volatile("buffer_inv sc1" ::: "memory");
            else asm volatile("" ::: "memory");
        }
    }
    __device__ __forceinline__ int pub_tile(const Unit& u) const { return (u.e & 32) ? -1 : (u.row0 >> 8); }
    __device__ __forceinline__ void publish(int rt, int lane) const { if (lane == 0) __hip_atomic_fetch_add(upcnt + rt, 1, __ATOMIC_RELAXED, __HIP_MEMORY_SCOPE_AGENT); }
};
}

__device__ __forceinline__ int win_row(int oc) {
    if (oc >= 1024) return oc;
    const int base = oc & ~511, o = oc & 511;
    return base + 32 * ((o >> 6) * 2 + ((o & 31) >> 4)) + 8 * ((o & 15) >> 2) + 4 * ((o >> 5) & 1) + (o & 3);
}
__device__ __forceinline__ int wgu_row(int oc) { const int jj = oc >> 1, il = oc & 1; return 32 * (jj >> 4) + 8 * ((jj & 15) >> 2) + 4 * il + (jj & 3); }

struct CvtItem { const float* W; bf16_t* WT; int ldw, nvalid, K, k0, n0, map; };
__device__ __forceinline__ void cvt_load(const CvtItem& it, int lane, float4 (&v)[8]) {
    const int col = it.n0 + (lane & 7) * 4;
    const float* src = it.W + (size_t)(it.k0 + (lane >> 3)) * it.ldw + col;
#pragma unroll
    for (int i = 0; i < 8; ++i) { const f32x4 t = (col < it.nvalid) ? __builtin_nontemporal_load((const f32x4*)(src + (size_t)(8 * i) * it.ldw)) : (f32x4){0.f, 0.f, 0.f, 0.f};
        v[i] = make_float4(t[0], t[1], t[2], t[3]); }
}
__device__ __forceinline__ void cvt_store(const CvtItem& it, int lane, const float4 (&v)[8], float* scr) {
    const int r8 = lane >> 3, c4 = (lane & 7) * 4;
#pragma unroll
    for (int i = 0; i < 8; ++i) { float* d = scr + (8 * i + r8) * 33 + c4; d[0] = v[i].x; d[1] = v[i].y; d[2] = v[i].z; d[3] = v[i].w; }
    asm volatile("s_waitcnt lgkmcnt(0)" ::: "memory");
    const int c = lane & 7;
#pragma unroll
    for (int j = 0; j < 4; ++j) { const int n = (lane >> 3) + 8 * j; const float* s = scr + (8 * c) * 33 + n;
        uint4 o; o.x = pk2(s[0 * 33], s[1 * 33]); o.y = pk2(s[2 * 33], s[3 * 33]); o.z = pk2(s[4 * 33], s[5 * 33]); o.w = pk2(s[6 * 33], s[7 * 33]);
        const int oc = it.n0 + n;
        const int orow = it.map == 1 ? win_row(oc) : (it.map == 2 ? wgu_row(oc) : oc);
        ntstore4u((uint4*)(it.WT + (size_t)orow * it.K + it.k0 + 8 * c), o); }
    asm volatile("s_waitcnt lgkmcnt(0)" ::: "memory");
}
__device__ void phase_prep(const Params& p, unsigned char* lds) {
    const int tid = threadIdx.x, lane = tid & 63, wave = tid >> 6;
    unsigned char* ws = p.ws;
    for (int i = blockIdx.x * NTHREADS + tid; i < PMAX; i += gridDim.x * NTHREADS) ((int*)(ws + WS_IDT))[i] = i;
    if ((int)blockIdx.x < 192) {
        float* sl = (float*)lds;
        float* red = sl + 2048;
        for (int i = tid; i < 2048; i += NTHREADS) sl[i] = fsilu(p.c[i]);
        __syncthreads();
        for (int it = blockIdx.x; it < 192; it += gridDim.x) {
            const int col = it * 32 + (tid & 31), kg = tid >> 5;
            float a0 = 0.f, a1 = 0.f;
#pragma unroll 8
            for (int kk = 0; kk < 64; ++kk) { const int k = kg * 64 + kk; const float w = __builtin_nontemporal_load(p.w_mod + (size_t)k * 6144 + col); a0 += sl[k] * w; a1 += sl[1024 + k] * w; }
            red[(kg * 32 + (tid & 31)) * 2 + 0] = a0; red[(kg * 32 + (tid & 31)) * 2 + 1] = a1;
            __syncthreads();
            if (tid < 64) { const int b = tid >> 5, cg_ = tid & 31; float s = 0.f;
#pragma unroll
                for (int g = 0; g < 16; ++g) s += red[(g * 32 + cg_) * 2 + b];
                const int cc = it * 32 + cg_;
                __hip_atomic_store((float*)(ws + WS_MOD) + b * 6144 + cc, s + p.b_mod[cc], __ATOMIC_RELAXED, __HIP_MEMORY_SCOPE_AGENT);
                asm volatile("s_waitcnt vmcnt(0)" ::: "memory"); }
            __syncthreads();
            if (tid == 0) __hip_atomic_fetch_add((unsigned*)(ws + WS_CTL) + CW_MODCNT, 1u, __ATOMIC_RELAXED, __HIP_MEMORY_SCOPE_AGENT);
        }
    }
    __syncthreads();
    {
        float2* rope = (float2*)(ws + WS_ROPE);
        for (int i = blockIdx.x * NTHREADS + tid; i < S * 32; i += gridDim.x * NTHREADS) {
            const int pos = i >> 5, d = i & 31;
            const float angf = (float)pos * p.inv_freq[d];
            const double ang = (double)angf;
            const double TWO_PI = 6.283185307179586476925286766559, HALF_PI = 1.5707963267948966192313216916398;
            const double n = __builtin_rint(ang / TWO_PI);
            const double rr = ang - n * TWO_PI;
            const double q = __builtin_rint(rr / HALF_PI);
            const double y = rr - q * HALF_PI;
            const double y2 = y * y;
            const double sy = y * (1.0 + y2 * (-1.0 / 6 + y2 * (1.0 / 120 + y2 * (-1.0 / 5040 + y2 * (1.0 / 362880 + y2 * (-1.0 / 39916800 + y2 * (1.0 / 6227020800.0)))))));
            const double cy = 1.0 + y2 * (-0.5 + y2 * (1.0 / 24 + y2 * (-1.0 / 720 + y2 * (1.0 / 40320 + y2 * (-1.0 / 3628800 + y2 * (1.0 / 479001600.0))))));
            const int qi = ((int)q) & 3;
            double cs, sn;
            if (qi == 0) { cs = cy; sn = sy; } else if (qi == 1) { cs = -sy; sn = cy; } else if (qi == 2) { cs = -cy; sn = -sy; } else { cs = sy; sn = -cy; }
            rope[i] = make_float2((float)cs, (float)sn);
        }
    }
    {
        float* scr = (float*)(lds + wave * 8448);
        const int gw = blockIdx.x * NW + wave, ngw = gridDim.x * NW;
        constexpr int I_IN = 16 * 97, I_OUT = 16 * 32, I_GU = 16 * 64, I_DN = 16 * 32;
        constexpr int NITEMS = I_IN + I_OUT + NE * I_GU + NE * I_DN;
        auto decode = [&](int r, CvtItem& it) {
            if (r < I_IN) { it.W = p.w_in; it.WT = (bf16_t*)(ws + WS_WINT); it.ldw = DIN; it.nvalid = DIN; it.K = D; it.k0 = (r / 97) * 64; it.n0 = (r % 97) * 32; it.map = 1; return; }
            r -= I_IN;
            if (r < I_OUT) { it.W = p.w_out; it.WT = (bf16_t*)(ws + WS_WOUTT); it.ldw = D; it.nvalid = D; it.K = D; it.k0 = (r / 32) * 64; it.n0 = (r % 32) * 32; it.map = 0; return; }
            r -= I_OUT;
            if (r < NE * I_GU) { const int e = r / I_GU, q = r % I_GU;
                it.W = p.w_gate_up + (size_t)e * D * 2048; it.WT = (bf16_t*)(ws + WS_WGUT) + (size_t)e * 2048 * D; it.ldw = 2048; it.nvalid = 2048; it.K = D; it.k0 = (q / 64) * 64; it.n0 = (q % 64) * 32; it.map = 2; return; }
            r -= NE * I_GU;
            { const int e = r / I_DN, q = r % I_DN;
                it.W = p.w_down + (size_t)e * DFF * D; it.WT = (bf16_t*)(ws + WS_WDT) + (size_t)e * D * DFF; it.ldw = D; it.nvalid = D; it.K = DFF; it.k0 = (q / 32) * 64; it.n0 = (q % 32) * 32; it.map = 0; }
        };
        if (gw < NITEMS) {
            CvtItem cur, nxt; float4 vc[8], vn[8];
            decode(gw, cur); cvt_load(cur, lane, vc);
            for (int r = gw; r < NITEMS; r += ngw) {
                const bool more = r + ngw < NITEMS;
                if (more) { decode(r + ngw, nxt); cvt_load(nxt, lane, vn); }
                cvt_store(cur, lane, vc, scr);
                if (more) { cur = nxt;
#pragma unroll
                    for (int i = 0; i < 8; ++i) vc[i] = vn[i]; }
            }
        }
    }
}

__device__ void phase_prenorm(const Params& p) {
    const int tid = threadIdx.x, lane = tid & 63, wave = tid >> 6;
    if (tid == 0) {
        unsigned* cnt = (unsigned*)(p.ws + WS_CTL) + CW_MODCNT; unsigned sp = 0;
        while (__hip_atomic_load(cnt, __ATOMIC_RELAXED, __HIP_MEMORY_SCOPE_AGENT) < 192u) { __builtin_amdgcn_s_sleep(2); if (++sp > (1u << 20)) break; }
        __builtin_amdgcn_fence(__ATOMIC_ACQUIRE, "agent");
        asm volatile("s_waitcnt vmcnt(0)" ::: "memory");
    }
    __syncthreads();
    const float* mod = (const float*)(p.ws + WS_MOD);
    bf16_t* H = (bf16_t*)(p.ws + WS_H);
    for (int m0 = (blockIdx.x * NW + wave) * 2; m0 < T; m0 += gridDim.x * NW * 2) {
        float4 v[2][4];
#pragma unroll
        for (int q = 0; q < 2; ++q) { const float4* xr = (const float4*)(p.x + (size_t)(m0 + q) * D) + lane;
#pragma unroll
            for (int j = 0; j < 4; ++j) v[q][j] = ntload4(xr + 64 * j); }
#pragma unroll
        for (int q = 0; q < 2; ++q) {
            const int m = m0 + q, b = m >> 13;
            float ss = 0.f;
#pragma unroll
            for (int j = 0; j < 4; ++j) ss += v[q][j].x * v[q][j].x + v[q][j].y * v[q][j].y + v[q][j].z * v[q][j].z + v[q][j].w * v[q][j].w;
            const float rstd = rsqrtf(wave_sum(ss) * (1.f / D) + EPS);
#pragma unroll
            for (int j = 0; j < 4; ++j) { const int c = 4 * lane + 256 * j;
                const float4 g = *(const float4*)(p.g_pre_mix + c), sh = *(const float4*)(mod + b * 6144 + c), sc = *(const float4*)(mod + b * 6144 + 1024 + c);
                const float h0 = v[q][j].x * rstd * g.x * (1.f + sc.x) + sh.x, h1 = v[q][j].y * rstd * g.y * (1.f + sc.y) + sh.y;
                const float h2 = v[q][j].z * rstd * g.z * (1.f + sc.z) + sh.z, h3 = v[q][j].w * rstd * g.w * (1.f + sc.w) + sh.w;
                uint2 o; o.x = pk2(h0, h1); o.y = pk2(h2, h3);
                *(uint2*)(H + (size_t)m * D + c) = o; }
        }
    }
}

struct EpiIn {
    static constexpr bool PERM = true;
    unsigned char* ws;
    __device__ __forceinline__ void operator()(const f32x4 (&acc)[2][2][4][2], const pg8::Unit& u, int wr, int wc, int fr, int fq) const {
        const int cbase = u.pn * 256;
        if (cbase < 1024) {
            const bool isq = cbase < 512;
            bf16_t* dst = (bf16_t*)(ws + (isq ? WS_QA : WS_KA));
            const float2* rope = (const float2*)(ws + WS_ROPE);
            const float scl = isq ? 0.125f * LOG2E : 1.f;
#pragma unroll
            for (int bj = 0; bj < 2; ++bj) {
                const int grp = ((cbase & 511) >> 5) + 4 * bj + wc, head = grp >> 1, dl = (grp & 1) * 16 + 4 * fq;
#pragma unroll
                for (int ai = 0; ai < 2; ++ai)
#pragma unroll
                    for (int m = 0; m < 4; ++m) { const int row = u.row0 + 128 * ai + 64 * wr + 16 * m + fr, pos = row & (S - 1);
                        const float4 c01 = *(const float4*)(rope + pos * 32 + dl), c23 = *(const float4*)(rope + pos * 32 + dl + 2);
                        const f32x4 x1 = acc[ai][bj][m][0], x2 = acc[ai][bj][m][1];
                        uint2 lo, hi;
                        lo.x = pk2((x1[0] * c01.x - x2[0] * c01.y) * scl, (x1[1] * c01.z - x2[1] * c01.w) * scl);
                        lo.y = pk2((x1[2] * c23.x - x2[2] * c23.y) * scl, (x1[3] * c23.z - x2[3] * c23.w) * scl);
                        hi.x = pk2((x2[0] * c01.x + x1[0] * c01.y) * scl, (x2[1] * c01.z + x1[1] * c01.w) * scl);
                        hi.y = pk2((x2[2] * c23.x + x1[2] * c23.y) * scl, (x2[3] * c23.z + x1[3] * c23.w) * scl);
                        const int bh = (row >> 13) * 8 + head;
                        bf16_t* o = dst + ((size_t)(bh * S + (pos & 15) * 512 + (pos >> 4)) * 64 + dl); *(uint2*)o = lo; *(uint2*)(o + 32) = hi; }
            }
        } else {
            bf16_t* dst; int ldc, cb;
            if (cbase < 1536) { dst = (bf16_t*)(ws + WS_VA); ldc = 512; cb = cbase - 1024; }
            else if (cbase < 1792) { dst = (bf16_t*)(ws + WS_QG); ldc = 256; cb = cbase - 1536; }
            else if (cbase < 2048) { dst = (bf16_t*)(ws + WS_KG); ldc = 256; cb = cbase - 1792; }
            else if (cbase < 2560) { dst = (bf16_t*)(ws + WS_VG); ldc = 512; cb = cbase - 2048; }
            else { dst = (bf16_t*)(ws + WS_RG); ldc = 512; cb = cbase - 2560; }
#pragma unroll
            for (int ai = 0; ai < 2; ++ai)
#pragma unroll
                for (int m = 0; m < 4; ++m) { const int row = u.row0 + 128 * ai + 64 * wr + 16 * m + fr;
#pragma unroll
                    for (int bj = 0; bj < 2; ++bj) { const f32x4 v0 = acc[ai][bj][m][0], v1 = acc[ai][bj][m][1];
                        u32x4 w; w.x = pk2(v0[0], v0[1]); w.y = pk2(v0[2], v0[3]); w.z = pk2(v1[0], v1[1]); w.w = pk2(v1[2], v1[3]);
                        *(u32x4*)(dst + (size_t)row * ldc + cb + 128 * bj + 32 * wc + 8 * fq) = w; } }
        }
    }
};

__device__ void phase_gemm_in(const Params& p, unsigned char* lds) {
    unsigned char* ws = p.ws;
    {
        pg8::DenseSched Sd; Sd.init(ws + WS_H, ws + WS_WINT, T, 3072, D);
        EpiIn E{ws};
        pg8::gemm_phase<EpiIn, pg8::DenseSched>((LAS unsigned char*)lds, D, Sd, E);
    }
    const int tid = threadIdx.x, lane = tid & 63, wave = tid >> 6, fr = lane & 15, fq = lane >> 4;
    const bf16_t* H = (const bf16_t*)(ws + WS_H); const bf16_t* Wl = (const bf16_t*)(ws + WS_WINT) + (size_t)3072 * D;
    float* glr = (float*)(ws + WS_GLR);
    float* part = (float*)lds;
    for (int item = blockIdx.x; item < T / 64; item += gridDim.x) {
        const int mt = wave & 3, kh = wave >> 2, r0 = item * 64 + mt * 16;
        f32x4 a = (f32x4){0.f, 0.f, 0.f, 0.f};
        const bf16_t* ap = H + (size_t)(r0 + fr) * D + kh * 512 + fq * 8;
        const bf16_t* bp = Wl + (size_t)fr * D + kh * 512 + fq * 8;
#pragma unroll 4
        for (int ks = 0; ks < 16; ++ks) a = __builtin_amdgcn_mfma_f32_16x16x32_bf16(*(const bf16x8*)(ap + ks * 32), *(const bf16x8*)(bp + ks * 32), a, 0, 0, 0);
        __syncthreads();
        if (kh == 1) {
#pragma unroll
            for (int j = 0; j < 4; ++j) part[(mt * 16 + 4 * fq + j) * 16 + fr] = a[j];
        }
        __syncthreads();
        if (kh == 0) {
#pragma unroll
            for (int j = 0; j < 4; ++j) glr[(size_t)(r0 + 4 * fq + j) * 16 + fr] = a[j] + part[(mt * 16 + 4 * fq + j) * 16 + fr];
        }
    }
    __syncthreads();
}

__device__ void vtrans_items(const Params& p, unsigned char* lds) {
    const int tid = threadIdx.x;
    unsigned char* ws = p.ws;
    const bf16_t* VA = (const bf16_t*)(ws + WS_VA);
    bf16_t* vb = (bf16_t*)(ws + WS_VB);
    constexpr int VS = 72;
    bf16_t* tile = (bf16_t*)lds;
    for (int item = blockIdx.x; item < 512; item += gridDim.x) {
        const int bh = item >> 5, blk = item & 31, b = bh >> 3, h = bh & 7, pos0 = blk * 256;
        { const int tok = tid >> 1, hf = tid & 1;
          const uint4* src = (const uint4*)(VA + (size_t)(b * S + pos0 + tok) * 512 + h * 64 + hf * 32);
          uint4 v0 = src[0], v1 = src[1], v2 = src[2], v3 = src[3];
          uint4* d = (uint4*)(tile + tok * VS + hf * 32);
          d[0] = v0; d[1] = v1; d[2] = v2; d[3] = v3; }
        __syncthreads();
        const int dv = tid >> 3, l8 = tid & 7;
#pragma unroll
        for (int cc = 0; cc < 2; ++cc) { const int cls = 2 * l8 + cc;
#pragma unroll
            for (int hh = 0; hh < 2; ++hh) { unsigned w[4];
#pragma unroll
                for (int i = 0; i < 4; ++i) w[i] = (unsigned)tile[(16 * (hh * 8 + 2 * i) + cls) * VS + dv] | ((unsigned)tile[(16 * (hh * 8 + 2 * i + 1) + cls) * VS + dv] << 16);
                const int blkidx = (bh * S + cls * 512 + 16 * blk + hh * 8) >> 3;
                *(uint4*)(vb + ((size_t)blkidx * 64 + dv) * 8) = make_uint4(w[0], w[1], w[2], w[3]); } }
        __syncthreads();
    }
}

struct AttnFrag { bf16x8 ka[4], vf[4]; };
__device__ __forceinline__ void attn_load(AttnFrag& f, const bf16_t* kp, const bf16_t* vp) {
    f.ka[0] = *(const bf16x8*)kp; f.ka[1] = *(const bf16x8*)(kp + 32); f.ka[2] = *(const bf16x8*)(kp + 256); f.ka[3] = *(const bf16x8*)(kp + 288);
#pragma unroll
    for (int n = 0; n < 4; ++n) f.vf[n] = *(const bf16x8*)(vp + n * 128);
}
struct AttnState { float m, l; f32x4 o[4]; bf16x8 q0, q1; };
__device__ __forceinline__ float max2a(float a, float b) { float r; asm("v_max_f32_e32 %0, %1, %2" : "=v"(r) : "v"(a), "v"(b)); return r; }
__device__ __forceinline__ float max3a(float a, float b, float c) { float r; asm("v_max3_f32 %0, %1, %2, %3" : "=v"(r) : "v"(a), "v"(b), "v"(c)); return r; }
__device__ __forceinline__ float rowmax4(float x) {
    const unsigned u = __builtin_bit_cast(unsigned, x);
    const auto a = __builtin_amdgcn_permlane16_swap(u, u, false, false);
    const float y = fmaxf(__builtin_bit_cast(float, a[0]), __builtin_bit_cast(float, a[1]));
    const unsigned v = __builtin_bit_cast(unsigned, y);
    const auto b = __builtin_amdgcn_permlane32_swap(v, v, false, false);
    return fmaxf(__builtin_bit_cast(float, b[0]), __builtin_bit_cast(float, b[1]));
}
template <bool FIRST>
__device__ __forceinline__ float attn_scores(const AttnFrag& f, const AttnState& t, const int d0, const int js, float (&sv)[8]) {
    const float nm = FIRST ? 0.f : -t.m;
    f32x4 st0 = (f32x4){nm, nm, nm, nm}, st1 = (f32x4){nm, nm, nm, nm};
    st0 = __builtin_amdgcn_mfma_f32_16x16x32_bf16(f.ka[0], t.q0, st0, 0, 0, 0);
    st0 = __builtin_amdgcn_mfma_f32_16x16x32_bf16(f.ka[1], t.q1, st0, 0, 0, 0);
    st1 = __builtin_amdgcn_mfma_f32_16x16x32_bf16(f.ka[2], t.q0, st1, 0, 0, 0);
    st1 = __builtin_amdgcn_mfma_f32_16x16x32_bf16(f.ka[3], t.q1, st1, 0, 0, 0);
#pragma unroll
    for (int j = 0; j < 8; ++j) { const bool vd = (unsigned)(d0 - (j << js)) <= 128u; const float x = (j < 4) ? st0[j] : st1[j - 4]; sv[j] = vd ? x : -3.0e38f; }
    float mx = max3a(max3a(sv[0], sv[1], sv[2]), max3a(sv[3], sv[4], sv[5]), max2a(sv[6], sv[7]));
    return rowmax4(mx);
}
__device__ __forceinline__ void attn_grow(AttnState& t, float (&sv)[8], const float mx) {
    const float gr = fmaxf(mx, 0.f), alpha = fexp2(-gr);
    t.m += gr;
#pragma unroll
    for (int j = 0; j < 8; ++j) sv[j] -= gr;
    t.l = t.l * alpha;
#pragma unroll
    for (int n = 0; n < 4; ++n) t.o[n] = t.o[n] * alpha;
}
__device__ __forceinline__ void attn_pv(const AttnFrag& f, AttnState& t, const float (&sv)[8]) {
    float pj[8];
#pragma unroll
    for (int j = 0; j < 8; ++j) pj[j] = fexp2(sv[j]);
    t.l += ((pj[0] + pj[1]) + (pj[2] + pj[3])) + ((pj[4] + pj[5]) + (pj[6] + pj[7]));
    u32x4 pw; pw.x = pk2(pj[0], pj[1]); pw.y = pk2(pj[2], pj[3]); pw.z = pk2(pj[4], pj[5]); pw.w = pk2(pj[6], pj[7]);
    const bf16x8 pf = __builtin_bit_cast(bf16x8, pw);
#pragma unroll
    for (int n = 0; n < 4; ++n) t.o[n] = __builtin_amdgcn_mfma_f32_16x16x32_bf16(f.vf[n], pf, t.o[n], 0, 0, 0);
}
template <bool FIRST>
__device__ __forceinline__ void attn_math2(const AttnFrag& fa, const AttnFrag& fb, AttnState& ta, AttnState& tb, const int d0a, const int d0b, const int js) {
    float sa[8], sb[8];
    const float mxa = attn_scores<FIRST>(fa, ta, d0a, js, sa), mxb = attn_scores<FIRST>(fb, tb, d0b, js, sb);
    if (FIRST) {
        ta.m = mxa; tb.m = mxb;
#pragma unroll
        for (int j = 0; j < 8; ++j) { sa[j] -= mxa; sb[j] -= mxb; }
    } else if (__any(fmaxf(mxa, mxb) > 8.f)) {
        attn_grow(ta, sa, mxa); attn_grow(tb, sb, mxb);
    }
    attn_pv(fa, ta, sa); attn_pv(fb, tb, sb);
}
__device__ void phase_attn(const Params& p, unsigned char* lds) {
    const int tid = threadIdx.x, lane = tid & 63, wave = tid >> 6, qi = lane & 15, g = lane >> 4, gp = qi >> 2, jj = qi & 3;
    unsigned char* ws = p.ws;
    const bf16_t* QA = (const bf16_t*)(ws + WS_QA);
    bf16_t* CAT = (bf16_t*)(ws + WS_CAT);
    const bf16_t* K = (const bf16_t*)(ws + WS_KA); const bf16_t* V = (const bf16_t*)(ws + WS_VB);
    constexpr int LV = 49152;
    constexpr int CLS8 = 8 * 512 * 64;
    const int nwg = gridDim.x, xg = blockIdx.x & 7, xl = blockIdx.x >> 3;
    const bool xord = (nwg & 7) == 0;
    const int k0 = xord ? xl : (int)blockIdx.x, kst = xord ? (nwg >> 3) : nwg, kend = xord ? 64 : 512;
    for (int k = k0; k < kend; k += kst) {
        const int idd = xord ? ((xg + 8 * (k >> 5)) << 5) + (k & 31) : k;
        const int bh = idd >> 5, blk = idd & 31, r = wave, b = bh >> 3, h = bh & 7;
        const int tq = 256 * blk + r + 16 * qi, rho4 = r & 3;
        __syncthreads();
        uint4 pre[12];
#pragma unroll
        for (int i = 0; i < 6; ++i) { const int pid = tid + 512 * i, row = pid >> 3, cls = row / 24, il = row - cls * 24;
            pre[i] = *(const uint4*)(K + ((bh * S + cls * 512 + 16 * blk - 8 + il) * 64 + (pid & 7) * 8)); }
#pragma unroll
        for (int i = 0; i < 6; ++i) { const int vp = tid + 512 * i, b3 = vp >> 6, cls = b3 / 3, bl = b3 - cls * 3;
            pre[6 + i] = *(const uint4*)(V + ((((bh * S + cls * 512 + 16 * blk - 8) >> 3) + bl) * 512 + (vp & 63) * 8)); }
        const int ks16 = ((16 * blk) & ~31) - 128;
        const int c16 = ks16 < 0 ? ((-ks16) >> 5) : 0;
        const int kb16 = (bh * S + r * 512 + ks16 + 8 * gp + jj) * 64 + 8 * g, vb16 = (((bh * S + r * 512 + ks16) >> 3) + g) * 512 + qi * 8;
        const int dq16 = 16 * blk + qi - (ks16 + 8 * g);
        const int c4 = blk == 0 ? 4 : (blk == 1 ? 2 : 0);
        const int kb4 = (bh * S + (rho4 + 4 * gp) * 512 + 16 * blk - 32 + jj) * 64 + 8 * g, vb4 = ((bh * S + (rho4 + 4 * g) * 512 + 16 * blk - 32) >> 3) * 512 + qi * 8;
        const int dq4 = 4 * qi + 128 + (r >> 2) - g;
        AttnFrag fxa, fxb, fya;
        attn_load(fxa, K + (kb16 + 4 * 2048), V + (vb16 + 4 * 2048)); attn_load(fxb, K + (kb16 + 4 * 2048 + CLS8), V + (vb16 + 4 * 2048 + CLS8));
        attn_load(fya, K + kb4, V + vb4);
        AttnState ta, tb;
        { const bf16_t* qrow = QA + ((size_t)(bh * S + r * 512 + 16 * blk + qi) * 64 + 8 * g);
          ta.q0 = *(const bf16x8*)qrow; ta.q1 = *(const bf16x8*)(qrow + 32); tb.q0 = *(const bf16x8*)(qrow + CLS8); tb.q1 = *(const bf16x8*)(qrow + CLS8 + 32); }
        ta.m = 0.f; tb.m = 0.f; ta.l = 0.f; tb.l = 0.f;
#pragma unroll
        for (int n = 0; n < 4; ++n) { ta.o[n] = (f32x4){0.f, 0.f, 0.f, 0.f}; tb.o[n] = ta.o[n]; }
        attn_math2<true>(fxa, fxb, ta, tb, dq16 - 128, dq16 - 128, 0);
        {
            const int m0 = c4 <= 0 ? 0 : (1 << 20), m1 = c4 <= 1 ? 0 : (1 << 20), m2 = c4 <= 2 ? 0 : (1 << 20);
            attn_load(fxa, K + (kb4 + 1 * 512), V + (vb4 + 1 * 512));
            attn_math2<false>(fya, fya, ta, tb, dq4 - m0, dq4 + 2 - m0, 2);
            attn_load(fya, K + (kb4 + 2 * 512), V + (vb4 + 2 * 512));
            attn_math2<false>(fxa, fxa, ta, tb, dq4 - 32 - m1, dq4 + 2 - 32 - m1, 2);
            attn_math2<false>(fya, fya, ta, tb, dq4 - 64 - m2, dq4 + 2 - 64 - m2, 2);
        }
#pragma unroll
        for (int i = 0; i < 12; ++i) *(uint4*)(lds + (tid + 512 * i) * 16) = pre[i];
        __syncthreads();
        {
            const int d1 = 16 * qi + 128 + r - g;
            const unsigned char* kl = lds + (gp * 24 + jj) * 128 + g * 16;
            const unsigned char* vl = lds + LV + g * 3072 + qi * 16;
            int c1 = (blk == 0 ? 4 : 0);
            const unsigned char* kl4 = lds + ((rho4 + 4 * gp) * 24 + jj) * 128 + g * 16;
            const unsigned char* vl4 = lds + LV + (rho4 + 4 * g) * 3072 + qi * 16;
            const int c4l = c4 > 3 ? c4 : 3;
#define ATTN_D1_CHUNK() do { const int w = c1 >> 2, q = c1 & 3; const unsigned char* kq = kl + q * 12288 + w * 1024; const unsigned char* vq = vl + q * 12288 + w * 1024; \
                fya.ka[0] = *(const bf16x8*)kq; fya.ka[1] = *(const bf16x8*)(kq + 64); fya.ka[2] = *(const bf16x8*)(kq + 512); fya.ka[3] = *(const bf16x8*)(kq + 576); \
                _Pragma("unroll") for (int n = 0; n < 4; ++n) fya.vf[n] = *(const bf16x8*)(vq + n * 256); \
                attn_math2<false>(fya, fya, ta, tb, d1 - 128 * w - 4 * q, d1 + 8 - 128 * w - 4 * q, 4); ++c1; } while (0)
#define ATTN_D4_CHUNK(w4) do { const unsigned char* kq = kl4 + ((w4) - 3) * 1024; const unsigned char* vq = vl4 + ((w4) - 3) * 1024; \
                fya.ka[0] = *(const bf16x8*)kq; fya.ka[1] = *(const bf16x8*)(kq + 64); fya.ka[2] = *(const bf16x8*)(kq + 512); fya.ka[3] = *(const bf16x8*)(kq + 576); \
                _Pragma("unroll") for (int n = 0; n < 4; ++n) fya.vf[n] = *(const bf16x8*)(vq + n * 256); \
                attn_math2<false>(fya, fya, ta, tb, dq4 - 32 * (w4), dq4 + 2 - 32 * (w4), 2); } while (0)
            for (int cc = c16; cc < 4; ++cc) {
                attn_load(fxa, K + (kb16 + cc * 2048), V + (vb16 + cc * 2048)); attn_load(fxb, K + (kb16 + cc * 2048 + CLS8), V + (vb16 + cc * 2048 + CLS8));
                for (int q3 = 0; q3 < 3 && c1 < 12; ++q3) ATTN_D1_CHUNK();
                if (3 + (cc - c16) >= c4l && 3 + (cc - c16) < 6) ATTN_D4_CHUNK(3 + (cc - c16));
                attn_math2<false>(fxa, fxb, ta, tb, dq16 - 32 * cc, dq16 - 32 * cc, 0);
            }
            while (c1 < 12) ATTN_D1_CHUNK();
            for (int w4 = (4 - c16 < 3 ? 3 + (4 - c16) : 6); w4 < 6; ++w4) { if (w4 >= c4l) ATTN_D4_CHUNK(w4); }
#undef ATTN_D1_CHUNK
#undef ATTN_D4_CHUNK
        }
        {
            float la = ta.l, lb = tb.l;
            la += __shfl_xor(la, 16); la += __shfl_xor(la, 32); lb += __shfl_xor(lb, 16); lb += __shfl_xor(lb, 32);
            const float ia = 1.f / la, ib = 1.f / lb;
            bf16_t* orow = CAT + (size_t)(b * S + tq) * D + h * 64 + 4 * g;
#pragma unroll
            for (int n = 0; n < 4; ++n) { uint2 ov; ov.x = pk2(ta.o[n][0] * ia, ta.o[n][1] * ia); ov.y = pk2(ta.o[n][2] * ia, ta.o[n][3] * ia); *(uint2*)(orow + 16 * n) = ov;
                uint2 ow; ow.x = pk2(tb.o[n][0] * ib, tb.o[n][1] * ib); ow.y = pk2(tb.o[n][2] * ib, tb.o[n][3] * ib); *(uint2*)(orow + 8 * D + 16 * n) = ow; }
        }
    }
}

constexpr int TS = 72;
constexpr int GL_LA = 0, GL_A1 = 16640, GL_A2 = GL_A1 + 64 * TS * 2, GL_VT = GL_A2 + 64 * TS * 2, GL_ATT = GL_VT + 128 * TS * 2;
static_assert(GL_ATT + 64 * TS * 2 <= 65536, "gla lds");

struct GlaIn { uint4 kr0, kr1, qr0, qr1, vr[4]; float4 gl; };
template <int MODE>
__device__ __forceinline__ void gla_fetch(const Params& p, int item, int tid, GlaIn& in) {
    unsigned char* ws = p.ws;
    const int bh4 = item >> 7, n = item & 127, b = bh4 >> 2, hh = bh4 & 3;
    const int t0 = b * S + n * 64;
    const int c = tid >> 2, d0 = (tid & 3) * 16, e0 = (tid & 3) * 32;
    const bf16_t* kp = (const bf16_t*)(ws + WS_KG) + (size_t)(t0 + c) * 256 + hh * 64 + d0;
    in.kr0 = *(const uint4*)kp; in.kr1 = *(const uint4*)(kp + 8);
    const bf16_t* qp = (const bf16_t*)(ws + WS_QG) + (size_t)(t0 + c) * 256 + hh * 64 + d0;
    in.qr0 = make_uint4(0, 0, 0, 0); in.qr1 = make_uint4(0, 0, 0, 0);
    if (MODE == 1) { in.qr0 = *(const uint4*)qp; in.qr1 = *(const uint4*)(qp + 8); }
    const bf16_t* vp = (const bf16_t*)(ws + WS_VG) + (size_t)(t0 + c) * 512 + hh * 128 + e0;
#pragma unroll
    for (int q = 0; q < 4; ++q) in.vr[q] = *(const uint4*)(vp + 8 * q);
    in.gl = *(const float4*)((const float*)(ws + WS_GLR) + (size_t)t0 * 16 + tid * 4);
}
template <int MODE>
__device__ __forceinline__ void gla_prep(const Params& p, unsigned char* lds, int item, int tid, const GlaIn& in) {
    const int bh4 = item >> 7, hh = bh4 & 3;
    float* LA = (float*)(lds + GL_LA);
    bf16_t* A1 = (bf16_t*)(lds + GL_A1); bf16_t* A2 = (bf16_t*)(lds + GL_A2); bf16_t* VTl = (bf16_t*)(lds + GL_VT);
    const int c = tid >> 2, d0 = (tid & 3) * 16, e0 = (tid & 3) * 32;
    const uint4 kr0 = in.kr0, kr1 = in.kr1, qr0 = in.qr0, qr1 = in.qr1;
    float* GLRL = (float*)(lds + GL_ATT + 1024);
    *(float4*)(GLRL + tid * 4) = in.gl;
    __syncthreads();
    {
        const int dd = tid & 63, cgp = tid >> 6;
        float w[16];
#pragma unroll
        for (int r = 0; r < 16; ++r) w[r] = p.w_gate_lr[r * 256 + hh * 64 + dd];
        const float bias = p.b_gate[hh * 64 + dd];
        float pre[16]; float run = 0.f;
#pragma unroll
        for (int i = 0; i < 16; ++i) {
            const float4* gp = (const float4*)(GLRL + (cgp * 16 + i) * 16);
            const float4 g0 = gp[0], g1 = gp[1], g2 = gp[2], g3 = gp[3];
            float z = bias;
            z += g0.x * w[0] + g0.y * w[1] + g0.z * w[2] + g0.w * w[3];
            z += g1.x * w[4] + g1.y * w[5] + g1.z * w[6] + g1.w * w[7];
            z += g2.x * w[8] + g2.y * w[9] + g2.z * w[10] + g2.w * w[11];
            z += g3.x * w[12] + g3.y * w[13] + g3.z * w[14] + g3.w * w[15];
            const float ls = fminf(z, 0.f) - flog(1.f + fexp(-fabsf(z)));
            run += ls * (1.f / 16.f); pre[i] = run;
        }
        float* tot = (float*)(lds + GL_ATT);
        tot[cgp * 64 + dd] = run;
        __syncthreads();
        float off = 0.f;
#pragma unroll
        for (int gq = 0; gq < 3; ++gq) off += (gq < cgp) ? tot[gq * 64 + dd] : 0.f;
#pragma unroll
        for (int i = 0; i < 16; ++i) LA[(cgp * 16 + i) * 65 + dd] = pre[i] + off;
    }
    __syncthreads();
    {
        unsigned kw[8] = {kr0.x, kr0.y, kr0.z, kr0.w, kr1.x, kr1.y, kr1.z, kr1.w};
        if (MODE == 0) {
#pragma unroll
            for (int i = 0; i < 16; ++i) { const int dd = d0 + i; const float kv = bf2f((unsigned short)((kw[i >> 1] >> ((i & 1) * 16)) & 0xffff));
                const float f = fexp(LA[63 * 65 + dd] - LA[c * 65 + dd]);
                A1[dd * TS + c] = (bf16_t)f2bf(kv * f); }
        } else {
            unsigned qw[8] = {qr0.x, qr0.y, qr0.z, qr0.w, qr1.x, qr1.y, qr1.z, qr1.w};
            unsigned oq[8], ok[8];
#pragma unroll
            for (int i = 0; i < 8; ++i) {
                const float bb0 = LA[c * 65 + d0 + 2 * i], bb1 = LA[c * 65 + d0 + 2 * i + 1];
                const float q0 = bf2f((unsigned short)(qw[i] & 0xffff)), q1 = bf2f((unsigned short)(qw[i] >> 16));
                const float k0 = bf2f((unsigned short)(kw[i] & 0xffff)), k1 = bf2f((unsigned short)(kw[i] >> 16));
                oq[i] = pk2(q0 * 0.125f * fexp(bb0), q1 * 0.125f * fexp(bb1));
                ok[i] = pk2(k0 * fexp(-bb0), k1 * fexp(-bb1));
            }
            *(uint4*)(A1 + c * TS + d0) = make_uint4(oq[0], oq[1], oq[2], oq[3]); *(uint4*)(A1 + c * TS + d0 + 8) = make_uint4(oq[4], oq[5], oq[6], oq[7]);
            *(uint4*)(A2 + c * TS + d0) = make_uint4(ok[0], ok[1], ok[2], ok[3]); *(uint4*)(A2 + c * TS + d0 + 8) = make_uint4(ok[4], ok[5], ok[6], ok[7]);
        }
#pragma unroll
        for (int q = 0; q < 4; ++q) { const unsigned vw[4] = {in.vr[q].x, in.vr[q].y, in.vr[q].z, in.vr[q].w};
#pragma unroll
            for (int i = 0; i < 4; ++i) { VTl[(e0 + 8 * q + 2 * i) * TS + c] = (bf16_t)(vw[i] & 0xffff); VTl[(e0 + 8 * q + 2 * i + 1) * TS + c] = (bf16_t)(vw[i] >> 16); } }
    }
    __syncthreads();
}

__device__ void gla1_items(const Params& p, unsigned char* lds0) {
    const int half = threadIdx.x >> 8, tid = threadIdx.x & 255, lane = tid & 63, w = tid >> 6, fr = lane & 15, fq = lane >> 4;
    unsigned char* lds = lds0 + half * 65536;
    float* UT = (float*)(p.ws + WS_UT); float* AG = (float*)(p.ws + WS_AG);
    const float* LA = (const float*)(lds + GL_LA);
    const bf16_t* A1 = (const bf16_t*)(lds + GL_A1); const bf16_t* VTl = (const bf16_t*)(lds + GL_VT);
    GlaIn cur, nxt;
    if ((int)blockIdx.x < 512) gla_fetch<0>(p, 2 * blockIdx.x + half, tid, cur);
    for (int it = blockIdx.x; it < 512; it += gridDim.x) {
        const int item = 2 * it + half;
        const bool more = it + (int)gridDim.x < 512;
        if (more) gla_fetch<0>(p, 2 * (it + gridDim.x) + half, tid, nxt);
        gla_prep<0>(p, lds, item, tid, cur);
        f32x4 acc[8];
#pragma unroll
        for (int n = 0; n < 8; ++n) acc[n] = (f32x4){0.f, 0.f, 0.f, 0.f};
#pragma unroll
        for (int ks = 0; ks < 2; ++ks) {
            const bf16x8 af = *(const bf16x8*)(A1 + (16 * w + fr) * TS + ks * 32 + fq * 8);
#pragma unroll
            for (int n = 0; n < 8; ++n) { const bf16x8 bfr = *(const bf16x8*)(VTl + (16 * n + fr) * TS + ks * 32 + fq * 8);
                acc[n] = __builtin_amdgcn_mfma_f32_16x16x32_bf16(af, bfr, acc[n], 0, 0, 0); }
        }
#pragma unroll
        for (int n = 0; n < 8; ++n) *(f32x4*)(UT + ((size_t)item * 128 + 16 * n + fr) * 64 + 16 * w + 4 * fq) = acc[n];
        if (tid < 64) AG[item * 64 + tid] = fexp(LA[63 * 65 + tid]);
        __syncthreads();
        if (more) cur = nxt;
    }
}
__device__ void gla2_scan(const Params& p) {
    const float* UT = (const float*)(p.ws + WS_UT); const float* AG = (const float*)(p.ws + WS_AG);
    bf16_t* SPT = (bf16_t*)(p.ws + WS_SPT);
    for (int rec = blockIdx.x * NTHREADS + threadIdx.x; rec < 65536; rec += gridDim.x * NTHREADS) {
        const int bh4 = rec >> 13, e = (rec >> 6) & 127, dd = rec & 63;
        float st = 0.f;
        for (int n0 = 0; n0 < 128; n0 += 32) {
            float av[32], uv[32];
#pragma unroll
            for (int q = 0; q < 32; ++q) { const int item = bh4 * 128 + n0 + q; av[q] = AG[item * 64 + dd]; uv[q] = UT[((size_t)item * 128 + e) * 64 + dd]; }
#pragma unroll
            for (int q = 0; q < 32; ++q) { const int item = bh4 * 128 + n0 + q; SPT[((size_t)item * 128 + e) * 64 + dd] = (bf16_t)f2bf(st); st = av[q] * st + uv[q]; }
        }
    }
}
__device__ void gla3_items(const Params& p, unsigned char* lds0) {
    const int half = threadIdx.x >> 8, tid = threadIdx.x & 255, lane = tid & 63, w = tid >> 6, fr = lane & 15, fq = lane >> 4;
    unsigned char* lds = lds0 + half * 65536;
    unsigned char* ws = p.ws;
    const bf16_t* SPT = (const bf16_t*)(ws + WS_SPT); const bf16_t* RG = (const bf16_t*)(ws + WS_RG);
    bf16_t* CAT = (bf16_t*)(ws + WS_CAT);
    const bf16_t* A1 = (const bf16_t*)(lds + GL_A1); const bf16_t* A2 = (const bf16_t*)(lds + GL_A2); const bf16_t* VTl = (const bf16_t*)(lds + GL_VT);
    bf16_t* ATT = (bf16_t*)(lds + GL_ATT);
    GlaIn cur, nxt;
    if ((int)blockIdx.x < 512) gla_fetch<1>(p, 2 * blockIdx.x + half, tid, cur);
    for (int it = blockIdx.x; it < 512; it += gridDim.x) {
        const int item = 2 * it + half;
        const bool more = it + (int)gridDim.x < 512;
        const int bh4 = item >> 7, n_ = item & 127, b = bh4 >> 2, hh = bh4 & 3;
        const int t0 = b * S + n_ * 64;
        bf16x8 sf[8][2]; uint2 rw[8];
#pragma unroll
        for (int n = 0; n < 8; ++n) { const bf16_t* sp = SPT + ((size_t)item * 128 + 16 * n + fr) * 64 + fq * 8; sf[n][0] = *(const bf16x8*)sp; sf[n][1] = *(const bf16x8*)(sp + 32);
            rw[n] = *(const uint2*)(RG + (size_t)(t0 + 16 * w + fr) * 512 + hh * 128 + 16 * n + 4 * fq); }
        if (more) gla_fetch<1>(p, 2 * (it + gridDim.x) + half, tid, nxt);
        gla_prep<1>(p, lds, item, tid, cur);
        const bf16x8 aq0 = *(const bf16x8*)(A1 + (16 * w + fr) * TS + fq * 8), aq1 = *(const bf16x8*)(A1 + (16 * w + fr) * TS + 32 + fq * 8);
#pragma unroll
        for (int np = 0; np < 4; ++np) {
            f32x4 a = (f32x4){0.f, 0.f, 0.f, 0.f};
            if (np <= w) {
                const bf16x8 b0 = *(const bf16x8*)(A2 + (16 * np + fr) * TS + fq * 8), b1 = *(const bf16x8*)(A2 + (16 * np + fr) * TS + 32 + fq * 8);
                a = __builtin_amdgcn_mfma_f32_16x16x32_bf16(aq0, b0, a, 0, 0, 0);
                a = __builtin_amdgcn_mfma_f32_16x16x32_bf16(aq1, b1, a, 0, 0, 0);
            }
#pragma unroll
            for (int j = 0; j < 4; ++j) { const int c = 16 * w + 4 * fq + j, cp = 16 * np + fr; ATT[c * TS + cp] = (bf16_t)f2bf(cp <= c ? a[j] : 0.f); }
        }
        __syncthreads();
        const bf16x8 at0 = *(const bf16x8*)(ATT + (16 * w + fr) * TS + fq * 8), at1 = *(const bf16x8*)(ATT + (16 * w + fr) * TS + 32 + fq * 8);
        f32x4 acc[8];
#pragma unroll
        for (int n = 0; n < 8; ++n) {
            acc[n] = (f32x4){0.f, 0.f, 0.f, 0.f};
            const bf16x8 v0 = *(const bf16x8*)(VTl + (16 * n + fr) * TS + fq * 8), v1 = *(const bf16x8*)(VTl + (16 * n + fr) * TS + 32 + fq * 8);
            const bf16x8 s0 = sf[n][0], s1 = sf[n][1];
            acc[n] = __builtin_amdgcn_mfma_f32_16x16x32_bf16(v0, at0, acc[n], 0, 0, 0);
            acc[n] = __builtin_amdgcn_mfma_f32_16x16x32_bf16(v1, at1, acc[n], 0, 0, 0);
            acc[n] = __builtin_amdgcn_mfma_f32_16x16x32_bf16(s0, aq0, acc[n], 0, 0, 0);
            acc[n] = __builtin_amdgcn_mfma_f32_16x16x32_bf16(s1, aq1, acc[n], 0, 0, 0);
        }
        {
            float ss = 0.f;
#pragma unroll
            for (int n = 0; n < 8; ++n) ss += acc[n][0] * acc[n][0] + acc[n][1] * acc[n][1] + acc[n][2] * acc[n][2] + acc[n][3] * acc[n][3];
            ss += __shfl_xor(ss, 16); ss += __shfl_xor(ss, 32);
            const float rstd = rsqrtf(ss * (1.f / 128.f) + EPS);
            const int t = t0 + 16 * w + fr;
#pragma unroll
            for (int n = 0; n < 8; ++n) { const int e = 16 * n + 4 * fq;
                const float4 gg = *(const float4*)(p.g_gla + e);
                const float r0 = bf2f((unsigned short)(rw[n].x & 0xffff)), r1 = bf2f((unsigned short)(rw[n].x >> 16)), r2 = bf2f((unsigned short)(rw[n].y & 0xffff)), r3 = bf2f((unsigned short)(rw[n].y >> 16));
                uint2 ov; ov.x = pk2(acc[n][0] * rstd * gg.x * fsilu(r0), acc[n][1] * rstd * gg.y * fsilu(r1)); ov.y = pk2(acc[n][2] * rstd * gg.z * fsilu(r2), acc[n][3] * rstd * gg.w * fsilu(r3));
                *(uint2*)(CAT + (size_t)t * D + 512 + hh * 128 + e) = ov; }
        }
        __syncthreads();
        if (more) cur = nxt;
    }
}

struct EpiBf16Plain {
    static constexpr bool PERM = true;
    bf16_t* C; int ldc;
    __device__ __forceinline__ void operator()(const f32x4 (&acc)[2][2][4][2], const pg8::Unit& u, int wr, int wc, int fr, int fq) const {
#pragma unroll
        for (int ai = 0; ai < 2; ++ai)
#pragma unroll
            for (int m = 0; m < 4; ++m) { const int row = u.row0 + 128 * ai + 64 * wr + 16 * m + fr;
#pragma unroll
                for (int bj = 0; bj < 2; ++bj) { const f32x4 v0 = acc[ai][bj][m][0], v1 = acc[ai][bj][m][1];
                    u32x4 w; w.x = pk2(v0[0], v0[1]); w.y = pk2(v0[2], v0[3]); w.z = pk2(v1[0], v1[1]); w.w = pk2(v1[2], v1[3]);
                    *(u32x4*)(C + (size_t)row * ldc + 256 * u.pn + 128 * bj + 32 * wc + 8 * fq) = w; } }
    }
};
__device__ void phase_gemm_out(const Params& p, unsigned char* lds) {
    pg8::DenseSched Sd; Sd.init(p.ws + WS_CAT, p.ws + WS_WOUTT, T, D, D);
    EpiBf16Plain E{(bf16_t*)(p.ws + WS_YMIX), D};
    pg8::gemm_phase<EpiBf16Plain, pg8::DenseSched>((LAS unsigned char*)lds, D, Sd, E);
}

constexpr int HS_STRIDE = 1028;
__device__ void phase_postmix(const Params& p, unsigned char* lds, const bool dry) {
    const int tid = threadIdx.x, lane = tid & 63, wave = tid >> 6;
    unsigned char* ws = p.ws;
    const float* mod = (const float*)(ws + WS_MOD);
    const bf16_t* Y = (const bf16_t*)(ws + WS_YMIX);
    bf16_t* H = (bf16_t*)(ws + WS_H);
    bf16_t* X1 = (bf16_t*)(ws + WS_X1);
    float* hs = (float*)lds;
    float* part = (float*)(lds + 66048);
    float* lg = (float*)(lds + 66048 + 16384);
    float* tvs = lg + 512;
    int* tis = (int*)(tvs + 64);
    constexpr int MAXG = 8;
    int* sel_e = tis + 64;
    float* sel_g = (float*)(sel_e + MAXG * 64);
    int* lrank = (int*)(sel_g + MAXG * 64);
    int* lcnt = lrank + MAXG * 64;
    int* lbase = lcnt + 32;
    int* CNT = (int*)(ws + WS_CTL) + CW_CNT;
    float wb0[32], wb1[32];
    { const float* wp = p.router_w + (size_t)(128 * wave + (lane >> 4)) * 32 + (lane & 15);
#pragma unroll
      for (int ks = 0; ks < 32; ++ks) { wb0[ks] = wp[(size_t)(4 * ks) * 32]; wb1[ks] = wp[(size_t)(4 * ks) * 32 + 16]; } }
    if (tid < 32) lcnt[tid] = 0;
    int gl = 0, grp0 = blockIdx.x;
    uint2 yw[2][4]; float4 xv[2][4];
    if ((int)blockIdx.x < T / 16) {
#pragma unroll
        for (int i = 0; i < 2; ++i) { const int m = blockIdx.x * 16 + wave * 2 + i;
            const uint2* yr = (const uint2*)(Y + (size_t)m * D) + lane; const float4* xr = (const float4*)(p.x + (size_t)m * D) + lane;
#pragma unroll
            for (int j = 0; j < 4; ++j) { yw[i][j] = ntload2(yr + 64 * j); xv[i][j] = ntload4(xr + 64 * j); } }
    }
    for (int grp = blockIdx.x; grp < T / 16; grp += gridDim.x) {
        const int m0 = grp * 16;
#pragma unroll
        for (int i = 0; i < 2; ++i) {
            const int rl = wave * 2 + i, m = m0 + rl, b = m >> 13;
            float4 yv[4]; float ss = 0.f;
#pragma unroll
            for (int j = 0; j < 4; ++j) { const uint2 w = yw[i][j];
                yv[j] = make_float4(bf2f((unsigned short)(w.x & 0xffff)), bf2f((unsigned short)(w.x >> 16)), bf2f((unsigned short)(w.y & 0xffff)), bf2f((unsigned short)(w.y >> 16)));
                ss += yv[j].x * yv[j].x + yv[j].y * yv[j].y + yv[j].z * yv[j].z + yv[j].w * yv[j].w; }
            const float rstd1 = rsqrtf(wave_sum(ss) * (1.f / D) + EPS);
            float4 x1[4]; float ss2 = 0.f;
#pragma unroll
            for (int j = 0; j < 4; ++j) { const int c = 4 * lane + 256 * j;
                const float4 xq = xv[i][j], g = *(const float4*)(p.g_post_mix + c), gt = *(const float4*)(mod + b * 6144 + 2048 + c);
                x1[j].x = xq.x + gt.x * (yv[j].x * rstd1 * g.x); x1[j].y = xq.y + gt.y * (yv[j].y * rstd1 * g.y);
                x1[j].z = xq.z + gt.z * (yv[j].z * rstd1 * g.z); x1[j].w = xq.w + gt.w * (yv[j].w * rstd1 * g.w);
                ss2 += x1[j].x * x1[j].x + x1[j].y * x1[j].y + x1[j].z * x1[j].z + x1[j].w * x1[j].w;
                { uint2 xo; xo.x = pk2(x1[j].x, x1[j].y); xo.y = pk2(x1[j].z, x1[j].w); ntstore2((uint2*)(X1 + (size_t)m * D + c), xo); } }
            const float rstd2 = rsqrtf(wave_sum(ss2) * (1.f / D) + EPS);
#pragma unroll
            for (int j = 0; j < 4; ++j) { const int c = 4 * lane + 256 * j;
                const float4 g = *(const float4*)(p.g_pre_ffn + c), sh = *(const float4*)(mod + b * 6144 + 3072 + c), sc = *(const float4*)(mod + b * 6144 + 4096 + c);
                float4 h;
                h.x = x1[j].x * rstd2 * g.x * (1.f + sc.x) + sh.x; h.y = x1[j].y * rstd2 * g.y * (1.f + sc.y) + sh.y;
                h.z = x1[j].z * rstd2 * g.z * (1.f + sc.z) + sh.z; h.w = x1[j].w * rstd2 * g.w * (1.f + sc.w) + sh.w;
                uint2 o; o.x = pk2(h.x, h.y); o.y = pk2(h.z, h.w);
                *(uint2*)(H + (size_t)m * D + c) = o;
                *(float4*)(hs + rl * HS_STRIDE + c) = h; }
        }
        if (grp + (int)gridDim.x < T / 16) {
#pragma unroll
            for (int i = 0; i < 2; ++i) { const int m = (grp + gridDim.x) * 16 + wave * 2 + i;
                const uint2* yr = (const uint2*)(Y + (size_t)m * D) + lane; const float4* xr = (const float4*)(p.x + (size_t)m * D) + lane;
#pragma unroll
                for (int j = 0; j < 4; ++j) { yw[i][j] = ntload2(yr + 64 * j); xv[i][j] = ntload4(xr + 64 * j); } }
        }
        __syncthreads();
        f32x4 a0 = (f32x4){0.f, 0.f, 0.f, 0.f}, a1 = (f32x4){0.f, 0.f, 0.f, 0.f};
        {
            const float* hp = hs + (lane & 15) * HS_STRIDE + 128 * wave + (lane >> 4);
#pragma unroll
            for (int ks = 0; ks < 32; ++ks) {
                const float av = hp[4 * ks];
                a0 = __builtin_amdgcn_mfma_f32_16x16x4f32(av, wb0[ks], a0, 0, 0, 0);
                a1 = __builtin_amdgcn_mfma_f32_16x16x4f32(av, wb1[ks], a1, 0, 0, 0);
            }
        }
        {
            const int fr = lane & 15, fq = lane >> 4;
#pragma unroll
            for (int j = 0; j < 4; ++j) { part[(wave * 16 + 4 * fq + j) * 32 + fr] = a0[j]; part[(wave * 16 + 4 * fq + j) * 32 + 16 + fr] = a1[j]; }
        }
        __syncthreads();
        { const int e = tid & 31; float s = p.router_b[e];
#pragma unroll
          for (int w8 = 0; w8 < 8; ++w8) s += part[w8 * 512 + tid];
          lg[tid] = s; }
        __syncthreads();
        {
            const int row = tid >> 5, e = tid & 31; const float v = lg[tid]; int rank = 0;
#pragma unroll
            for (int q = 0; q < 32; ++q) { const float u = lg[row * 32 + q]; rank += (u > v || (u == v && q < e)) ? 1 : 0; }
            if (rank < 4) { tvs[row * 4 + rank] = v; tis[row * 4 + rank] = e; }
        }
        __syncthreads();
        if (tid < 64) { const int row = tid >> 2, k = tid & 3;
            const float t0 = tvs[row * 4], e1 = fexp(tvs[row * 4 + 1] - t0), e2 = fexp(tvs[row * 4 + 2] - t0), e3 = fexp(tvs[row * 4 + 3] - t0);
            const float inv = 1.f / (1.f + e1 + e2 + e3);
            const float ek = k == 0 ? 1.f : (k == 1 ? e1 : (k == 2 ? e2 : e3));
            const int e = tis[tid];
            sel_e[gl * 64 + tid] = e; sel_g[gl * 64 + tid] = ek * inv;
            lrank[gl * 64 + tid] = atomicAdd(&lcnt[e], 1); }
        ++gl;
        const bool lastg = grp + (int)gridDim.x >= T / 16;
        if (gl == MAXG || lastg) {
            __syncthreads();
            if (tid < 32) { const int c = lcnt[tid]; lbase[tid] = (c > 0 && !dry) ? atomicAdd(&CNT[tid], c) : 0; }
            __syncthreads();
            if (!dry) for (int i = tid; i < gl * 64; i += NTHREADS) { const int gq = i >> 6, a = (grp0 + gq * (int)gridDim.x) * 64 + (i & 63); const int e = sel_e[i];
                const int pos = lbase[e] + lrank[i];
                ((int*)(ws + WS_TOPI))[a] = e; ((float*)(ws + WS_GATE))[a] = sel_g[i]; ((int*)(ws + WS_POS))[a] = pos; ((int*)(ws + WS_TOK))[e * T + pos] = a >> 2; }
            __syncthreads();
            if (tid < 32) lcnt[tid] = 0;
            gl = 0; grp0 = grp + gridDim.x;
        }
        __syncthreads();
    }
}

__device__ __forceinline__ void compute_pstart(const Params& p, unsigned char* lds) {
    int* ps = (int*)(lds + LDS_PS); int* cn = (int*)(lds + LDS_CNT);
    if (threadIdx.x < 64) {
        const int lane = threadIdx.x;
        const int* CNT = (const int*)(p.ws + WS_CTL) + CW_CNT;
        const int c = lane < NE ? __hip_atomic_load(&CNT[lane], __ATOMIC_RELAXED, __HIP_MEMORY_SCOPE_AGENT) : 0;
        int incl = (c + 255) & ~255;
#pragma unroll
        for (int o = 1; o < 32; o <<= 1) { const int t = __shfl_up(incl, o); if (lane >= o) incl += t; }
        if (lane < NE) { ps[lane + 1] = incl; cn[lane] = c; }
        if (lane == 0) ps[0] = 0;
    }
    __syncthreads();
}

struct EpiUp {
    static constexpr bool PERM = true;
    bf16_t* ACT; const float* bgu;
    __device__ __forceinline__ void operator()(const f32x4 (&acc)[2][2][4][2], const pg8::Unit& u, int wr, int wc, int fr, int fq) const {
#pragma unroll
        for (int bj = 0; bj < 2; ++bj) {
            const int grp = 8 * u.pn + 4 * bj + wc, jc = 16 * grp + 4 * fq;
            const float* bp = bgu + (size_t)(u.e & 31) * 2048 + 2 * jc;
            const float4 b01 = *(const float4*)bp, b23 = *(const float4*)(bp + 4);
            const float bg[4] = {b01.x, b01.z, b23.x, b23.z}, bl[4] = {b01.y, b01.w, b23.y, b23.w};
#pragma unroll
            for (int ai = 0; ai < 2; ++ai)
#pragma unroll
                for (int m = 0; m < 4; ++m) { const int row = u.row0 + 128 * ai + 64 * wr + 16 * m + fr;
                    float a[4];
#pragma unroll
                    for (int j = 0; j < 4; ++j) { float gl = acc[ai][bj][m][0][j] + bg[j], ln = acc[ai][bj][m][1][j] + bl[j];
                        gl = fminf(gl, 7.f); ln = fminf(fmaxf(ln, -7.f), 7.f);
                        a[j] = gl / (1.f + fexp(-1.702f * gl)) * (ln + 1.f); }
                    uint2 o; o.x = pk2(a[0], a[1]); o.y = pk2(a[2], a[3]);
                    if (u.e & 64) __hip_atomic_store((unsigned long long*)(ACT + (size_t)row * DFF + jc), (unsigned long long)o.x | ((unsigned long long)o.y << 32), __ATOMIC_RELAXED, __HIP_MEMORY_SCOPE_AGENT);
                    else *(uint2*)(ACT + (size_t)row * DFF + jc) = o; }
        }
    }
};
__device__ void phase_moe_up(const Params& p, unsigned char* lds) {
    int* ps = (int*)(lds + LDS_PS);
    compute_pstart(p, lds);
    pg8::MoeSched<true> Sm; Sm.init(p.ws + WS_H, p.ws + WS_WGUT, D, 8, 2048, ps, (const int*)(p.ws + WS_TOK));
    EpiUp E{(bf16_t*)(p.ws + WS_ACT), p.b_gate_up};
    pg8::gemm_phase<EpiUp, pg8::MoeSched<true>>((LAS unsigned char*)lds, D, Sm, E);
}

struct EpiDown {
    static constexpr bool PERM = true;
    bf16_t* YE; const float* bd;
    __device__ __forceinline__ void operator()(const f32x4 (&acc)[2][2][4][2], const pg8::Unit& u, int wr, int wc, int fr, int fq) const {
#pragma unroll
        for (int bj = 0; bj < 2; ++bj) {
            const int c0 = 256 * u.pn + 128 * bj + 32 * wc + 8 * fq;
            const float* bp = bd + (size_t)(u.e & 31) * D + c0;
            const float4 b0 = *(const float4*)bp, b1 = *(const float4*)(bp + 4);
#pragma unroll
            for (int ai = 0; ai < 2; ++ai)
#pragma unroll
                for (int m = 0; m < 4; ++m) { const int row = u.row0 + 128 * ai + 64 * wr + 16 * m + fr;
                    const f32x4 v0 = acc[ai][bj][m][0], v1 = acc[ai][bj][m][1];
                    u32x4 w; w.x = pk2(v0[0] + b0.x, v0[1] + b0.y); w.y = pk2(v0[2] + b0.z, v0[3] + b0.w); w.z = pk2(v1[0] + b1.x, v1[1] + b1.y); w.w = pk2(v1[2] + b1.z, v1[3] + b1.w);
                    *(u32x4*)(YE + (size_t)row * D + c0) = w; }
        }
    }
};
struct EpiMoe {
    static constexpr bool PERM = true;
    EpiUp up; EpiDown dn;
    __device__ __forceinline__ void operator()(const f32x4 (&acc)[2][2][4][2], const pg8::Unit& u, int wr, int wc, int fr, int fq) const {
        if ((u.e & 32) == 0) up(acc, u, wr, wc, fr, fq); else dn(acc, u, wr, wc, fr, fq);
    }
};
__device__ void phase_moe(const Params& p, unsigned char* lds) {
    int* ps = (int*)(lds + LDS_PS);
    compute_pstart(p, lds);
    const volatile unsigned* xs = (const volatile unsigned*)(lds + LDS_BARW);
    LAS int* ms = (LAS int*)(lds + LDS_BARW + 128);
    if (threadIdx.x == 0) {
        const int gt = gridDim.x, RT = ps[NE] >> 8, R = (12 * RT + gt - 1) / gt, x = (int)xs[4];
        int totE = 0, totF = 0, base = 0;
        for (int j = 0; j < 16; ++j) { const int cj = (int)xs[16 + j]; if (cj == 0) continue;
            const int tiles = RT * (base + cj) / gt - RT * base / gt, cap = R * cj, un = 12 * tiles;
            totE += un > cap ? min(tiles, (un - cap + 3) / 4) : 0; totF += un <= cap ? (cap - un) / 4 : 0; base += cj; }
        const int E = min(min(totE, totF), 24);
        int ge = 0, gf = 0; base = 0;
        LAS int* tmp = (LAS int*)lds;
        ms[2] = 0; ms[3] = 0;
        for (int j = 0; j < 16; ++j) { const int cj = (int)xs[16 + j]; if (cj == 0) continue;
            const int t0j = RT * base / gt, tiles = RT * (base + cj) / gt - t0j, cap = R * cj, un = 12 * tiles;
            const int ej = un > cap ? min(tiles, (un - cap + 3) / 4) : 0, fj = un <= cap ? (cap - un) / 4 : 0;
            const int eff = max(0, min(ej, E - ge));
            for (int k = 0; k < eff; ++k) tmp[ge + k] = t0j + k;
            if (j == x) { ms[0] = t0j; ms[1] = tiles; ms[2] = eff; ms[4] = min(gf, E); ms[3] = min(gf + fj, E) - min(gf, E); }
            ge += ej; gf += fj; base += cj; }
        for (int k = 0; k < ms[3]; ++k) ms[8 + k] = tmp[ms[4] + k];
    }
    __syncthreads();
    pg8::MoeSched2 Sm; Sm.init(p.ws, ps, (int)xs[0], (int)xs[2], ms);
    EpiMoe E{EpiUp{(bf16_t*)(p.ws + WS_ACT), p.b_gate_up}, EpiDown{(bf16_t*)(p.ws + WS_YE), p.b_down}};
    pg8::gemm_phase<EpiMoe, pg8::MoeSched2>((LAS unsigned char*)lds, D, Sm, E);
}
__device__ void phase_moe_down(const Params& p, unsigned char* lds) {
    int* ps = (int*)(lds + LDS_PS);
    compute_pstart(p, lds);
    pg8::MoeSched<false> Sm; Sm.init(p.ws + WS_ACT, p.ws + WS_WDT, DFF, 4, 1024, ps, nullptr);
    EpiDown E{(bf16_t*)(p.ws + WS_YE), p.b_down};
    pg8::gemm_phase<EpiDown, pg8::MoeSched<false>>((LAS unsigned char*)lds, DFF, Sm, E);
}

__device__ void phase_combine(const Params& p, unsigned char* lds) {
    const int tid = threadIdx.x, lane = tid & 63, wave = tid >> 6;
    unsigned char* ws = p.ws;
    const float* mod = (const float*)(ws + WS_MOD);
    const bf16_t* YE = (const bf16_t*)(ws + WS_YE);
    const bf16_t* X1 = (const bf16_t*)(ws + WS_X1);
    const int* TOPI = (const int*)(ws + WS_TOPI); const int* POS = (const int*)(ws + WS_POS); const float* GATE = (const float*)(ws + WS_GATE);
    compute_pstart(p, lds);
    const int* ps = (const int*)(lds + LDS_PS);
    for (int m0 = (blockIdx.x * NW + wave) * 2; m0 < T; m0 += gridDim.x * NW * 2) {
        const int4 te0 = *(const int4*)(TOPI + m0 * 4), te1 = *(const int4*)(TOPI + m0 * 4 + 4), tp0 = *(const int4*)(POS + m0 * 4), tp1 = *(const int4*)(POS + m0 * 4 + 4);
        const float4 gk0 = *(const float4*)(GATE + m0 * 4), gk1 = *(const float4*)(GATE + m0 * 4 + 4);
        const int slot[2][4] = {{ps[te0.x] + tp0.x, ps[te0.y] + tp0.y, ps[te0.z] + tp0.z, ps[te0.w] + tp0.w}, {ps[te1.x] + tp1.x, ps[te1.y] + tp1.y, ps[te1.z] + tp1.z, ps[te1.w] + tp1.w}};
        const float gk[2][4] = {{gk0.x, gk0.y, gk0.z, gk0.w}, {gk1.x, gk1.y, gk1.z, gk1.w}};
        uint2 u[2][4][4]; float4 x1[2][4];
#pragma unroll
        for (int q = 0; q < 2; ++q) {
#pragma unroll
            for (int k = 0; k < 4; ++k) { const uint2* yr = (const uint2*)(YE + (size_t)slot[q][k] * D) + lane;
#pragma unroll
                for (int j = 0; j < 4; ++j) u[q][k][j] = ntload2(yr + 64 * j); }
            const uint2* xr = (const uint2*)(X1 + (size_t)(m0 + q) * D) + lane;
#pragma unroll
            for (int j = 0; j < 4; ++j) { const uint2 w = ntload2(xr + 64 * j);
                x1[q][j] = make_float4(bf2f((unsigned short)(w.x & 0xffff)), bf2f((unsigned short)(w.x >> 16)), bf2f((unsigned short)(w.y & 0xffff)), bf2f((unsigned short)(w.y >> 16))); }
        }
#pragma unroll
        for (int q = 0; q < 2; ++q) {
            const int m = m0 + q, b = m >> 13;
            float4 y[4];
#pragma unroll
            for (int j = 0; j < 4; ++j) { y[j] = make_float4(0.f, 0.f, 0.f, 0.f);
#pragma unroll
                for (int k = 0; k < 4; ++k) { const uint2 w = u[q][k][j]; const float g = gk[q][k];
                    y[j].x += g * bf2f((unsigned short)(w.x & 0xffff)); y[j].y += g * bf2f((unsigned short)(w.x >> 16));
                    y[j].z += g * bf2f((unsigned short)(w.y & 0xffff)); y[j].w += g * bf2f((unsigned short)(w.y >> 16)); } }
            float ss = 0.f;
#pragma unroll
            for (int j = 0; j < 4; ++j) ss += y[j].x * y[j].x + y[j].y * y[j].y + y[j].z * y[j].z + y[j].w * y[j].w;
            const float rstd = rsqrtf(wave_sum(ss) * (1.f / D) + EPS);
#pragma unroll
            for (int j = 0; j < 4; ++j) { const int c = 4 * lane + 256 * j;
                const float4 g = *(const float4*)(p.g_post_ffn + c), gt = *(const float4*)(mod + b * 6144 + 5120 + c);
                float4 o;
                o.x = x1[q][j].x + gt.x * (y[j].x * rstd * g.x); o.y = x1[q][j].y + gt.y * (y[j].y * rstd * g.y);
                o.z = x1[q][j].z + gt.z * (y[j].z * rstd * g.z); o.w = x1[q][j].w + gt.w * (y[j].w * rstd * g.w);
                ntstore4((float4*)(p.out + (size_t)m * D + c), o); }
        }
    }
}

#define XB_TMO      128
#define XB_XCNT(j)  (256  + 64 * (j))
#define XB_XSUB(j)  (1280 + 64 * (j))
#define XB_XGEN(j)  (2304 + 64 * (j))
#define XB_TOP      3328
#define XB_TOPGEN   3392
#define XCD_BAR_WORDS 3456
#define XB_SPIN_CAP (1u << 18)
__device__ __forceinline__ unsigned xb_ld(unsigned* p)              { return __hip_atomic_load(p, __ATOMIC_RELAXED, __HIP_MEMORY_SCOPE_AGENT); }
__device__ __forceinline__ unsigned xb_add(unsigned* p, unsigned v) { return __hip_atomic_fetch_add(p, v, __ATOMIC_RELAXED, __HIP_MEMORY_SCOPE_AGENT); }
__device__ __forceinline__ unsigned xb_xcc_id() { return (unsigned)__builtin_amdgcn_s_getreg((3 << 11) | 20) & 0xFu; }
#define XB_SPIN(cond, bar) do { unsigned _sp = 0; while (cond) { __builtin_amdgcn_s_sleep(1); \
    if ((++_sp & 255u) == 0u) { if (xb_ld(&(bar)[XB_TMO])) break; if (_sp > XB_SPIN_CAP) { atomicAdd(&(bar)[XB_TMO], 1u); break; } } } } while (0)
struct XcdBarrier { unsigned* bar; unsigned x; volatile LAS unsigned* st; };
__device__ __forceinline__ XcdBarrier xcd_barrier_post(unsigned* bar, volatile LAS unsigned* st) {
    XcdBarrier b; b.bar = bar; b.x = xb_xcc_id(); b.st = st;
    if (threadIdx.x == 0) st[2] = xb_add(&bar[XB_XCNT(b.x)], 1u);
    return b;
}
__device__ __forceinline__ void xcd_barrier_complete(unsigned* bar, unsigned x, unsigned& nloc, unsigned& nx, unsigned& base) {
    const unsigned G = gridDim.x * gridDim.y * gridDim.z;
    unsigned sum, cnt, mine, sp = 0u;
    for (;;) {
        sum = 0u; cnt = 0u; mine = 0u; base = 0u;
#pragma unroll
        for (unsigned j = 0; j < 16; ++j) { const unsigned c = xb_ld(&bar[XB_XCNT(j)]); sum += c; cnt += (c > 0u) ? 1u : 0u; mine = (j == x) ? c : mine; base += (j < x) ? c : 0u; }
        if (sum == G) break;
        __builtin_amdgcn_s_sleep(1);
        if ((++sp & 255u) == 0u) { if (xb_ld(&bar[XB_TMO])) break; if (sp > XB_SPIN_CAP) { atomicAdd(&bar[XB_TMO], 1u); break; } }
    }
    nloc = mine > 0u ? mine : 1u; nx = cnt > 0u ? cnt : 1u;
}
__device__ __forceinline__ void xcd_barrier(const XcdBarrier& b) {
    asm volatile("s_waitcnt vmcnt(0)" ::: "memory");
    __syncthreads();
    if (threadIdx.x == 0) {
        unsigned* bar = b.bar;
        __builtin_amdgcn_s_waitcnt(0);
        unsigned nloc = b.st[0], nx = b.st[1];
        if (nloc == 0u) { unsigned base; xcd_barrier_complete(bar, b.x, nloc, nx, base); b.st[0] = nloc; b.st[1] = nx; b.st[3] = base; b.st[4] = b.x;
            for (unsigned j = 0; j < 16; ++j) b.st[16 + j] = xb_ld(&bar[XB_XCNT(j)]); }
        const unsigned old = xb_add(&bar[XB_XSUB(b.x)], 1u);
        const unsigned gen = old / nloc;
        if (old + 1u == (gen + 1u) * nloc) {
            __builtin_amdgcn_fence(__ATOMIC_RELEASE, "agent");
            asm volatile("s_waitcnt vmcnt(0)" ::: "memory");
            const unsigned og = xb_add(&bar[XB_TOP], 1u);
            const unsigned tg = og / nx;
            if (og + 1u == (tg + 1u) * nx) xb_add(&bar[XB_TOPGEN], 1u);
            else XB_SPIN(xb_ld(&bar[XB_TOPGEN]) == tg, bar);
            __builtin_amdgcn_fence(__ATOMIC_ACQUIRE, "agent");
            xb_add(&bar[XB_XGEN(b.x)], 1u);
            asm volatile("s_waitcnt vmcnt(0)" ::: "memory");
        } else {
            XB_SPIN(xb_ld(&bar[XB_XGEN(b.x)]) == gen, bar);
            __builtin_amdgcn_fence(__ATOMIC_ACQUIRE, "agent");
            asm volatile("s_waitcnt vmcnt(0)" ::: "memory");
        }
    }
    __syncthreads();
}

__global__ void __launch_bounds__(NTHREADS, 2) fwd_kernel(Params p) {
    extern __shared__ __attribute__((aligned(16))) unsigned char lds[];
    const int lo = p.ph_lo, hi = p.ph_hi;
    volatile LAS unsigned* st = (volatile LAS unsigned*)(lds + LDS_BARW);
    if (threadIdx.x == 0) { st[0] = 0u; st[1] = 0u; }
    __syncthreads();
    XcdBarrier bar; bar.bar = (unsigned*)(p.ws + WS_CTL); bar.x = 0; bar.st = st;
    if (hi - lo > 1) bar = xcd_barrier_post((unsigned*)(p.ws + WS_CTL), st);
#ifndef PROBE_DUP
#define PROBE_DUP -1
#endif
#define PHASE(k, call) if (lo <= (k) && (k) < hi) { const int nrep = ((k) == PROBE_DUP) ? hi - 9 : 1; for (int rep = 0; rep < nrep; ++rep) { const bool dry = rep > 0; (void)dry; call; if (rep + 1 < nrep) __syncthreads(); } if ((k) + 1 < hi) xcd_barrier(bar); }
    PHASE(0, { phase_prep(p, lds); phase_prenorm(p); })
    PHASE(2, phase_gemm_in(p, lds))
    PHASE(3, { vtrans_items(p, lds); gla1_items(p, lds); })
    PHASE(4, { gla2_scan(p); phase_attn(p, lds); })
    PHASE(5, gla3_items(p, lds))
    PHASE(6, phase_gemm_out(p, lds))
    PHASE(7, phase_postmix(p, lds, dry))
    PHASE(8, phase_moe(p, lds))
    PHASE(10, phase_combine(p, lds))
#undef PHASE
}

extern "C" void kernel_launch(void* const* d_in, const int* in_sizes, int n_in, void* d_out, int out_size, void* d_ws, size_t ws_size, hipStream_t stream) {
    static int grid_blocks = 0;
    if (grid_blocks == 0) {
        if (n_in != 19 || out_size != T * D || ws_size < WS_END) { fprintf(stderr, "kernel_launch: unexpected shapes (n_in %d out %d ws %zu need %zu)\n", n_in, out_size, ws_size, (size_t)WS_END); grid_blocks = -1; return; }
        int dev = 0, cus = 0, per_cu = 0;
        (void)hipGetDevice(&dev);
        (void)hipDeviceGetAttribute(&cus, hipDeviceAttributeMultiprocessorCount, dev);
        if (hipFuncSetAttribute((const void*)fwd_kernel, hipFuncAttributeMaxDynamicSharedMemorySize, LDS_BYTES) != hipSuccess) { fprintf(stderr, "kernel_launch: hipFuncSetAttribute failed\n"); grid_blocks = -1; return; }
        (void)hipOccupancyMaxActiveBlocksPerMultiprocessor(&per_cu, fwd_kernel, NTHREADS, LDS_BYTES);
        if (per_cu < 1) { fprintf(stderr, "kernel_launch: occupancy query reports %d blocks per CU\n", per_cu); per_cu = 1; }
        grid_blocks = cus;
        (void)hipGetLastError();
    }
    if (grid_blocks < 0) return;
    (void)hipMemsetAsync((char*)d_ws + WS_CTL, 0, CTL_BYTES, stream);
    Params p{};
    p.x = (const float*)d_in[0]; p.c = (const float*)d_in[1]; p.w_mod = (const float*)d_in[2]; p.b_mod = (const float*)d_in[3];
    p.g_pre_mix = (const float*)d_in[4]; p.w_in = (const float*)d_in[5]; p.w_gate_lr = (const float*)d_in[6]; p.b_gate = (const float*)d_in[7];
    p.g_gla = (const float*)d_in[8]; p.w_out = (const float*)d_in[9]; p.g_post_mix = (const float*)d_in[10]; p.g_pre_ffn = (const float*)d_in[11];
    p.router_w = (const float*)d_in[12]; p.router_b = (const float*)d_in[13]; p.w_gate_up = (const float*)d_in[14]; p.b_gate_up = (const float*)d_in[15];
    p.w_down = (const float*)d_in[16]; p.b_down = (const float*)d_in[17]; p.g_post_ffn = (const float*)d_in[18];
    p.out = (float*)d_out; p.ws = (unsigned char*)d_ws;
    for (int d = 0; d < 32; ++d) p.inv_freq[d] = powf(10000.0f, -(float)d / 32.0f);
#if ONE_LAUNCH
    p.ph_lo = 0; p.ph_hi = NPHASE;
    void* args[] = {&p};
    hipError_t e = hipLaunchCooperativeKernel((void*)fwd_kernel, dim3(grid_blocks), dim3(NTHREADS), args, LDS_BYTES, stream);
    if (e != hipSuccess) fprintf(stderr, "cooperative launch failed: %s (grid %d)\n", hipGetErrorString(e), grid_blocks);
#else
    for (int k = 0; k < NPHASE; ++k) { p.ph_lo = k; p.ph_hi = k + 1; hipLaunchKernelGGL(fwd_kernel, dim3(grid_blocks), dim3(NTHREADS), LDS_BYTES, stream, p); }
#endif
}
```

```cpp
#include <hip/hip_runtime.h>
#include <cstdio>
#include <cstdint>
#include <cmath>

#ifndef ONE_LAUNCH
#define ONE_LAUNCH 1
#endif

typedef unsigned short bf16_t;
typedef short bf16x8 __attribute__((ext_vector_type(8)));
typedef float f32x4 __attribute__((ext_vector_type(4)));
typedef unsigned u32x4 __attribute__((ext_vector_type(4)));
#define LAS __attribute__((address_space(3)))

constexpr int T = 16384, D = 1024, S = 8192;
constexpr int DIN = 3088, DINP = 3104;
constexpr int NE = 32, DFF = 1024;
constexpr int PMAX = 65536 + NE * 256;
constexpr int NTHREADS = 512, NW = 8;
constexpr int LDS_STAGE = 131072;
constexpr int LDS_PS = LDS_STAGE;
constexpr int LDS_BARW = LDS_STAGE + 256;
constexpr int LDS_CNT = LDS_STAGE + 512;
constexpr int LDS_TOKB = LDS_STAGE + 1024;
constexpr int LDS_BYTES = LDS_STAGE + 4096;
constexpr int NPHASE = 11;
constexpr float EPS = 1e-6f;
constexpr float LOG2E = 1.4426950408889634f;

constexpr size_t al(size_t x) { return (x + 255) & ~(size_t)255; }
constexpr size_t WS_CTL   = 0;
constexpr size_t CTL_BYTES = 65536;
constexpr size_t WS_MOD   = WS_CTL + CTL_BYTES;
constexpr size_t WS_ROPE  = al(WS_MOD + 2 * 6144 * 4);
constexpr size_t WS_WINT  = al(WS_ROPE + (size_t)S * 32 * 2 * 4);
constexpr size_t WS_WOUTT = al(WS_WINT + (size_t)DINP * D * 2);
constexpr size_t WS_WGUT  = al(WS_WOUTT + (size_t)D * D * 2);
constexpr size_t WS_WDT   = al(WS_WGUT + (size_t)NE * 2048 * D * 2);
constexpr size_t WS_H     = al(WS_WDT + (size_t)NE * D * DFF * 2);
constexpr size_t WS_QA    = al(WS_H + (size_t)T * D * 2);
constexpr size_t WS_KA    = al(WS_QA + (size_t)T * 512 * 2);
constexpr size_t WS_VA    = al(WS_KA + (size_t)T * 512 * 2);
constexpr size_t WS_VB    = al(WS_VA + (size_t)T * 512 * 2);
constexpr size_t WS_QG    = al(WS_VB + (size_t)T * 512 * 2);
constexpr size_t WS_KG    = al(WS_QG + (size_t)T * 256 * 2);
constexpr size_t WS_VG    = al(WS_KG + (size_t)T * 256 * 2);
constexpr size_t WS_RG    = al(WS_VG + (size_t)T * 512 * 2);
constexpr size_t WS_GLR   = al(WS_RG + (size_t)T * 512 * 2);
constexpr size_t WS_UT    = al(WS_GLR + (size_t)T * 16 * 4);
constexpr size_t WS_AG    = al(WS_UT + (size_t)1024 * 128 * 64 * 4);
constexpr size_t WS_SPT   = al(WS_AG + (size_t)1024 * 64 * 4);
constexpr size_t WS_CAT   = al(WS_SPT + (size_t)1024 * 128 * 64 * 2);
constexpr size_t WS_TOPI  = al(WS_CAT + (size_t)T * D * 2);
constexpr size_t WS_GATE  = al(WS_TOPI + (size_t)T * 4 * 4);
constexpr size_t WS_POS   = al(WS_GATE + (size_t)T * 4 * 4);
constexpr size_t WS_SLOT  = al(WS_POS + (size_t)T * 4 * 4);
constexpr size_t WS_TOK   = al(WS_SLOT + (size_t)T * 4 * 4);
constexpr size_t WS_ACT   = al(WS_TOK + (size_t)NE * T * 4);
constexpr size_t WS_YMIX  = WS_ACT;
constexpr size_t WS_X1    = WS_UT;
constexpr size_t WS_YE    = al(WS_ACT + (size_t)PMAX * DFF * 2);
constexpr size_t WS_IDT   = al(WS_YE + (size_t)PMAX * D * 2);
constexpr size_t WS_END   = al(WS_IDT + (size_t)PMAX * 4);
static_assert((size_t)T * D * 4 <= (size_t)PMAX * DFF * 2, "YMIX alias fits in ACT");
static_assert(WS_X1 + (size_t)T * D * 2 <= WS_AG, "X1 alias fits in UT");
constexpr int CW_CNT = 4096;
constexpr int CW_UPCNT = 4352;
constexpr int CW_MODCNT = 4224;

struct Params {
    const float *x, *c, *w_mod, *b_mod, *g_pre_mix, *w_in, *w_gate_lr, *b_gate, *g_gla, *w_out, *g_post_mix, *g_pre_ffn,
                *router_w, *router_b, *w_gate_up, *b_gate_up, *w_down, *b_down, *g_post_ffn;
    float* out; unsigned char* ws;
    int ph_lo, ph_hi;
    float inv_freq[32];
};

__device__ __forceinline__ unsigned f2bf(float f) { unsigned u = __builtin_bit_cast(unsigned, f); return (u + 0x7fffu + ((u >> 16) & 1u)) >> 16; }
typedef float f32x2_t __attribute__((ext_vector_type(2))); typedef __bf16 bf16x2_t __attribute__((ext_vector_type(2)));
__device__ __forceinline__ unsigned pk2(float lo, float hi) { f32x2_t v = {lo, hi}; bf16x2_t b = __builtin_convertvector(v, bf16x2_t); return __builtin_bit_cast(unsigned, b); }
__device__ __forceinline__ float bf2f(unsigned short b) { return __builtin_bit_cast(float, (unsigned)b << 16); }
__device__ __forceinline__ float4 ntload4(const float4* p) { const f32x4 t = __builtin_nontemporal_load((const f32x4*)p); return make_float4(t[0], t[1], t[2], t[3]); }
__device__ __forceinline__ uint2 ntload2(const uint2* p) { typedef unsigned u32x2 __attribute__((ext_vector_type(2))); const u32x2 t = __builtin_nontemporal_load((const u32x2*)p); return make_uint2(t[0], t[1]); }
__device__ __forceinline__ void ntstore4(float4* p, float4 v) { const f32x4 t = {v.x, v.y, v.z, v.w}; __builtin_nontemporal_store(t, (f32x4*)p); }
__device__ __forceinline__ void ntstore2(uint2* p, uint2 v) { typedef unsigned u32x2 __attribute__((ext_vector_type(2))); const u32x2 t = {v.x, v.y}; __builtin_nontemporal_store(t, (u32x2*)p); }
__device__ __forceinline__ void ntstore4u(uint4* p, uint4 v) { const u32x4 t = {v.x, v.y, v.z, v.w}; __builtin_nontemporal_store(t, (u32x4*)p); }
__device__ __forceinline__ float wave_sum(float v) {
#pragma unroll
    for (int o = 1; o < 64; o <<= 1) v += __shfl_xor(v, o);
    return v;
}
__device__ __forceinline__ float fexp2(float x) { return __builtin_amdgcn_exp2f(x); }
__device__ __forceinline__ float fexp(float x) { return __builtin_amdgcn_exp2f(x * LOG2E); }
__device__ __forceinline__ float flog(float x) { return __builtin_amdgcn_logf(x) * 0.6931471805599453f; }
__device__ __forceinline__ float fsilu(float x) { return x / (1.f + fexp(-x)); }

#define GAS __attribute__((address_space(1)))
namespace pg8 {
constexpr int BM = 256, BK = 64, HALF = 128, HTB = HALF * BK * 2, NXCD = 8, WGM = 8;
__host__ __device__ __forceinline__ int lds_byte(int r, int c) { const int st = (r >> 4) * 2 + (c >> 5), rr = r & 15, cc = c & 31, ob = rr * 64 + cc * 2; return st * 1024 + (ob ^ (((ob >> 9) & 1) << 5)); }
__host__ __device__ __forceinline__ void stage_rc(int b, int& R, int& C) { const int st = b / 1024, sb = b % 1024, swz = sb ^ (((sb >> 9) & 1) << 5); R = (st >> 1) * 16 + swz / 64; C = (st & 1) * 32 + (swz % 64) / 2; }
__host__ __device__ __forceinline__ int perm32(int rho) { const int n = rho >> 4, i = rho & 15; return 8 * (i >> 2) + 4 * n + (i & 3); }

struct Unit { const char* A; const char* B; unsigned ao[2][2]; int row0, pn, e, nvalid, tb0; };

__device__ __forceinline__ int xcd_remap(int wgid, int nwg) { const int q = nwg / NXCD, r = nwg % NXCD, xcd = wgid % NXCD, off = wgid / NXCD; return (xcd < r ? xcd * (q + 1) : r * (q + 1) + (xcd - r) * q) + off; }
__device__ __forceinline__ const char* uptr(const char* p) {
    const unsigned long long v = (unsigned long long)p;
    const unsigned lo = __builtin_amdgcn_readfirstlane((unsigned)v), hi = __builtin_amdgcn_readfirstlane((unsigned)(v >> 32));
    return (const char*)(((unsigned long long)hi << 32) | lo);
}

template <class Epi, class Sched>
__device__ __forceinline__ void gemm_phase(LAS unsigned char* lds, const int K, const Sched& S, const Epi& E) {
    constexpr bool GATHER = Sched::GATHER;
    const int tid = threadIdx.x, wid = __builtin_amdgcn_readfirstlane(tid >> 6), lane = tid & 63, wr = wid >> 2, wc = wid & 3, fr = lane & 15, fq = lane >> 4;
    const int nt = K / BK;
    unsigned voffA[2], voffB[2];
#pragma unroll
    for (int i = 0; i < 2; ++i) { int R, C; stage_rc(tid * 16 + i * 8192, R, C); const int Rb = Epi::PERM ? ((R & ~31) + perm32(R & 31)) : R;
        voffA[i] = (unsigned)(R * K + C) * 2u; voffB[i] = (unsigned)(Rb * K + C) * 2u; }
    const size_t kstep = (size_t)(BK * 2);
    const size_t hstep = (size_t)HALF * K * 2;
    const unsigned ldsw = (unsigned)wid * 1024u;
    const int aoff = lds_byte(wr * 64 + fr, fq * 8), boff = lds_byte(wc * 32 + fr, fq * 8);
#define PG8_SA(b, h) (((b) * 2 + (h)) * HTB)
#define PG8_SB(b, h) ((4 + (b) * 2 + (h)) * HTB)
#define PG8_STAGE(bufoff, gbase, voff) do { _Pragma("unroll") for (int _i = 0; _i < 2; ++_i) \
        __builtin_amdgcn_global_load_lds((const unsigned*)((const char*)(gbase) + (voff)[_i]), (LAS unsigned*)(lds + (bufoff) + ldsw + _i * 8192), 16, 0, 0); } while (0)
#define PG8_STAGE_A(bufoff, ap, ao, h) do { if constexpr (GATHER) PG8_STAGE(bufoff, ap, (ao)[h]); else PG8_STAGE(bufoff, (ap) + (size_t)(h) * hstep, voffA); } while (0)
#define PG8_LDA(dst, b, h) do { _Pragma("unroll") for (int m = 0; m < 4; ++m) _Pragma("unroll") for (int k = 0; k < 2; ++k) dst[m][k] = *(const LAS bf16x8*)(lds + PG8_SA(b, h) + aoff + m * 2048 + k * 1024); } while (0)
#define PG8_LDB(dst, b, h) do { _Pragma("unroll") for (int n = 0; n < 2; ++n) _Pragma("unroll") for (int k = 0; k < 2; ++k) dst[n][k] = *(const LAS bf16x8*)(lds + PG8_SB(b, h) + boff + n * 2048 + k * 1024); } while (0)
#define PG8_MMA(ai, bj, At, Bt) do { __builtin_amdgcn_s_setprio(1); _Pragma("unroll") for (int m = 0; m < 4; ++m) _Pragma("unroll") for (int n = 0; n < 2; ++n) _Pragma("unroll") for (int k = 0; k < 2; ++k) \
        acc[ai][bj][m][n] = __builtin_amdgcn_mfma_f32_16x16x32_bf16(Bt[n][k], At[m][k], acc[ai][bj][m][n], 0, 0, 0); __builtin_amdgcn_s_setprio(0); } while (0)
#define PG8_UCOPY(d, s_) do { (d).A = (s_).A; (d).B = (s_).B; (d).row0 = (s_).row0; (d).pn = (s_).pn; (d).e = (s_).e; (d).nvalid = (s_).nvalid; (d).tb0 = (s_).tb0; } while (0)
#define PG8_WAIT_V(n) asm volatile("s_waitcnt vmcnt(" #n ")" ::: "memory")
#define PG8_WAIT_L(n) asm volatile("s_waitcnt lgkmcnt(" #n ")" ::: "memory")
#define PG8_BAR __builtin_amdgcn_s_barrier()
#define PG8_SCHED __builtin_amdgcn_sched_barrier(0)
    Unit cur, nxt; int ui = 0;
    int pend = -1;
    if (!S.next(0, cur)) return;
    if constexpr (GATHER) S.first_rows(cur);
    f32x4 acc[2][2][4][2];
#pragma unroll
    for (int a = 0; a < 2; ++a)
#pragma unroll
        for (int b = 0; b < 2; ++b)
#pragma unroll
            for (int m = 0; m < 4; ++m)
#pragma unroll
                for (int n = 0; n < 2; ++n) acc[a][b][m][n] = (f32x4){0.f, 0.f, 0.f, 0.f};
    bf16x8 At[4][2], B0[2][2], B1[2][2];
#ifndef PG8_SP2
#define PG8_SP2 1
#endif
#if PG8_SP2
    PG8_STAGE(PG8_SB(0, 0), cur.B, voffB); PG8_STAGE(PG8_SB(0, 1), cur.B + hstep, voffB); PG8_STAGE_A(PG8_SA(0, 0), cur.A, cur.ao, 0); PG8_STAGE_A(PG8_SA(0, 1), cur.A, cur.ao, 1);
    if (wr == 1) PG8_BAR;
    PG8_WAIT_V(2); PG8_BAR;
#else
    PG8_STAGE(PG8_SB(0, 0), cur.B, voffB); PG8_STAGE_A(PG8_SA(0, 0), cur.A, cur.ao, 0); PG8_STAGE(PG8_SB(0, 1), cur.B + hstep, voffB); PG8_STAGE_A(PG8_SA(0, 1), cur.A, cur.ao, 1);
    if (wr == 1) PG8_BAR;
    PG8_WAIT_V(4); PG8_BAR;
#endif
    PG8_STAGE(PG8_SB(1, 0), cur.B + kstep, voffB); PG8_STAGE_A(PG8_SA(1, 0), cur.A + kstep, cur.ao, 0); PG8_STAGE(PG8_SB(1, 1), cur.B + hstep + kstep, voffB);
    PG8_WAIT_V(6); PG8_BAR;
    for (;;) {
        const bool has_next = S.next(ui + 1, nxt);
        if constexpr (GATHER) { if (has_next && wid < 4) S.prefetch_rows(nxt, (LAS unsigned*)(lds + LDS_TOKB + ((ui + 1) & 1) * 1024 + wid * 256), wid, lane); }
        if constexpr (Sched::HOOKS) { if (has_next) S.poll(nxt, (LAS unsigned*)(lds + LDS_BARW + 32 + wid * 4), lane); }
        if (!has_next) { PG8_UCOPY(nxt, cur); }
        for (int t = 0; t < nt; t += 2) {
            const bool last = (t == nt - 2);
            if constexpr (Sched::HOOKS) {
                if (t == 2 && pend >= 0) { S.publish(pend, lane); pend = -1; }
                if (last && has_next) S.a_ready(nxt, (const LAS unsigned*)(lds + LDS_BARW + 32 + wid * 4));
            }
            const char* a1 = cur.A + (size_t)(t + 1) * kstep;
            const char* a2 = last ? nxt.A : cur.A + (size_t)(t + 2) * kstep; const char* b2 = last ? nxt.B : cur.B + (size_t)(t + 2) * kstep;
            const char* a3 = a2 + kstep; const char* b3 = b2 + kstep;
            unsigned o2[2][2];
            if constexpr (GATHER) {
                const LAS int* tb = (const LAS int*)(lds + LDS_TOKB + ((ui + 1) & 1) * 1024);
#pragma unroll
                for (int q = 0; q < 2; ++q) { int R, C; stage_rc(tid * 16 + q * 8192, R, C);
#pragma unroll
                    for (int h = 0; h < 2; ++h) { const int i = h * HALF + R; const int tk = i < nxt.nvalid ? tb[i] : 0; o2[h][q] = (last && has_next) ? (unsigned)(tk * K + C) * 2u : cur.ao[h][q]; } }
            }
#if !PG8_SP2
            PG8_LDB(B0, 0, 0); PG8_SCHED; PG8_LDA(At, 0, 0); PG8_STAGE_A(PG8_SA(1, 1), a1, cur.ao, 1);
            PG8_WAIT_L(8); PG8_BAR; PG8_WAIT_L(0); PG8_MMA(0, 0, At, B0); PG8_BAR; PG8_SCHED;
            PG8_LDB(B1, 0, 1); PG8_STAGE(PG8_SB(0, 0), b2, voffB);
            PG8_BAR; PG8_WAIT_L(0); PG8_MMA(0, 1, At, B1); PG8_BAR;
            PG8_LDA(At, 0, 1); PG8_STAGE_A(PG8_SA(0, 0), a2, o2, 0);
            PG8_BAR; PG8_WAIT_L(0); PG8_MMA(1, 0, At, B0); PG8_BAR; PG8_SCHED;
            PG8_STAGE(PG8_SB(0, 1), b2 + hstep, voffB);
            PG8_WAIT_V(6); PG8_BAR; PG8_MMA(1, 1, At, B1); PG8_BAR;
            PG8_LDB(B0, 1, 0); PG8_SCHED; PG8_LDA(At, 1, 0); PG8_STAGE_A(PG8_SA(0, 1), a2, o2, 1);
            PG8_WAIT_L(8); PG8_BAR; PG8_WAIT_L(0); PG8_MMA(0, 0, At, B0); PG8_BAR; PG8_SCHED;
            PG8_LDB(B1, 1, 1); PG8_STAGE(PG8_SB(1, 0), b3, voffB);
            PG8_BAR; PG8_WAIT_L(0); PG8_MMA(0, 1, At, B1); PG8_BAR;
            PG8_LDA(At, 1, 1); PG8_STAGE_A(PG8_SA(1, 0), a3, o2, 0);
            PG8_BAR; PG8_WAIT_L(0); PG8_MMA(1, 0, At, B0); PG8_BAR; PG8_SCHED;
            PG8_STAGE(PG8_SB(1, 1), b3 + hstep, voffB);
            PG8_WAIT_V(6); PG8_BAR; PG8_MMA(1, 1, At, B1); PG8_BAR;
#else
            PG8_LDB(B0, 0, 0); PG8_LDB(B1, 0, 1); PG8_SCHED; PG8_LDA(At, 0, 0); PG8_STAGE_A(PG8_SA(1, 1), a1, cur.ao, 1);
            PG8_WAIT_V(8); PG8_WAIT_L(0); PG8_BAR; PG8_MMA(0, 0, At, B0); PG8_MMA(0, 1, At, B1); PG8_BAR; PG8_SCHED;
            PG8_LDA(At, 0, 1); PG8_STAGE(PG8_SB(0, 0), b2, voffB); PG8_STAGE(PG8_SB(0, 1), b2 + hstep, voffB); PG8_STAGE_A(PG8_SA(0, 0), a2, o2, 0);
            PG8_WAIT_V(8); PG8_WAIT_L(0); PG8_BAR; PG8_MMA(1, 0, At, B0); PG8_MMA(1, 1, At, B1); PG8_BAR; PG8_SCHED;
            PG8_LDB(B0, 1, 0); PG8_LDB(B1, 1, 1); PG8_SCHED; PG8_LDA(At, 1, 0); PG8_STAGE_A(PG8_SA(0, 1), a2, o2, 1);
            PG8_WAIT_V(8); PG8_WAIT_L(0); PG8_BAR; PG8_MMA(0, 0, At, B0); PG8_MMA(0, 1, At, B1); PG8_BAR; PG8_SCHED;
            PG8_LDA(At, 1, 1); PG8_STAGE(PG8_SB(1, 0), b3, voffB); PG8_STAGE(PG8_SB(1, 1), b3 + hstep, voffB); PG8_STAGE_A(PG8_SA(1, 0), a3, o2, 0);
            PG8_WAIT_V(8); PG8_WAIT_L(0); PG8_BAR; PG8_MMA(1, 0, At, B0); PG8_MMA(1, 1, At, B1); PG8_BAR; PG8_SCHED;
#endif
        }
        if (wr == 0) PG8_BAR;
        E(acc, cur, wr, wc, fr, fq);
        if constexpr (Sched::HOOKS) pend = S.pub_tile(cur);
        if (!has_next) break;
#pragma unroll
        for (int a = 0; a < 2; ++a)
#pragma unroll
            for (int b = 0; b < 2; ++b)
#pragma unroll
                for (int m = 0; m < 4; ++m)
#pragma unroll
                    for (int n = 0; n < 2; ++n) acc[a][b][m][n] = (f32x4){0.f, 0.f, 0.f, 0.f};
        PG8_UCOPY(cur, nxt); ++ui;
        if constexpr (GATHER) {
            const LAS int* tb = (const LAS int*)(lds + LDS_TOKB + (ui & 1) * 1024);
#pragma unroll
            for (int q = 0; q < 2; ++q) { int R, C; stage_rc(tid * 16 + q * 8192, R, C);
#pragma unroll
                for (int h = 0; h < 2; ++h) { const int i = h * HALF + R; const int tk = i < cur.nvalid ? tb[i] : 0; cur.ao[h][q] = (unsigned)(tk * K + C) * 2u; } }
        }
        if (wr == 1) PG8_BAR;
    }
    PG8_WAIT_V(0);
    if constexpr (Sched::HOOKS) { if (pend >= 0) S.publish(pend, lane); }
    PG8_BAR;
#undef PG8_SA
#undef PG8_SB
#undef PG8_STAGE
#undef PG8_STAGE_A
#undef PG8_LDA
#undef PG8_LDB
#undef PG8_MMA
#undef PG8_WAIT_V
#undef PG8_UCOPY
#undef PG8_WAIT_L
#undef PG8_BAR
#undef PG8_SCHED
}

struct DenseSched {
    static constexpr bool GATHER = false, HOOKS = false;
    const char* A; const char* Bt; int K, nM, nN, nwg, G, c;
    __device__ __forceinline__ void init(const void* A_, const void* Bt_, int M, int N, int K_) {
        A = uptr((const char*)A_); Bt = uptr((const char*)Bt_); K = K_; nM = M / BM; nN = N / BM; nwg = nM * nN; G = gridDim.x; c = blockIdx.x;
    }
    __device__ __forceinline__ bool next(int i, Unit& u) const {
        const long L = (long)i * G + c; if (L >= nwg) return false;
        const int wgid = xcd_remap((int)L, nwg);
        const int nig = WGM * nN, gid = wgid / nig, fm = gid * WGM, gsz = (nM - fm) < WGM ? (nM - fm) : WGM;
        const int pm = fm + ((wgid % nig) % gsz), pn = (wgid % nig) / gsz;
        u.A = A + (size_t)pm * BM * K * 2; u.B = Bt + (size_t)pn * BM * K * 2; u.row0 = pm * BM; u.pn = pn; u.e = 0; u.nvalid = BM; u.tb0 = 0;
        return true;
    }
};
template <bool GATHER_>
struct MoeSched {
    static constexpr bool GATHER = GATHER_, HOOKS = false;
    const char* A; const char* W; int K, nN, rows_per_e, nwg, G, c; const int* ps; const int* cn; const int* tok;
    __device__ __forceinline__ void init(const void* A_, const void* W_, int K_, int nN_, int rows_per_e_, const int* ps_, const int* tok_) {
        A = uptr((const char*)A_); W = uptr((const char*)W_); K = K_; nN = nN_; rows_per_e = rows_per_e_; ps = ps_; cn = ps_ + (LDS_CNT - LDS_PS) / 4; tok = (const int*)uptr((const char*)tok_); G = gridDim.x; c = blockIdx.x;
        nwg = __builtin_amdgcn_readfirstlane((ps[NE] >> 8) * nN);
    }
    __device__ __forceinline__ bool next(int i, Unit& u) const {
        const long L = (long)i * G + c; if (L >= nwg) return false;
        const int wgid = xcd_remap((int)L, nwg);
        const int rt = wgid / nN, pn = wgid % nN, slot0 = rt * BM;
        int e = 0;
        for (int q = 1; q < NE; ++q) e = (ps[q] <= slot0) ? q : e;
        e = __builtin_amdgcn_readfirstlane(e);
        u.B = W + ((size_t)e * rows_per_e + (size_t)pn * BM) * K * 2; u.row0 = slot0; u.pn = pn; u.e = e;
        const int pos0 = __builtin_amdgcn_readfirstlane(slot0 - ps[e]);
        u.nvalid = __builtin_amdgcn_readfirstlane(cn[e]) - pos0; u.tb0 = e * T + pos0;
        if constexpr (GATHER) u.A = A; else u.A = A + (size_t)slot0 * K * 2;
        return true;
    }
    __device__ __forceinline__ void first_rows(Unit& u) const {
#pragma unroll
        for (int q = 0; q < 2; ++q) { int R, C; stage_rc(threadIdx.x * 16 + q * 8192, R, C);
#pragma unroll
            for (int h = 0; h < 2; ++h) { const int i = h * HALF + R; const int tk = i < u.nvalid ? tok[u.tb0 + i] : 0; u.ao[h][q] = (unsigned)(tk * K + C) * 2u; } }
    }
    __device__ __forceinline__ void prefetch_rows(const Unit& u, LAS unsigned* dst, int wid, int lane) const {
        __builtin_amdgcn_global_load_lds((const unsigned*)(tok + u.tb0 + wid * 64 + lane), dst, 4, 0, 0);
    }
};
struct MoeSched2 {
    static constexpr bool GATHER = true, HOOKS = true;
    const char* ws; int K, nU, nDl, nwg, G, c, rt0, nexp; const int* ps; const int* cn; const int* tok; const LAS int* imp; GAS int* upcnt;
    __device__ __forceinline__ void init(unsigned char* ws_, const int* ps_, int nloc, int rank, const LAS int* ms) {
        ws = uptr((const char*)ws_); K = D; ps = ps_; cn = ps_ + (LDS_CNT - LDS_PS) / 4; tok = (const int*)(ws + WS_TOK); upcnt = (GAS int*)(ws + WS_CTL) + CW_UPCNT;
        G = __builtin_amdgcn_readfirstlane(nloc); c = __builtin_amdgcn_readfirstlane(rank);
        rt0 = __builtin_amdgcn_readfirstlane(ms[0]); const int nt_ = __builtin_amdgcn_readfirstlane(ms[1]); nexp = __builtin_amdgcn_readfirstlane(ms[2]); const int nimp = __builtin_amdgcn_readfirstlane(ms[3]); imp = ms + 8;
        nU = nt_ * 8; nDl = (nt_ - nexp) * 4; nwg = nU + nDl + nimp * 4;
    }
    __device__ __forceinline__ bool next(int i, Unit& u) const {
        const int L = i * G + c; if (L >= nwg) return false;
        const bool dn = L >= nU;
        int rt, pn, sh = 0;
        if (!dn) { rt = rt0 + (L >> 3); pn = L & 7; sh = (L >> 3) < nexp ? 64 : 0; }
        else if (L >= nwg - nDl) { const int d = L - (nwg - nDl); rt = rt0 + nexp + (d >> 2); pn = d & 3; }
        else { const int d = L - nU; rt = __builtin_amdgcn_readfirstlane(imp[d >> 2]); pn = d & 3; sh = 64; }
        const int slot0 = rt * BM;
        int e = 0;
        for (int q = 1; q < NE; ++q) e = (ps[q] <= slot0) ? q : e;
        e = __builtin_amdgcn_readfirstlane(e);
        u.row0 = slot0; u.pn = pn;
        const int pos0 = __builtin_amdgcn_readfirstlane(slot0 - ps[e]);
        if (dn) { u.B = ws + WS_WDT + ((size_t)e * 1024 + (size_t)pn * BM) * (size_t)(D * 2); u.A = ws + WS_ACT; u.e = e | 32 | sh; u.nvalid = BM; u.tb0 = (int)((WS_IDT - WS_TOK) / 4) + slot0; }
        else    { u.B = ws + WS_WGUT + ((size_t)e * 2048 + (size_t)pn * BM) * (size_t)(D * 2); u.A = ws + WS_H; u.e = e | sh; u.nvalid = __builtin_amdgcn_readfirstlane(cn[e]) - pos0; u.tb0 = e * T + pos0; }
        return true;
    }
    __device__ __forceinline__ void first_rows(Unit& u) const {
#pragma unroll
        for (int q = 0; q < 2; ++q) { int R, C; stage_rc(threadIdx.x * 16 + q * 8192, R, C);
#pragma unroll
            for (int h = 0; h < 2; ++h) { const int i = h * HALF + R; const int tk = i < u.nvalid ? tok[u.tb0 + i] : 0; u.ao[h][q] = (unsigned)(tk * K + C) * 2u; } }
    }
    __device__ __forceinline__ void prefetch_rows(const Unit& u, LAS unsigned* dst, int wid, int lane) const {
        __builtin_amdgcn_global_load_lds((const unsigned*)(tok + u.tb0 + wid * 64 + lane), dst, 4, 0, 0);
    }
    __device__ __forceinline__ void poll(const Unit& u, LAS unsigned* w, int lane) const {
        if ((u.e & 32) && lane == 0) __builtin_amdgcn_global_load_lds((const GAS unsigned*)(upcnt + (u.row0 >> 8)), w, 4, 0, 16  );
    }
    __device__ __forceinline__ void a_ready(const Unit& u, const LAS unsigned* w) const {
        if (u.e & 32) {
            const int rdy = __builtin_amdgcn_readfirstlane((int)*w);
            if (rdy < 64) { const GAS int* cp = upcnt + (u.row0 >> 8); int spins = 0;
                while (__hip_atomic_load(cp, __ATOMIC_RELAXED, __HIP_MEMORY_SCOPE_AGENT) < 64 && ++spins < (1 << 22)) __builtin_amdgcn_s_sleep(4); }
            if (u.e & 64) asm volatile("buffer_inv sc1" ::: "memory");
            else asm volatile("" ::: "memory");
        }
    }
    __device__ __forceinline__ int pub_tile(const Unit& u) const { return (u.e & 32) ? -1 : (u.row0 >> 8); }
    __device__ __forceinline__ void publish(int rt, int lane) const { if (lane == 0) __hip_atomic_fetch_add(upcnt + rt, 1, __ATOMIC_RELAXED, __HIP_MEMORY_SCOPE_AGENT); }
};
}

__device__ __forceinline__ int win_row(int oc) {
    if (oc >= 1024) return oc;
    const int base = oc & ~511, o = oc & 511;
    return base + 32 * ((o >> 6) * 2 + ((o & 31) >> 4)) + 8 * ((o & 15) >> 2) + 4 * ((o >> 5) & 1) + (o & 3);
}
__device__ __forceinline__ int wgu_row(int oc) { const int jj = oc >> 1, il = oc & 1; return 32 * (jj >> 4) + 8 * ((jj & 15) >> 2) + 4 * il + (jj & 3); }

struct CvtItem { const float* W; bf16_t* WT; int ldw, nvalid, K, k0, n0, map; };
__device__ __forceinline__ void cvt_load(const CvtItem& it, int lane, float4 (&v)[8]) {
    const int col = it.n0 + (lane & 7) * 4;
    const float* src = it.W + (size_t)(it.k0 + (lane >> 3)) * it.ldw + col;
#pragma unroll
    for (int i = 0; i < 8; ++i) { const f32x4 t = (col < it.nvalid) ? __builtin_nontemporal_load((const f32x4*)(src + (size_t)(8 * i) * it.ldw)) : (f32x4){0.f, 0.f, 0.f, 0.f};
        v[i] = make_float4(t[0], t[1], t[2], t[3]); }
}
__device__ __forceinline__ void cvt_store(const CvtItem& it, int lane, const float4 (&v)[8], float* scr) {
    const int r8 = lane >> 3, c4 = (lane & 7) * 4;
#pragma unroll
    for (int i = 0; i < 8; ++i) { float* d = scr + (8 * i + r8) * 33 + c4; d[0] = v[i].x; d[1] = v[i].y; d[2] = v[i].z; d[3] = v[i].w; }
    asm volatile("s_waitcnt lgkmcnt(0)" ::: "memory");
    const int c = lane & 7;
#pragma unroll
    for (int j = 0; j < 4; ++j) { const int n = (lane >> 3) + 8 * j; const float* s = scr + (8 * c) * 33 + n;
        uint4 o; o.x = pk2(s[0 * 33], s[1 * 33]); o.y = pk2(s[2 * 33], s[3 * 33]); o.z = pk2(s[4 * 33], s[5 * 33]); o.w = pk2(s[6 * 33], s[7 * 33]);
        const int oc = it.n0 + n;
        const int orow = it.map == 1 ? win_row(oc) : (it.map == 2 ? wgu_row(oc) : oc);
        ntstore4u((uint4*)(it.WT + (size_t)orow * it.K + it.k0 + 8 * c), o); }
    asm volatile("s_waitcnt lgkmcnt(0)" ::: "memory");
}
__device__ void phase_prep(const Params& p, unsigned char* lds) {
    const int tid = threadIdx.x, lane = tid & 63, wave = tid >> 6;
    unsigned char* ws = p.ws;
    for (int i = blockIdx.x * NTHREADS + tid; i < PMAX; i += gridDim.x * NTHREADS) ((int*)(ws + WS_IDT))[i] = i;
    if ((int)blockIdx.x < 192) {
        float* sl = (float*)lds;
        float* red = sl + 2048;
        for (int i = tid; i < 2048; i += NTHREADS) sl[i] = fsilu(p.c[i]);
        __syncthreads();
        for (int it = blockIdx.x; it < 192; it += gridDim.x) {
            const int col = it * 32 + (tid & 31), kg = tid >> 5;
            float a0 = 0.f, a1 = 0.f;
#pragma unroll 8
            for (int kk = 0; kk < 64; ++kk) { const int k = kg * 64 + kk; const float w = __builtin_nontemporal_load(p.w_mod + (size_t)k * 6144 + col); a0 += sl[k] * w; a1 += sl[1024 + k] * w; }
            red[(kg * 32 + (tid & 31)) * 2 + 0] = a0; red[(kg * 32 + (tid & 31)) * 2 + 1] = a1;
            __syncthreads();
            if (tid < 64) { const int b = tid >> 5, cg_ = tid & 31; float s = 0.f;
#pragma unroll
                for (int g = 0; g < 16; ++g) s += red[(g * 32 + cg_) * 2 + b];
                const int cc = it * 32 + cg_;
                __hip_atomic_store((float*)(ws + WS_MOD) + b * 6144 + cc, s + p.b_mod[cc], __ATOMIC_RELAXED, __HIP_MEMORY_SCOPE_AGENT);
                asm volatile("s_waitcnt vmcnt(0)" ::: "memory"); }
            __syncthreads();
            if (tid == 0) __hip_atomic_fetch_add((unsigned*)(ws + WS_CTL) + CW_MODCNT, 1u, __ATOMIC_RELAXED, __HIP_MEMORY_SCOPE_AGENT);
        }
    }
    __syncthreads();
    {
        float2* rope = (float2*)(ws + WS_ROPE);
        for (int i = blockIdx.x * NTHREADS + tid; i < S * 32; i += gridDim.x * NTHREADS) {
            const int pos = i >> 5, d = i & 31;
            const float angf = (float)pos * p.inv_freq[d];
            const double ang = (double)angf;
            const double TWO_PI = 6.283185307179586476925286766559, HALF_PI = 1.5707963267948966192313216916398;
            const double n = __builtin_rint(ang / TWO_PI);
            const double rr = ang - n * TWO_PI;
            const double q = __builtin_rint(rr / HALF_PI);
            const double y = rr - q * HALF_PI;
            const double y2 = y * y;
            const double sy = y * (1.0 + y2 * (-1.0 / 6 + y2 * (1.0 / 120 + y2 * (-1.0 / 5040 + y2 * (1.0 / 362880 + y2 * (-1.0 / 39916800 + y2 * (1.0 / 6227020800.0)))))));
            const double cy = 1.0 + y2 * (-0.5 + y2 * (1.0 / 24 + y2 * (-1.0 / 720 + y2 * (1.0 / 40320 + y2 * (-1.0 / 3628800 + y2 * (1.0 / 479001600.0))))));
            const int qi = ((int)q) & 3;
            double cs, sn;
            if (qi == 0) { cs = cy; sn = sy; } else if (qi == 1) { cs = -sy; sn = cy; } else if (qi == 2) { cs = -cy; sn = -sy; } else { cs = sy; sn = -cy; }
            rope[i] = make_float2((float)cs, (float)sn);
        }
    }
    {
        float* scr = (float*)(lds + wave * 8448);
        const int gw = blockIdx.x * NW + wave, ngw = gridDim.x * NW;
        constexpr int I_IN = 16 * 97, I_OUT = 16 * 32, I_GU = 16 * 64, I_DN = 16 * 32;
        constexpr int NITEMS = I_IN + I_OUT + NE * I_GU + NE * I_DN;
        auto decode = [&](int r, CvtItem& it) {
            if (r < I_IN) { it.W = p.w_in; it.WT = (bf16_t*)(ws + WS_WINT); it.ldw = DIN; it.nvalid = DIN; it.K = D; it.k0 = (r / 97) * 64; it.n0 = (r % 97) * 32; it.map = 1; return; }
            r -= I_IN;
            if (r < I_OUT) { it.W = p.w_out; it.WT = (bf16_t*)(ws + WS_WOUTT); it.ldw = D; it.nvalid = D; it.K = D; it.k0 = (r / 32) * 64; it.n0 = (r % 32) * 32; it.map = 0; return; }
            r -= I_OUT;
            if (r < NE * I_GU) { const int e = r / I_GU, q = r % I_GU;
                it.W = p.w_gate_up + (size_t)e * D * 2048; it.WT = (bf16_t*)(ws + WS_WGUT) + (size_t)e * 2048 * D; it.ldw = 2048; it.nvalid = 2048; it.K = D; it.k0 = (q / 64) * 64; it.n0 = (q % 64) * 32; it.map = 2; return; }
            r -= NE * I_GU;
            { const int e = r / I_DN, q = r % I_DN;
                it.W = p.w_down + (size_t)e * DFF * D; it.WT = (bf16_t*)(ws + WS_WDT) + (size_t)e * D * DFF; it.ldw = D; it.nvalid = D; it.K = DFF; it.k0 = (q / 32) * 64; it.n0 = (q % 32) * 32; it.map = 0; }
        };
        if (gw < NITEMS) {
            CvtItem cur, nxt; float4 vc[8], vn[8];
            decode(gw, cur); cvt_load(cur, lane, vc);
            for (int r = gw; r < NITEMS; r += ngw) {
                const bool more = r + ngw < NITEMS;
                if (more) { decode(r + ngw, nxt); cvt_load(nxt, lane, vn); }
                cvt_store(cur, lane, vc, scr);
                if (more) { cur = nxt;
#pragma unroll
                    for (int i = 0; i < 8; ++i) vc[i] = vn[i]; }
            }
        }
    }
}

__device__ void phase_prenorm(const Params& p) {
    const int tid = threadIdx.x, lane = tid & 63, wave = tid >> 6;
    if (tid == 0) {
        unsigned* cnt = (unsigned*)(p.ws + WS_CTL) + CW_MODCNT; unsigned sp = 0;
        while (__hip_atomic_load(cnt, __ATOMIC_RELAXED, __HIP_MEMORY_SCOPE_AGENT) < 192u) { __builtin_amdgcn_s_sleep(2); if (++sp > (1u << 20)) break; }
        __builtin_amdgcn_fence(__ATOMIC_ACQUIRE, "agent");
        asm volatile("s_waitcnt vmcnt(0)" ::: "memory");
    }
    __syncthreads();
    const float* mod = (const float*)(p.ws + WS_MOD);
    bf16_t* H = (bf16_t*)(p.ws + WS_H);
    for (int m0 = (blockIdx.x * NW + wave) * 2; m0 < T; m0 += gridDim.x * NW * 2) {
        float4 v[2][4];
#pragma unroll
        for (int q = 0; q < 2; ++q) { const float4* xr = (const float4*)(p.x + (size_t)(m0 + q) * D) + lane;
#pragma unroll
            for (int j = 0; j < 4; ++j) v[q][j] = ntload4(xr + 64 * j); }
#pragma unroll
        for (int q = 0; q < 2; ++q) {
            const int m = m0 + q, b = m >> 13;
            float ss = 0.f;
#pragma unroll
            for (int j = 0; j < 4; ++j) ss += v[q][j].x * v[q][j].x + v[q][j].y * v[q][j].y + v[q][j].z * v[q][j].z + v[q][j].w * v[q][j].w;
            const float rstd = rsqrtf(wave_sum(ss) * (1.f / D) + EPS);
#pragma unroll
            for (int j = 0; j < 4; ++j) { const int c = 4 * lane + 256 * j;
                const float4 g = *(const float4*)(p.g_pre_mix + c), sh = *(const float4*)(mod + b * 6144 + c), sc = *(const float4*)(mod + b * 6144 + 1024 + c);
                const float h0 = v[q][j].x * rstd * g.x * (1.f + sc.x) + sh.x, h1 = v[q][j].y * rstd * g.y * (1.f + sc.y) + sh.y;
                const float h2 = v[q][j].z * rstd * g.z * (1.f + sc.z) + sh.z, h3 = v[q][j].w * rstd * g.w * (1.f + sc.w) + sh.w;
                uint2 o; o.x = pk2(h0, h1); o.y = pk2(h2, h3);
                *(uint2*)(H + (size_t)m * D + c) = o; }
        }
    }
}

struct EpiIn {
    static constexpr bool PERM = true;
    unsigned char* ws;
    __device__ __forceinline__ void operator()(const f32x4 (&acc)[2][2][4][2], const pg8::Unit& u, int wr, int wc, int fr, int fq) const {
        const int cbase = u.pn * 256;
        if (cbase < 1024) {
            const bool isq = cbase < 512;
            bf16_t* dst = (bf16_t*)(ws + (isq ? WS_QA : WS_KA));
            const float2* rope = (const float2*)(ws + WS_ROPE);
            const float scl = isq ? 0.125f * LOG2E : 1.f;
#pragma unroll
            for (int bj = 0; bj < 2; ++bj) {
                const int grp = ((cbase & 511) >> 5) + 4 * bj + wc, head = grp >> 1, dl = (grp & 1) * 16 + 4 * fq;
#pragma unroll
                for (int ai = 0; ai < 2; ++ai)
#pragma unroll
                    for (int m = 0; m < 4; ++m) { const int row = u.row0 + 128 * ai + 64 * wr + 16 * m + fr, pos = row & (S - 1);
                        const float4 c01 = *(const float4*)(rope + pos * 32 + dl), c23 = *(const float4*)(rope + pos * 32 + dl + 2);
                        const f32x4 x1 = acc[ai][bj][m][0], x2 = acc[ai][bj][m][1];
                        uint2 lo, hi;
                        lo.x = pk2((x1[0] * c01.x - x2[0] * c01.y) * scl, (x1[1] * c01.z - x2[1] * c01.w) * scl);
                        lo.y = pk2((x1[2] * c23.x - x2[2] * c23.y) * scl, (x1[3] * c23.z - x2[3] * c23.w) * scl);
                        hi.x = pk2((x2[0] * c01.x + x1[0] * c01.y) * scl, (x2[1] * c01.z + x1[1] * c01.w) * scl);
                        hi.y = pk2((x2[2] * c23.x + x1[2] * c23.y) * scl, (x2[3] * c23.z + x1[3] * c23.w) * scl);
                        const int bh = (row >> 13) * 8 + head;
                        bf16_t* o = dst + ((size_t)(bh * S + (pos & 15) * 512 + (pos >> 4)) * 64 + dl); *(uint2*)o = lo; *(uint2*)(o + 32) = hi; }
            }
        } else {
            bf16_t* dst; int ldc, cb;
            if (cbase < 1536) { dst = (bf16_t*)(ws + WS_VA); ldc = 512; cb = cbase - 1024; }
            else if (cbase < 1792) { dst = (bf16_t*)(ws + WS_QG); ldc = 256; cb = cbase - 1536; }
            else if (cbase < 2048) { dst = (bf16_t*)(ws + WS_KG); ldc = 256; cb = cbase - 1792; }
            else if (cbase < 2560) { dst = (bf16_t*)(ws + WS_VG); ldc = 512; cb = cbase - 2048; }
            else { dst = (bf16_t*)(ws + WS_RG); ldc = 512; cb = cbase - 2560; }
#pragma unroll
            for (int ai = 0; ai < 2; ++ai)
#pragma unroll
                for (int m = 0; m < 4; ++m) { const int row = u.row0 + 128 * ai + 64 * wr + 16 * m + fr;
#pragma unroll
                    for (int bj = 0; bj < 2; ++bj) { const f32x4 v0 = acc[ai][bj][m][0], v1 = acc[ai][bj][m][1];
                        u32x4 w; w.x = pk2(v0[0], v0[1]); w.y = pk2(v0[2], v0[3]); w.z = pk2(v1[0], v1[1]); w.w = pk2(v1[2], v1[3]);
                        *(u32x4*)(dst + (size_t)row * ldc + cb + 128 * bj + 32 * wc + 8 * fq) = w; } }
        }
    }
};

__device__ void phase_gemm_in(const Params& p, unsigned char* lds) {
    unsigned char* ws = p.ws;
    {
        pg8::DenseSched Sd; Sd.init(ws + WS_H, ws + WS_WINT, T, 3072, D);
        EpiIn E{ws};
        pg8::gemm_phase<EpiIn, pg8::DenseSched>((LAS unsigned char*)lds, D, Sd, E);
    }
    const int tid = threadIdx.x, lane = tid & 63, wave = tid >> 6, fr = lane & 15, fq = lane >> 4;
    const bf16_t* H = (const bf16_t*)(ws + WS_H); const bf16_t* Wl = (const bf16_t*)(ws + WS_WINT) + (size_t)3072 * D;
    float* glr = (float*)(ws + WS_GLR);
    float* part = (float*)lds;
    for (int item = blockIdx.x; item < T / 64; item += gridDim.x) {
        const int mt = wave & 3, kh = wave >> 2, r0 = item * 64 + mt * 16;
        f32x4 a = (f32x4){0.f, 0.f, 0.f, 0.f};
        const bf16_t* ap = H + (size_t)(r0 + fr) * D + kh * 512 + fq * 8;
        const bf16_t* bp = Wl + (size_t)fr * D + kh * 512 + fq * 8;
#pragma unroll 4
        for (int ks = 0; ks < 16; ++ks) a = __builtin_amdgcn_mfma_f32_16x16x32_bf16(*(const bf16x8*)(ap + ks * 32), *(const bf16x8*)(bp + ks * 32), a, 0, 0, 0);
        __syncthreads();
        if (kh == 1) {
#pragma unroll
            for (int j = 0; j < 4; ++j) part[(mt * 16 + 4 * fq + j) * 16 + fr] = a[j];
        }
        __syncthreads();
        if (kh == 0) {
#pragma unroll
            for (int j = 0; j < 4; ++j) glr[(size_t)(r0 + 4 * fq + j) * 16 + fr] = a[j] + part[(mt * 16 + 4 * fq + j) * 16 + fr];
        }
    }
    __syncthreads();
}

__device__ void vtrans_items(const Params& p, unsigned char* lds) {
    const int tid = threadIdx.x;
    unsigned char* ws = p.ws;
    const bf16_t* VA = (const bf16_t*)(ws + WS_VA);
    bf16_t* vb = (bf16_t*)(ws + WS_VB);
    constexpr int VS = 72;
    bf16_t* tile = (bf16_t*)lds;
    for (int item = blockIdx.x; item < 512; item += gridDim.x) {
        const int bh = item >> 5, blk = item & 31, b = bh >> 3, h = bh & 7, pos0 = blk * 256;
        { const int tok = tid >> 1, hf = tid & 1;
          const uint4* src = (const uint4*)(VA + (size_t)(b * S + pos0 + tok) * 512 + h * 64 + hf * 32);
          uint4 v0 = src[0], v1 = src[1], v2 = src[2], v3 = src[3];
          uint4* d = (uint4*)(tile + tok * VS + hf * 32);
          d[0] = v0; d[1] = v1; d[2] = v2; d[3] = v3; }
        __syncthreads();
        const int dv = tid >> 3, l8 = tid & 7;
#pragma unroll
        for (int cc = 0; cc < 2; ++cc) { const int cls = 2 * l8 + cc;
#pragma unroll
            for (int hh = 0; hh < 2; ++hh) { unsigned w[4];
#pragma unroll
                for (int i = 0; i < 4; ++i) w[i] = (unsigned)tile[(16 * (hh * 8 + 2 * i) + cls) * VS + dv] | ((unsigned)tile[(16 * (hh * 8 + 2 * i + 1) + cls) * VS + dv] << 16);
                const int blkidx = (bh * S + cls * 512 + 16 * blk + hh * 8) >> 3;
                *(uint4*)(vb + ((size_t)blkidx * 64 + dv) * 8) = make_uint4(w[0], w[1], w[2], w[3]); } }
        __syncthreads();
    }
}

struct AttnFrag { bf16x8 ka[4], vf[4]; };
__device__ __forceinline__ void attn_load(AttnFrag& f, const bf16_t* kp, const bf16_t* vp) {
    f.ka[0] = *(const bf16x8*)kp; f.ka[1] = *(const bf16x8*)(kp + 32); f.ka[2] = *(const bf16x8*)(kp + 256); f.ka[3] = *(const bf16x8*)(kp + 288);
#pragma unroll
    for (int n = 0; n < 4; ++n) f.vf[n] = *(const bf16x8*)(vp + n * 128);
}
struct AttnState { float m, l; f32x4 o[4]; bf16x8 q0, q1; };
__device__ __forceinline__ float max2a(float a, float b) { float r; asm("v_max_f32_e32 %0, %1, %2" : "=v"(r) : "v"(a), "v"(b)); return r; }
__device__ __forceinline__ float max3a(float a, float b, float c) { float r; asm("v_max3_f32 %0, %1, %2, %3" : "=v"(r) : "v"(a), "v"(b), "v"(c)); return r; }
__device__ __forceinline__ float rowmax4(float x) {
    const unsigned u = __builtin_bit_cast(unsigned, x);
    const auto a = __builtin_amdgcn_permlane16_swap(u, u, false, false);
    const float y = fmaxf(__builtin_bit_cast(float, a[0]), __builtin_bit_cast(float, a[1]));
    const unsigned v = __builtin_bit_cast(unsigned, y);
    const auto b = __builtin_amdgcn_permlane32_swap(v, v, false, false);
    return fmaxf(__builtin_bit_cast(float, b[0]), __builtin_bit_cast(float, b[1]));
}
template <bool FIRST>
__device__ __forceinline__ float attn_scores(const AttnFrag& f, const AttnState& t, const int d0, const int js, float (&sv)[8]) {
    const float nm = FIRST ? 0.f : -t.m;
    f32x4 st0 = (f32x4){nm, nm, nm, nm}, st1 = (f32x4){nm, nm, nm, nm};
    st0 = __builtin_amdgcn_mfma_f32_16x16x32_bf16(f.ka[0], t.q0, st0, 0, 0, 0);
    st0 = __builtin_amdgcn_mfma_f32_16x16x32_bf16(f.ka[1], t.q1, st0, 0, 0, 0);
    st1 = __builtin_amdgcn_mfma_f32_16x16x32_bf16(f.ka[2], t.q0, st1, 0, 0, 0);
    st1 = __builtin_amdgcn_mfma_f32_16x16x32_bf16(f.ka[3], t.q1, st1, 0, 0, 0);
#pragma unroll
    for (int j = 0; j < 8; ++j) { const bool vd = (unsigned)(d0 - (j << js)) <= 128u; const float x = (j < 4) ? st0[j] : st1[j - 4]; sv[j] = vd ? x : -3.0e38f; }
    float mx = max3a(max3a(sv[0], sv[1], sv[2]), max3a(sv[3], sv[4], sv[5]), max2a(sv[6], sv[7]));
    return rowmax4(mx);
}
__device__ __forceinline__ void attn_grow(AttnState& t, float (&sv)[8], const float mx) {
    const float gr = fmaxf(mx, 0.f), alpha = fexp2(-gr);
    t.m += gr;
#pragma unroll
    for (int j = 0; j < 8; ++j) sv[j] -= gr;
    t.l = t.l * alpha;
#pragma unroll
    for (int n = 0; n < 4; ++n) t.o[n] = t.o[n] * alpha;
}
__device__ __forceinline__ void attn_pv(const AttnFrag& f, AttnState& t, const float (&sv)[8]) {
    float pj[8];
#pragma unroll
    for (int j = 0; j < 8; ++j) pj[j] = fexp2(sv[j]);
    t.l += ((pj[0] + pj[1]) + (pj[2] + pj[3])) + ((pj[4] + pj[5]) + (pj[6] + pj[7]));
    u32x4 pw; pw.x = pk2(pj[0], pj[1]); pw.y = pk2(pj[2], pj[3]); pw.z = pk2(pj[4], pj[5]); pw.w = pk2(pj[6], pj[7]);
    const bf16x8 pf = __builtin_bit_cast(bf16x8, pw);
#pragma unroll
    for (int n = 0; n < 4; ++n) t.o[n] = __builtin_amdgcn_mfma_f32_16x16x32_bf16(f.vf[n], pf, t.o[n], 0, 0, 0);
}
template <bool FIRST>
__device__ __forceinline__ void attn_math2(const AttnFrag& fa, const AttnFrag& fb, AttnState& ta, AttnState& tb, const int d0a, const int d0b, const int js) {
    float sa[8], sb[8];
    const float mxa = attn_scores<FIRST>(fa, ta, d0a, js, sa), mxb = attn_scores<FIRST>(fb, tb, d0b, js, sb);
    if (FIRST) {
        ta.m = mxa; tb.m = mxb;
#pragma unroll
        for (int j = 0; j < 8; ++j) { sa[j] -= mxa; sb[j] -= mxb; }
    } else if (__any(fmaxf(mxa, mxb) > 8.f)) {
        attn_grow(ta, sa, mxa); attn_grow(tb, sb, mxb);
    }
    attn_pv(fa, ta, sa); attn_pv(fb, tb, sb);
}
__device__ void phase_attn(const Params& p, unsigned char* lds) {
    const int tid = threadIdx.x, lane = tid & 63, wave = tid >> 6, qi = lane & 15, g = lane >> 4, gp = qi >> 2, jj = qi & 3;
    unsigned char* ws = p.ws;
    const bf16_t* QA = (const bf16_t*)(ws + WS_QA);
    bf16_t* CAT = (bf16_t*)(ws + WS_CAT);
    const bf16_t* K = (const bf16_t*)(ws + WS_KA); const bf16_t* V = (const bf16_t*)(ws + WS_VB);
    constexpr int LV = 49152;
    constexpr int CLS8 = 8 * 512 * 64;
    const int nwg = gridDim.x, xg = blockIdx.x & 7, xl = blockIdx.x >> 3;
    const bool xord = (nwg & 7) == 0;
    const int k0 = xord ? xl : (int)blockIdx.x, kst = xord ? (nwg >> 3) : nwg, kend = xord ? 64 : 512;
    for (int k = k0; k < kend; k += kst) {
        const int idd = xord ? ((xg + 8 * (k >> 5)) << 5) + (k & 31) : k;
        const int bh = idd >> 5, blk = idd & 31, r = wave, b = bh >> 3, h = bh & 7;
        const int tq = 256 * blk + r + 16 * qi, rho4 = r & 3;
        __syncthreads();
        uint4 pre[12];
#pragma unroll
        for (int i = 0; i < 6; ++i) { const int pid = tid + 512 * i, row = pid >> 3, cls = row / 24, il = row - cls * 24;
            pre[i] = *(const uint4*)(K + ((bh * S + cls * 512 + 16 * blk - 8 + il) * 64 + (pid & 7) * 8)); }
#pragma unroll
        for (int i = 0; i < 6; ++i) { const int vp = tid + 512 * i, b3 = vp >> 6, cls = b3 / 3, bl = b3 - cls * 3;
            pre[6 + i] = *(const uint4*)(V + ((((bh * S + cls * 512 + 16 * blk - 8) >> 3) + bl) * 512 + (vp & 63) * 8)); }
        const int ks16 = ((16 * blk) & ~31) - 128;
        const int c16 = ks16 < 0 ? ((-ks16) >> 5) : 0;
        const int kb16 = (bh * S + r * 512 + ks16 + 8 * gp + jj) * 64 + 8 * g, vb16 = (((bh * S + r * 512 + ks16) >> 3) + g) * 512 + qi * 8;
        const int dq16 = 16 * blk + qi - (ks16 + 8 * g);
        const int c4 = blk == 0 ? 4 : (blk == 1 ? 2 : 0);
        const int kb4 = (bh * S + (rho4 + 4 * gp) * 512 + 16 * blk - 32 + jj) * 64 + 8 * g, vb4 = ((bh * S + (rho4 + 4 * g) * 512 + 16 * blk - 32) >> 3) * 512 + qi * 8;
        const int dq4 = 4 * qi + 128 + (r >> 2) - g;
        AttnFrag fxa, fxb, fya;
        attn_load(fxa, K + (kb16 + 4 * 2048), V + (vb16 + 4 * 2048)); attn_load(fxb, K + (kb16 + 4 * 2048 + CLS8), V + (vb16 + 4 * 2048 + CLS8));
        attn_load(fya, K + kb4, V + vb4);
        AttnState ta, tb;
        { const bf16_t* qrow = QA + ((size_t)(bh * S + r * 512 + 16 * blk + qi) * 64 + 8 * g);
          ta.q0 = *(const bf16x8*)qrow; ta.q1 = *(const bf16x8*)(qrow + 32); tb.q0 = *(const bf16x8*)(qrow + CLS8); tb.q1 = *(const bf16x8*)(qrow + CLS8 + 32); }
        ta.m = 0.f; tb.m = 0.f; ta.l = 0.f; tb.l = 0.f;
#pragma unroll
        for (int n = 0; n < 4; ++n) { ta.o[n] = (f32x4){0.f, 0.f, 0.f, 0.f}; tb.o[n] = ta.o[n]; }
        attn_math2<true>(fxa, fxb, ta, tb, dq16 - 128, dq16 - 128, 0);
        {
            const int m0 = c4 <= 0 ? 0 : (1 << 20), m1 = c4 <= 1 ? 0 : (1 << 20), m2 = c4 <= 2 ? 0 : (1 << 20);
            attn_load(fxa, K + (kb4 + 1 * 512), V + (vb4 + 1 * 512));
            attn_math2<false>(fya, fya, ta, tb, dq4 - m0, dq4 + 2 - m0, 2);
            attn_load(fya, K + (kb4 + 2 * 512), V + (vb4 + 2 * 512));
            attn_math2<false>(fxa, fxa, ta, tb, dq4 - 32 - m1, dq4 + 2 - 32 - m1, 2);
            attn_math2<false>(fya, fya, ta, tb, dq4 - 64 - m2, dq4 + 2 - 64 - m2, 2);
        }
#pragma unroll
        for (int i = 0; i < 12; ++i) *(uint4*)(lds + (tid + 512 * i) * 16) = pre[i];
        __syncthreads();
        {
            const int d1 = 16 * qi + 128 + r - g;
            const unsigned char* kl = lds + (gp * 24 + jj) * 128 + g * 16;
            const unsigned char* vl = lds + LV + g * 3072 + qi * 16;
            int c1 = (blk == 0 ? 4 : 0);
            const unsigned char* kl4 = lds + ((rho4 + 4 * gp) * 24 + jj) * 128 + g * 16;
            const unsigned char* vl4 = lds + LV + (rho4 + 4 * g) * 3072 + qi * 16;
            const int c4l = c4 > 3 ? c4 : 3;
#define ATTN_D1_CHUNK() do { const int w = c1 >> 2, q = c1 & 3; const unsigned char* kq = kl + q * 12288 + w * 1024; const unsigned char* vq = vl + q * 12288 + w * 1024; \
                fya.ka[0] = *(const bf16x8*)kq; fya.ka[1] = *(const bf16x8*)(kq + 64); fya.ka[2] = *(const bf16x8*)(kq + 512); fya.ka[3] = *(const bf16x8*)(kq + 576); \
                _Pragma("unroll") for (int n = 0; n < 4; ++n) fya.vf[n] = *(const bf16x8*)(vq + n * 256); \
                attn_math2<false>(fya, fya, ta, tb, d1 - 128 * w - 4 * q, d1 + 8 - 128 * w - 4 * q, 4); ++c1; } while (0)
#define ATTN_D4_CHUNK(w4) do { const unsigned char* kq = kl4 + ((w4) - 3) * 1024; const unsigned char* vq = vl4 + ((w4) - 3) * 1024; \
                fya.ka[0] = *(const bf16x8*)kq; fya.ka[1] = *(const bf16x8*)(kq + 64); fya.ka[2] = *(const bf16x8*)(kq + 512); fya.ka[3] = *(const bf16x8*)(kq + 576); \
                _Pragma("unroll") for (int n = 0; n < 4; ++n) fya.vf[n] = *(const bf16x8*)(vq + n * 256); \
                attn_math2<false>(fya, fya, ta, tb, dq4 - 32 * (w4), dq4 + 2 - 32 * (w4), 2); } while (0)
            for (int cc = c16; cc < 4; ++cc) {
                attn_load(fxa, K + (kb16 + cc * 2048), V + (vb16 + cc * 2048)); attn_load(fxb, K + (kb16 + cc * 2048 + CLS8), V + (vb16 + cc * 2048 + CLS8));
                for (int q3 = 0; q3 < 3 && c1 < 12; ++q3) ATTN_D1_CHUNK();
                if (3 + (cc - c16) >= c4l && 3 + (cc - c16) < 6) ATTN_D4_CHUNK(3 + (cc - c16));
                attn_math2<false>(fxa, fxb, ta, tb, dq16 - 32 * cc, dq16 - 32 * cc, 0);
            }
            while (c1 < 12) ATTN_D1_CHUNK();
            for (int w4 = (4 - c16 < 3 ? 3 + (4 - c16) : 6); w4 < 6; ++w4) { if (w4 >= c4l) ATTN_D4_CHUNK(w4); }
#undef ATTN_D1_CHUNK
#undef ATTN_D4_CHUNK
        }
        {
            float la = ta.l, lb = tb.l;
            la += __shfl_xor(la, 16); la += __shfl_xor(la, 32); lb += __shfl_xor(lb, 16); lb += __shfl_xor(lb, 32);
            const float ia = 1.f / la, ib = 1.f / lb;
            bf16_t* orow = CAT + (size_t)(b * S + tq) * D + h * 64 + 4 * g;
#pragma unroll
            for (int n = 0; n < 4; ++n) { uint2 ov; ov.x = pk2(ta.o[n][0] * ia, ta.o[n][1] * ia); ov.y = pk2(ta.o[n][2] * ia, ta.o[n][3] * ia); *(uint2*)(orow + 16 * n) = ov;
                uint2 ow; ow.x = pk2(tb.o[n][0] * ib, tb.o[n][1] * ib); ow.y = pk2(tb.o[n][2] * ib, tb.o[n][3] * ib); *(uint2*)(orow + 8 * D + 16 * n) = ow; }
        }
    }
}

constexpr int TS = 72;
constexpr int GL_LA = 0, GL_A1 = 16640, GL_A2 = GL_A1 + 64 * TS * 2, GL_VT = GL_A2 + 64 * TS * 2, GL_ATT = GL_VT + 128 * TS * 2;
static_assert(GL_ATT + 64 * TS * 2 <= 65536, "gla lds");

struct GlaIn { uint4 kr0, kr1, qr0, qr1, vr[4]; float4 gl; };
template <int MODE>
__device__ __forceinline__ void gla_fetch(const Params& p, int item, int tid, GlaIn& in) {
    unsigned char* ws = p.ws;
    const int bh4 = item >> 7, n = item & 127, b = bh4 >> 2, hh = bh4 & 3;
    const int t0 = b * S + n * 64;
    const int c = tid >> 2, d0 = (tid & 3) * 16, e0 = (tid & 3) * 32;
    const bf16_t* kp = (const bf16_t*)(ws + WS_KG) + (size_t)(t0 + c) * 256 + hh * 64 + d0;
    in.kr0 = *(const uint4*)kp; in.kr1 = *(const uint4*)(kp + 8);
    const bf16_t* qp = (const bf16_t*)(ws + WS_QG) + (size_t)(t0 + c) * 256 + hh * 64 + d0;
    in.qr0 = make_uint4(0, 0, 0, 0); in.qr1 = make_uint4(0, 0, 0, 0);
    if (MODE == 1) { in.qr0 = *(const uint4*)qp; in.qr1 = *(const uint4*)(qp + 8); }
    const bf16_t* vp = (const bf16_t*)(ws + WS_VG) + (size_t)(t0 + c) * 512 + hh * 128 + e0;
#pragma unroll
    for (int q = 0; q < 4; ++q) in.vr[q] = *(const uint4*)(vp + 8 * q);
    in.gl = *(const float4*)((const float*)(ws + WS_GLR) + (size_t)t0 * 16 + tid * 4);
}
template <int MODE>
__device__ __forceinline__ void gla_prep(const Params& p, unsigned char* lds, int item, int tid, const GlaIn& in) {
    const int bh4 = item >> 7, hh = bh4 & 3;
    float* LA = (float*)(lds + GL_LA);
    bf16_t* A1 = (bf16_t*)(lds + GL_A1); bf16_t* A2 = (bf16_t*)(lds + GL_A2); bf16_t* VTl = (bf16_t*)(lds + GL_VT);
    const int c = tid >> 2, d0 = (tid & 3) * 16, e0 = (tid & 3) * 32;
    const uint4 kr0 = in.kr0, kr1 = in.kr1, qr0 = in.qr0, qr1 = in.qr1;
    float* GLRL = (float*)(lds + GL_ATT + 1024);
    *(float4*)(GLRL + tid * 4) = in.gl;
    __syncthreads();
    {
        const int dd = tid & 63, cgp = tid >> 6;
        float w[16];
#pragma unroll
        for (int r = 0; r < 16; ++r) w[r] = p.w_gate_lr[r * 256 + hh * 64 + dd];
        const float bias = p.b_gate[hh * 64 + dd];
        float pre[16]; float run = 0.f;
#pragma unroll
        for (int i = 0; i < 16; ++i) {
            const float4* gp = (const float4*)(GLRL + (cgp * 16 + i) * 16);
            const float4 g0 = gp[0], g1 = gp[1], g2 = gp[2], g3 = gp[3];
            float z = bias;
            z += g0.x * w[0] + g0.y * w[1] + g0.z * w[2] + g0.w * w[3];
            z += g1.x * w[4] + g1.y * w[5] + g1.z * w[6] + g1.w * w[7];
            z += g2.x * w[8] + g2.y * w[9] + g2.z * w[10] + g2.w * w[11];
            z += g3.x * w[12] + g3.y * w[13] + g3.z * w[14] + g3.w * w[15];
            const float ls = fminf(z, 0.f) - flog(1.f + fexp(-fabsf(z)));
            run += ls * (1.f / 16.f); pre[i] = run;
        }
        float* tot = (float*)(lds + GL_ATT);
        tot[cgp * 64 + dd] = run;
        __syncthreads();
        float off = 0.f;
#pragma unroll
        for (int gq = 0; gq < 3; ++gq) off += (gq < cgp) ? tot[gq * 64 + dd] : 0.f;
#pragma unroll
        for (int i = 0; i < 16; ++i) LA[(cgp * 16 + i) * 65 + dd] = pre[i] + off;
    }
    __syncthreads();
    {
        unsigned kw[8] = {kr0.x, kr0.y, kr0.z, kr0.w, kr1.x, kr1.y, kr1.z, kr1.w};
        if (MODE == 0) {
#pragma unroll
            for (int i = 0; i < 16; ++i) { const int dd = d0 + i; const float kv = bf2f((unsigned short)((kw[i >> 1] >> ((i & 1) * 16)) & 0xffff));
                const float f = fexp(LA[63 * 65 + dd] - LA[c * 65 + dd]);
                A1[dd * TS + c] = (bf16_t)f2bf(kv * f); }
        } else {
            unsigned qw[8] = {qr0.x, qr0.y, qr0.z, qr0.w, qr1.x, qr1.y, qr1.z, qr1.w};
            unsigned oq[8], ok[8];
#pragma unroll
            for (int i = 0; i < 8; ++i) {
                const float bb0 = LA[c * 65 + d0 + 2 * i], bb1 = LA[c * 65 + d0 + 2 * i + 1];
                const float q0 = bf2f((unsigned short)(qw[i] & 0xffff)), q1 = bf2f((unsigned short)(qw[i] >> 16));
                const float k0 = bf2f((unsigned short)(kw[i] & 0xffff)), k1 = bf2f((unsigned short)(kw[i] >> 16));
                oq[i] = pk2(q0 * 0.125f * fexp(bb0), q1 * 0.125f * fexp(bb1));
                ok[i] = pk2(k0 * fexp(-bb0), k1 * fexp(-bb1));
            }
            *(uint4*)(A1 + c * TS + d0) = make_uint4(oq[0], oq[1], oq[2], oq[3]); *(uint4*)(A1 + c * TS + d0 + 8) = make_uint4(oq[4], oq[5], oq[6], oq[7]);
            *(uint4*)(A2 + c * TS + d0) = make_uint4(ok[0], ok[1], ok[2], ok[3]); *(uint4*)(A2 + c * TS + d0 + 8) = make_uint4(ok[4], ok[5], ok[6], ok[7]);
        }
#pragma unroll
        for (int q = 0; q < 4; ++q) { const unsigned vw[4] = {in.vr[q].x, in.vr[q].y, in.vr[q].z, in.vr[q].w};
#pragma unroll
            for (int i = 0; i < 4; ++i) { VTl[(e0 + 8 * q + 2 * i) * TS + c] = (bf16_t)(vw[i] & 0xffff); VTl[(e0 + 8 * q + 2 * i + 1) * TS + c] = (bf16_t)(vw[i] >> 16); } }
    }
    __syncthreads();
}

__device__ void gla1_items(const Params& p, unsigned char* lds0) {
    const int half = threadIdx.x >> 8, tid = threadIdx.x & 255, lane = tid & 63, w = tid >> 6, fr = lane & 15, fq = lane >> 4;
    unsigned char* lds = lds0 + half * 65536;
    float* UT = (float*)(p.ws + WS_UT); float* AG = (float*)(p.ws + WS_AG);
    const float* LA = (const float*)(lds + GL_LA);
    const bf16_t* A1 = (const bf16_t*)(lds + GL_A1); const bf16_t* VTl = (const bf16_t*)(lds + GL_VT);
    GlaIn cur, nxt;
    if ((int)blockIdx.x < 512) gla_fetch<0>(p, 2 * blockIdx.x + half, tid, cur);
    for (int it = blockIdx.x; it < 512; it += gridDim.x) {
        const int item = 2 * it + half;
        const bool more = it + (int)gridDim.x < 512;
        if (more) gla_fetch<0>(p, 2 * (it + gridDim.x) + half, tid, nxt);
        gla_prep<0>(p, lds, item, tid, cur);
        f32x4 acc[8];
#pragma unroll
        for (int n = 0; n < 8; ++n) acc[n] = (f32x4){0.f, 0.f, 0.f, 0.f};
#pragma unroll
        for (int ks = 0; ks < 2; ++ks) {
            const bf16x8 af = *(const bf16x8*)(A1 + (16 * w + fr) * TS + ks * 32 + fq * 8);
#pragma unroll
            for (int n = 0; n < 8; ++n) { const bf16x8 bfr = *(const bf16x8*)(VTl + (16 * n + fr) * TS + ks * 32 + fq * 8);
                acc[n] = __builtin_amdgcn_mfma_f32_16x16x32_bf16(af, bfr, acc[n], 0, 0, 0); }
        }
#pragma unroll
        for (int n = 0; n < 8; ++n) *(f32x4*)(UT + ((size_t)item * 128 + 16 * n + fr) * 64 + 16 * w + 4 * fq) = acc[n];
        if (tid < 64) AG[item * 64 + tid] = fexp(LA[63 * 65 + tid]);
        __syncthreads();
        if (more) cur = nxt;
    }
}
__device__ void gla2_scan(const Params& p) {
    const float* UT = (const float*)(p.ws + WS_UT); const float* AG = (const float*)(p.ws + WS_AG);
    bf16_t* SPT = (bf16_t*)(p.ws + WS_SPT);
    for (int rec = blockIdx.x * NTHREADS + threadIdx.x; rec < 65536; rec += gridDim.x * NTHREADS) {
        const int bh4 = rec >> 13, e = (rec >> 6) & 127, dd = rec & 63;
        float st = 0.f;
        for (int n0 = 0; n0 < 128; n0 += 32) {
            float av[32], uv[32];
#pragma unroll
            for (int q = 0; q < 32; ++q) { const int item = bh4 * 128 + n0 + q; av[q] = AG[item * 64 + dd]; uv[q] = UT[((size_t)item * 128 + e) * 64 + dd]; }
#pragma unroll
            for (int q = 0; q < 32; ++q) { const int item = bh4 * 128 + n0 + q; SPT[((size_t)item * 128 + e) * 64 + dd] = (bf16_t)f2bf(st); st = av[q] * st + uv[q]; }
        }
    }
}
__device__ void gla3_items(const Params& p, unsigned char* lds0) {
    const int half = threadIdx.x >> 8, tid = threadIdx.x & 255, lane = tid & 63, w = tid >> 6, fr = lane & 15, fq = lane >> 4;
    unsigned char* lds = lds0 + half * 65536;
    unsigned char* ws = p.ws;
    const bf16_t* SPT = (const bf16_t*)(ws + WS_SPT); const bf16_t* RG = (const bf16_t*)(ws + WS_RG);
    bf16_t* CAT = (bf16_t*)(ws + WS_CAT);
    const bf16_t* A1 = (const bf16_t*)(lds + GL_A1); const bf16_t* A2 = (const bf16_t*)(lds + GL_A2); const bf16_t* VTl = (const bf16_t*)(lds + GL_VT);
    bf16_t* ATT = (bf16_t*)(lds + GL_ATT);
    GlaIn cur, nxt;
    if ((int)blockIdx.x < 512) gla_fetch<1>(p, 2 * blockIdx.x + half, tid, cur);
    for (int it = blockIdx.x; it < 512; it += gridDim.x) {
        const int item = 2 * it + half;
        const bool more = it + (int)gridDim.x < 512;
        const int bh4 = item >> 7, n_ = item & 127, b = bh4 >> 2, hh = bh4 & 3;
        const int t0 = b * S + n_ * 64;
        bf16x8 sf[8][2]; uint2 rw[8];
#pragma unroll
        for (int n = 0; n < 8; ++n) { const bf16_t* sp = SPT + ((size_t)item * 128 + 16 * n + fr) * 64 + fq * 8; sf[n][0] = *(const bf16x8*)sp; sf[n][1] = *(const bf16x8*)(sp + 32);
            rw[n] = *(const uint2*)(RG + (size_t)(t0 + 16 * w + fr) * 512 + hh * 128 + 16 * n + 4 * fq); }
        if (more) gla_fetch<1>(p, 2 * (it + gridDim.x) + half, tid, nxt);
        gla_prep<1>(p, lds, item, tid, cur);
        const bf16x8 aq0 = *(const bf16x8*)(A1 + (16 * w + fr) * TS + fq * 8), aq1 = *(const bf16x8*)(A1 + (16 * w + fr) * TS + 32 + fq * 8);
#pragma unroll
        for (int np = 0; np < 4; ++np) {
            f32x4 a = (f32x4){0.f, 0.f, 0.f, 0.f};
            if (np <= w) {
                const bf16x8 b0 = *(const bf16x8*)(A2 + (16 * np + fr) * TS + fq * 8), b1 = *(const bf16x8*)(A2 + (16 * np + fr) * TS + 32 + fq * 8);
                a = __builtin_amdgcn_mfma_f32_16x16x32_bf16(aq0, b0, a, 0, 0, 0);
                a = __builtin_amdgcn_mfma_f32_16x16x32_bf16(aq1, b1, a, 0, 0, 0);
            }
#pragma unroll
            for (int j = 0; j < 4; ++j) { const int c = 16 * w + 4 * fq + j, cp = 16 * np + fr; ATT[c * TS + cp] = (bf16_t)f2bf(cp <= c ? a[j] : 0.f); }
        }
        __syncthreads();
        const bf16x8 at0 = *(const bf16x8*)(ATT + (16 * w + fr) * TS + fq * 8), at1 = *(const bf16x8*)(ATT + (16 * w + fr) * TS + 32 + fq * 8);
        f32x4 acc[8];
#pragma unroll
        for (int n = 0; n < 8; ++n) {
            acc[n] = (f32x4){0.f, 0.f, 0.f, 0.f};
            const bf16x8 v0 = *(const bf16x8*)(VTl + (16 * n + fr) * TS + fq * 8), v1 = *(const bf16x8*)(VTl + (16 * n + fr) * TS + 32 + fq * 8);
            const bf16x8 s0 = sf[n][0], s1 = sf[n][1];
            acc[n] = __builtin_amdgcn_mfma_f32_16x16x32_bf16(v0, at0, acc[n], 0, 0, 0);
            acc[n] = __builtin_amdgcn_mfma_f32_16x16x32_bf16(v1, at1, acc[n], 0, 0, 0);
            acc[n] = __builtin_amdgcn_mfma_f32_16x16x32_bf16(s0, aq0, acc[n], 0, 0, 0);
            acc[n] = __builtin_amdgcn_mfma_f32_16x16x32_bf16(s1, aq1, acc[n], 0, 0, 0);
        }
        {
            float ss = 0.f;
#pragma unroll
            for (int n = 0; n < 8; ++n) ss += acc[n][0] * acc[n][0] + acc[n][1] * acc[n][1] + acc[n][2] * acc[n][2] + acc[n][3] * acc[n][3];
            ss += __shfl_xor(ss, 16); ss += __shfl_xor(ss, 32);
            const float rstd = rsqrtf(ss * (1.f / 128.f) + EPS);
            const int t = t0 + 16 * w + fr;
#pragma unroll
            for (int n = 0; n < 8; ++n) { const int e = 16 * n + 4 * fq;
                const float4 gg = *(const float4*)(p.g_gla + e);
                const float r0 = bf2f((unsigned short)(rw[n].x & 0xffff)), r1 = bf2f((unsigned short)(rw[n].x >> 16)), r2 = bf2f((unsigned short)(rw[n].y & 0xffff)), r3 = bf2f((unsigned short)(rw[n].y >> 16));
                uint2 ov; ov.x = pk2(acc[n][0] * rstd * gg.x * fsilu(r0), acc[n][1] * rstd * gg.y * fsilu(r1)); ov.y = pk2(acc[n][2] * rstd * gg.z * fsilu(r2), acc[n][3] * rstd * gg.w * fsilu(r3));
                *(uint2*)(CAT + (size_t)t * D + 512 + hh * 128 + e) = ov; }
        }
        __syncthreads();
        if (more) cur = nxt;
    }
}

struct EpiBf16Plain {
    static constexpr bool PERM = true;
    bf16_t* C; int ldc;
    __device__ __forceinline__ void operator()(const f32x4 (&acc)[2][2][4][2], const pg8::Unit& u, int wr, int wc, int fr, int fq) const {
#pragma unroll
        for (int ai = 0; ai < 2; ++ai)
#pragma unroll
            for (int m = 0; m < 4; ++m) { const int row = u.row0 + 128 * ai + 64 * wr + 16 * m + fr;
#pragma unroll
                for (int bj = 0; bj < 2; ++bj) { const f32x4 v0 = acc[ai][bj][m][0], v1 = acc[ai][bj][m][1];
                    u32x4 w; w.x = pk2(v0[0], v0[1]); w.y = pk2(v0[2], v0[3]); w.z = pk2(v1[0], v1[1]); w.w = pk2(v1[2], v1[3]);
                    *(u32x4*)(C + (size_t)row * ldc + 256 * u.pn + 128 * bj + 32 * wc + 8 * fq) = w; } }
    }
};
__device__ void phase_gemm_out(const Params& p, unsigned char* lds) {
    pg8::DenseSched Sd; Sd.init(p.ws + WS_CAT, p.ws + WS_WOUTT, T, D, D);
    EpiBf16Plain E{(bf16_t*)(p.ws + WS_YMIX), D};
    pg8::gemm_phase<EpiBf16Plain, pg8::DenseSched>((LAS unsigned char*)lds, D, Sd, E);
}

constexpr int HS_STRIDE = 1028;
__device__ void phase_postmix(const Params& p, unsigned char* lds, const bool dry) {
    const int tid = threadIdx.x, lane = tid & 63, wave = tid >> 6;
    unsigned char* ws = p.ws;
    const float* mod = (const float*)(ws + WS_MOD);
    const bf16_t* Y = (const bf16_t*)(ws + WS_YMIX);
    bf16_t* H = (bf16_t*)(ws + WS_H);
    bf16_t* X1 = (bf16_t*)(ws + WS_X1);
    float* hs = (float*)lds;
    float* part = (float*)(lds + 66048);
    float* lg = (float*)(lds + 66048 + 16384);
    float* tvs = lg + 512;
    int* tis = (int*)(tvs + 64);
    constexpr int MAXG = 8;
    int* sel_e = tis + 64;
    float* sel_g = (float*)(sel_e + MAXG * 64);
    int* lrank = (int*)(sel_g + MAXG * 64);
    int* lcnt = lrank + MAXG * 64;
    int* lbase = lcnt + 32;
    int* CNT = (int*)(ws + WS_CTL) + CW_CNT;
    float wb0[32], wb1[32];
    { const float* wp = p.router_w + (size_t)(128 * wave + (lane >> 4)) * 32 + (lane & 15);
#pragma unroll
      for (int ks = 0; ks < 32; ++ks) { wb0[ks] = wp[(size_t)(4 * ks) * 32]; wb1[ks] = wp[(size_t)(4 * ks) * 32 + 16]; } }
    if (tid < 32) lcnt[tid] = 0;
    int gl = 0, grp0 = blockIdx.x;
    uint2 yw[2][4]; float4 xv[2][4];
    if ((int)blockIdx.x < T / 16) {
#pragma unroll
        for (int i = 0; i < 2; ++i) { const int m = blockIdx.x * 16 + wave * 2 + i;
            const uint2* yr = (const uint2*)(Y + (size_t)m * D) + lane; const float4* xr = (const float4*)(p.x + (size_t)m * D) + lane;
#pragma unroll
            for (int j = 0; j < 4; ++j) { yw[i][j] = ntload2(yr + 64 * j); xv[i][j] = ntload4(xr + 64 * j); } }
    }
    for (int grp = blockIdx.x; grp < T / 16; grp += gridDim.x) {
        const int m0 = grp * 16;
#pragma unroll
        for (int i = 0; i < 2; ++i) {
            const int rl = wave * 2 + i, m = m0 + rl, b = m >> 13;
            float4 yv[4]; float ss = 0.f;
#pragma unroll
            for (int j = 0; j < 4; ++j) { const uint2 w = yw[i][j];
                yv[j] = make_float4(bf2f((unsigned short)(w.x & 0xffff)), bf2f((unsigned short)(w.x >> 16)), bf2f((unsigned short)(w.y & 0xffff)), bf2f((unsigned short)(w.y >> 16)));
                ss += yv[j].x * yv[j].x + yv[j].y * yv[j].y + yv[j].z * yv[j].z + yv[j].w * yv[j].w; }
            const float rstd1 = rsqrtf(wave_sum(ss) * (1.f / D) + EPS);
            float4 x1[4]; float ss2 = 0.f;
#pragma unroll
            for (int j = 0; j < 4; ++j) { const int c = 4 * lane + 256 * j;
                const float4 xq = xv[i][j], g = *(const float4*)(p.g_post_mix + c), gt = *(const float4*)(mod + b * 6144 + 2048 + c);
                x1[j].x = xq.x + gt.x * (yv[j].x * rstd1 * g.x); x1[j].y = xq.y + gt.y * (yv[j].y * rstd1 * g.y);
                x1[j].z = xq.z + gt.z * (yv[j].z * rstd1 * g.z); x1[j].w = xq.w + gt.w * (yv[j].w * rstd1 * g.w);
                ss2 += x1[j].x * x1[j].x + x1[j].y * x1[j].y + x1[j].z * x1[j].z + x1[j].w * x1[j].w;
                { uint2 xo; xo.x = pk2(x1[j].x, x1[j].y); xo.y = pk2(x1[j].z, x1[j].w); ntstore2((uint2*)(X1 + (size_t)m * D + c), xo); } }
            const float rstd2 = rsqrtf(wave_sum(ss2) * (1.f / D) + EPS);
#pragma unroll
            for (int j = 0; j < 4; ++j) { const int c = 4 * lane + 256 * j;
                const float4 g = *(const float4*)(p.g_pre_ffn + c), sh = *(const float4*)(mod + b * 6144 + 3072 + c), sc = *(const float4*)(mod + b * 6144 + 4096 + c);
                float4 h;
                h.x = x1[j].x * rstd2 * g.x * (1.f + sc.x) + sh.x; h.y = x1[j].y * rstd2 * g.y * (1.f + sc.y) + sh.y;
                h.z = x1[j].z * rstd2 * g.z * (1.f + sc.z) + sh.z; h.w = x1[j].w * rstd2 * g.w * (1.f + sc.w) + sh.w;
                uint2 o; o.x = pk2(h.x, h.y); o.y = pk2(h.z, h.w);
                *(uint2*)(H + (size_t)m * D + c) = o;
                *(float4*)(hs + rl * HS_STRIDE + c) = h; }
        }
        if (grp + (int)gridDim.x < T / 16) {
#pragma unroll
            for (int i = 0; i < 2; ++i) { const int m = (grp + gridDim.x) * 16 + wave * 2 + i;
                const uint2* yr = (const uint2*)(Y + (size_t)m * D) + lane; const float4* xr = (const float4*)(p.x + (size_t)m * D) + lane;
#pragma unroll
                for (int j = 0; j < 4; ++j) { yw[i][j] = ntload2(yr + 64 * j); xv[i][j] = ntload4(xr + 64 * j); } }
        }
        __syncthreads();
        f32x4 a0 = (f32x4){0.f, 0.f, 0.f, 0.f}, a1 = (f32x4){0.f, 0.f, 0.f, 0.f};
        {
            const float* hp = hs + (lane & 15) * HS_STRIDE + 128 * wave + (lane >> 4);
#pragma unroll
            for (int ks = 0; ks < 32; ++ks) {
                const float av = hp[4 * ks];
                a0 = __builtin_amdgcn_mfma_f32_16x16x4f32(av, wb0[ks], a0, 0, 0, 0);
                a1 = __builtin_amdgcn_mfma_f32_16x16x4f32(av, wb1[ks], a1, 0, 0, 0);
            }
        }
        {
            const int fr = lane & 15, fq = lane >> 4;
#pragma unroll
            for (int j = 0; j < 4; ++j) { part[(wave * 16 + 4 * fq + j) * 32 + fr] = a0[j]; part[(wave * 16 + 4 * fq + j) * 32 + 16 + fr] = a1[j]; }
        }
        __syncthreads();
        { const int e = tid & 31; float s = p.router_b[e];
#pragma unroll
          for (int w8 = 0; w8 < 8; ++w8) s += part[w8 * 512 + tid];
          lg[tid] = s; }
        __syncthreads();
        {
            const int row = tid >> 5, e = tid & 31; const float v = lg[tid]; int rank = 0;
#pragma unroll
            for (int q = 0; q < 32; ++q) { const float u = lg[row * 32 + q]; rank += (u > v || (u == v && q < e)) ? 1 : 0; }
            if (rank < 4) { tvs[row * 4 + rank] = v; tis[row * 4 + rank] = e; }
        }
        __syncthreads();
        if (tid < 64) { const int row = tid >> 2, k = tid & 3;
            const float t0 = tvs[row * 4], e1 = fexp(tvs[row * 4 + 1] - t0), e2 = fexp(tvs[row * 4 + 2] - t0), e3 = fexp(tvs[row * 4 + 3] - t0);
            const float inv = 1.f / (1.f + e1 + e2 + e3);
            const float ek = k == 0 ? 1.f : (k == 1 ? e1 : (k == 2 ? e2 : e3));
            const int e = tis[tid];
            sel_e[gl * 64 + tid] = e; sel_g[gl * 64 + tid] = ek * inv;
            lrank[gl * 64 + tid] = atomicAdd(&lcnt[e], 1); }
        ++gl;
        const bool lastg = grp + (int)gridDim.x >= T / 16;
        if (gl == MAXG || lastg) {
            __syncthreads();
            if (tid < 32) { const int c = lcnt[tid]; lbase[tid] = (c > 0 && !dry) ? atomicAdd(&CNT[tid], c) : 0; }
            __syncthreads();
            if (!dry) for (int i = tid; i < gl * 64; i += NTHREADS) { const int gq = i >> 6, a = (grp0 + gq * (int)gridDim.x) * 64 + (i & 63); const int e = sel_e[i];
                const int pos = lbase[e] + lrank[i];
                ((int*)(ws + WS_TOPI))[a] = e; ((float*)(ws + WS_GATE))[a] = sel_g[i]; ((int*)(ws + WS_POS))[a] = pos; ((int*)(ws + WS_TOK))[e * T + pos] = a >> 2; }
            __syncthreads();
            if (tid < 32) lcnt[tid] = 0;
            gl = 0; grp0 = grp + gridDim.x;
        }
        __syncthreads();
    }
}

__device__ __forceinline__ void compute_pstart(const Params& p, unsigned char* lds) {
    int* ps = (int*)(lds + LDS_PS); int* cn = (int*)(lds + LDS_CNT);
    if (threadIdx.x < 64) {
        const int lane = threadIdx.x;
        const int* CNT = (const int*)(p.ws + WS_CTL) + CW_CNT;
        const int c = lane < NE ? __hip_atomic_load(&CNT[lane], __ATOMIC_RELAXED, __HIP_MEMORY_SCOPE_AGENT) : 0;
        int incl = (c + 255) & ~255;
#pragma unroll
        for (int o = 1; o < 32; o <<= 1) { const int t = __shfl_up(incl, o); if (lane >= o) incl += t; }
        if (lane < NE) { ps[lane + 1] = incl; cn[lane] = c; }
        if (lane == 0) ps[0] = 0;
    }
    __syncthreads();
}

struct EpiUp {
    static constexpr bool PERM = true;
    bf16_t* ACT; const float* bgu;
    __device__ __forceinline__ void operator()(const f32x4 (&acc)[2][2][4][2], const pg8::Unit& u, int wr, int wc, int fr, int fq) const {
        if (u.e & 64) body<true>(acc, u, wr, wc, fr, fq); else body<false>(acc, u, wr, wc, fr, fq);
    }
    template <bool WT>
    __device__ __forceinline__ void body(const f32x4 (&acc)[2][2][4][2], const pg8::Unit& u, int wr, int wc, int fr, int fq) const {
#pragma unroll
        for (int bj = 0; bj < 2; ++bj) {
            const int grp = 8 * u.pn + 4 * bj + wc, jc = 16 * grp + 4 * fq;
            const float* bp = bgu + (size_t)(u.e & 31) * 2048 + 2 * jc;
            const float4 b01 = *(const float4*)bp, b23 = *(const float4*)(bp + 4);
            const float bg[4] = {b01.x, b01.z, b23.x, b23.z}, bl[4] = {b01.y, b01.w, b23.y, b23.w};
#pragma unroll
            for (int ai = 0; ai < 2; ++ai)
#pragma unroll
                for (int m = 0; m < 4; ++m) { const int row = u.row0 + 128 * ai + 64 * wr + 16 * m + fr;
                    float a[4];
#pragma unroll
                    for (int j = 0; j < 4; ++j) { float gl = acc[ai][bj][m][0][j] + bg[j], ln = acc[ai][bj][m][1][j] + bl[j];
                        gl = fminf(gl, 7.f); ln = fminf(fmaxf(ln, -7.f), 7.f);
                        a[j] = gl / (1.f + fexp(-1.702f * gl)) * (ln + 1.f); }
                    uint2 o; o.x = pk2(a[0], a[1]); o.y = pk2(a[2], a[3]);
                    if constexpr (WT) __hip_atomic_store((unsigned long long*)(ACT + (size_t)row * DFF + jc), (unsigned long long)o.x | ((unsigned long long)o.y << 32), __ATOMIC_RELAXED, __HIP_MEMORY_SCOPE_AGENT);
                    else *(uint2*)(ACT + (size_t)row * DFF + jc) = o; }
        }
    }
};
__device__ void phase_moe_up(const Params& p, unsigned char* lds) {
    int* ps = (int*)(lds + LDS_PS);
    compute_pstart(p, lds);
    pg8::MoeSched<true> Sm; Sm.init(p.ws + WS_H, p.ws + WS_WGUT, D, 8, 2048, ps, (const int*)(p.ws + WS_TOK));
    EpiUp E{(bf16_t*)(p.ws + WS_ACT), p.b_gate_up};
    pg8::gemm_phase<EpiUp, pg8::MoeSched<true>>((LAS unsigned char*)lds, D, Sm, E);
}

struct EpiDown {
    static constexpr bool PERM = true;
    bf16_t* YE; const float* bd;
    __device__ __forceinline__ void operator()(const f32x4 (&acc)[2][2][4][2], const pg8::Unit& u, int wr, int wc, int fr, int fq) const {
#pragma unroll
        for (int bj = 0; bj < 2; ++bj) {
            const int c0 = 256 * u.pn + 128 * bj + 32 * wc + 8 * fq;
            const float* bp = bd + (size_t)(u.e & 31) * D + c0;
            const float4 b0 = *(const float4*)bp, b1 = *(const float4*)(bp + 4);
#pragma unroll
            for (int ai = 0; ai < 2; ++ai)
#pragma unroll
                for (int m = 0; m < 4; ++m) { const int row = u.row0 + 128 * ai + 64 * wr + 16 * m + fr;
                    const f32x4 v0 = acc[ai][bj][m][0], v1 = acc[ai][bj][m][1];
                    u32x4 w; w.x = pk2(v0[0] + b0.x, v0[1] + b0.y); w.y = pk2(v0[2] + b0.z, v0[3] + b0.w); w.z = pk2(v1[0] + b1.x, v1[1] + b1.y); w.w = pk2(v1[2] + b1.z, v1[3] + b1.w);
                    *(u32x4*)(YE + (size_t)row * D + c0) = w; }
        }
    }
};
struct EpiMoe {
    static constexpr bool PERM = true;
    EpiUp up; EpiDown dn;
    __device__ __forceinline__ void operator()(const f32x4 (&acc)[2][2][4][2], const pg8::Unit& u, int wr, int wc, int fr, int fq) const {
        if ((u.e & 32) == 0) up(acc, u, wr, wc, fr, fq); else dn(acc, u, wr, wc, fr, fq);
    }
};
__device__ void phase_moe(const Params& p, unsigned char* lds) {
    int* ps = (int*)(lds + LDS_PS);
    compute_pstart(p, lds);
    const volatile unsigned* xs = (const volatile unsigned*)(lds + LDS_BARW);
    LAS int* ms = (LAS int*)(lds + LDS_BARW + 128);
    if (threadIdx.x == 0) {
        const int gt = gridDim.x, RT = ps[NE] >> 8, R = (12 * RT + gt - 1) / gt, x = (int)xs[4];
        int totE = 0, totF = 0, base = 0;
        for (int j = 0; j < 16; ++j) { const int cj = (int)xs[16 + j]; if (cj == 0) continue;
            const int tiles = RT * (base + cj) / gt - RT * base / gt, cap = R * cj, un = 12 * tiles;
            totE += un > cap ? min(tiles, (un - cap + 3) / 4) : 0; totF += un <= cap ? (cap - un) / 4 : 0; base += cj; }
        const int E = min(min(totE, totF), 24);
        int ge = 0, gf = 0; base = 0;
        LAS int* tmp = (LAS int*)lds;
        ms[2] = 0; ms[3] = 0;
        for (int j = 0; j < 16; ++j) { const int cj = (int)xs[16 + j]; if (cj == 0) continue;
            const int t0j = RT * base / gt, tiles = RT * (base + cj) / gt - t0j, cap = R * cj, un = 12 * tiles;
            const int ej = un > cap ? min(tiles, (un - cap + 3) / 4) : 0, fj = un <= cap ? (cap - un) / 4 : 0;
            const int eff = max(0, min(ej, E - ge));
            for (int k = 0; k < eff; ++k) tmp[ge + k] = t0j + k;
            if (j == x) { ms[0] = t0j; ms[1] = tiles; ms[2] = eff; ms[4] = min(gf, E); ms[3] = min(gf + fj, E) - min(gf, E); }
            ge += ej; gf += fj; base += cj; }
        for (int k = 0; k < ms[3]; ++k) ms[8 + k] = tmp[ms[4] + k];
    }
    __syncthreads();
    pg8::MoeSched2 Sm; Sm.init(p.ws, ps, (int)xs[0], (int)xs[2], ms);
    EpiMoe E{EpiUp{(bf16_t*)(p.ws + WS_ACT), p.b_gate_up}, EpiDown{(bf16_t*)(p.ws + WS_YE), p.b_down}};
    pg8::gemm_phase<EpiMoe, pg8::MoeSched2>((LAS unsigned char*)lds, D, Sm, E);
}
__device__ void phase_moe_down(const Params& p, unsigned char* lds) {
    int* ps = (int*)(lds + LDS_PS);
    compute_pstart(p, lds);
    pg8::MoeSched<false> Sm; Sm.init(p.ws + WS_ACT, p.ws + WS_WDT, DFF, 4, 1024, ps, nullptr);
    EpiDown E{(bf16_t*)(p.ws + WS_YE), p.b_down};
    pg8::gemm_phase<EpiDown, pg8::MoeSched<false>>((LAS unsigned char*)lds, DFF, Sm, E);
}

__device__ void phase_combine(const Params& p, unsigned char* lds) {
    const int tid = threadIdx.x, lane = tid & 63, wave = tid >> 6;
    unsigned char* ws = p.ws;
    const float* mod = (const float*)(ws + WS_MOD);
    const bf16_t* YE = (const bf16_t*)(ws + WS_YE);
    const bf16_t* X1 = (const bf16_t*)(ws + WS_X1);
    const int* TOPI = (const int*)(ws + WS_TOPI); const int* POS = (const int*)(ws + WS_POS); const float* GATE = (const float*)(ws + WS_GATE);
    compute_pstart(p, lds);
    const int* ps = (const int*)(lds + LDS_PS);
    for (int m0 = (blockIdx.x * NW + wave) * 2; m0 < T; m0 += gridDim.x * NW * 2) {
        const int4 te0 = *(const int4*)(TOPI + m0 * 4), te1 = *(const int4*)(TOPI + m0 * 4 + 4), tp0 = *(const int4*)(POS + m0 * 4), tp1 = *(const int4*)(POS + m0 * 4 + 4);
        const float4 gk0 = *(const float4*)(GATE + m0 * 4), gk1 = *(const float4*)(GATE + m0 * 4 + 4);
        const int slot[2][4] = {{ps[te0.x] + tp0.x, ps[te0.y] + tp0.y, ps[te0.z] + tp0.z, ps[te0.w] + tp0.w}, {ps[te1.x] + tp1.x, ps[te1.y] + tp1.y, ps[te1.z] + tp1.z, ps[te1.w] + tp1.w}};
        const float gk[2][4] = {{gk0.x, gk0.y, gk0.z, gk0.w}, {gk1.x, gk1.y, gk1.z, gk1.w}};
        uint2 u[2][4][4]; float4 x1[2][4];
#pragma unroll
        for (int q = 0; q < 2; ++q) {
#pragma unroll
            for (int k = 0; k < 4; ++k) { const uint2* yr = (const uint2*)(YE + (size_t)slot[q][k] * D) + lane;
#pragma unroll
                for (int j = 0; j < 4; ++j) u[q][k][j] = ntload2(yr + 64 * j); }
            const uint2* xr = (const uint2*)(X1 + (size_t)(m0 + q) * D) + lane;
#pragma unroll
            for (int j = 0; j < 4; ++j) { const uint2 w = ntload2(xr + 64 * j);
                x1[q][j] = make_float4(bf2f((unsigned short)(w.x & 0xffff)), bf2f((unsigned short)(w.x >> 16)), bf2f((unsigned short)(w.y & 0xffff)), bf2f((unsigned short)(w.y >> 16))); }
        }
#pragma unroll
        for (int q = 0; q < 2; ++q) {
            const int m = m0 + q, b = m >> 13;
            float4 y[4];
#pragma unroll
            for (int j = 0; j < 4; ++j) { y[j] = make_float4(0.f, 0.f, 0.f, 0.f);
#pragma unroll
                for (int k = 0; k < 4; ++k) { const uint2 w = u[q][k][j]; const float g = gk[q][k];
                    y[j].x += g * bf2f((unsigned short)(w.x & 0xffff)); y[j].y += g * bf2f((unsigned short)(w.x >> 16));
                    y[j].z += g * bf2f((unsigned short)(w.y & 0xffff)); y[j].w += g * bf2f((unsigned short)(w.y >> 16)); } }
            float ss = 0.f;
#pragma unroll
            for (int j = 0; j < 4; ++j) ss += y[j].x * y[j].x + y[j].y * y[j].y + y[j].z * y[j].z + y[j].w * y[j].w;
            const float rstd = rsqrtf(wave_sum(ss) * (1.f / D) + EPS);
#pragma unroll
            for (int j = 0; j < 4; ++j) { const int c = 4 * lane + 256 * j;
                const float4 g = *(const float4*)(p.g_post_ffn + c), gt = *(const float4*)(mod + b * 6144 + 5120 + c);
                float4 o;
                o.x = x1[q][j].x + gt.x * (y[j].x * rstd * g.x); o.y = x1[q][j].y + gt.y * (y[j].y * rstd * g.y);
                o.z = x1[q][j].z + gt.z * (y[j].z * rstd * g.z); o.w = x1[q][j].w + gt.w * (y[j].w * rstd * g.w);
                ntstore4((float4*)(p.out + (size_t)m * D + c), o); }
        }
    }
}

#define XB_TMO      128
#define XB_XCNT(j)  (256  + 64 * (j))
#define XB_XSUB(j)  (1280 + 64 * (j))
#define XB_XGEN(j)  (2304 + 64 * (j))
#define XB_TOP      3328
#define XB_TOPGEN   3392
#define XCD_BAR_WORDS 3456
#define XB_SPIN_CAP (1u << 18)
__device__ __forceinline__ unsigned xb_ld(unsigned* p)              { return __hip_atomic_load(p, __ATOMIC_RELAXED, __HIP_MEMORY_SCOPE_AGENT); }
__device__ __forceinline__ unsigned xb_add(unsigned* p, unsigned v) { return __hip_atomic_fetch_add(p, v, __ATOMIC_RELAXED, __HIP_MEMORY_SCOPE_AGENT); }
__device__ __forceinline__ unsigned xb_xcc_id() { return (unsigned)__builtin_amdgcn_s_getreg((3 << 11) | 20) & 0xFu; }
#define XB_SPIN(cond, bar) do { unsigned _sp = 0; while (cond) { __builtin_amdgcn_s_sleep(1); \
    if ((++_sp & 255u) == 0u) { if (xb_ld(&(bar)[XB_TMO])) break; if (_sp > XB_SPIN_CAP) { atomicAdd(&(bar)[XB_TMO], 1u); break; } } } } while (0)
struct XcdBarrier { unsigned* bar; unsigned x; volatile LAS unsigned* st; };
__device__ __forceinline__ XcdBarrier xcd_barrier_post(unsigned* bar, volatile LAS unsigned* st) {
    XcdBarrier b; b.bar = bar; b.x = xb_xcc_id(); b.st = st;
    if (threadIdx.x == 0) st[2] = xb_add(&bar[XB_XCNT(b.x)], 1u);
    return b;
}
__device__ __forceinline__ void xcd_barrier_complete(unsigned* bar, unsigned x, unsigned& nloc, unsigned& nx, unsigned& base) {
    const unsigned G = gridDim.x * gridDim.y * gridDim.z;
    unsigned sum, cnt, mine, sp = 0u;
    for (;;) {
        sum = 0u; cnt = 0u; mine = 0u; base = 0u;
#pragma unroll
        for (unsigned j = 0; j < 16; ++j) { const unsigned c = xb_ld(&bar[XB_XCNT(j)]); sum += c; cnt += (c > 0u) ? 1u : 0u; mine = (j == x) ? c : mine; base += (j < x) ? c : 0u; }
        if (sum == G) break;
        __builtin_amdgcn_s_sleep(1);
        if ((++sp & 255u) == 0u) { if (xb_ld(&bar[XB_TMO])) break; if (sp > XB_SPIN_CAP) { atomicAdd(&bar[XB_TMO], 1u); break; } }
    }
    nloc = mine > 0u ? mine : 1u; nx = cnt > 0u ? cnt : 1u;
}
__device__ __forceinline__ void xcd_barrier(const XcdBarrier& b) {
    asm volatile("s_waitcnt vmcnt(0)" ::: "memory");
    __syncthreads();
    if (threadIdx.x == 0) {
        unsigned* bar = b.bar;
        __builtin_amdgcn_s_waitcnt(0);
        unsigned nloc = b.st[0], nx = b.st[1];
        if (nloc == 0u) { unsigned base; xcd_barrier_complete(bar, b.x, nloc, nx, base); b.st[0] = nloc; b.st[1] = nx; b.st[3] = base; b.st[4] = b.x;
            for (unsigned j = 0; j < 16; ++j) b.st[16 + j] = xb_ld(&bar[XB_XCNT(j)]); }
        const unsigned old = xb_add(&bar[XB_XSUB(b.x)], 1u);
        const unsigned gen = old / nloc;
        if (old + 1u == (gen + 1u) * nloc) {
            __builtin_amdgcn_fence(__ATOMIC_RELEASE, "agent");
            asm volatile("s_waitcnt vmcnt(0)" ::: "memory");
            const unsigned og = xb_add(&bar[XB_TOP], 1u);
            const unsigned tg = og / nx;
            if (og + 1u == (tg + 1u) * nx) xb_add(&bar[XB_TOPGEN], 1u);
            else XB_SPIN(xb_ld(&bar[XB_TOPGEN]) == tg, bar);
            __builtin_amdgcn_fence(__ATOMIC_ACQUIRE, "agent");
            xb_add(&bar[XB_XGEN(b.x)], 1u);
            asm volatile("s_waitcnt vmcnt(0)" ::: "memory");
        } else {
            XB_SPIN(xb_ld(&bar[XB_XGEN(b.x)]) == gen, bar);
            __builtin_amdgcn_fence(__ATOMIC_ACQUIRE, "agent");
            asm volatile("s_waitcnt vmcnt(0)" ::: "memory");
        }
    }
    __syncthreads();
}

__global__ void __launch_bounds__(NTHREADS, 2) fwd_kernel(Params p) {
    extern __shared__ __attribute__((aligned(16))) unsigned char lds[];
    const int lo = p.ph_lo, hi = p.ph_hi;
    volatile LAS unsigned* st = (volatile LAS unsigned*)(lds + LDS_BARW);
    if (threadIdx.x == 0) { st[0] = 0u; st[1] = 0u; }
    __syncthreads();
    XcdBarrier bar; bar.bar = (unsigned*)(p.ws + WS_CTL); bar.x = 0; bar.st = st;
    if (hi - lo > 1) bar = xcd_barrier_post((unsigned*)(p.ws + WS_CTL), st);
#ifndef PROBE_DUP
#define PROBE_DUP -1
#endif
#define PHASE(k, call) if (lo <= (k) && (k) < hi) { const int nrep = ((k) == PROBE_DUP) ? hi - 9 : 1; for (int rep = 0; rep < nrep; ++rep) { const bool dry = rep > 0; (void)dry; call; if (rep + 1 < nrep) __syncthreads(); } if ((k) + 1 < hi) xcd_barrier(bar); }
    PHASE(0, { phase_prep(p, lds); phase_prenorm(p); })
    PHASE(2, phase_gemm_in(p, lds))
    PHASE(3, { vtrans_items(p, lds); gla1_items(p, lds); })
    PHASE(4, { gla2_scan(p); phase_attn(p, lds); })
    PHASE(5, gla3_items(p, lds))
    PHASE(6, phase_gemm_out(p, lds))
    PHASE(7, phase_postmix(p, lds, dry))
    PHASE(8, phase_moe(p, lds))
    PHASE(10, phase_combine(p, lds))
#undef PHASE
}

extern "C" void kernel_launch(void* const* d_in, const int* in_sizes, int n_in, void* d_out, int out_size, void* d_ws, size_t ws_size, hipStream_t stream) {
    static int grid_blocks = 0;
    if (grid_blocks == 0) {
        if (n_in != 19 || out_size != T * D || ws_size < WS_END) { fprintf(stderr, "kernel_launch: unexpected shapes (n_in %d out %d ws %zu need %zu)\n", n_in, out_size, ws_size, (size_t)WS_END); grid_blocks = -1; return; }
        int dev = 0, cus = 0, per_cu = 0;
        (void)hipGetDevice(&dev);
        (void)hipDeviceGetAttribute(&cus, hipDeviceAttributeMultiprocessorCount, dev);
        if (hipFuncSetAttribute((const void*)fwd_kernel, hipFuncAttributeMaxDynamicSharedMemorySize, LDS_BYTES) != hipSuccess) { fprintf(stderr, "kernel_launch: hipFuncSetAttribute failed\n"); grid_blocks = -1; return; }
        (void)hipOccupancyMaxActiveBlocksPerMultiprocessor(&per_cu, fwd_kernel, NTHREADS, LDS_BYTES);
        if (per_cu < 1) { fprintf(stderr, "kernel_launch: occupancy query reports %d blocks per CU\n", per_cu); per_cu = 1; }
        grid_blocks = cus;
        (void)hipGetLastError();
    }
    if (grid_blocks < 0) return;
    (void)hipMemsetAsync((char*)d_ws + WS_CTL, 0, CTL_BYTES, stream);
    Params p{};
    p.x = (const float*)d_in[0]; p.c = (const float*)d_in[1]; p.w_mod = (const float*)d_in[2]; p.b_mod = (const float*)d_in[3];
    p.g_pre_mix = (const float*)d_in[4]; p.w_in = (const float*)d_in[5]; p.w_gate_lr = (const float*)d_in[6]; p.b_gate = (const float*)d_in[7];
    p.g_gla = (const float*)d_in[8]; p.w_out = (const float*)d_in[9]; p.g_post_mix = (const float*)d_in[10]; p.g_pre_ffn = (const float*)d_in[11];
    p.router_w = (const float*)d_in[12]; p.router_b = (const float*)d_in[13]; p.w_gate_up = (const float*)d_in[14]; p.b_gate_up = (const float*)d_in[15];
    p.w_down = (const float*)d_in[16]; p.b_down = (const float*)d_in[17]; p.g_post_ffn = (const float*)d_in[18];
    p.out = (float*)d_out; p.ws = (unsigned char*)d_ws;
    for (int d = 0; d < 32; ++d) p.inv_freq[d] = powf(10000.0f, -(float)d / 32.0f);
#if ONE_LAUNCH
    p.ph_lo = 0; p.ph_hi = NPHASE;
    void* args[] = {&p};
    hipError_t e = hipLaunchCooperativeKernel((void*)fwd_kernel, dim3(grid_blocks), dim3(NTHREADS), args, LDS_BYTES, stream);
    if (e != hipSuccess) fprintf(stderr, "cooperative launch failed: %s (grid %d)\n", hipGetErrorString(e), grid_blocks);
#else
    for (int k = 0; k < NPHASE; ++k) { p.ph_lo = k; p.ph_hi = k + 1; hipLaunchKernelGGL(fwd_kernel, dim3(grid_blocks), dim3(NTHREADS), LDS_BYTES, stream, p); }
#endif
}
```

```cpp
#include <hip/hip_runtime.h>
#include <cstdio>
#include <cstdint>
#include <cmath>

#ifndef ONE_LAUNCH
#define ONE_LAUNCH 1
#endif

typedef unsigned short bf16_t;
typedef short bf16x8 __attribute__((ext_vector_type(8)));
typedef float f32x4 __attribute__((ext_vector_type(4)));
typedef unsigned u32x4 __attribute__((ext_vector_type(4)));
#define LAS __attribute__((address_space(3)))

constexpr int T = 16384, D = 1024, S = 8192;
constexpr int DIN = 3088, DINP = 3104;
constexpr int NE = 32, DFF = 1024;
constexpr int PMAX = 65536 + NE * 256;
constexpr int NTHREADS = 512, NW = 8;
constexpr int LDS_STAGE = 131072;
constexpr int LDS_PS = LDS_STAGE;
constexpr int LDS_BARW = LDS_STAGE + 256;
constexpr int LDS_CNT = LDS_STAGE + 512;
constexpr int LDS_TOKB = LDS_STAGE + 1024;
constexpr int LDS_BYTES = LDS_STAGE + 4096;
constexpr int NPHASE = 11;
constexpr float EPS = 1e-6f;
constexpr float LOG2E = 1.4426950408889634f;

constexpr size_t al(size_t x) { return (x + 255) & ~(size_t)255; }
constexpr size_t WS_CTL   = 0;
constexpr size_t CTL_BYTES = 65536;
constexpr size_t WS_MOD   = WS_CTL + CTL_BYTES;
constexpr size_t WS_ROPE  = al(WS_MOD + 2 * 6144 * 4);
constexpr size_t WS_WINT  = al(WS_ROPE + (size_t)S * 32 * 2 * 4);
constexpr size_t WS_WOUTT = al(WS_WINT + (size_t)DINP * D * 2);
constexpr size_t WS_WGUT  = al(WS_WOUTT + (size_t)D * D * 2);
constexpr size_t WS_WDT   = al(WS_WGUT + (size_t)NE * 2048 * D * 2);
constexpr size_t WS_H     = al(WS_WDT + (size_t)NE * D * DFF * 2);
constexpr size_t WS_QA    = al(WS_H + (size_t)T * D * 2);
constexpr size_t WS_KA    = al(WS_QA + (size_t)T * 512 * 2);
constexpr size_t WS_VA    = al(WS_KA + (size_t)T * 512 * 2);
constexpr size_t WS_VB    = al(WS_VA + (size_t)T * 512 * 2);
constexpr size_t WS_QG    = al(WS_VB + (size_t)T * 512 * 2);
constexpr size_t WS_KG    = al(WS_QG + (size_t)T * 256 * 2);
constexpr size_t WS_VG    = al(WS_KG + (size_t)T * 256 * 2);
constexpr size_t WS_RG    = al(WS_VG + (size_t)T * 512 * 2);
constexpr size_t WS_GLR   = al(WS_RG + (size_t)T * 512 * 2);
constexpr size_t WS_UT    = al(WS_GLR + (size_t)T * 16 * 4);
constexpr size_t WS_AG    = al(WS_UT + (size_t)1024 * 128 * 64 * 4);
constexpr size_t WS_SPT   = al(WS_AG + (size_t)1024 * 64 * 4);
constexpr size_t WS_CAT   = al(WS_SPT + (size_t)1024 * 128 * 64 * 2);
constexpr size_t WS_TOPI  = al(WS_CAT + (size_t)T * D * 2);
constexpr size_t WS_GATE  = al(WS_TOPI + (size_t)T * 4 * 4);
constexpr size_t WS_POS   = al(WS_GATE + (size_t)T * 4 * 4);
constexpr size_t WS_SLOT  = al(WS_POS + (size_t)T * 4 * 4);
constexpr size_t WS_TOK   = al(WS_SLOT + (size_t)T * 4 * 4);
constexpr size_t WS_ACT   = al(WS_TOK + (size_t)NE * T * 4);
constexpr size_t WS_YMIX  = WS_ACT;
constexpr size_t WS_X1    = WS_UT;
constexpr size_t WS_YE    = al(WS_ACT + (size_t)PMAX * DFF * 2);
constexpr size_t WS_IDT   = al(WS_YE + (size_t)PMAX * D * 2);
constexpr size_t WS_END   = al(WS_IDT + (size_t)PMAX * 4);
static_assert((size_t)T * D * 4 <= (size_t)PMAX * DFF * 2, "YMIX alias fits in ACT");
static_assert(WS_X1 + (size_t)T * D * 2 <= WS_AG, "X1 alias fits in UT");
constexpr int CW_CNT = 4096;
constexpr int CW_UPCNT = 4352;
constexpr int CW_MODCNT = 4224;

struct Params {
    const float *x, *c, *w_mod, *b_mod, *g_pre_mix, *w_in, *w_gate_lr, *b_gate, *g_gla, *w_out, *g_post_mix, *g_pre_ffn,
                *router_w, *router_b, *w_gate_up, *b_gate_up, *w_down, *b_down, *g_post_ffn;
    float* out; unsigned char* ws;
    int ph_lo, ph_hi;
    float inv_freq[32];
};

__device__ __forceinline__ unsigned f2bf(float f) { unsigned u = __builtin_bit_cast(unsigned, f); return (u + 0x7fffu + ((u >> 16) & 1u)) >> 16; }
typedef float f32x2_t __attribute__((ext_vector_type(2))); typedef __bf16 bf16x2_t __attribute__((ext_vector_type(2)));
__device__ __forceinline__ unsigned pk2(float lo, float hi) { f32x2_t v = {lo, hi}; bf16x2_t b = __builtin_convertvector(v, bf16x2_t); return __builtin_bit_cast(unsigned, b); }
__device__ __forceinline__ float bf2f(unsigned short b) { return __builtin_bit_cast(float, (unsigned)b << 16); }
__device__ __forceinline__ float4 ntload4(const float4* p) { const f32x4 t = __builtin_nontemporal_load((const f32x4*)p); return make_float4(t[0], t[1], t[2], t[3]); }
__device__ __forceinline__ uint2 ntload2(const uint2* p) { typedef unsigned u32x2 __attribute__((ext_vector_type(2))); const u32x2 t = __builtin_nontemporal_load((const u32x2*)p); return make_uint2(t[0], t[1]); }
__device__ __forceinline__ void ntstore4(float4* p, float4 v) { const f32x4 t = {v.x, v.y, v.z, v.w}; __builtin_nontemporal_store(t, (f32x4*)p); }
__device__ __forceinline__ void ntstore2(uint2* p, uint2 v) { typedef unsigned u32x2 __attribute__((ext_vector_type(2))); const u32x2 t = {v.x, v.y}; __builtin_nontemporal_store(t, (u32x2*)p); }
__device__ __forceinline__ void ntstore4u(uint4* p, uint4 v) { const u32x4 t = {v.x, v.y, v.z, v.w}; __builtin_nontemporal_store(t, (u32x4*)p); }
__device__ __forceinline__ float wave_sum(float v) {
#pragma unroll
    for (int o = 1; o < 64; o <<= 1) v += __shfl_xor(v, o);
    return v;
}
__device__ __forceinline__ float fexp2(float x) { return __builtin_amdgcn_exp2f(x); }
__device__ __forceinline__ float fexp(float x) { return __builtin_amdgcn_exp2f(x * LOG2E); }
__device__ __forceinline__ float flog(float x) { return __builtin_amdgcn_logf(x) * 0.6931471805599453f; }
__device__ __forceinline__ float fsilu(float x) { return x / (1.f + fexp(-x)); }

#define GAS __attribute__((address_space(1)))
namespace pg8 {
constexpr int BM = 256, BK = 64, HALF = 128, HTB = HALF * BK * 2, NXCD = 8, WGM = 8;
__host__ __device__ __forceinline__ int lds_byte(int r, int c) { const int st = (r >> 4) * 2 + (c >> 5), rr = r & 15, cc = c & 31, ob = rr * 64 + cc * 2; return st * 1024 + (ob ^ (((ob >> 9) & 1) << 5)); }
__host__ __device__ __forceinline__ void stage_rc(int b, int& R, int& C) { const int st = b / 1024, sb = b % 1024, swz = sb ^ (((sb >> 9) & 1) << 5); R = (st >> 1) * 16 + swz / 64; C = (st & 1) * 32 + (swz % 64) / 2; }
__host__ __device__ __forceinline__ int perm32(int rho) { const int n = rho >> 4, i = rho & 15; return 8 * (i >> 2) + 4 * n + (i & 3); }

struct Unit { const char* A; const char* B; unsigned ao[2][2]; int row0, pn, e, nvalid, tb0; };

__device__ __forceinline__ int xcd_remap(int wgid, int nwg) { const int q = nwg / NXCD, r = nwg % NXCD, xcd = wgid % NXCD, off = wgid / NXCD; return (xcd < r ? xcd * (q + 1) : r * (q + 1) + (xcd - r) * q) + off; }
__device__ __forceinline__ const char* uptr(const char* p) {
    const unsigned long long v = (unsigned long long)p;
    const unsigned lo = __builtin_amdgcn_readfirstlane((unsigned)v), hi = __builtin_amdgcn_readfirstlane((unsigned)(v >> 32));
    return (const char*)(((unsigned long long)hi << 32) | lo);
}

template <class Epi, class Sched>
__device__ __forceinline__ void gemm_phase(LAS unsigned char* lds, const int K, const Sched& S, const Epi& E) {
    constexpr bool GATHER = Sched::GATHER;
    const int tid = threadIdx.x, wid = __builtin_amdgcn_readfirstlane(tid >> 6), lane = tid & 63, wr = wid >> 2, wc = wid & 3, fr = lane & 15, fq = lane >> 4;
    const int nt = K / BK;
    unsigned voffA[2], voffB[2];
#pragma unroll
    for (int i = 0; i < 2; ++i) { int R, C; stage_rc(tid * 16 + i * 8192, R, C); const int Rb = Epi::PERM ? ((R & ~31) + perm32(R & 31)) : R;
        voffA[i] = (unsigned)(R * K + C) * 2u; voffB[i] = (unsigned)(Rb * K + C) * 2u; }
    const size_t kstep = (size_t)(BK * 2);
    const size_t hstep = (size_t)HALF * K * 2;
    const unsigned ldsw = (unsigned)wid * 1024u;
    const int aoff = lds_byte(wr * 64 + fr, fq * 8), boff = lds_byte(wc * 32 + fr, fq * 8);
#define PG8_SA(b, h) (((b) * 2 + (h)) * HTB)
#define PG8_SB(b, h) ((4 + (b) * 2 + (h)) * HTB)
#define PG8_STAGE(bufoff, gbase, voff) do { _Pragma("unroll") for (int _i = 0; _i < 2; ++_i) \
        __builtin_amdgcn_global_load_lds((const unsigned*)((const char*)(gbase) + (voff)[_i]), (LAS unsigned*)(lds + (bufoff) + ldsw + _i * 8192), 16, 0, 0); } while (0)
#define PG8_STAGE_A(bufoff, ap, ao, h) do { if constexpr (GATHER) PG8_STAGE(bufoff, ap, (ao)[h]); else PG8_STAGE(bufoff, (ap) + (size_t)(h) * hstep, voffA); } while (0)
#define PG8_LDA(dst, b, h) do { _Pragma("unroll") for (int m = 0; m < 4; ++m) _Pragma("unroll") for (int k = 0; k < 2; ++k) dst[m][k] = *(const LAS bf16x8*)(lds + PG8_SA(b, h) + aoff + m * 2048 + k * 1024); } while (0)
#define PG8_LDB(dst, b, h) do { _Pragma("unroll") for (int n = 0; n < 2; ++n) _Pragma("unroll") for (int k = 0; k < 2; ++k) dst[n][k] = *(const LAS bf16x8*)(lds + PG8_SB(b, h) + boff + n * 2048 + k * 1024); } while (0)
#define PG8_MMA(ai, bj, At, Bt) do { __builtin_amdgcn_s_setprio(1); _Pragma("unroll") for (int m = 0; m < 4; ++m) _Pragma("unroll") for (int n = 0; n < 2; ++n) _Pragma("unroll") for (int k = 0; k < 2; ++k) \
        acc[ai][bj][m][n] = __builtin_amdgcn_mfma_f32_16x16x32_bf16(Bt[n][k], At[m][k], acc[ai][bj][m][n], 0, 0, 0); __builtin_amdgcn_s_setprio(0); } while (0)
#define PG8_UCOPY(d, s_) do { (d).A = (s_).A; (d).B = (s_).B; (d).row0 = (s_).row0; (d).pn = (s_).pn; (d).e = (s_).e; (d).nvalid = (s_).nvalid; (d).tb0 = (s_).tb0; } while (0)
#define PG8_WAIT_V(n) asm volatile("s_waitcnt vmcnt(" #n ")" ::: "memory")
#define PG8_WAIT_L(n) asm volatile("s_waitcnt lgkmcnt(" #n ")" ::: "memory")
#define PG8_BAR __builtin_amdgcn_s_barrier()
#define PG8_SCHED __builtin_amdgcn_sched_barrier(0)
    Unit cur, nxt; int ui = 0;
    int pend = -1;
    if (!S.next(0, cur)) return;
    if constexpr (GATHER) S.first_rows(cur);
    f32x4 acc[2][2][4][2];
    if constexpr (Epi::BINIT) E.init(acc, cur, wc, fq);
    else {
#pragma unroll
    for (int a = 0; a < 2; ++a)
#pragma unroll
        for (int b = 0; b < 2; ++b)
#pragma unroll
            for (int m = 0; m < 4; ++m)
#pragma unroll
                for (int n = 0; n < 2; ++n) acc[a][b][m][n] = (f32x4){0.f, 0.f, 0.f, 0.f};
    }
    bf16x8 At[4][2], B0[2][2], B1[2][2];
#ifndef PG8_SP2
#define PG8_SP2 1
#endif
#if PG8_SP2
    PG8_STAGE(PG8_SB(0, 0), cur.B, voffB); PG8_STAGE(PG8_SB(0, 1), cur.B + hstep, voffB); PG8_STAGE_A(PG8_SA(0, 0), cur.A, cur.ao, 0); PG8_STAGE_A(PG8_SA(0, 1), cur.A, cur.ao, 1);
    if (wr == 1) PG8_BAR;
    PG8_WAIT_V(2); PG8_BAR;
#else
    PG8_STAGE(PG8_SB(0, 0), cur.B, voffB); PG8_STAGE_A(PG8_SA(0, 0), cur.A, cur.ao, 0); PG8_STAGE(PG8_SB(0, 1), cur.B + hstep, voffB); PG8_STAGE_A(PG8_SA(0, 1), cur.A, cur.ao, 1);
    if (wr == 1) PG8_BAR;
    PG8_WAIT_V(4); PG8_BAR;
#endif
    PG8_STAGE(PG8_SB(1, 0), cur.B + kstep, voffB); PG8_STAGE_A(PG8_SA(1, 0), cur.A + kstep, cur.ao, 0); PG8_STAGE(PG8_SB(1, 1), cur.B + hstep + kstep, voffB);
    PG8_WAIT_V(6); PG8_BAR;
    for (;;) {
        const bool has_next = S.next(ui + 1, nxt);
        if constexpr (GATHER) { if (has_next && wid < 4) S.prefetch_rows(nxt, (LAS unsigned*)(lds + LDS_TOKB + ((ui + 1) & 1) * 1024 + wid * 256), wid, lane); }
        if constexpr (Sched::HOOKS) { if (has_next) S.poll(nxt, (LAS unsigned*)(lds + LDS_BARW + 32 + wid * 4), lane); }
        if (!has_next) { PG8_UCOPY(nxt, cur); }
        for (int t = 0; t < nt; t += 2) {
            const bool last = (t == nt - 2);
            if constexpr (Sched::HOOKS) {
                if (t == 2 && pend >= 0) { S.publish(pend, lane); pend = -1; }
                if (last && has_next) S.a_ready(nxt, (const LAS unsigned*)(lds + LDS_BARW + 32 + wid * 4));
            }
            const char* a1 = cur.A + (size_t)(t + 1) * kstep;
            const char* a2 = last ? nxt.A : cur.A + (size_t)(t + 2) * kstep; const char* b2 = last ? nxt.B : cur.B + (size_t)(t + 2) * kstep;
            const char* a3 = a2 + kstep; const char* b3 = b2 + kstep;
            unsigned o2[2][2];
            if constexpr (GATHER) {
                const LAS int* tb = (const LAS int*)(lds + LDS_TOKB + ((ui + 1) & 1) * 1024);
#pragma unroll
                for (int q = 0; q < 2; ++q) { int R, C; stage_rc(tid * 16 + q * 8192, R, C);
#pragma unroll
                    for (int h = 0; h < 2; ++h) { const int i = h * HALF + R; const int tk = i < nxt.nvalid ? tb[i] : 0; o2[h][q] = (last && has_next) ? (unsigned)(tk * K + C) * 2u : cur.ao[h][q]; } }
            }
#if !PG8_SP2
            PG8_LDB(B0, 0, 0); PG8_SCHED; PG8_LDA(At, 0, 0); PG8_STAGE_A(PG8_SA(1, 1), a1, cur.ao, 1);
            PG8_WAIT_L(8); PG8_BAR; PG8_WAIT_L(0); PG8_MMA(0, 0, At, B0); PG8_BAR; PG8_SCHED;
            PG8_LDB(B1, 0, 1); PG8_STAGE(PG8_SB(0, 0), b2, voffB);
            PG8_BAR; PG8_WAIT_L(0); PG8_MMA(0, 1, At, B1); PG8_BAR;
            PG8_LDA(At, 0, 1); PG8_STAGE_A(PG8_SA(0, 0), a2, o2, 0);
            PG8_BAR; PG8_WAIT_L(0); PG8_MMA(1, 0, At, B0); PG8_BAR; PG8_SCHED;
            PG8_STAGE(PG8_SB(0, 1), b2 + hstep, voffB);
            PG8_WAIT_V(6); PG8_BAR; PG8_MMA(1, 1, At, B1); PG8_BAR;
            PG8_LDB(B0, 1, 0); PG8_SCHED; PG8_LDA(At, 1, 0); PG8_STAGE_A(PG8_SA(0, 1), a2, o2, 1);
            PG8_WAIT_L(8); PG8_BAR; PG8_WAIT_L(0); PG8_MMA(0, 0, At, B0); PG8_BAR; PG8_SCHED;
            PG8_LDB(B1, 1, 1); PG8_STAGE(PG8_SB(1, 0), b3, voffB);
            PG8_BAR; PG8_WAIT_L(0); PG8_MMA(0, 1, At, B1); PG8_BAR;
            PG8_LDA(At, 1, 1); PG8_STAGE_A(PG8_SA(1, 0), a3, o2, 0);
            PG8_BAR; PG8_WAIT_L(0); PG8_MMA(1, 0, At, B0); PG8_BAR; PG8_SCHED;
            PG8_STAGE(PG8_SB(1, 1), b3 + hstep, voffB);
            PG8_WAIT_V(6); PG8_BAR; PG8_MMA(1, 1, At, B1); PG8_BAR;
#else
            PG8_LDB(B0, 0, 0); PG8_LDB(B1, 0, 1); PG8_SCHED; PG8_LDA(At, 0, 0); PG8_STAGE_A(PG8_SA(1, 1), a1, cur.ao, 1);
            PG8_WAIT_V(8); PG8_WAIT_L(0); PG8_BAR; PG8_MMA(0, 0, At, B0); PG8_MMA(0, 1, At, B1); PG8_BAR; PG8_SCHED;
            PG8_LDA(At, 0, 1); PG8_STAGE(PG8_SB(0, 0), b2, voffB); PG8_STAGE(PG8_SB(0, 1), b2 + hstep, voffB); PG8_STAGE_A(PG8_SA(0, 0), a2, o2, 0);
            PG8_WAIT_V(8); PG8_WAIT_L(0); PG8_BAR; PG8_MMA(1, 0, At, B0); PG8_MMA(1, 1, At, B1); PG8_BAR; PG8_SCHED;
            PG8_LDB(B0, 1, 0); PG8_LDB(B1, 1, 1); PG8_SCHED; PG8_LDA(At, 1, 0); PG8_STAGE_A(PG8_SA(0, 1), a2, o2, 1);
            PG8_WAIT_V(8); PG8_WAIT_L(0); PG8_BAR; PG8_MMA(0, 0, At, B0); PG8_MMA(0, 1, At, B1); PG8_BAR; PG8_SCHED;
            PG8_LDA(At, 1, 1); PG8_STAGE(PG8_SB(1, 0), b3, voffB); PG8_STAGE(PG8_SB(1, 1), b3 + hstep, voffB); PG8_STAGE_A(PG8_SA(1, 0), a3, o2, 0);
            PG8_WAIT_V(8); PG8_WAIT_L(0); PG8_BAR; PG8_MMA(1, 0, At, B0); PG8_MMA(1, 1, At, B1); PG8_BAR; PG8_SCHED;
#endif
        }
        if (wr == 0) PG8_BAR;
        E(acc, cur, wr, wc, fr, fq);
        if constexpr (Sched::HOOKS) pend = S.pub_tile(cur);
        if (!has_next) break;
        PG8_UCOPY(cur, nxt); ++ui;
        if constexpr (Epi::BINIT) E.init(acc, cur, wc, fq);
        else {
#pragma unroll
        for (int a = 0; a < 2; ++a)
#pragma unroll
            for (int b = 0; b < 2; ++b)
#pragma unroll
                for (int m = 0; m < 4; ++m)
#pragma unroll
                    for (int n = 0; n < 2; ++n) acc[a][b][m][n] = (f32x4){0.f, 0.f, 0.f, 0.f};
        }
        if constexpr (GATHER) {
            const LAS int* tb = (const LAS int*)(lds + LDS_TOKB + (ui & 1) * 1024);
#pragma unroll
            for (int q = 0; q < 2; ++q) { int R, C; stage_rc(tid * 16 + q * 8192, R, C);
#pragma unroll
                for (int h = 0; h < 2; ++h) { const int i = h * HALF + R; const int tk = i < cur.nvalid ? tb[i] : 0; cur.ao[h][q] = (unsigned)(tk * K + C) * 2u; } }
        }
        if (wr == 1) PG8_BAR;
    }
    PG8_WAIT_V(0);
    if constexpr (Sched::HOOKS) { if (pend >= 0) S.publish(pend, lane); }
    PG8_BAR;
#undef PG8_SA
#undef PG8_SB
#undef PG8_STAGE
#undef PG8_STAGE_A
#undef PG8_LDA
#undef PG8_LDB
#undef PG8_MMA
#undef PG8_WAIT_V
#undef PG8_UCOPY
#undef PG8_WAIT_L
#undef PG8_BAR
#undef PG8_SCHED
}

struct DenseSched {
    static constexpr bool GATHER = false, HOOKS = false;
    const char* A; const char* Bt; int K, nM, nN, nwg, G, c;
    __device__ __forceinline__ void init(const void* A_, const void* Bt_, int M, int N, int K_) {
        A = uptr((const char*)A_); Bt = uptr((const char*)Bt_); K = K_; nM = M / BM; nN = N / BM; nwg = nM * nN; G = gridDim.x; c = blockIdx.x;
    }
    __device__ __forceinline__ bool next(int i, Unit& u) const {
        const long L = (long)i * G + c; if (L >= nwg) return false;
        const int wgid = xcd_remap((int)L, nwg);
        const int nig = WGM * nN, gid = wgid / nig, fm = gid * WGM, gsz = (nM - fm) < WGM ? (nM - fm) : WGM;
        const int pm = fm + ((wgid % nig) % gsz), pn = (wgid % nig) / gsz;
        u.A = A + (size_t)pm * BM * K * 2; u.B = Bt + (size_t)pn * BM * K * 2; u.row0 = pm * BM; u.pn = pn; u.e = 0; u.nvalid = BM; u.tb0 = 0;
        return true;
    }
};
template <bool GATHER_>
struct MoeSched {
    static constexpr bool GATHER = GATHER_, HOOKS = false;
    const char* A; const char* W; int K, nN, rows_per_e, nwg, G, c; const int* ps; const int* cn; const int* tok;
    __device__ __forceinline__ void init(const void* A_, const void* W_, int K_, int nN_, int rows_per_e_, const int* ps_, const int* tok_) {
        A = uptr((const char*)A_); W = uptr((const char*)W_); K = K_; nN = nN_; rows_per_e = rows_per_e_; ps = ps_; cn = ps_ + (LDS_CNT - LDS_PS) / 4; tok = (const int*)uptr((const char*)tok_); G = gridDim.x; c = blockIdx.x;
        nwg = __builtin_amdgcn_readfirstlane((ps[NE] >> 8) * nN);
    }
    __device__ __forceinline__ bool next(int i, Unit& u) const {
        const long L = (long)i * G + c; if (L >= nwg) return false;
        const int wgid = xcd_remap((int)L, nwg);
        const int rt = wgid / nN, pn = wgid % nN, slot0 = rt * BM;
        int e = 0;
        for (int q = 1; q < NE; ++q) e = (ps[q] <= slot0) ? q : e;
        e = __builtin_amdgcn_readfirstlane(e);
        u.B = W + ((size_t)e * rows_per_e + (size_t)pn * BM) * K * 2; u.row0 = slot0; u.pn = pn; u.e = e;
        const int pos0 = __builtin_amdgcn_readfirstlane(slot0 - ps[e]);
        u.nvalid = __builtin_amdgcn_readfirstlane(cn[e]) - pos0; u.tb0 = e * T + pos0;
        if constexpr (GATHER) u.A = A; else u.A = A + (size_t)slot0 * K * 2;
        return true;
    }
    __device__ __forceinline__ void first_rows(Unit& u) const {
#pragma unroll
        for (int q = 0; q < 2; ++q) { int R, C; stage_rc(threadIdx.x * 16 + q * 8192, R, C);
#pragma unroll
            for (int h = 0; h < 2; ++h) { const int i = h * HALF + R; const int tk = i < u.nvalid ? tok[u.tb0 + i] : 0; u.ao[h][q] = (unsigned)(tk * K + C) * 2u; } }
    }
    __device__ __forceinline__ void prefetch_rows(const Unit& u, LAS unsigned* dst, int wid, int lane) const {
        __builtin_amdgcn_global_load_lds((const unsigned*)(tok + u.tb0 + wid * 64 + lane), dst, 4, 0, 0);
    }
};
struct MoeSched2 {
    static constexpr bool GATHER = true, HOOKS = true;
    const char* ws; int K, nU, nwg, G, c, rt0; const int* ps; const int* cn; const int* tok; GAS int* upcnt;
    __device__ __forceinline__ void init(unsigned char* ws_, const int* ps_, int nloc, int rank, int base) {
        ws = uptr((const char*)ws_); K = D; ps = ps_; cn = ps_ + (LDS_CNT - LDS_PS) / 4; tok = (const int*)(ws + WS_TOK); upcnt = (GAS int*)(ws + WS_CTL) + CW_UPCNT;
        G = __builtin_amdgcn_readfirstlane(nloc); c = __builtin_amdgcn_readfirstlane(rank);
        const int rt = __builtin_amdgcn_readfirstlane(ps[NE] >> 8), gt = gridDim.x;
        rt0 = __builtin_amdgcn_readfirstlane(rt * base / gt); const int rt1 = __builtin_amdgcn_readfirstlane(rt * (base + nloc) / gt);
        nU = (rt1 - rt0) * 8; nwg = (rt1 - rt0) * 12;
    }
    __device__ __forceinline__ bool next(int i, Unit& u) const {
        const int L = i * G + c; if (L >= nwg) return false;
        const bool dn = L >= nU;
        const int wgid = dn ? L - nU : L;
        const int rt = rt0 + (dn ? wgid >> 2 : wgid >> 3), pn = dn ? wgid & 3 : wgid & 7, slot0 = rt * BM;
        int e = 0;
        for (int q = 1; q < NE; ++q) e = (ps[q] <= slot0) ? q : e;
        e = __builtin_amdgcn_readfirstlane(e);
        u.row0 = slot0; u.pn = pn;
        const int pos0 = __builtin_amdgcn_readfirstlane(slot0 - ps[e]);
        if (dn) { u.B = ws + WS_WDT + ((size_t)e * 1024 + (size_t)pn * BM) * (size_t)(D * 2); u.A = ws + WS_ACT; u.e = e | 32; u.nvalid = BM; u.tb0 = (int)((WS_IDT - WS_TOK) / 4) + slot0; }
        else    { u.B = ws + WS_WGUT + ((size_t)e * 2048 + (size_t)pn * BM) * (size_t)(D * 2); u.A = ws + WS_H; u.e = e; u.nvalid = __builtin_amdgcn_readfirstlane(cn[e]) - pos0; u.tb0 = e * T + pos0; }
        return true;
    }
    __device__ __forceinline__ void first_rows(Unit& u) const {
#pragma unroll
        for (int q = 0; q < 2; ++q) { int R, C; stage_rc(threadIdx.x * 16 + q * 8192, R, C);
#pragma unroll
            for (int h = 0; h < 2; ++h) { const int i = h * HALF + R; const int tk = i < u.nvalid ? tok[u.tb0 + i] : 0; u.ao[h][q] = (unsigned)(tk * K + C) * 2u; } }
    }
    __device__ __forceinline__ void prefetch_rows(const Unit& u, LAS unsigned* dst, int wid, int lane) const {
        __builtin_amdgcn_global_load_lds((const unsigned*)(tok + u.tb0 + wid * 64 + lane), dst, 4, 0, 0);
    }
    __device__ __forceinline__ void poll(const Unit& u, LAS unsigned* w, int lane) const {
        if (u.e >= 32 && lane == 0) __builtin_amdgcn_global_load_lds((const GAS unsigned*)(upcnt + (u.row0 >> 8)), w, 4, 0, 16  );
    }
    __device__ __forceinline__ void a_ready(const Unit& u, const LAS unsigned* w) const {
        if (u.e >= 32) {
            const int rdy = __builtin_amdgcn_readfirstlane((int)*w);
            if (rdy < 64) { const GAS int* cp = upcnt + (u.row0 >> 8); int spins = 0;
                while (__hip_atomic_load(cp, __ATOMIC_RELAXED, __HIP_MEMORY_SCOPE_AGENT) < 64 && ++spins < (1 << 22)) __builtin_amdgcn_s_sleep(4); }
            asm volatile("" ::: "memory");
        }
    }
    __device__ __forceinline__ int pub_tile(const Unit& u) const { return u.e < 32 ? (u.row0 >> 8) : -1; }
    __device__ __forceinline__ void publish(int rt, int lane) const { if (lane == 0) __hip_atomic_fetch_add(upcnt + rt, 1, __ATOMIC_RELAXED, __HIP_MEMORY_SCOPE_AGENT); }
};
}

__device__ __forceinline__ int win_row(int oc) {
    if (oc >= 1024) return oc;
    const int base = oc & ~511, o = oc & 511;
    return base + 32 * ((o >> 6) * 2 + ((o & 31) >> 4)) + 8 * ((o & 15) >> 2) + 4 * ((o >> 5) & 1) + (o & 3);
}
__device__ __forceinline__ int wgu_row(int oc) { const int jj = oc >> 1, il = oc & 1; return 256 * (jj >> 7) + 128 * ((jj >> 2) & 1) + 32 * ((jj >> 5) & 3) + 8 * ((jj >> 3) & 3) + 4 * il + (jj & 3); }

struct CvtItem { const float* W; bf16_t* WT; int ldw, nvalid, K, k0, n0, map; };
__device__ __forceinline__ void cvt_load(const CvtItem& it, int lane, float4 (&v)[8]) {
    const int col = it.n0 + (lane & 7) * 4;
    const float* src = it.W + (size_t)(it.k0 + (lane >> 3)) * it.ldw + col;
#pragma unroll
    for (int i = 0; i < 8; ++i) { const f32x4 t = (col < it.nvalid) ? __builtin_nontemporal_load((const f32x4*)(src + (size_t)(8 * i) * it.ldw)) : (f32x4){0.f, 0.f, 0.f, 0.f};
        v[i] = make_float4(t[0], t[1], t[2], t[3]); }
}
__device__ __forceinline__ void cvt_store(const CvtItem& it, int lane, const float4 (&v)[8], float* scr) {
    const int r8 = lane >> 3, c4 = (lane & 7) * 4;
#pragma unroll
    for (int i = 0; i < 8; ++i) { float* d = scr + (8 * i + r8) * 33 + c4; d[0] = v[i].x; d[1] = v[i].y; d[2] = v[i].z; d[3] = v[i].w; }
    asm volatile("s_waitcnt lgkmcnt(0)" ::: "memory");
    const int c = lane & 7;
#pragma unroll
    for (int j = 0; j < 4; ++j) { const int n = (lane >> 3) + 8 * j; const float* s = scr + (8 * c) * 33 + n;
        uint4 o; o.x = pk2(s[0 * 33], s[1 * 33]); o.y = pk2(s[2 * 33], s[3 * 33]); o.z = pk2(s[4 * 33], s[5 * 33]); o.w = pk2(s[6 * 33], s[7 * 33]);
        const int oc = it.n0 + n;
        const int orow = it.map == 1 ? win_row(oc) : (it.map == 2 ? wgu_row(oc) : oc);
        ntstore4u((uint4*)(it.WT + (size_t)orow * it.K + it.k0 + 8 * c), o); }
    asm volatile("s_waitcnt lgkmcnt(0)" ::: "memory");
}
__device__ void phase_prep(const Params& p, unsigned char* lds) {
    const int tid = threadIdx.x, lane = tid & 63, wave = tid >> 6;
    unsigned char* ws = p.ws;
    for (int i = blockIdx.x * NTHREADS + tid; i < PMAX; i += gridDim.x * NTHREADS) ((int*)(ws + WS_IDT))[i] = i;
    if ((int)blockIdx.x < 192) {
        float* sl = (float*)lds;
        float* red = sl + 2048;
        for (int i = tid; i < 2048; i += NTHREADS) sl[i] = fsilu(p.c[i]);
        __syncthreads();
        for (int it = blockIdx.x; it < 192; it += gridDim.x) {
            const int col = it * 32 + (tid & 31), kg = tid >> 5;
            float a0 = 0.f, a1 = 0.f;
#pragma unroll 8
            for (int kk = 0; kk < 64; ++kk) { const int k = kg * 64 + kk; const float w = __builtin_nontemporal_load(p.w_mod + (size_t)k * 6144 + col); a0 += sl[k] * w; a1 += sl[1024 + k] * w; }
            red[(kg * 32 + (tid & 31)) * 2 + 0] = a0; red[(kg * 32 + (tid & 31)) * 2 + 1] = a1;
            __syncthreads();
            if (tid < 64) { const int b = tid >> 5, cg_ = tid & 31; float s = 0.f;
#pragma unroll
                for (int g = 0; g < 16; ++g) s += red[(g * 32 + cg_) * 2 + b];
                const int cc = it * 32 + cg_;
                __hip_atomic_store((float*)(ws + WS_MOD) + b * 6144 + cc, s + p.b_mod[cc], __ATOMIC_RELAXED, __HIP_MEMORY_SCOPE_AGENT);
                asm volatile("s_waitcnt vmcnt(0)" ::: "memory"); }
            __syncthreads();
            if (tid == 0) __hip_atomic_fetch_add((unsigned*)(ws + WS_CTL) + CW_MODCNT, 1u, __ATOMIC_RELAXED, __HIP_MEMORY_SCOPE_AGENT);
        }
    }
    __syncthreads();
    {
        float2* rope = (float2*)(ws + WS_ROPE);
        for (int i = blockIdx.x * NTHREADS + tid; i < S * 32; i += gridDim.x * NTHREADS) {
            const int pos = i >> 5, d = i & 31;
            const float angf = (float)pos * p.inv_freq[d];
            const double ang = (double)angf;
            const double TWO_PI = 6.283185307179586476925286766559, HALF_PI = 1.5707963267948966192313216916398;
            const double n = __builtin_rint(ang / TWO_PI);
            const double rr = ang - n * TWO_PI;
            const double q = __builtin_rint(rr / HALF_PI);
            const double y = rr - q * HALF_PI;
            const double y2 = y * y;
            const double sy = y * (1.0 + y2 * (-1.0 / 6 + y2 * (1.0 / 120 + y2 * (-1.0 / 5040 + y2 * (1.0 / 362880 + y2 * (-1.0 / 39916800 + y2 * (1.0 / 6227020800.0)))))));
            const double cy = 1.0 + y2 * (-0.5 + y2 * (1.0 / 24 + y2 * (-1.0 / 720 + y2 * (1.0 / 40320 + y2 * (-1.0 / 3628800 + y2 * (1.0 / 479001600.0))))));
            const int qi = ((int)q) & 3;
            double cs, sn;
            if (qi == 0) { cs = cy; sn = sy; } else if (qi == 1) { cs = -sy; sn = cy; } else if (qi == 2) { cs = -cy; sn = -sy; } else { cs = sy; sn = -cy; }
            rope[i] = make_float2((float)cs, (float)sn);
        }
    }
    {
        float* scr = (float*)(lds + wave * 8448);
        const int gw = blockIdx.x * NW + wave, ngw = gridDim.x * NW;
        constexpr int I_IN = 16 * 97, I_OUT = 16 * 32, I_GU = 16 * 64, I_DN = 16 * 32;
        constexpr int NITEMS = I_IN + I_OUT + NE * I_GU + NE * I_DN;
        auto decode = [&](int r, CvtItem& it) {
            if (r < I_IN) { it.W = p.w_in; it.WT = (bf16_t*)(ws + WS_WINT); it.ldw = DIN; it.nvalid = DIN; it.K = D; it.k0 = (r / 97) * 64; it.n0 = (r % 97) * 32; it.map = 1; return; }
            r -= I_IN;
            if (r < I_OUT) { it.W = p.w_out; it.WT = (bf16_t*)(ws + WS_WOUTT); it.ldw = D; it.nvalid = D; it.K = D; it.k0 = (r / 32) * 64; it.n0 = (r % 32) * 32; it.map = 0; return; }
            r -= I_OUT;
            if (r < NE * I_GU) { const int e = r / I_GU, q = r % I_GU;
                it.W = p.w_gate_up + (size_t)e * D * 2048; it.WT = (bf16_t*)(ws + WS_WGUT) + (size_t)e * 2048 * D; it.ldw = 2048; it.nvalid = 2048; it.K = D; it.k0 = (q / 64) * 64; it.n0 = (q % 64) * 32; it.map = 2; return; }
            r -= NE * I_GU;
            { const int e = r / I_DN, q = r % I_DN;
                it.W = p.w_down + (size_t)e * DFF * D; it.WT = (bf16_t*)(ws + WS_WDT) + (size_t)e * D * DFF; it.ldw = D; it.nvalid = D; it.K = DFF; it.k0 = (q / 32) * 64; it.n0 = (q % 32) * 32; it.map = 0; }
        };
        if (gw < NITEMS) {
            CvtItem cur, nxt; float4 vc[8], vn[8];
            decode(gw, cur); cvt_load(cur, lane, vc);
            for (int r = gw; r < NITEMS; r += ngw) {
                const bool more = r + ngw < NITEMS;
                if (more) { decode(r + ngw, nxt); cvt_load(nxt, lane, vn); }
                cvt_store(cur, lane, vc, scr);
                if (more) { cur = nxt;
#pragma unroll
                    for (int i = 0; i < 8; ++i) vc[i] = vn[i]; }
            }
        }
    }
}

__device__ void phase_prenorm(const Params& p) {
    const int tid = threadIdx.x, lane = tid & 63, wave = tid >> 6;
    if (tid == 0) {
        unsigned* cnt = (unsigned*)(p.ws + WS_CTL) + CW_MODCNT; unsigned sp = 0;
        while (__hip_atomic_load(cnt, __ATOMIC_RELAXED, __HIP_MEMORY_SCOPE_AGENT) < 192u) { __builtin_amdgcn_s_sleep(2); if (++sp > (1u << 20)) break; }
        __builtin_amdgcn_fence(__ATOMIC_ACQUIRE, "agent");
        asm volatile("s_waitcnt vmcnt(0)" ::: "memory");
    }
    __syncthreads();
    const float* mod = (const float*)(p.ws + WS_MOD);
    bf16_t* H = (bf16_t*)(p.ws + WS_H);
    for (int m0 = (blockIdx.x * NW + wave) * 2; m0 < T; m0 += gridDim.x * NW * 2) {
        float4 v[2][4];
#pragma unroll
        for (int q = 0; q < 2; ++q) { const float4* xr = (const float4*)(p.x + (size_t)(m0 + q) * D) + lane;
#pragma unroll
            for (int j = 0; j < 4; ++j) v[q][j] = ntload4(xr + 64 * j); }
#pragma unroll
        for (int q = 0; q < 2; ++q) {
            const int m = m0 + q, b = m >> 13;
            float ss = 0.f;
#pragma unroll
            for (int j = 0; j < 4; ++j) ss += v[q][j].x * v[q][j].x + v[q][j].y * v[q][j].y + v[q][j].z * v[q][j].z + v[q][j].w * v[q][j].w;
            const float rstd = rsqrtf(wave_sum(ss) * (1.f / D) + EPS);
#pragma unroll
            for (int j = 0; j < 4; ++j) { const int c = 4 * lane + 256 * j;
                const float4 g = *(const float4*)(p.g_pre_mix + c), sh = *(const float4*)(mod + b * 6144 + c), sc = *(const float4*)(mod + b * 6144 + 1024 + c);
                const float h0 = v[q][j].x * rstd * g.x * (1.f + sc.x) + sh.x, h1 = v[q][j].y * rstd * g.y * (1.f + sc.y) + sh.y;
                const float h2 = v[q][j].z * rstd * g.z * (1.f + sc.z) + sh.z, h3 = v[q][j].w * rstd * g.w * (1.f + sc.w) + sh.w;
                uint2 o; o.x = pk2(h0, h1); o.y = pk2(h2, h3);
                *(uint2*)(H + (size_t)m * D + c) = o; }
        }
    }
}

struct EpiIn {
    static constexpr bool PERM = true, BINIT = false;
    unsigned char* ws;
    __device__ __forceinline__ void operator()(const f32x4 (&acc)[2][2][4][2], const pg8::Unit& u, int wr, int wc, int fr, int fq) const {
        const int cbase = u.pn * 256;
        if (cbase < 1024) {
            const bool isq = cbase < 512;
            bf16_t* dst = (bf16_t*)(ws + (isq ? WS_QA : WS_KA));
            const float2* rope = (const float2*)(ws + WS_ROPE);
            const float scl = isq ? 0.125f * LOG2E : 1.f;
#pragma unroll
            for (int bj = 0; bj < 2; ++bj) {
                const int grp = ((cbase & 511) >> 5) + 4 * bj + wc, head = grp >> 1, dl = (grp & 1) * 16 + 4 * fq;
#pragma unroll
                for (int ai = 0; ai < 2; ++ai)
#pragma unroll
                    for (int m = 0; m < 4; ++m) { const int row = u.row0 + 128 * ai + 64 * wr + 16 * m + fr, pos = row & (S - 1);
                        const float4 c01 = *(const float4*)(rope + pos * 32 + dl), c23 = *(const float4*)(rope + pos * 32 + dl + 2);
                        const f32x4 x1 = acc[ai][bj][m][0], x2 = acc[ai][bj][m][1];
                        uint2 lo, hi;
                        lo.x = pk2((x1[0] * c01.x - x2[0] * c01.y) * scl, (x1[1] * c01.z - x2[1] * c01.w) * scl);
                        lo.y = pk2((x1[2] * c23.x - x2[2] * c23.y) * scl, (x1[3] * c23.z - x2[3] * c23.w) * scl);
                        hi.x = pk2((x2[0] * c01.x + x1[0] * c01.y) * scl, (x2[1] * c01.z + x1[1] * c01.w) * scl);
                        hi.y = pk2((x2[2] * c23.x + x1[2] * c23.y) * scl, (x2[3] * c23.z + x1[3] * c23.w) * scl);
                        const int bh = (row >> 13) * 8 + head;
                        bf16_t* o = dst + ((size_t)(bh * S + (pos & 15) * 512 + (pos >> 4)) * 64 + dl); *(uint2*)o = lo; *(uint2*)(o + 32) = hi; }
            }
        } else {
            bf16_t* dst; int ldc, cb;
            if (cbase < 1536) { dst = (bf16_t*)(ws + WS_VA); ldc = 512; cb = cbase - 1024; }
            else if (cbase < 1792) { dst = (bf16_t*)(ws + WS_QG); ldc = 256; cb = cbase - 1536; }
            else if (cbase < 2048) { dst = (bf16_t*)(ws + WS_KG); ldc = 256; cb = cbase - 1792; }
            else if (cbase < 2560) { dst = (bf16_t*)(ws + WS_VG); ldc = 512; cb = cbase - 2048; }
            else { dst = (bf16_t*)(ws + WS_RG); ldc = 512; cb = cbase - 2560; }
#pragma unroll
            for (int ai = 0; ai < 2; ++ai)
#pragma unroll
                for (int m = 0; m < 4; ++m) { const int row = u.row0 + 128 * ai + 64 * wr + 16 * m + fr;
#pragma unroll
                    for (int bj = 0; bj < 2; ++bj) { const f32x4 v0 = acc[ai][bj][m][0], v1 = acc[ai][bj][m][1];
                        u32x4 w; w.x = pk2(v0[0], v0[1]); w.y = pk2(v0[2], v0[3]); w.z = pk2(v1[0], v1[1]); w.w = pk2(v1[2], v1[3]);
                        *(u32x4*)(dst + (size_t)row * ldc + cb + 128 * bj + 32 * wc + 8 * fq) = w; } }
        }
    }
};

__device__ void phase_gemm_in(const Params& p, unsigned char* lds) {
    unsigned char* ws = p.ws;
    {
        pg8::DenseSched Sd; Sd.init(ws + WS_H, ws + WS_WINT, T, 3072, D);
        EpiIn E{ws};
        pg8::gemm_phase<EpiIn, pg8::DenseSched>((LAS unsigned char*)lds, D, Sd, E);
    }
    const int tid = threadIdx.x, lane = tid & 63, wave = tid >> 6, fr = lane & 15, fq = lane >> 4;
    const bf16_t* H = (const bf16_t*)(ws + WS_H); const bf16_t* Wl = (const bf16_t*)(ws + WS_WINT) + (size_t)3072 * D;
    float* glr = (float*)(ws + WS_GLR);
    float* part = (float*)lds;
    for (int item = blockIdx.x; item < T / 64; item += gridDim.x) {
        const int mt = wave & 3, kh = wave >> 2, r0 = item * 64 + mt * 16;
        f32x4 a = (f32x4){0.f, 0.f, 0.f, 0.f};
        const bf16_t* ap = H + (size_t)(r0 + fr) * D + kh * 512 + fq * 8;
        const bf16_t* bp = Wl + (size_t)fr * D + kh * 512 + fq * 8;
#pragma unroll 4
        for (int ks = 0; ks < 16; ++ks) a = __builtin_amdgcn_mfma_f32_16x16x32_bf16(*(const bf16x8*)(ap + ks * 32), *(const bf16x8*)(bp + ks * 32), a, 0, 0, 0);
        __syncthreads();
        if (kh == 1) {
#pragma unroll
            for (int j = 0; j < 4; ++j) part[(mt * 16 + 4 * fq + j) * 16 + fr] = a[j];
        }
        __syncthreads();
        if (kh == 0) {
#pragma unroll
            for (int j = 0; j < 4; ++j) glr[(size_t)(r0 + 4 * fq + j) * 16 + fr] = a[j] + part[(mt * 16 + 4 * fq + j) * 16 + fr];
        }
    }
    __syncthreads();
}

__device__ void vtrans_items(const Params& p, unsigned char* lds) {
    const int tid = threadIdx.x;
    unsigned char* ws = p.ws;
    const bf16_t* VA = (const bf16_t*)(ws + WS_VA);
    bf16_t* vb = (bf16_t*)(ws + WS_VB);
    constexpr int VS = 72;
    bf16_t* tile = (bf16_t*)lds;
    for (int item = blockIdx.x; item < 512; item += gridDim.x) {
        const int bh = item >> 5, blk = item & 31, b = bh >> 3, h = bh & 7, pos0 = blk * 256;
        { const int tok = tid >> 1, hf = tid & 1;
          const uint4* src = (const uint4*)(VA + (size_t)(b * S + pos0 + tok) * 512 + h * 64 + hf * 32);
          uint4 v0 = src[0], v1 = src[1], v2 = src[2], v3 = src[3];
          uint4* d = (uint4*)(tile + tok * VS + hf * 32);
          d[0] = v0; d[1] = v1; d[2] = v2; d[3] = v3; }
        __syncthreads();
        const int dv = tid >> 3, l8 = tid & 7;
#pragma unroll
        for (int cc = 0; cc < 2; ++cc) { const int cls = 2 * l8 + cc;
#pragma unroll
            for (int hh = 0; hh < 2; ++hh) { unsigned w[4];
#pragma unroll
                for (int i = 0; i < 4; ++i) w[i] = (unsigned)tile[(16 * (hh * 8 + 2 * i) + cls) * VS + dv] | ((unsigned)tile[(16 * (hh * 8 + 2 * i + 1) + cls) * VS + dv] << 16);
                const int blkidx = (bh * S + cls * 512 + 16 * blk + hh * 8) >> 3;
                *(uint4*)(vb + ((size_t)blkidx * 64 + dv) * 8) = make_uint4(w[0], w[1], w[2], w[3]); } }
        __syncthreads();
    }
}

struct AttnFrag { bf16x8 ka[4], vf[4]; };
__device__ __forceinline__ void attn_load(AttnFrag& f, const bf16_t* kp, const bf16_t* vp) {
    f.ka[0] = *(const bf16x8*)kp; f.ka[1] = *(const bf16x8*)(kp + 32); f.ka[2] = *(const bf16x8*)(kp + 256); f.ka[3] = *(const bf16x8*)(kp + 288);
#pragma unroll
    for (int n = 0; n < 4; ++n) f.vf[n] = *(const bf16x8*)(vp + n * 128);
}
struct AttnState { float m, l; f32x4 o[4]; bf16x8 q0, q1; };
__device__ __forceinline__ float max2a(float a, float b) { float r; asm("v_max_f32_e32 %0, %1, %2" : "=v"(r) : "v"(a), "v"(b)); return r; }
__device__ __forceinline__ float max3a(float a, float b, float c) { float r; asm("v_max3_f32 %0, %1, %2, %3" : "=v"(r) : "v"(a), "v"(b), "v"(c)); return r; }
__device__ __forceinline__ float rowmax4(float x) {
    const unsigned u = __builtin_bit_cast(unsigned, x);
    const auto a = __builtin_amdgcn_permlane16_swap(u, u, false, false);
    const float y = fmaxf(__builtin_bit_cast(float, a[0]), __builtin_bit_cast(float, a[1]));
    const unsigned v = __builtin_bit_cast(unsigned, y);
    const auto b = __builtin_amdgcn_permlane32_swap(v, v, false, false);
    return fmaxf(__builtin_bit_cast(float, b[0]), __builtin_bit_cast(float, b[1]));
}
template <bool FIRST>
__device__ __forceinline__ float attn_scores(const AttnFrag& f, const AttnState& t, const int d0, const int js, float (&sv)[8]) {
    const float nm = FIRST ? 0.f : -t.m;
    f32x4 st0 = (f32x4){nm, nm, nm, nm}, st1 = (f32x4){nm, nm, nm, nm};
    st0 = __builtin_amdgcn_mfma_f32_16x16x32_bf16(f.ka[0], t.q0, st0, 0, 0, 0);
    st0 = __builtin_amdgcn_mfma_f32_16x16x32_bf16(f.ka[1], t.q1, st0, 0, 0, 0);
    st1 = __builtin_amdgcn_mfma_f32_16x16x32_bf16(f.ka[2], t.q0, st1, 0, 0, 0);
    st1 = __builtin_amdgcn_mfma_f32_16x16x32_bf16(f.ka[3], t.q1, st1, 0, 0, 0);
#pragma unroll
    for (int j = 0; j < 8; ++j) { const bool vd = (unsigned)(d0 - (j << js)) <= 128u; const float x = (j < 4) ? st0[j] : st1[j - 4]; sv[j] = vd ? x : -3.0e38f; }
    float mx = max3a(max3a(sv[0], sv[1], sv[2]), max3a(sv[3], sv[4], sv[5]), max2a(sv[6], sv[7]));
    return rowmax4(mx);
}
__device__ __forceinline__ void attn_grow(AttnState& t, float (&sv)[8], const float mx) {
    const float gr = fmaxf(mx, 0.f), alpha = fexp2(-gr);
    t.m += gr;
#pragma unroll
    for (int j = 0; j < 8; ++j) sv[j] -= gr;
    t.l = t.l * alpha;
#pragma unroll
    for (int n = 0; n < 4; ++n) t.o[n] = t.o[n] * alpha;
}
__device__ __forceinline__ void attn_pv(const AttnFrag& f, AttnState& t, const float (&sv)[8]) {
    float pj[8];
#pragma unroll
    for (int j = 0; j < 8; ++j) pj[j] = fexp2(sv[j]);
    t.l += ((pj[0] + pj[1]) + (pj[2] + pj[3])) + ((pj[4] + pj[5]) + (pj[6] + pj[7]));
    u32x4 pw; pw.x = pk2(pj[0], pj[1]); pw.y = pk2(pj[2], pj[3]); pw.z = pk2(pj[4], pj[5]); pw.w = pk2(pj[6], pj[7]);
    const bf16x8 pf = __builtin_bit_cast(bf16x8, pw);
#pragma unroll
    for (int n = 0; n < 4; ++n) t.o[n] = __builtin_amdgcn_mfma_f32_16x16x32_bf16(f.vf[n], pf, t.o[n], 0, 0, 0);
}
template <bool FIRST>
__device__ __forceinline__ void attn_math2(const AttnFrag& fa, const AttnFrag& fb, AttnState& ta, AttnState& tb, const int d0a, const int d0b, const int js) {
    float sa[8], sb[8];
    const float mxa = attn_scores<FIRST>(fa, ta, d0a, js, sa), mxb = attn_scores<FIRST>(fb, tb, d0b, js, sb);
    if (FIRST) {
        ta.m = mxa; tb.m = mxb;
#pragma unroll
        for (int j = 0; j < 8; ++j) { sa[j] -= mxa; sb[j] -= mxb; }
    } else if (__any(fmaxf(mxa, mxb) > 8.f)) {
        attn_grow(ta, sa, mxa); attn_grow(tb, sb, mxb);
    }
    attn_pv(fa, ta, sa); attn_pv(fb, tb, sb);
}
__device__ void phase_attn(const Params& p, unsigned char* lds) {
    const int tid = threadIdx.x, lane = tid & 63, wave = tid >> 6, qi = lane & 15, g = lane >> 4, gp = qi >> 2, jj = qi & 3;
    unsigned char* ws = p.ws;
    const bf16_t* QA = (const bf16_t*)(ws + WS_QA);
    bf16_t* CAT = (bf16_t*)(ws + WS_CAT);
    const bf16_t* K = (const bf16_t*)(ws + WS_KA); const bf16_t* V = (const bf16_t*)(ws + WS_VB);
    constexpr int LV = 49152;
    constexpr int CLS8 = 8 * 512 * 64;
    const int nwg = gridDim.x, xg = blockIdx.x & 7, xl = blockIdx.x >> 3;
    const bool xord = (nwg & 7) == 0;
    const int k0 = xord ? xl : (int)blockIdx.x, kst = xord ? (nwg >> 3) : nwg, kend = xord ? 64 : 512;
    for (int k = k0; k < kend; k += kst) {
        const int idd = xord ? ((xg + 8 * (k >> 5)) << 5) + (k & 31) : k;
        const int bh = idd >> 5, blk = idd & 31, r = wave, b = bh >> 3, h = bh & 7;
        const int tq = 256 * blk + r + 16 * qi, rho4 = r & 3;
        __syncthreads();
        uint4 pre[12];
#pragma unroll
        for (int i = 0; i < 6; ++i) { const int pid = tid + 512 * i, row = pid >> 3, cls = row / 24, il = row - cls * 24;
            pre[i] = *(const uint4*)(K + ((bh * S + cls * 512 + 16 * blk - 8 + il) * 64 + (pid & 7) * 8)); }
#pragma unroll
        for (int i = 0; i < 6; ++i) { const int vp = tid + 512 * i, b3 = vp >> 6, cls = b3 / 3, bl = b3 - cls * 3;
            pre[6 + i] = *(const uint4*)(V + ((((bh * S + cls * 512 + 16 * blk - 8) >> 3) + bl) * 512 + (vp & 63) * 8)); }
        const int ks16 = ((16 * blk) & ~31) - 128;
        const int c16 = ks16 < 0 ? ((-ks16) >> 5) : 0;
        const int kb16 = (bh * S + r * 512 + ks16 + 8 * gp + jj) * 64 + 8 * g, vb16 = (((bh * S + r * 512 + ks16) >> 3) + g) * 512 + qi * 8;
        const int dq16 = 16 * blk + qi - (ks16 + 8 * g);
        const int c4 = blk == 0 ? 4 : (blk == 1 ? 2 : 0);
        const int kb4 = (bh * S + (rho4 + 4 * gp) * 512 + 16 * blk - 32 + jj) * 64 + 8 * g, vb4 = ((bh * S + (rho4 + 4 * g) * 512 + 16 * blk - 32) >> 3) * 512 + qi * 8;
        const int dq4 = 4 * qi + 128 + (r >> 2) - g;
        AttnFrag fxa, fxb, fya;
        attn_load(fxa, K + (kb16 + 4 * 2048), V + (vb16 + 4 * 2048)); attn_load(fxb, K + (kb16 + 4 * 2048 + CLS8), V + (vb16 + 4 * 2048 + CLS8));
        attn_load(fya, K + kb4, V + vb4);
        AttnState ta, tb;
        { const bf16_t* qrow = QA + ((size_t)(bh * S + r * 512 + 16 * blk + qi) * 64 + 8 * g);
          ta.q0 = *(const bf16x8*)qrow; ta.q1 = *(const bf16x8*)(qrow + 32); tb.q0 = *(const bf16x8*)(qrow + CLS8); tb.q1 = *(const bf16x8*)(qrow + CLS8 + 32); }
        ta.m = 0.f; tb.m = 0.f; ta.l = 0.f; tb.l = 0.f;
#pragma unroll
        for (int n = 0; n < 4; ++n) { ta.o[n] = (f32x4){0.f, 0.f, 0.f, 0.f}; tb.o[n] = ta.o[n]; }
        attn_math2<true>(fxa, fxb, ta, tb, dq16 - 128, dq16 - 128, 0);
        {
            const int m0 = c4 <= 0 ? 0 : (1 << 20), m1 = c4 <= 1 ? 0 : (1 << 20), m2 = c4 <= 2 ? 0 : (1 << 20);
            attn_load(fxa, K + (kb4 + 1 * 512), V + (vb4 + 1 * 512));
            attn_math2<false>(fya, fya, ta, tb, dq4 - m0, dq4 + 2 - m0, 2);
            attn_load(fya, K + (kb4 + 2 * 512), V + (vb4 + 2 * 512));
            attn_math2<false>(fxa, fxa, ta, tb, dq4 - 32 - m1, dq4 + 2 - 32 - m1, 2);
            attn_math2<false>(fya, fya, ta, tb, dq4 - 64 - m2, dq4 + 2 - 64 - m2, 2);
        }
#pragma unroll
        for (int i = 0; i < 12; ++i) *(uint4*)(lds + (tid + 512 * i) * 16) = pre[i];
        __syncthreads();
        {
            const int d1 = 16 * qi + 128 + r - g;
            const unsigned char* kl = lds + (gp * 24 + jj) * 128 + g * 16;
            const unsigned char* vl = lds + LV + g * 3072 + qi * 16;
            int c1 = (blk == 0 ? 4 : 0);
            const unsigned char* kl4 = lds + ((rho4 + 4 * gp) * 24 + jj) * 128 + g * 16;
            const unsigned char* vl4 = lds + LV + (rho4 + 4 * g) * 3072 + qi * 16;
            const int c4l = c4 > 3 ? c4 : 3;
#define ATTN_D1_CHUNK() do { const int w = c1 >> 2, q = c1 & 3; const unsigned char* kq = kl + q * 12288 + w * 1024; const unsigned char* vq = vl + q * 12288 + w * 1024; \
                fya.ka[0] = *(const bf16x8*)kq; fya.ka[1] = *(const bf16x8*)(kq + 64); fya.ka[2] = *(const bf16x8*)(kq + 512); fya.ka[3] = *(const bf16x8*)(kq + 576); \
                _Pragma("unroll") for (int n = 0; n < 4; ++n) fya.vf[n] = *(const bf16x8*)(vq + n * 256); \
                attn_math2<false>(fya, fya, ta, tb, d1 - 128 * w - 4 * q, d1 + 8 - 128 * w - 4 * q, 4); ++c1; } while (0)
#define ATTN_D4_CHUNK(w4) do { const unsigned char* kq = kl4 + ((w4) - 3) * 1024; const unsigned char* vq = vl4 + ((w4) - 3) * 1024; \
                fya.ka[0] = *(const bf16x8*)kq; fya.ka[1] = *(const bf16x8*)(kq + 64); fya.ka[2] = *(const bf16x8*)(kq + 512); fya.ka[3] = *(const bf16x8*)(kq + 576); \
                _Pragma("unroll") for (int n = 0; n < 4; ++n) fya.vf[n] = *(const bf16x8*)(vq + n * 256); \
                attn_math2<false>(fya, fya, ta, tb, dq4 - 32 * (w4), dq4 + 2 - 32 * (w4), 2); } while (0)
            for (int cc = c16; cc < 4; ++cc) {
                attn_load(fxa, K + (kb16 + cc * 2048), V + (vb16 + cc * 2048)); attn_load(fxb, K + (kb16 + cc * 2048 + CLS8), V + (vb16 + cc * 2048 + CLS8));
                for (int q3 = 0; q3 < 3 && c1 < 12; ++q3) ATTN_D1_CHUNK();
                if (3 + (cc - c16) >= c4l && 3 + (cc - c16) < 6) ATTN_D4_CHUNK(3 + (cc - c16));
                attn_math2<false>(fxa, fxb, ta, tb, dq16 - 32 * cc, dq16 - 32 * cc, 0);
            }
            while (c1 < 12) ATTN_D1_CHUNK();
            for (int w4 = (4 - c16 < 3 ? 3 + (4 - c16) : 6); w4 < 6; ++w4) { if (w4 >= c4l) ATTN_D4_CHUNK(w4); }
#undef ATTN_D1_CHUNK
#undef ATTN_D4_CHUNK
        }
        {
            float la = ta.l, lb = tb.l;
            la += __shfl_xor(la, 16); la += __shfl_xor(la, 32); lb += __shfl_xor(lb, 16); lb += __shfl_xor(lb, 32);
            const float ia = 1.f / la, ib = 1.f / lb;
            bf16_t* orow = CAT + (size_t)(b * S + tq) * D + h * 64 + 4 * g;
#pragma unroll
            for (int n = 0; n < 4; ++n) { uint2 ov; ov.x = pk2(ta.o[n][0] * ia, ta.o[n][1] * ia); ov.y = pk2(ta.o[n][2] * ia, ta.o[n][3] * ia); *(uint2*)(orow + 16 * n) = ov;
                uint2 ow; ow.x = pk2(tb.o[n][0] * ib, tb.o[n][1] * ib); ow.y = pk2(tb.o[n][2] * ib, tb.o[n][3] * ib); *(uint2*)(orow + 8 * D + 16 * n) = ow; }
        }
    }
}

constexpr int TS = 72;
constexpr int GL_LA = 0, GL_A1 = 16640, GL_A2 = GL_A1 + 64 * TS * 2, GL_VT = GL_A2 + 64 * TS * 2, GL_ATT = GL_VT + 128 * TS * 2;
static_assert(GL_ATT + 64 * TS * 2 <= 65536, "gla lds");

struct GlaIn { uint4 kr0, kr1, qr0, qr1, vr[4]; float4 gl; };
template <int MODE>
__device__ __forceinline__ void gla_fetch(const Params& p, int item, int tid, GlaIn& in) {
    unsigned char* ws = p.ws;
    const int bh4 = item >> 7, n = item & 127, b = bh4 >> 2, hh = bh4 & 3;
    const int t0 = b * S + n * 64;
    const int c = tid >> 2, d0 = (tid & 3) * 16, e0 = (tid & 3) * 32;
    const bf16_t* kp = (const bf16_t*)(ws + WS_KG) + (size_t)(t0 + c) * 256 + hh * 64 + d0;
    in.kr0 = *(const uint4*)kp; in.kr1 = *(const uint4*)(kp + 8);
    const bf16_t* qp = (const bf16_t*)(ws + WS_QG) + (size_t)(t0 + c) * 256 + hh * 64 + d0;
    in.qr0 = make_uint4(0, 0, 0, 0); in.qr1 = make_uint4(0, 0, 0, 0);
    if (MODE == 1) { in.qr0 = *(const uint4*)qp; in.qr1 = *(const uint4*)(qp + 8); }
    const bf16_t* vp = (const bf16_t*)(ws + WS_VG) + (size_t)(t0 + c) * 512 + hh * 128 + e0;
#pragma unroll
    for (int q = 0; q < 4; ++q) in.vr[q] = *(const uint4*)(vp + 8 * q);
    in.gl = *(const float4*)((const float*)(ws + WS_GLR) + (size_t)t0 * 16 + tid * 4);
}
template <int MODE>
__device__ __forceinline__ void gla_prep(const Params& p, unsigned char* lds, int item, int tid, const GlaIn& in) {
    const int bh4 = item >> 7, hh = bh4 & 3;
    float* LA = (float*)(lds + GL_LA);
    bf16_t* A1 = (bf16_t*)(lds + GL_A1); bf16_t* A2 = (bf16_t*)(lds + GL_A2); bf16_t* VTl = (bf16_t*)(lds + GL_VT);
    const int c = tid >> 2, d0 = (tid & 3) * 16, e0 = (tid & 3) * 32;
    const uint4 kr0 = in.kr0, kr1 = in.kr1, qr0 = in.qr0, qr1 = in.qr1;
    float* GLRL = (float*)(lds + GL_ATT + 1024);
    *(float4*)(GLRL + tid * 4) = in.gl;
    __syncthreads();
    {
        const int dd = tid & 63, cgp = tid >> 6;
        float w[16];
#pragma unroll
        for (int r = 0; r < 16; ++r) w[r] = p.w_gate_lr[r * 256 + hh * 64 + dd];
        const float bias = p.b_gate[hh * 64 + dd];
        float pre[16]; float run = 0.f;
#pragma unroll
        for (int i = 0; i < 16; ++i) {
            const float4* gp = (const float4*)(GLRL + (cgp * 16 + i) * 16);
            const float4 g0 = gp[0], g1 = gp[1], g2 = gp[2], g3 = gp[3];
            float z = bias;
            z += g0.x * w[0] + g0.y * w[1] + g0.z * w[2] + g0.w * w[3];
            z += g1.x * w[4] + g1.y * w[5] + g1.z * w[6] + g1.w * w[7];
            z += g2.x * w[8] + g2.y * w[9] + g2.z * w[10] + g2.w * w[11];
            z += g3.x * w[12] + g3.y * w[13] + g3.z * w[14] + g3.w * w[15];
            const float ls = fminf(z, 0.f) - flog(1.f + fexp(-fabsf(z)));
            run += ls * (1.f / 16.f); pre[i] = run;
        }
        float* tot = (float*)(lds + GL_ATT);
        tot[cgp * 64 + dd] = run;
        __syncthreads();
        float off = 0.f;
#pragma unroll
        for (int gq = 0; gq < 3; ++gq) off += (gq < cgp) ? tot[gq * 64 + dd] : 0.f;
#pragma unroll
        for (int i = 0; i < 16; ++i) LA[(cgp * 16 + i) * 65 + dd] = pre[i] + off;
    }
    __syncthreads();
    {
        unsigned kw[8] = {kr0.x, kr0.y, kr0.z, kr0.w, kr1.x, kr1.y, kr1.z, kr1.w};
        if (MODE == 0) {
#pragma unroll
            for (int i = 0; i < 16; ++i) { const int dd = d0 + i; const float kv = bf2f((unsigned short)((kw[i >> 1] >> ((i & 1) * 16)) & 0xffff));
                const float f = fexp(LA[63 * 65 + dd] - LA[c * 65 + dd]);
                A1[dd * TS + c] = (bf16_t)f2bf(kv * f); }
        } else {
            unsigned qw[8] = {qr0.x, qr0.y, qr0.z, qr0.w, qr1.x, qr1.y, qr1.z, qr1.w};
            unsigned oq[8], ok[8];
#pragma unroll
            for (int i = 0; i < 8; ++i) {
                const float bb0 = LA[c * 65 + d0 + 2 * i], bb1 = LA[c * 65 + d0 + 2 * i + 1];
                const float q0 = bf2f((unsigned short)(qw[i] & 0xffff)), q1 = bf2f((unsigned short)(qw[i] >> 16));
                const float k0 = bf2f((unsigned short)(kw[i] & 0xffff)), k1 = bf2f((unsigned short)(kw[i] >> 16));
                oq[i] = pk2(q0 * 0.125f * fexp(bb0), q1 * 0.125f * fexp(bb1));
                ok[i] = pk2(k0 * fexp(-bb0), k1 * fexp(-bb1));
            }
            *(uint4*)(A1 + c * TS + d0) = make_uint4(oq[0], oq[1], oq[2], oq[3]); *(uint4*)(A1 + c * TS + d0 + 8) = make_uint4(oq[4], oq[5], oq[6], oq[7]);
            *(uint4*)(A2 + c * TS + d0) = make_uint4(ok[0], ok[1], ok[2], ok[3]); *(uint4*)(A2 + c * TS + d0 + 8) = make_uint4(ok[4], ok[5], ok[6], ok[7]);
        }
#pragma unroll
        for (int q = 0; q < 4; ++q) { const unsigned vw[4] = {in.vr[q].x, in.vr[q].y, in.vr[q].z, in.vr[q].w};
#pragma unroll
            for (int i = 0; i < 4; ++i) { VTl[(e0 + 8 * q + 2 * i) * TS + c] = (bf16_t)(vw[i] & 0xffff); VTl[(e0 + 8 * q + 2 * i + 1) * TS + c] = (bf16_t)(vw[i] >> 16); } }
    }
    __syncthreads();
}

__device__ void gla1_items(const Params& p, unsigned char* lds0) {
    const int half = threadIdx.x >> 8, tid = threadIdx.x & 255, lane = tid & 63, w = tid >> 6, fr = lane & 15, fq = lane >> 4;
    unsigned char* lds = lds0 + half * 65536;
    float* UT = (float*)(p.ws + WS_UT); float* AG = (float*)(p.ws + WS_AG);
    const float* LA = (const float*)(lds + GL_LA);
    const bf16_t* A1 = (const bf16_t*)(lds + GL_A1); const bf16_t* VTl = (const bf16_t*)(lds + GL_VT);
    GlaIn cur, nxt;
    if ((int)blockIdx.x < 512) gla_fetch<0>(p, 2 * blockIdx.x + half, tid, cur);
    for (int it = blockIdx.x; it < 512; it += gridDim.x) {
        const int item = 2 * it + half;
        const bool more = it + (int)gridDim.x < 512;
        if (more) gla_fetch<0>(p, 2 * (it + gridDim.x) + half, tid, nxt);
        gla_prep<0>(p, lds, item, tid, cur);
        f32x4 acc[8];
#pragma unroll
        for (int n = 0; n < 8; ++n) acc[n] = (f32x4){0.f, 0.f, 0.f, 0.f};
#pragma unroll
        for (int ks = 0; ks < 2; ++ks) {
            const bf16x8 af = *(const bf16x8*)(A1 + (16 * w + fr) * TS + ks * 32 + fq * 8);
#pragma unroll
            for (int n = 0; n < 8; ++n) { const bf16x8 bfr = *(const bf16x8*)(VTl + (16 * n + fr) * TS + ks * 32 + fq * 8);
                acc[n] = __builtin_amdgcn_mfma_f32_16x16x32_bf16(af, bfr, acc[n], 0, 0, 0); }
        }
#pragma unroll
        for (int n = 0; n < 8; ++n) *(f32x4*)(UT + ((size_t)item * 128 + 16 * n + fr) * 64 + 16 * w + 4 * fq) = acc[n];
        if (tid < 64) AG[item * 64 + tid] = fexp(LA[63 * 65 + tid]);
        __syncthreads();
        if (more) cur = nxt;
    }
}
__device__ void gla2_scan(const Params& p) {
    const float* UT = (const float*)(p.ws + WS_UT); const float* AG = (const float*)(p.ws + WS_AG);
    bf16_t* SPT = (bf16_t*)(p.ws + WS_SPT);
    for (int rec = blockIdx.x * NTHREADS + threadIdx.x; rec < 65536; rec += gridDim.x * NTHREADS) {
        const int bh4 = rec >> 13, e = (rec >> 6) & 127, dd = rec & 63;
        float st = 0.f;
        for (int n0 = 0; n0 < 128; n0 += 32) {
            float av[32], uv[32];
#pragma unroll
            for (int q = 0; q < 32; ++q) { const int item = bh4 * 128 + n0 + q; av[q] = AG[item * 64 + dd]; uv[q] = UT[((size_t)item * 128 + e) * 64 + dd]; }
#pragma unroll
            for (int q = 0; q < 32; ++q) { const int item = bh4 * 128 + n0 + q; SPT[((size_t)item * 128 + e) * 64 + dd] = (bf16_t)f2bf(st); st = av[q] * st + uv[q]; }
        }
    }
}
__device__ void gla3_items(const Params& p, unsigned char* lds0) {
    const int half = threadIdx.x >> 8, tid = threadIdx.x & 255, lane = tid & 63, w = tid >> 6, fr = lane & 15, fq = lane >> 4;
    unsigned char* lds = lds0 + half * 65536;
    unsigned char* ws = p.ws;
    const bf16_t* SPT = (const bf16_t*)(ws + WS_SPT); const bf16_t* RG = (const bf16_t*)(ws + WS_RG);
    bf16_t* CAT = (bf16_t*)(ws + WS_CAT);
    const bf16_t* A1 = (const bf16_t*)(lds + GL_A1); const bf16_t* A2 = (const bf16_t*)(lds + GL_A2); const bf16_t* VTl = (const bf16_t*)(lds + GL_VT);
    bf16_t* ATT = (bf16_t*)(lds + GL_ATT);
    GlaIn cur, nxt;
    if ((int)blockIdx.x < 512) gla_fetch<1>(p, 2 * blockIdx.x + half, tid, cur);
    for (int it = blockIdx.x; it < 512; it += gridDim.x) {
        const int item = 2 * it + half;
        const bool more = it + (int)gridDim.x < 512;
        const int bh4 = item >> 7, n_ = item & 127, b = bh4 >> 2, hh = bh4 & 3;
        const int t0 = b * S + n_ * 64;
        bf16x8 sf[8][2]; uint2 rw[8];
#pragma unroll
        for (int n = 0; n < 8; ++n) { const bf16_t* sp = SPT + ((size_t)item * 128 + 16 * n + fr) * 64 + fq * 8; sf[n][0] = *(const bf16x8*)sp; sf[n][1] = *(const bf16x8*)(sp + 32);
            rw[n] = *(const uint2*)(RG + (size_t)(t0 + 16 * w + fr) * 512 + hh * 128 + 16 * n + 4 * fq); }
        if (more) gla_fetch<1>(p, 2 * (it + gridDim.x) + half, tid, nxt);
        gla_prep<1>(p, lds, item, tid, cur);
        const bf16x8 aq0 = *(const bf16x8*)(A1 + (16 * w + fr) * TS + fq * 8), aq1 = *(const bf16x8*)(A1 + (16 * w + fr) * TS + 32 + fq * 8);
#pragma unroll
        for (int np = 0; np < 4; ++np) {
            f32x4 a = (f32x4){0.f, 0.f, 0.f, 0.f};
            if (np <= w) {
                const bf16x8 b0 = *(const bf16x8*)(A2 + (16 * np + fr) * TS + fq * 8), b1 = *(const bf16x8*)(A2 + (16 * np + fr) * TS + 32 + fq * 8);
                a = __builtin_amdgcn_mfma_f32_16x16x32_bf16(aq0, b0, a, 0, 0, 0);
                a = __builtin_amdgcn_mfma_f32_16x16x32_bf16(aq1, b1, a, 0, 0, 0);
            }
#pragma unroll
            for (int j = 0; j < 4; ++j) { const int c = 16 * w + 4 * fq + j, cp = 16 * np + fr; ATT[c * TS + cp] = (bf16_t)f2bf(cp <= c ? a[j] : 0.f); }
        }
        __syncthreads();
        const bf16x8 at0 = *(const bf16x8*)(ATT + (16 * w + fr) * TS + fq * 8), at1 = *(const bf16x8*)(ATT + (16 * w + fr) * TS + 32 + fq * 8);
        f32x4 acc[8];
#pragma unroll
        for (int n = 0; n < 8; ++n) {
            acc[n] = (f32x4){0.f, 0.f, 0.f, 0.f};
            const bf16x8 v0 = *(const bf16x8*)(VTl + (16 * n + fr) * TS + fq * 8), v1 = *(const bf16x8*)(VTl + (16 * n + fr) * TS + 32 + fq * 8);
            const bf16x8 s0 = sf[n][0], s1 = sf[n][1];
            acc[n] = __builtin_amdgcn_mfma_f32_16x16x32_bf16(v0, at0, acc[n], 0, 0, 0);
            acc[n] = __builtin_amdgcn_mfma_f32_16x16x32_bf16(v1, at1, acc[n], 0, 0, 0);
            acc[n] = __builtin_amdgcn_mfma_f32_16x16x32_bf16(s0, aq0, acc[n], 0, 0, 0);
            acc[n] = __builtin_amdgcn_mfma_f32_16x16x32_bf16(s1, aq1, acc[n], 0, 0, 0);
        }
        {
            float ss = 0.f;
#pragma unroll
            for (int n = 0; n < 8; ++n) ss += acc[n][0] * acc[n][0] + acc[n][1] * acc[n][1] + acc[n][2] * acc[n][2] + acc[n][3] * acc[n][3];
            ss += __shfl_xor(ss, 16); ss += __shfl_xor(ss, 32);
            const float rstd = rsqrtf(ss * (1.f / 128.f) + EPS);
            const int t = t0 + 16 * w + fr;
#pragma unroll
            for (int n = 0; n < 8; ++n) { const int e = 16 * n + 4 * fq;
                const float4 gg = *(const float4*)(p.g_gla + e);
                const float r0 = bf2f((unsigned short)(rw[n].x & 0xffff)), r1 = bf2f((unsigned short)(rw[n].x >> 16)), r2 = bf2f((unsigned short)(rw[n].y & 0xffff)), r3 = bf2f((unsigned short)(rw[n].y >> 16));
                uint2 ov; ov.x = pk2(acc[n][0] * rstd * gg.x * fsilu(r0), acc[n][1] * rstd * gg.y * fsilu(r1)); ov.y = pk2(acc[n][2] * rstd * gg.z * fsilu(r2), acc[n][3] * rstd * gg.w * fsilu(r3));
                *(uint2*)(CAT + (size_t)t * D + 512 + hh * 128 + e) = ov; }
        }
        __syncthreads();
        if (more) cur = nxt;
    }
}

struct EpiBf16Plain {
    static constexpr bool PERM = true, BINIT = false;
    bf16_t* C; int ldc;
    __device__ __forceinline__ void operator()(const f32x4 (&acc)[2][2][4][2], const pg8::Unit& u, int wr, int wc, int fr, int fq) const {
#pragma unroll
        for (int ai = 0; ai < 2; ++ai)
#pragma unroll
            for (int m = 0; m < 4; ++m) { const int row = u.row0 + 128 * ai + 64 * wr + 16 * m + fr;
#pragma unroll
                for (int bj = 0; bj < 2; ++bj) { const f32x4 v0 = acc[ai][bj][m][0], v1 = acc[ai][bj][m][1];
                    u32x4 w; w.x = pk2(v0[0], v0[1]); w.y = pk2(v0[2], v0[3]); w.z = pk2(v1[0], v1[1]); w.w = pk2(v1[2], v1[3]);
                    *(u32x4*)(C + (size_t)row * ldc + 256 * u.pn + 128 * bj + 32 * wc + 8 * fq) = w; } }
    }
};
__device__ void phase_gemm_out(const Params& p, unsigned char* lds) {
    pg8::DenseSched Sd; Sd.init(p.ws + WS_CAT, p.ws + WS_WOUTT, T, D, D);
    EpiBf16Plain E{(bf16_t*)(p.ws + WS_YMIX), D};
    pg8::gemm_phase<EpiBf16Plain, pg8::DenseSched>((LAS unsigned char*)lds, D, Sd, E);
}

constexpr int HS_STRIDE = 1028;
__device__ void phase_postmix(const Params& p, unsigned char* lds, const bool dry) {
    const int tid = threadIdx.x, lane = tid & 63, wave = tid >> 6;
    unsigned char* ws = p.ws;
    const float* mod = (const float*)(ws + WS_MOD);
    const bf16_t* Y = (const bf16_t*)(ws + WS_YMIX);
    bf16_t* H = (bf16_t*)(ws + WS_H);
    bf16_t* X1 = (bf16_t*)(ws + WS_X1);
    float* hs = (float*)lds;
    float* part = (float*)(lds + 66048);
    float* lg = (float*)(lds + 66048 + 16384);
    float* tvs = lg + 512;
    int* tis = (int*)(tvs + 64);
    constexpr int MAXG = 8;
    int* sel_e = tis + 64;
    float* sel_g = (float*)(sel_e + MAXG * 64);
    int* lrank = (int*)(sel_g + MAXG * 64);
    int* lcnt = lrank + MAXG * 64;
    int* lbase = lcnt + 32;
    int* CNT = (int*)(ws + WS_CTL) + CW_CNT;
    float wb0[32], wb1[32];
    { const float* wp = p.router_w + (size_t)(128 * wave + (lane >> 4)) * 32 + (lane & 15);
#pragma unroll
      for (int ks = 0; ks < 32; ++ks) { wb0[ks] = wp[(size_t)(4 * ks) * 32]; wb1[ks] = wp[(size_t)(4 * ks) * 32 + 16]; } }
    if (tid < 32) lcnt[tid] = 0;
    int gl = 0, grp0 = blockIdx.x;
    uint2 yw[2][4]; float4 xv[2][4];
    if ((int)blockIdx.x < T / 16) {
#pragma unroll
        for (int i = 0; i < 2; ++i) { const int m = blockIdx.x * 16 + wave * 2 + i;
            const uint2* yr = (const uint2*)(Y + (size_t)m * D) + lane; const float4* xr = (const float4*)(p.x + (size_t)m * D) + lane;
#pragma unroll
            for (int j = 0; j < 4; ++j) { yw[i][j] = ntload2(yr + 64 * j); xv[i][j] = ntload4(xr + 64 * j); } }
    }
    for (int grp = blockIdx.x; grp < T / 16; grp += gridDim.x) {
        const int m0 = grp * 16;
#pragma unroll
        for (int i = 0; i < 2; ++i) {
            const int rl = wave * 2 + i, m = m0 + rl, b = m >> 13;
            float4 yv[4]; float ss = 0.f;
#pragma unroll
            for (int j = 0; j < 4; ++j) { const uint2 w = yw[i][j];
                yv[j] = make_float4(bf2f((unsigned short)(w.x & 0xffff)), bf2f((unsigned short)(w.x >> 16)), bf2f((unsigned short)(w.y & 0xffff)), bf2f((unsigned short)(w.y >> 16)));
                ss += yv[j].x * yv[j].x + yv[j].y * yv[j].y + yv[j].z * yv[j].z + yv[j].w * yv[j].w; }
            const float rstd1 = rsqrtf(wave_sum(ss) * (1.f / D) + EPS);
            float4 x1[4]; float ss2 = 0.f;
#pragma unroll
            for (int j = 0; j < 4; ++j) { const int c = 4 * lane + 256 * j;
                const float4 xq = xv[i][j], g = *(const float4*)(p.g_post_mix + c), gt = *(const float4*)(mod + b * 6144 + 2048 + c);
                x1[j].x = xq.x + gt.x * (yv[j].x * rstd1 * g.x); x1[j].y = xq.y + gt.y * (yv[j].y * rstd1 * g.y);
                x1[j].z = xq.z + gt.z * (yv[j].z * rstd1 * g.z); x1[j].w = xq.w + gt.w * (yv[j].w * rstd1 * g.w);
                ss2 += x1[j].x * x1[j].x + x1[j].y * x1[j].y + x1[j].z * x1[j].z + x1[j].w * x1[j].w;
                { uint2 xo; xo.x = pk2(x1[j].x, x1[j].y); xo.y = pk2(x1[j].z, x1[j].w); ntstore2((uint2*)(X1 + (size_t)m * D + c), xo); } }
            const float rstd2 = rsqrtf(wave_sum(ss2) * (1.f / D) + EPS);
#pragma unroll
            for (int j = 0; j < 4; ++j) { const int c = 4 * lane + 256 * j;
                const float4 g = *(const float4*)(p.g_pre_ffn + c), sh = *(const float4*)(mod + b * 6144 + 3072 + c), sc = *(const float4*)(mod + b * 6144 + 4096 + c);
                float4 h;
                h.x = x1[j].x * rstd2 * g.x * (1.f + sc.x) + sh.x; h.y = x1[j].y * rstd2 * g.y * (1.f + sc.y) + sh.y;
                h.z = x1[j].z * rstd2 * g.z * (1.f + sc.z) + sh.z; h.w = x1[j].w * rstd2 * g.w * (1.f + sc.w) + sh.w;
                uint2 o; o.x = pk2(h.x, h.y); o.y = pk2(h.z, h.w);
                *(uint2*)(H + (size_t)m * D + c) = o;
                *(float4*)(hs + rl * HS_STRIDE + c) = h; }
        }
        if (grp + (int)gridDim.x < T / 16) {
#pragma unroll
            for (int i = 0; i < 2; ++i) { const int m = (grp + gridDim.x) * 16 + wave * 2 + i;
                const uint2* yr = (const uint2*)(Y + (size_t)m * D) + lane; const float4* xr = (const float4*)(p.x + (size_t)m * D) + lane;
#pragma unroll
                for (int j = 0; j < 4; ++j) { yw[i][j] = ntload2(yr + 64 * j); xv[i][j] = ntload4(xr + 64 * j); } }
        }
        __syncthreads();
        f32x4 a0 = (f32x4){0.f, 0.f, 0.f, 0.f}, a1 = (f32x4){0.f, 0.f, 0.f, 0.f};
        {
            const float* hp = hs + (lane & 15) * HS_STRIDE + 128 * wave + (lane >> 4);
#pragma unroll
            for (int ks = 0; ks < 32; ++ks) {
                const float av = hp[4 * ks];
                a0 = __builtin_amdgcn_mfma_f32_16x16x4f32(av, wb0[ks], a0, 0, 0, 0);
                a1 = __builtin_amdgcn_mfma_f32_16x16x4f32(av, wb1[ks], a1, 0, 0, 0);
            }
        }
        {
            const int fr = lane & 15, fq = lane >> 4;
#pragma unroll
            for (int j = 0; j < 4; ++j) { part[(wave * 16 + 4 * fq + j) * 32 + fr] = a0[j]; part[(wave * 16 + 4 * fq + j) * 32 + 16 + fr] = a1[j]; }
        }
        __syncthreads();
        { const int e = tid & 31; float s = p.router_b[e];
#pragma unroll
          for (int w8 = 0; w8 < 8; ++w8) s += part[w8 * 512 + tid];
          lg[tid] = s; }
        __syncthreads();
        {
            const int row = tid >> 5, e = tid & 31; const float v = lg[tid]; int rank = 0;
#pragma unroll
            for (int q = 0; q < 32; ++q) { const float u = lg[row * 32 + q]; rank += (u > v || (u == v && q < e)) ? 1 : 0; }
            if (rank < 4) { tvs[row * 4 + rank] = v; tis[row * 4 + rank] = e; }
        }
        __syncthreads();
        if (tid < 64) { const int row = tid >> 2, k = tid & 3;
            const float t0 = tvs[row * 4], e1 = fexp(tvs[row * 4 + 1] - t0), e2 = fexp(tvs[row * 4 + 2] - t0), e3 = fexp(tvs[row * 4 + 3] - t0);
            const float inv = 1.f / (1.f + e1 + e2 + e3);
            const float ek = k == 0 ? 1.f : (k == 1 ? e1 : (k == 2 ? e2 : e3));
            const int e = tis[tid];
            sel_e[gl * 64 + tid] = e; sel_g[gl * 64 + tid] = ek * inv;
            lrank[gl * 64 + tid] = atomicAdd(&lcnt[e], 1); }
        ++gl;
        const bool lastg = grp + (int)gridDim.x >= T / 16;
        if (gl == MAXG || lastg) {
            __syncthreads();
            if (tid < 32) { const int c = lcnt[tid]; lbase[tid] = (c > 0 && !dry) ? atomicAdd(&CNT[tid], c) : 0; }
            __syncthreads();
            if (!dry) for (int i = tid; i < gl * 64; i += NTHREADS) { const int gq = i >> 6, a = (grp0 + gq * (int)gridDim.x) * 64 + (i & 63); const int e = sel_e[i];
                const int pos = lbase[e] + lrank[i];
                ((int*)(ws + WS_TOPI))[a] = e; ((float*)(ws + WS_GATE))[a] = sel_g[i]; ((int*)(ws + WS_POS))[a] = pos; ((int*)(ws + WS_TOK))[e * T + pos] = a >> 2; }
            __syncthreads();
            if (tid < 32) lcnt[tid] = 0;
            gl = 0; grp0 = grp + gridDim.x;
        }
        __syncthreads();
    }
}

__device__ __forceinline__ void compute_pstart(const Params& p, unsigned char* lds) {
    int* ps = (int*)(lds + LDS_PS); int* cn = (int*)(lds + LDS_CNT);
    if (threadIdx.x < 64) {
        const int lane = threadIdx.x;
        const int* CNT = (const int*)(p.ws + WS_CTL) + CW_CNT;
        const int c = lane < NE ? __hip_atomic_load(&CNT[lane], __ATOMIC_RELAXED, __HIP_MEMORY_SCOPE_AGENT) : 0;
        int incl = (c + 255) & ~255;
#pragma unroll
        for (int o = 1; o < 32; o <<= 1) { const int t = __shfl_up(incl, o); if (lane >= o) incl += t; }
        if (lane < NE) { ps[lane + 1] = incl; cn[lane] = c; }
        if (lane == 0) ps[0] = 0;
    }
    __syncthreads();
}

struct EpiUp {
    static constexpr bool PERM = true, BINIT = false;
    bf16_t* ACT; const float* bgu;
    __device__ __forceinline__ void operator()(const f32x4 (&acc)[2][2][4][2], const pg8::Unit& u, int wr, int wc, int fr, int fq) const {
        const int jc = 128 * u.pn + 32 * wc + 8 * fq;
#pragma unroll
        for (int ai = 0; ai < 2; ++ai)
#pragma unroll
            for (int m = 0; m < 4; ++m) { const int row = u.row0 + 128 * ai + 64 * wr + 16 * m + fr;
                u32x4 o;
#pragma unroll
                for (int bj = 0; bj < 2; ++bj) { float a[4];
#pragma unroll
                    for (int j = 0; j < 4; ++j) { float gl = acc[ai][bj][m][0][j], ln = acc[ai][bj][m][1][j];
                        gl = fminf(gl, 7.f); ln = fminf(fmaxf(ln, -7.f), 7.f);
                        a[j] = gl / (1.f + fexp(-1.702f * gl)) * (ln + 1.f); }
                    o[2 * bj] = pk2(a[0], a[1]); o[2 * bj + 1] = pk2(a[2], a[3]); }
                *(u32x4*)(ACT + (size_t)row * DFF + jc) = o; }
    }
};
struct EpiDown {
    static constexpr bool PERM = true, BINIT = false;
    bf16_t* YE; const float* bd;
    __device__ __forceinline__ void operator()(const f32x4 (&acc)[2][2][4][2], const pg8::Unit& u, int wr, int wc, int fr, int fq) const {
#pragma unroll
        for (int bj = 0; bj < 2; ++bj) {
            const int c0 = 256 * u.pn + 128 * bj + 32 * wc + 8 * fq;
#pragma unroll
            for (int ai = 0; ai < 2; ++ai)
#pragma unroll
                for (int m = 0; m < 4; ++m) { const int row = u.row0 + 128 * ai + 64 * wr + 16 * m + fr;
                    const f32x4 v0 = acc[ai][bj][m][0], v1 = acc[ai][bj][m][1];
                    u32x4 w; w.x = pk2(v0[0], v0[1]); w.y = pk2(v0[2], v0[3]); w.z = pk2(v1[0], v1[1]); w.w = pk2(v1[2], v1[3]);
                    *(u32x4*)(YE + (size_t)row * D + c0) = w; }
        }
    }
};
struct EpiMoe {
    static constexpr bool PERM = true, BINIT = true;
    EpiUp up; EpiDown dn;
    __device__ __forceinline__ void init(f32x4 (&acc)[2][2][4][2], const pg8::Unit& u, int wc, int fq) const {
        f32x4 v[2][2];
        if (u.e < 32) { const float* bp = up.bgu + (size_t)u.e * 2048 + 2 * (128 * u.pn + 32 * wc + 8 * fq);
            const float4 c0 = *(const float4*)bp, c1 = *(const float4*)(bp + 4), c2 = *(const float4*)(bp + 8), c3 = *(const float4*)(bp + 12);
            v[0][0] = (f32x4){c0.x, c0.z, c1.x, c1.z}; v[0][1] = (f32x4){c0.y, c0.w, c1.y, c1.w}; v[1][0] = (f32x4){c2.x, c2.z, c3.x, c3.z}; v[1][1] = (f32x4){c2.y, c2.w, c3.y, c3.w}; }
        else { const float* bp = dn.bd + (size_t)(u.e & 31) * D + 256 * u.pn + 32 * wc + 8 * fq;
            const float4 b00 = *(const float4*)bp, b01 = *(const float4*)(bp + 4), b10 = *(const float4*)(bp + 128), b11 = *(const float4*)(bp + 132);
            v[0][0] = (f32x4){b00.x, b00.y, b00.z, b00.w}; v[0][1] = (f32x4){b01.x, b01.y, b01.z, b01.w}; v[1][0] = (f32x4){b10.x, b10.y, b10.z, b10.w}; v[1][1] = (f32x4){b11.x, b11.y, b11.z, b11.w}; }
#pragma unroll
        for (int a = 0; a < 2; ++a)
#pragma unroll
            for (int b = 0; b < 2; ++b)
#pragma unroll
                for (int m = 0; m < 4; ++m) { acc[a][b][m][0] = v[b][0]; acc[a][b][m][1] = v[b][1]; }
    }
    __device__ __forceinline__ void operator()(const f32x4 (&acc)[2][2][4][2], const pg8::Unit& u, int wr, int wc, int fr, int fq) const {
        if (u.e < 32) up(acc, u, wr, wc, fr, fq); else dn(acc, u, wr, wc, fr, fq);
    }
};
__device__ void phase_moe(const Params& p, unsigned char* lds) {
    int* ps = (int*)(lds + LDS_PS);
    compute_pstart(p, lds);
    const volatile unsigned* xs = (const volatile unsigned*)(lds + LDS_BARW);
    pg8::MoeSched2 Sm; Sm.init(p.ws, ps, (int)xs[0], (int)xs[2], (int)xs[3]);
    EpiMoe E{EpiUp{(bf16_t*)(p.ws + WS_ACT), p.b_gate_up}, EpiDown{(bf16_t*)(p.ws + WS_YE), p.b_down}};
    pg8::gemm_phase<EpiMoe, pg8::MoeSched2>((LAS unsigned char*)lds, D, Sm, E);
}
__device__ void phase_combine(const Params& p, unsigned char* lds) {
    const int tid = threadIdx.x, lane = tid & 63, wave = tid >> 6;
    unsigned char* ws = p.ws;
    const float* mod = (const float*)(ws + WS_MOD);
    const bf16_t* YE = (const bf16_t*)(ws + WS_YE);
    const bf16_t* X1 = (const bf16_t*)(ws + WS_X1);
    const int* TOPI = (const int*)(ws + WS_TOPI); const int* POS = (const int*)(ws + WS_POS); const float* GATE = (const float*)(ws + WS_GATE);
    compute_pstart(p, lds);
    const int* ps = (const int*)(lds + LDS_PS);
    for (int m0 = (blockIdx.x * NW + wave) * 2; m0 < T; m0 += gridDim.x * NW * 2) {
        const int4 te0 = *(const int4*)(TOPI + m0 * 4), te1 = *(const int4*)(TOPI + m0 * 4 + 4), tp0 = *(const int4*)(POS + m0 * 4), tp1 = *(const int4*)(POS + m0 * 4 + 4);
        const float4 gk0 = *(const float4*)(GATE + m0 * 4), gk1 = *(const float4*)(GATE + m0 * 4 + 4);
        const int slot[2][4] = {{ps[te0.x] + tp0.x, ps[te0.y] + tp0.y, ps[te0.z] + tp0.z, ps[te0.w] + tp0.w}, {ps[te1.x] + tp1.x, ps[te1.y] + tp1.y, ps[te1.z] + tp1.z, ps[te1.w] + tp1.w}};
        const float gk[2][4] = {{gk0.x, gk0.y, gk0.z, gk0.w}, {gk1.x, gk1.y, gk1.z, gk1.w}};
        uint2 u[2][4][4]; float4 x1[2][4];
#pragma unroll
        for (int q = 0; q < 2; ++q) {
#pragma unroll
            for (int k = 0; k < 4; ++k) { const uint2* yr = (const uint2*)(YE + (size_t)slot[q][k] * D) + lane;
#pragma unroll
                for (int j = 0; j < 4; ++j) u[q][k][j] = ntload2(yr + 64 * j); }
            const uint2* xr = (const uint2*)(X1 + (size_t)(m0 + q) * D) + lane;
#pragma unroll
            for (int j = 0; j < 4; ++j) { const uint2 w = ntload2(xr + 64 * j);
                x1[q][j] = make_float4(bf2f((unsigned short)(w.x & 0xffff)), bf2f((unsigned short)(w.x >> 16)), bf2f((unsigned short)(w.y & 0xffff)), bf2f((unsigned short)(w.y >> 16))); }
        }
#pragma unroll
        for (int q = 0; q < 2; ++q) {
            const int m = m0 + q, b = m >> 13;
            float4 y[4];
#pragma unroll
            for (int j = 0; j < 4; ++j) { y[j] = make_float4(0.f, 0.f, 0.f, 0.f);
#pragma unroll
                for (int k = 0; k < 4; ++k) { const uint2 w = u[q][k][j]; const float g = gk[q][k];
                    y[j].x += g * bf2f((unsigned short)(w.x & 0xffff)); y[j].y += g * bf2f((unsigned short)(w.x >> 16));
                    y[j].z += g * bf2f((unsigned short)(w.y & 0xffff)); y[j].w += g * bf2f((unsigned short)(w.y >> 16)); } }
            float ss = 0.f;
#pragma unroll
            for (int j = 0; j < 4; ++j) ss += y[j].x * y[j].x + y[j].y * y[j].y + y[j].z * y[j].z + y[j].w * y[j].w;
            const float rstd = rsqrtf(wave_sum(ss) * (1.f / D) + EPS);
#pragma unroll
            for (int j = 0; j < 4; ++j) { const int c = 4 * lane + 256 * j;
                const float4 g = *(const float4*)(p.g_post_ffn + c), gt = *(const float4*)(mod + b * 6144 + 5120 + c);
                float4 o;
                o.x = x1[q][j].x + gt.x * (y[j].x * rstd * g.x); o.y = x1[q][j].y + gt.y * (y[j].y * rstd * g.y);
                o.z = x1[q][j].z + gt.z * (y[j].z * rstd * g.z); o.w = x1[q][j].w + gt.w * (y[j].w * rstd * g.w);
                ntstore4((float4*)(p.out + (size_t)m * D + c), o); }
        }
    }
}

#define XB_TMO      128
#define XB_XCNT(j)  (256  + 64 * (j))
#define XB_XSUB(j)  (1280 + 64 * (j))
#define XB_XGEN(j)  (2304 + 64 * (j))
#define XB_TOP      3328
#define XB_TOPGEN   3392
#define XCD_BAR_WORDS 3456
#define XB_SPIN_CAP (1u << 18)
__device__ __forceinline__ unsigned xb_ld(unsigned* p)              { return __hip_atomic_load(p, __ATOMIC_RELAXED, __HIP_MEMORY_SCOPE_AGENT); }
__device__ __forceinline__ unsigned xb_add(unsigned* p, unsigned v) { return __hip_atomic_fetch_add(p, v, __ATOMIC_RELAXED, __HIP_MEMORY_SCOPE_AGENT); }
__device__ __forceinline__ unsigned xb_xcc_id() { return (unsigned)__builtin_amdgcn_s_getreg((3 << 11) | 20) & 0xFu; }
#define XB_SPIN(cond, bar) do { unsigned _sp = 0; while (cond) { __builtin_amdgcn_s_sleep(1); \
    if ((++_sp & 255u) == 0u) { if (xb_ld(&(bar)[XB_TMO])) break; if (_sp > XB_SPIN_CAP) { atomicAdd(&(bar)[XB_TMO], 1u); break; } } } } while (0)
struct XcdBarrier { unsigned* bar; unsigned x; volatile LAS unsigned* st; };
__device__ __forceinline__ XcdBarrier xcd_barrier_post(unsigned* bar, volatile LAS unsigned* st) {
    XcdBarrier b; b.bar = bar; b.x = xb_xcc_id(); b.st = st;
    if (threadIdx.x == 0) st[2] = xb_add(&bar[XB_XCNT(b.x)], 1u);
    return b;
}
__device__ __forceinline__ void xcd_barrier_complete(unsigned* bar, unsigned x, unsigned& nloc, unsigned& nx, unsigned& base) {
    const unsigned G = gridDim.x * gridDim.y * gridDim.z;
    unsigned sum, cnt, mine, sp = 0u;
    for (;;) {
        sum = 0u; cnt = 0u; mine = 0u; base = 0u;
#pragma unroll
        for (unsigned j = 0; j < 16; ++j) { const unsigned c = xb_ld(&bar[XB_XCNT(j)]); sum += c; cnt += (c > 0u) ? 1u : 0u; mine = (j == x) ? c : mine; base += (j < x) ? c : 0u; }
        if (sum == G) break;
        __builtin_amdgcn_s_sleep(1);
        if ((++sp & 255u) == 0u) { if (xb_ld(&bar[XB_TMO])) break; if (sp > XB_SPIN_CAP) { atomicAdd(&bar[XB_TMO], 1u); break; } }
    }
    nloc = mine > 0u ? mine : 1u; nx = cnt > 0u ? cnt : 1u;
}
__device__ __forceinline__ void xcd_barrier(const XcdBarrier& b) {
    asm volatile("s_waitcnt vmcnt(0)" ::: "memory");
    __syncthreads();
    if (threadIdx.x == 0) {
        unsigned* bar = b.bar;
        __builtin_amdgcn_s_waitcnt(0);
        unsigned nloc = b.st[0], nx = b.st[1];
        if (nloc == 0u) { unsigned base; xcd_barrier_complete(bar, b.x, nloc, nx, base); b.st[0] = nloc; b.st[1] = nx; b.st[3] = base; }
        const unsigned old = xb_add(&bar[XB_XSUB(b.x)], 1u);
        const unsigned gen = old / nloc;
        if (old + 1u == (gen + 1u) * nloc) {
            __builtin_amdgcn_fence(__ATOMIC_RELEASE, "agent");
            asm volatile("s_waitcnt vmcnt(0)" ::: "memory");
            const unsigned og = xb_add(&bar[XB_TOP], 1u);
            const unsigned tg = og / nx;
            if (og + 1u == (tg + 1u) * nx) xb_add(&bar[XB_TOPGEN], 1u);
            else XB_SPIN(xb_ld(&bar[XB_TOPGEN]) == tg, bar);
            __builtin_amdgcn_fence(__ATOMIC_ACQUIRE, "agent");
            xb_add(&bar[XB_XGEN(b.x)], 1u);
            asm volatile("s_waitcnt vmcnt(0)" ::: "memory");
        } else {
            XB_SPIN(xb_ld(&bar[XB_XGEN(b.x)]) == gen, bar);
            __builtin_amdgcn_fence(__ATOMIC_ACQUIRE, "agent");
            asm volatile("s_waitcnt vmcnt(0)" ::: "memory");
        }
    }
    __syncthreads();
}

__global__ void __launch_bounds__(NTHREADS, 2) fwd_kernel(Params p) {
    extern __shared__ __attribute__((aligned(16))) unsigned char lds[];
    const int lo = p.ph_lo, hi = p.ph_hi;
    volatile LAS unsigned* st = (volatile LAS unsigned*)(lds + LDS_BARW);
    if (threadIdx.x == 0) { st[0] = 0u; st[1] = 0u; }
    __syncthreads();
    XcdBarrier bar; bar.bar = (unsigned*)(p.ws + WS_CTL); bar.x = 0; bar.st = st;
    if (hi - lo > 1) bar = xcd_barrier_post((unsigned*)(p.ws + WS_CTL), st);
#ifndef PROBE_DUP
#define PROBE_DUP -1
#endif
#define PHASE(k, call) if (lo <= (k) && (k) < hi) { const int nrep = ((k) == PROBE_DUP) ? hi - 9 : 1; for (int rep = 0; rep < nrep; ++rep) { const bool dry = rep > 0; (void)dry; call; if (rep + 1 < nrep) __syncthreads(); } if ((k) + 1 < hi) xcd_barrier(bar); }
    PHASE(0, { phase_prep(p, lds); phase_prenorm(p); })
    PHASE(2, phase_gemm_in(p, lds))
    PHASE(3, { vtrans_items(p, lds); gla1_items(p, lds); })
    PHASE(4, { gla2_scan(p); phase_attn(p, lds); })
    PHASE(5, gla3_items(p, lds))
    PHASE(6, phase_gemm_out(p, lds))
    PHASE(7, phase_postmix(p, lds, dry))
    PHASE(8, phase_moe(p, lds))
    PHASE(10, phase_combine(p, lds))
#undef PHASE
}

extern "C" void kernel_launch(void* const* d_in, const int* in_sizes, int n_in, void* d_out, int out_size, void* d_ws, size_t ws_size, hipStream_t stream) {
    static int grid_blocks = 0;
    if (grid_blocks == 0) {
        if (n_in != 19 || out_size != T * D || ws_size < WS_END) { fprintf(stderr, "kernel_launch: unexpected shapes (n_in %d out %d ws %zu need %zu)\n", n_in, out_size, ws_size, (size_t)WS_END); grid_blocks = -1; return; }
        int dev = 0, cus = 0, per_cu = 0;
        (void)hipGetDevice(&dev);
        (void)hipDeviceGetAttribute(&cus, hipDeviceAttributeMultiprocessorCount, dev);
        if (hipFuncSetAttribute((const void*)fwd_kernel, hipFuncAttributeMaxDynamicSharedMemorySize, LDS_BYTES) != hipSuccess) { fprintf(stderr, "kernel_launch: hipFuncSetAttribute failed\n"); grid_blocks = -1; return; }
        (void)hipOccupancyMaxActiveBlocksPerMultiprocessor(&per_cu, fwd_kernel, NTHREADS, LDS_BYTES);
        if (per_cu < 1) { fprintf(stderr, "kernel_launch: occupancy query reports %d blocks per CU\n", per_cu); per_cu = 1; }
        grid_blocks = cus;
        (void)hipGetLastError();
    }
    if (grid_blocks < 0) return;
    (void)hipMemsetAsync((char*)d_ws + WS_CTL, 0, CTL_BYTES, stream);
    Params p{};
    p.x = (const float*)d_in[0]; p.c = (const float*)d_in[1]; p.w_mod = (const float*)d_in[2]; p.b_mod = (const float*)d_in[3];
    p.g_pre_mix = (const float*)d_in[4]; p.w_in = (const float*)d_in[5]; p.w_gate_lr = (const float*)d_in[6]; p.b_gate = (const float*)d_in[7];
    p.g_gla = (const float*)d_in[8]; p.w_out = (const float*)d_in[9]; p.g_post_mix = (const float*)d_in[10]; p.g_pre_ffn = (const float*)d_in[11];
    p.router_w = (const float*)d_in[12]; p.router_b = (const float*)d_in[13]; p.w_gate_up = (const float*)d_in[14]; p.b_gate_up = (const float*)d_in[15];
    p.w_down = (const float*)d_in[16]; p.b_down = (const float*)d_in[17]; p.g_post_ffn = (const float*)d_in[18];
    p.out = (float*)d_out; p.ws = (unsigned char*)d_ws;
    for (int d = 0; d < 32; ++d) p.inv_freq[d] = powf(10000.0f, -(float)d / 32.0f);
#if ONE_LAUNCH
    p.ph_lo = 0; p.ph_hi = NPHASE;
    void* args[] = {&p};
    hipError_t e = hipLaunchCooperativeKernel((void*)fwd_kernel, dim3(grid_blocks), dim3(NTHREADS), args, LDS_BYTES, stream);
    if (e != hipSuccess) fprintf(stderr, "cooperative launch failed: %s (grid %d)\n", hipGetErrorString(e), grid_blocks);
#else
    for (int k = 0; k < NPHASE; ++k) { p.ph_lo = k; p.ph_hi = k + 1; hipLaunchKernelGGL(fwd_kernel, dim3(grid_blocks), dim3(NTHREADS), LDS_BYTES, stream, p); }
#endif
}
```

```cpp
#include <hip/hip_runtime.h>
#include <cstdio>
#include <cstdint>
#include <cmath>

#ifndef ONE_LAUNCH
#define ONE_LAUNCH 1
#endif

typedef unsigned short bf16_t;
typedef short bf16x8 __attribute__((ext_vector_type(8)));
typedef float f32x4 __attribute__((ext_vector_type(4)));
typedef unsigned u32x4 __attribute__((ext_vector_type(4)));
#define LAS __attribute__((address_space(3)))

constexpr int T = 16384, D = 1024, S = 8192;
constexpr int DIN = 3088, DINP = 3104;
constexpr int NE = 32, DFF = 1024;
constexpr int PMAX = 65536 + NE * 256;
constexpr int NTHREADS = 512, NW = 8;
constexpr int LDS_STAGE = 131072;
constexpr int LDS_PS = LDS_STAGE;
constexpr int LDS_BARW = LDS_STAGE + 256;
constexpr int LDS_CNT = LDS_STAGE + 512;
constexpr int LDS_TOKB = LDS_STAGE + 1024;
constexpr int LDS_BYTES = LDS_STAGE + 4096;
constexpr int NPHASE = 11;
constexpr float EPS = 1e-6f;
constexpr float LOG2E = 1.4426950408889634f;

constexpr size_t al(size_t x) { return (x + 255) & ~(size_t)255; }
constexpr size_t WS_CTL   = 0;
constexpr size_t CTL_BYTES = 65536;
constexpr size_t WS_MOD   = WS_CTL + CTL_BYTES;
constexpr size_t WS_ROPE  = al(WS_MOD + 2 * 6144 * 4);
constexpr size_t WS_WINT  = al(WS_ROPE + (size_t)S * 32 * 2 * 4);
constexpr size_t WS_WOUTT = al(WS_WINT + (size_t)DINP * D * 2);
constexpr size_t WS_WGUT  = al(WS_WOUTT + (size_t)D * D * 2);
constexpr size_t WS_WDT   = al(WS_WGUT + (size_t)NE * 2048 * D * 2);
constexpr size_t WS_H     = al(WS_WDT + (size_t)NE * D * DFF * 2);
constexpr size_t WS_QA    = al(WS_H + (size_t)T * D * 2);
constexpr size_t WS_KA    = al(WS_QA + (size_t)T * 512 * 2);
constexpr size_t WS_VA    = al(WS_KA + (size_t)T * 512 * 2);
constexpr size_t WS_VB    = al(WS_VA + (size_t)T * 512 * 2);
constexpr size_t WS_QG    = al(WS_VB + (size_t)T * 512 * 2);
constexpr size_t WS_KG    = al(WS_QG + (size_t)T * 256 * 2);
constexpr size_t WS_VG    = al(WS_KG + (size_t)T * 256 * 2);
constexpr size_t WS_RG    = al(WS_VG + (size_t)T * 512 * 2);
constexpr size_t WS_GLR   = al(WS_RG + (size_t)T * 512 * 2);
constexpr size_t WS_UT    = al(WS_GLR + (size_t)T * 16 * 4);
constexpr size_t WS_AG    = al(WS_UT + (size_t)1024 * 128 * 64 * 4);
constexpr size_t WS_SPT   = al(WS_AG + (size_t)1024 * 64 * 4);
constexpr size_t WS_CAT   = al(WS_SPT + (size_t)1024 * 128 * 64 * 2);
constexpr size_t WS_TOPI  = al(WS_CAT + (size_t)T * D * 2);
constexpr size_t WS_GATE  = al(WS_TOPI + (size_t)T * 4 * 4);
constexpr size_t WS_POS   = al(WS_GATE + (size_t)T * 4 * 4);
constexpr size_t WS_SLOT  = al(WS_POS + (size_t)T * 4 * 4);
constexpr size_t WS_TOK   = al(WS_SLOT + (size_t)T * 4 * 4);
constexpr size_t WS_ACT   = al(WS_TOK + (size_t)NE * T * 4);
constexpr size_t WS_YMIX  = WS_ACT;
constexpr size_t WS_X1    = WS_UT;
constexpr size_t WS_YE    = al(WS_ACT + (size_t)PMAX * DFF * 2);
constexpr size_t WS_IDT   = al(WS_YE + (size_t)PMAX * D * 2);
constexpr size_t WS_END   = al(WS_IDT + (size_t)PMAX * 4);
static_assert((size_t)T * D * 4 <= (size_t)PMAX * DFF * 2, "YMIX alias fits in ACT");
static_assert(WS_X1 + (size_t)T * D * 2 <= WS_AG, "X1 alias fits in UT");
constexpr int CW_CNT = 4096;
constexpr int CW_UPCNT = 4352;
constexpr int CW_MODCNT = 4224;

struct Params {
    const float *x, *c, *w_mod, *b_mod, *g_pre_mix, *w_in, *w_gate_lr, *b_gate, *g_gla, *w_out, *g_post_mix, *g_pre_ffn,
                *router_w, *router_b, *w_gate_up, *b_gate_up, *w_down, *b_down, *g_post_ffn;
    float* out; unsigned char* ws;
    int ph_lo, ph_hi;
    float inv_freq[32];
};

__device__ __forceinline__ unsigned f2bf(float f) { unsigned u = __builtin_bit_cast(unsigned, f); return (u + 0x7fffu + ((u >> 16) & 1u)) >> 16; }
typedef float f32x2_t __attribute__((ext_vector_type(2))); typedef __bf16 bf16x2_t __attribute__((ext_vector_type(2)));
__device__ __forceinline__ unsigned pk2(float lo, float hi) { f32x2_t v = {lo, hi}; bf16x2_t b = __builtin_convertvector(v, bf16x2_t); return __builtin_bit_cast(unsigned, b); }
__device__ __forceinline__ float bf2f(unsigned short b) { return __builtin_bit_cast(float, (unsigned)b << 16); }
__device__ __forceinline__ float4 ntload4(const float4* p) { const f32x4 t = __builtin_nontemporal_load((const f32x4*)p); return make_float4(t[0], t[1], t[2], t[3]); }
__device__ __forceinline__ uint2 ntload2(const uint2* p) { typedef unsigned u32x2 __attribute__((ext_vector_type(2))); const u32x2 t = __builtin_nontemporal_load((const u32x2*)p); return make_uint2(t[0], t[1]); }
__device__ __forceinline__ void ntstore4(float4* p, float4 v) { const f32x4 t = {v.x, v.y, v.z, v.w}; __builtin_nontemporal_store(t, (f32x4*)p); }
__device__ __forceinline__ void ntstore2(uint2* p, uint2 v) { typedef unsigned u32x2 __attribute__((ext_vector_type(2))); const u32x2 t = {v.x, v.y}; __builtin_nontemporal_store(t, (u32x2*)p); }
__device__ __forceinline__ void ntstore4u(uint4* p, uint4 v) { const u32x4 t = {v.x, v.y, v.z, v.w}; __builtin_nontemporal_store(t, (u32x4*)p); }
__device__ __forceinline__ float wave_sum(float v) {
#pragma unroll
    for (int o = 1; o < 64; o <<= 1) v += __shfl_xor(v, o);
    return v;
}
__device__ __forceinline__ float fexp2(float x) { return __builtin_amdgcn_exp2f(x); }
__device__ __forceinline__ float fexp(float x) { return __builtin_amdgcn_exp2f(x * LOG2E); }
__device__ __forceinline__ float flog(float x) { return __builtin_amdgcn_logf(x) * 0.6931471805599453f; }
__device__ __forceinline__ float fsilu(float x) { return x * __builtin_amdgcn_rcpf(1.f + fexp(-x)); }

#define GAS __attribute__((address_space(1)))
namespace pg8 {
constexpr int BM = 256, BK = 64, HALF = 128, HTB = HALF * BK * 2, NXCD = 8, WGM = 8;
__host__ __device__ __forceinline__ int lds_byte(int r, int c) { const int st = (r >> 4) * 2 + (c >> 5), rr = r & 15, cc = c & 31, ob = rr * 64 + cc * 2; return st * 1024 + (ob ^ (((ob >> 9) & 1) << 5)); }
__host__ __device__ __forceinline__ void stage_rc(int b, int& R, int& C) { const int st = b / 1024, sb = b % 1024, swz = sb ^ (((sb >> 9) & 1) << 5); R = (st >> 1) * 16 + swz / 64; C = (st & 1) * 32 + (swz % 64) / 2; }
__host__ __device__ __forceinline__ int perm32(int rho) { const int n = rho >> 4, i = rho & 15; return 8 * (i >> 2) + 4 * n + (i & 3); }

struct Unit { const char* A; const char* B; unsigned ao[2][2]; int row0, pn, e, nvalid, tb0; };

__device__ __forceinline__ int xcd_remap(int wgid, int nwg) { const int q = nwg / NXCD, r = nwg % NXCD, xcd = wgid % NXCD, off = wgid / NXCD; return (xcd < r ? xcd * (q + 1) : r * (q + 1) + (xcd - r) * q) + off; }
__device__ __forceinline__ const char* uptr(const char* p) {
    const unsigned long long v = (unsigned long long)p;
    const unsigned lo = __builtin_amdgcn_readfirstlane((unsigned)v), hi = __builtin_amdgcn_readfirstlane((unsigned)(v >> 32));
    return (const char*)(((unsigned long long)hi << 32) | lo);
}

template <class Epi, class Sched>
__device__ __forceinline__ void gemm_phase(LAS unsigned char* lds, const int K, const Sched& S, const Epi& E, const char* wsb) {
    constexpr bool GATHER = Sched::GATHER;
    const int tid = threadIdx.x, wid = __builtin_amdgcn_readfirstlane(tid >> 6), lane = tid & 63, wr = wid >> 2, wc = wid & 3, fr = lane & 15, fq = lane >> 4;
    const int nt = K / BK;
    unsigned voffA[2], voffB[2];
#pragma unroll
    for (int i = 0; i < 2; ++i) { int R, C; stage_rc(tid * 16 + i * 8192, R, C); const int Rb = Epi::PERM ? ((R & ~31) + perm32(R & 31)) : R;
        voffA[i] = (unsigned)(R * K + C) * 2u; voffB[i] = (unsigned)(Rb * K + C) * 2u; }
    const size_t kstep = (size_t)(BK * 2);
    const size_t hstep = (size_t)HALF * K * 2;
    const unsigned ldsw = (unsigned)wid * 1024u;
    const int aoff = lds_byte(wr * 64 + fr, fq * 8), boff = lds_byte(wc * 32 + fr, fq * 8);
#define PG8_SA(b, h) (((b) * 2 + (h)) * HTB)
#define PG8_SB(b, h) ((4 + (b) * 2 + (h)) * HTB)
    const __amdgpu_buffer_rsrc_t rsrc = __builtin_amdgcn_make_buffer_rsrc((void*)wsb, 0, 0xFFFFFFFF, 0x00020000);
#define PG8_STAGE(bufoff, gbase, voff) do { const unsigned _so = (unsigned)((const char*)(gbase) - wsb); _Pragma("unroll") for (int _i = 0; _i < 2; ++_i) \
        __builtin_amdgcn_raw_ptr_buffer_load_lds(rsrc, (LAS void*)(lds + (bufoff) + ldsw + _i * 8192), 16, (voff)[_i], _so, 0, 0); } while (0)
#define PG8_STAGE_A(bufoff, ap, ao, h) do { if constexpr (GATHER) PG8_STAGE(bufoff, ap, (ao)[h]); else PG8_STAGE(bufoff, (ap) + (size_t)(h) * hstep, voffA); } while (0)
#define PG8_LDA(dst, b, h) do { _Pragma("unroll") for (int m = 0; m < 4; ++m) _Pragma("unroll") for (int k = 0; k < 2; ++k) dst[m][k] = *(const LAS bf16x8*)(lds + PG8_SA(b, h) + aoff + m * 2048 + k * 1024); } while (0)
#define PG8_LDB(dst, b, h) do { _Pragma("unroll") for (int n = 0; n < 2; ++n) _Pragma("unroll") for (int k = 0; k < 2; ++k) dst[n][k] = *(const LAS bf16x8*)(lds + PG8_SB(b, h) + boff + n * 2048 + k * 1024); } while (0)
#define PG8_MMA(ai, bj, At, Bt) do { _Pragma("unroll") for (int m = 0; m < 4; ++m) _Pragma("unroll") for (int n = 0; n < 2; ++n) _Pragma("unroll") for (int k = 0; k < 2; ++k) \
        acc[ai][bj][m][n] = __builtin_amdgcn_mfma_f32_16x16x32_bf16(Bt[n][k], At[m][k], acc[ai][bj][m][n], 0, 0, 0); } while (0)
#define PG8_UCOPY(d, s_) do { (d).A = (s_).A; (d).B = (s_).B; (d).row0 = (s_).row0; (d).pn = (s_).pn; (d).e = (s_).e; (d).nvalid = (s_).nvalid; (d).tb0 = (s_).tb0; } while (0)
#define PG8_WAIT_V(n) asm volatile("s_waitcnt vmcnt(" #n ")" ::: "memory")
#define PG8_WAIT_L(n) asm volatile("s_waitcnt lgkmcnt(" #n ")" ::: "memory")
#define PG8_BAR __builtin_amdgcn_s_barrier()
#define PG8_SCHED __builtin_amdgcn_sched_barrier(0)
    Unit cur, nxt; int ui = 0;
    int pend = -1;
    if (!S.next(0, cur)) return;
    if constexpr (GATHER) S.first_rows(cur);
    f32x4 acc[2][2][4][2];
    if constexpr (Epi::BINIT) E.init(acc, cur, wc, fq);
    else {
#pragma unroll
    for (int a = 0; a < 2; ++a)
#pragma unroll
        for (int b = 0; b < 2; ++b)
#pragma unroll
            for (int m = 0; m < 4; ++m)
#pragma unroll
                for (int n = 0; n < 2; ++n) acc[a][b][m][n] = (f32x4){0.f, 0.f, 0.f, 0.f};
    }
    bf16x8 At[4][2], B0[2][2], B1[2][2];
#ifndef PG8_SP2
#define PG8_SP2 1
#endif
#if PG8_SP2
    PG8_STAGE(PG8_SB(0, 0), cur.B, voffB); PG8_STAGE(PG8_SB(0, 1), cur.B + hstep, voffB); PG8_STAGE_A(PG8_SA(0, 0), cur.A, cur.ao, 0); PG8_STAGE_A(PG8_SA(0, 1), cur.A, cur.ao, 1);
    if (wr == 1) PG8_BAR;
    PG8_WAIT_V(2); PG8_BAR;
#else
    PG8_STAGE(PG8_SB(0, 0), cur.B, voffB); PG8_STAGE_A(PG8_SA(0, 0), cur.A, cur.ao, 0); PG8_STAGE(PG8_SB(0, 1), cur.B + hstep, voffB); PG8_STAGE_A(PG8_SA(0, 1), cur.A, cur.ao, 1);
    if (wr == 1) PG8_BAR;
    PG8_WAIT_V(4); PG8_BAR;
#endif
    PG8_STAGE(PG8_SB(1, 0), cur.B + kstep, voffB); PG8_STAGE_A(PG8_SA(1, 0), cur.A + kstep, cur.ao, 0); PG8_STAGE(PG8_SB(1, 1), cur.B + hstep + kstep, voffB);
    PG8_WAIT_V(6); PG8_BAR;
    bool slept = false;
    for (;;) {
        if constexpr (Sched::HOOKS) { if (!slept && S.stagger(cur)) { slept = true; __builtin_amdgcn_s_sleep(110); } }
        const bool has_next = S.next(ui + 1, nxt);
        if constexpr (GATHER) { if (has_next && wid < 4) S.prefetch_rows(nxt, (LAS unsigned*)(lds + LDS_TOKB + ((ui + 1) & 1) * 1024 + wid * 256), wid, lane); }
        if constexpr (Sched::HOOKS) { if (has_next) S.poll(nxt, (LAS unsigned*)(lds + LDS_BARW + 32 + wid * 4), lane); }
        if (!has_next) { PG8_UCOPY(nxt, cur); }
        for (int t = 0; t < nt; t += 2) {
            const bool last = (t == nt - 2);
            if constexpr (Sched::HOOKS) {
                if (t == 2 && pend >= 0) { S.publish(pend, lane); pend = -1; }
                if (last && has_next) S.a_ready(nxt, (const LAS unsigned*)(lds + LDS_BARW + 32 + wid * 4));
            }
            const char* a1 = cur.A + (size_t)(t + 1) * kstep;
            const char* a2 = last ? nxt.A : cur.A + (size_t)(t + 2) * kstep; const char* b2 = last ? nxt.B : cur.B + (size_t)(t + 2) * kstep;
            const char* a3 = a2 + kstep; const char* b3 = b2 + kstep;
            unsigned o2[2][2];
            if constexpr (GATHER) {
#pragma unroll
                for (int q = 0; q < 2; ++q)
#pragma unroll
                    for (int h = 0; h < 2; ++h) o2[h][q] = cur.ao[h][q];
                if (last && has_next) {
                    const LAS int* tb = (const LAS int*)(lds + LDS_TOKB + ((ui + 1) & 1) * 1024);
#pragma unroll
                    for (int q = 0; q < 2; ++q) { int R, C; stage_rc(tid * 16 + q * 8192, R, C);
#pragma unroll
                        for (int h = 0; h < 2; ++h) { const int i = h * HALF + R; const int tk = i < nxt.nvalid ? tb[i] : 0; o2[h][q] = (unsigned)(tk * K + C) * 2u; } }
                }
            }
#if !PG8_SP2
            PG8_LDB(B0, 0, 0); PG8_SCHED; PG8_LDA(At, 0, 0); PG8_STAGE_A(PG8_SA(1, 1), a1, cur.ao, 1);
            PG8_WAIT_L(8); PG8_BAR; PG8_WAIT_L(0); PG8_MMA(0, 0, At, B0); PG8_BAR; PG8_SCHED;
            PG8_LDB(B1, 0, 1); PG8_STAGE(PG8_SB(0, 0), b2, voffB);
            PG8_BAR; PG8_WAIT_L(0); PG8_MMA(0, 1, At, B1); PG8_BAR;
            PG8_LDA(At, 0, 1); PG8_STAGE_A(PG8_SA(0, 0), a2, o2, 0);
            PG8_BAR; PG8_WAIT_L(0); PG8_MMA(1, 0, At, B0); PG8_BAR; PG8_SCHED;
            PG8_STAGE(PG8_SB(0, 1), b2 + hstep, voffB);
            PG8_WAIT_V(6); PG8_BAR; PG8_MMA(1, 1, At, B1); PG8_BAR;
            PG8_LDB(B0, 1, 0); PG8_SCHED; PG8_LDA(At, 1, 0); PG8_STAGE_A(PG8_SA(0, 1), a2, o2, 1);
            PG8_WAIT_L(8); PG8_BAR; PG8_WAIT_L(0); PG8_MMA(0, 0, At, B0); PG8_BAR; PG8_SCHED;
            PG8_LDB(B1, 1, 1); PG8_STAGE(PG8_SB(1, 0), b3, voffB);
            PG8_BAR; PG8_WAIT_L(0); PG8_MMA(0, 1, At, B1); PG8_BAR;
            PG8_LDA(At, 1, 1); PG8_STAGE_A(PG8_SA(1, 0), a3, o2, 0);
            PG8_BAR; PG8_WAIT_L(0); PG8_MMA(1, 0, At, B0); PG8_BAR; PG8_SCHED;
            PG8_STAGE(PG8_SB(1, 1), b3 + hstep, voffB);
            PG8_WAIT_V(6); PG8_BAR; PG8_MMA(1, 1, At, B1); PG8_BAR;
#else
            PG8_LDB(B0, 0, 0); PG8_LDB(B1, 0, 1); PG8_SCHED; PG8_LDA(At, 0, 0); PG8_STAGE_A(PG8_SA(1, 1), a1, cur.ao, 1);
            PG8_WAIT_V(8); PG8_WAIT_L(0); PG8_BAR; __builtin_amdgcn_s_setprio(1); PG8_MMA(0, 0, At, B0); PG8_MMA(0, 1, At, B1); __builtin_amdgcn_s_setprio(0); PG8_BAR; PG8_SCHED;
            PG8_LDA(At, 0, 1); PG8_STAGE(PG8_SB(0, 0), b2, voffB); PG8_STAGE(PG8_SB(0, 1), b2 + hstep, voffB); PG8_STAGE_A(PG8_SA(0, 0), a2, o2, 0);
            PG8_WAIT_V(8); PG8_WAIT_L(0); PG8_BAR; __builtin_amdgcn_s_setprio(1); PG8_MMA(1, 0, At, B0); PG8_MMA(1, 1, At, B1); __builtin_amdgcn_s_setprio(0); PG8_BAR; PG8_SCHED;
            PG8_LDB(B0, 1, 0); PG8_LDB(B1, 1, 1); PG8_SCHED; PG8_LDA(At, 1, 0); PG8_STAGE_A(PG8_SA(0, 1), a2, o2, 1);
            PG8_WAIT_V(8); PG8_WAIT_L(0); PG8_BAR; __builtin_amdgcn_s_setprio(1); PG8_MMA(0, 0, At, B0); PG8_MMA(0, 1, At, B1); __builtin_amdgcn_s_setprio(0); PG8_BAR; PG8_SCHED;
            PG8_LDA(At, 1, 1); PG8_STAGE(PG8_SB(1, 0), b3, voffB); PG8_STAGE(PG8_SB(1, 1), b3 + hstep, voffB); PG8_STAGE_A(PG8_SA(1, 0), a3, o2, 0);
            PG8_WAIT_V(8); PG8_WAIT_L(0); PG8_BAR; __builtin_amdgcn_s_setprio(1); PG8_MMA(1, 0, At, B0); PG8_MMA(1, 1, At, B1); __builtin_amdgcn_s_setprio(0); PG8_BAR; PG8_SCHED;
#endif
        }
        if (wr == 0) PG8_BAR;
        E(acc, cur, wr, wc, fr, fq);
        if constexpr (Sched::HOOKS) pend = S.pub_tile(cur);
        if (!has_next) break;
        PG8_UCOPY(cur, nxt); ++ui;
        if constexpr (Epi::BINIT) E.init(acc, cur, wc, fq);
        else {
#pragma unroll
        for (int a = 0; a < 2; ++a)
#pragma unroll
            for (int b = 0; b < 2; ++b)
#pragma unroll
                for (int m = 0; m < 4; ++m)
#pragma unroll
                    for (int n = 0; n < 2; ++n) acc[a][b][m][n] = (f32x4){0.f, 0.f, 0.f, 0.f};
        }
        if constexpr (GATHER) {
            const LAS int* tb = (const LAS int*)(lds + LDS_TOKB + (ui & 1) * 1024);
#pragma unroll
            for (int q = 0; q < 2; ++q) { int R, C; stage_rc(tid * 16 + q * 8192, R, C);
#pragma unroll
                for (int h = 0; h < 2; ++h) { const int i = h * HALF + R; const int tk = i < cur.nvalid ? tb[i] : 0; cur.ao[h][q] = (unsigned)(tk * K + C) * 2u; } }
        }
        if (wr == 1) PG8_BAR;
    }
    PG8_WAIT_V(0);
    if constexpr (Sched::HOOKS) { if (pend >= 0) S.publish(pend, lane); }
    PG8_BAR;
#undef PG8_SA
#undef PG8_SB
#undef PG8_STAGE
#undef PG8_STAGE_A
#undef PG8_LDA
#undef PG8_LDB
#undef PG8_MMA
#undef PG8_WAIT_V
#undef PG8_UCOPY
#undef PG8_WAIT_L
#undef PG8_BAR
#undef PG8_SCHED
}

struct DenseSched {
    static constexpr bool GATHER = false, HOOKS = false;
    const char* A; const char* Bt; int K, nM, nN, nwg, G, c;
    __device__ __forceinline__ void init(const void* A_, const void* Bt_, int M, int N, int K_) {
        A = uptr((const char*)A_); Bt = uptr((const char*)Bt_); K = K_; nM = M / BM; nN = N / BM; nwg = nM * nN; G = gridDim.x; c = blockIdx.x;
    }
    __device__ __forceinline__ bool next(int i, Unit& u) const {
        const long L = (long)i * G + c; if (L >= nwg) return false;
        const int wgid = xcd_remap((int)L, nwg);
        const int nig = WGM * nN, gid = wgid / nig, fm = gid * WGM, gsz = (nM - fm) < WGM ? (nM - fm) : WGM;
        const int pm = fm + ((wgid % nig) % gsz), pn = (wgid % nig) / gsz;
        u.A = A + (size_t)pm * BM * K * 2; u.B = Bt + (size_t)pn * BM * K * 2; u.row0 = pm * BM; u.pn = pn; u.e = 0; u.nvalid = BM; u.tb0 = 0;
        return true;
    }
};
template <bool GATHER_>
struct MoeSched {
    static constexpr bool GATHER = GATHER_, HOOKS = false;
    const char* A; const char* W; int K, nN, rows_per_e, nwg, G, c; const int* ps; const int* cn; const int* tok;
    __device__ __forceinline__ void init(const void* A_, const void* W_, int K_, int nN_, int rows_per_e_, const int* ps_, const int* tok_) {
        A = uptr((const char*)A_); W = uptr((const char*)W_); K = K_; nN = nN_; rows_per_e = rows_per_e_; ps = ps_; cn = ps_ + (LDS_CNT - LDS_PS) / 4; tok = (const int*)uptr((const char*)tok_); G = gridDim.x; c = blockIdx.x;
        nwg = __builtin_amdgcn_readfirstlane((ps[NE] >> 8) * nN);
    }
    __device__ __forceinline__ bool next(int i, Unit& u) const {
        const long L = (long)i * G + c; if (L >= nwg) return false;
        const int wgid = xcd_remap((int)L, nwg);
        const int rt = wgid / nN, pn = wgid % nN, slot0 = rt * BM;
        int e = 0;
        for (int q = 1; q < NE; ++q) e = (ps[q] <= slot0) ? q : e;
        e = __builtin_amdgcn_readfirstlane(e);
        u.B = W + ((size_t)e * rows_per_e + (size_t)pn * BM) * K * 2; u.row0 = slot0; u.pn = pn; u.e = e;
        const int pos0 = __builtin_amdgcn_readfirstlane(slot0 - ps[e]);
        u.nvalid = __builtin_amdgcn_readfirstlane(cn[e]) - pos0; u.tb0 = e * T + pos0;
        if constexpr (GATHER) u.A = A; else u.A = A + (size_t)slot0 * K * 2;
        return true;
    }
    __device__ __forceinline__ void first_rows(Unit& u) const {
#pragma unroll
        for (int q = 0; q < 2; ++q) { int R, C; stage_rc(threadIdx.x * 16 + q * 8192, R, C);
#pragma unroll
            for (int h = 0; h < 2; ++h) { const int i = h * HALF + R; const int tk = i < u.nvalid ? tok[u.tb0 + i] : 0; u.ao[h][q] = (unsigned)(tk * K + C) * 2u; } }
    }
    __device__ __forceinline__ void prefetch_rows(const Unit& u, LAS unsigned* dst, int wid, int lane) const {
        __builtin_amdgcn_global_load_lds((const unsigned*)(tok + u.tb0 + wid * 64 + lane), dst, 4, 0, 0);
    }
};
struct MoeSched2 {
    static constexpr bool GATHER = true, HOOKS = true;
    const char* ws; int K, nU, nwg, G, c, rt0; const int* ps; const int* cn; const int* tok; GAS int* upcnt;
    __device__ __forceinline__ void init(unsigned char* ws_, const int* ps_, int nloc, int rank, int base) {
        ws = uptr((const char*)ws_); K = D; ps = ps_; cn = ps_ + (LDS_CNT - LDS_PS) / 4; tok = (const int*)(ws + WS_TOK); upcnt = (GAS int*)(ws + WS_CTL) + CW_UPCNT;
        G = __builtin_amdgcn_readfirstlane(nloc); c = __builtin_amdgcn_readfirstlane(rank);
        const int rt = __builtin_amdgcn_readfirstlane(ps[NE] >> 8), gt = gridDim.x;
        rt0 = __builtin_amdgcn_readfirstlane(rt * base / gt); const int rt1 = __builtin_amdgcn_readfirstlane(rt * (base + nloc) / gt);
        nU = (rt1 - rt0) * 8; nwg = (rt1 - rt0) * 12;
    }
    __device__ __forceinline__ bool next(int i, Unit& u) const {
        const int L = i * G + c; if (L >= nwg) return false;
        const bool dn = L >= nU;
        const int wgid = dn ? L - nU : L;
        const int rt = rt0 + (dn ? wgid >> 2 : wgid >> 3), pn = dn ? wgid & 3 : wgid & 7, slot0 = rt * BM;
        const int ln = (int)__builtin_amdgcn_mbcnt_hi(~0u, __builtin_amdgcn_mbcnt_lo(~0u, 0u)), lq = ln & 31;
        const int pv = ps[lq], cv = cn[lq];
        const int e = __builtin_popcountll(__ballot(ln >= 1 && ln < NE && pv <= slot0));
        u.row0 = slot0; u.pn = pn;
        const int pos0 = slot0 - __builtin_amdgcn_readlane(pv, e);
        if (dn) { u.B = ws + WS_WDT + ((size_t)e * 1024 + (size_t)pn * BM) * (size_t)(D * 2); u.A = ws + WS_ACT; u.e = e | 32; u.nvalid = BM; u.tb0 = (int)((WS_IDT - WS_TOK) / 4) + slot0; }
        else    { u.B = ws + WS_WGUT + ((size_t)e * 2048 + (size_t)pn * BM) * (size_t)(D * 2); u.A = ws + WS_H; u.e = e; u.nvalid = __builtin_amdgcn_readlane(cv, e) - pos0; u.tb0 = e * T + pos0; }
        return true;
    }
    __device__ __forceinline__ void first_rows(Unit& u) const {
#pragma unroll
        for (int q = 0; q < 2; ++q) { int R, C; stage_rc(threadIdx.x * 16 + q * 8192, R, C);
#pragma unroll
            for (int h = 0; h < 2; ++h) { const int i = h * HALF + R; const int tk = i < u.nvalid ? tok[u.tb0 + i] : 0; u.ao[h][q] = (unsigned)(tk * K + C) * 2u; } }
    }
    __device__ __forceinline__ void prefetch_rows(const Unit& u, LAS unsigned* dst, int wid, int lane) const {
        __builtin_amdgcn_global_load_lds((const unsigned*)(tok + u.tb0 + wid * 64 + lane), dst, 4, 0, 0);
    }
    __device__ __forceinline__ void poll(const Unit& u, LAS unsigned* w, int lane) const {
        if (u.e >= 32 && lane == 0) __builtin_amdgcn_global_load_lds((const GAS unsigned*)(upcnt + (u.row0 >> 8)), w, 4, 0, 16  );
    }
    __device__ __forceinline__ void a_ready(const Unit& u, const LAS unsigned* w) const {
        if (u.e >= 32) {
            const int rdy = __builtin_amdgcn_readfirstlane((int)*w);
            if (rdy < 64) { const GAS int* cp = upcnt + (u.row0 >> 8); int spins = 0;
                while (__hip_atomic_load(cp, __ATOMIC_RELAXED, __HIP_MEMORY_SCOPE_AGENT) < 64 && ++spins < (1 << 22)) __builtin_amdgcn_s_sleep(4); }
            asm volatile("" ::: "memory");
        }
    }
    __device__ __forceinline__ bool stagger(const Unit& u) const { return (c & 1); }
    __device__ __forceinline__ int pub_tile(const Unit& u) const { return u.e < 32 ? (u.row0 >> 8) : -1; }
    __device__ __forceinline__ void publish(int rt, int lane) const { if (lane == 0) __hip_atomic_fetch_add(upcnt + rt, 1, __ATOMIC_RELAXED, __HIP_MEMORY_SCOPE_AGENT); }
};
}

__device__ __forceinline__ int win_row(int oc) {
    if (oc >= 1024) return oc;
    const int base = oc & ~511, o = oc & 511;
    return base + 256 * (o >> 8) + 128 * ((o >> 2) & 1) + 32 * ((o >> 6) & 3) + 8 * ((o & 31) >> 3) + 4 * ((o >> 5) & 1) + (o & 3);
}
__device__ __forceinline__ int wgu_row(int oc) { const int jj = oc >> 1, il = oc & 1; return 256 * (jj >> 7) + 128 * ((jj >> 2) & 1) + 32 * ((jj >> 5) & 3) + 8 * ((jj >> 3) & 3) + 4 * il + (jj & 3); }

struct CvtItem { const float* W; bf16_t* WT; int ldw, nvalid, K, k0, n0, map; };
__device__ __forceinline__ void cvt_load(const CvtItem& it, int lane, float4 (&v)[8]) {
    const int col = it.n0 + (lane & 7) * 4;
    const float* src = it.W + (size_t)(it.k0 + (lane >> 3)) * it.ldw + col;
#pragma unroll
    for (int i = 0; i < 8; ++i) { const f32x4 t = (col < it.nvalid) ? __builtin_nontemporal_load((const f32x4*)(src + (size_t)(8 * i) * it.ldw)) : (f32x4){0.f, 0.f, 0.f, 0.f};
        v[i] = make_float4(t[0], t[1], t[2], t[3]); }
}
__device__ __forceinline__ void cvt_store(const CvtItem& it, int lane, const float4 (&v)[8], float* scr) {
    const int r8 = lane >> 3, c4 = (lane & 7) * 4;
#pragma unroll
    for (int i = 0; i < 8; ++i) { float* d = scr + (8 * i + r8) * 33 + c4; d[0] = v[i].x; d[1] = v[i].y; d[2] = v[i].z; d[3] = v[i].w; }
    asm volatile("s_waitcnt lgkmcnt(0)" ::: "memory");
    const int c = lane & 7;
#pragma unroll
    for (int j = 0; j < 4; ++j) { const int n = (lane >> 3) + 8 * j; const float* s = scr + (8 * c) * 33 + n;
        uint4 o; o.x = pk2(s[0 * 33], s[1 * 33]); o.y = pk2(s[2 * 33], s[3 * 33]); o.z = pk2(s[4 * 33], s[5 * 33]); o.w = pk2(s[6 * 33], s[7 * 33]);
        const int oc = it.n0 + n;
        const int orow = it.map == 1 ? win_row(oc) : (it.map == 2 ? wgu_row(oc) : oc);
        ntstore4u((uint4*)(it.WT + (size_t)orow * it.K + it.k0 + 8 * c), o); }
    asm volatile("s_waitcnt lgkmcnt(0)" ::: "memory");
}
__device__ void phase_prep(const Params& p, unsigned char* lds) {
    const int tid = threadIdx.x, lane = tid & 63, wave = tid >> 6;
    unsigned char* ws = p.ws;
    for (int i = blockIdx.x * NTHREADS + tid; i < PMAX; i += gridDim.x * NTHREADS) ((int*)(ws + WS_IDT))[i] = i;
    if ((int)blockIdx.x < 192) {
        float* sl = (float*)lds;
        float* red = sl + 2048;
        for (int i = tid; i < 2048; i += NTHREADS) sl[i] = fsilu(p.c[i]);
        __syncthreads();
        for (int it = blockIdx.x; it < 192; it += gridDim.x) {
            const int col = it * 32 + (tid & 31), kg = tid >> 5;
            float a0 = 0.f, a1 = 0.f;
#pragma unroll 32
            for (int kk = 0; kk < 64; ++kk) { const int k = kg * 64 + kk; const float w = __builtin_nontemporal_load(p.w_mod + (size_t)k * 6144 + col); a0 += sl[k] * w; a1 += sl[1024 + k] * w; }
            red[(kg * 32 + (tid & 31)) * 2 + 0] = a0; red[(kg * 32 + (tid & 31)) * 2 + 1] = a1;
            __syncthreads();
            if (tid < 64) { const int b = tid >> 5, cg_ = tid & 31; float s = 0.f;
#pragma unroll
                for (int g = 0; g < 16; ++g) s += red[(g * 32 + cg_) * 2 + b];
                const int cc = it * 32 + cg_;
                __hip_atomic_store((float*)(ws + WS_MOD) + b * 6144 + cc, s + p.b_mod[cc], __ATOMIC_RELAXED, __HIP_MEMORY_SCOPE_AGENT);
                asm volatile("s_waitcnt vmcnt(0)" ::: "memory"); }
            __syncthreads();
            if (tid == 0) __hip_atomic_fetch_add((unsigned*)(ws + WS_CTL) + CW_MODCNT, 1u, __ATOMIC_RELAXED, __HIP_MEMORY_SCOPE_AGENT);
        }
    }
    __syncthreads();
    {
        float2* rope = (float2*)(ws + WS_ROPE);
        for (int i = blockIdx.x * NTHREADS + tid; i < S * 32; i += gridDim.x * NTHREADS) {
            const int pos = i >> 5, d = i & 31;
            const float angf = (float)pos * p.inv_freq[d];
            const double ang = (double)angf;
            const double TWO_PI = 6.283185307179586476925286766559, HALF_PI = 1.5707963267948966192313216916398;
            const double n = __builtin_rint(ang / TWO_PI);
            const double rr = ang - n * TWO_PI;
            const double q = __builtin_rint(rr / HALF_PI);
            const double y = rr - q * HALF_PI;
            const double y2 = y * y;
            const double sy = y * (1.0 + y2 * (-1.0 / 6 + y2 * (1.0 / 120 + y2 * (-1.0 / 5040 + y2 * (1.0 / 362880 + y2 * (-1.0 / 39916800 + y2 * (1.0 / 6227020800.0)))))));
            const double cy = 1.0 + y2 * (-0.5 + y2 * (1.0 / 24 + y2 * (-1.0 / 720 + y2 * (1.0 / 40320 + y2 * (-1.0 / 3628800 + y2 * (1.0 / 479001600.0))))));
            const int qi = ((int)q) & 3;
            double cs, sn;
            if (qi == 0) { cs = cy; sn = sy; } else if (qi == 1) { cs = -sy; sn = cy; } else if (qi == 2) { cs = -cy; sn = -sy; } else { cs = sy; sn = -cy; }
            rope[i] = make_float2((float)cs, (float)sn);
        }
    }
    {
        float* scr = (float*)(lds + wave * 8448);
        const int gw = blockIdx.x * NW + wave, ngw = gridDim.x * NW;
        constexpr int I_IN = 16 * 97, I_OUT = 16 * 32, I_GU = 16 * 64, I_DN = 16 * 32;
        constexpr int NITEMS = I_IN + I_OUT + NE * I_GU + NE * I_DN;
        auto decode = [&](int r, CvtItem& it) {
            if (r < I_IN) { it.W = p.w_in; it.WT = (bf16_t*)(ws + WS_WINT); it.ldw = DIN; it.nvalid = DIN; it.K = D; it.k0 = (r / 97) * 64; it.n0 = (r % 97) * 32; it.map = 1; return; }
            r -= I_IN;
            if (r < I_OUT) { it.W = p.w_out; it.WT = (bf16_t*)(ws + WS_WOUTT); it.ldw = D; it.nvalid = D; it.K = D; it.k0 = (r / 32) * 64; it.n0 = (r % 32) * 32; it.map = 0; return; }
            r -= I_OUT;
            if (r < NE * I_GU) { const int e = r / I_GU, q = r % I_GU;
                it.W = p.w_gate_up + (size_t)e * D * 2048; it.WT = (bf16_t*)(ws + WS_WGUT) + (size_t)e * 2048 * D; it.ldw = 2048; it.nvalid = 2048; it.K = D; it.k0 = (q / 64) * 64; it.n0 = (q % 64) * 32; it.map = 2; return; }
            r -= NE * I_GU;
            { const int e = r / I_DN, q = r % I_DN;
                it.W = p.w_down + (size_t)e * DFF * D; it.WT = (bf16_t*)(ws + WS_WDT) + (size_t)e * D * DFF; it.ldw = D; it.nvalid = D; it.K = DFF; it.k0 = (q / 32) * 64; it.n0 = (q % 32) * 32; it.map = 0; }
        };
        if (gw < NITEMS) {
            CvtItem cur, nxt; float4 vc[8], vn[8];
            decode(gw, cur); cvt_load(cur, lane, vc);
            for (int r = gw; r < NITEMS; r += ngw) {
                const bool more = r + ngw < NITEMS;
                if (more) { decode(r + ngw, nxt); cvt_load(nxt, lane, vn); }
                cvt_store(cur, lane, vc, scr);
                if (more) { cur = nxt;
#pragma unroll
                    for (int i = 0; i < 8; ++i) vc[i] = vn[i]; }
            }
        }
    }
}

__device__ void phase_prenorm(const Params& p) {
    const int tid = threadIdx.x, lane = tid & 63, wave = tid >> 6;
    if (tid == 0) {
        unsigned* cnt = (unsigned*)(p.ws + WS_CTL) + CW_MODCNT; unsigned sp = 0;
        while (__hip_atomic_load(cnt, __ATOMIC_RELAXED, __HIP_MEMORY_SCOPE_AGENT) < 192u) { __builtin_amdgcn_s_sleep(2); if (++sp > (1u << 20)) break; }
        __builtin_amdgcn_fence(__ATOMIC_ACQUIRE, "agent");
        asm volatile("s_waitcnt vmcnt(0)" ::: "memory");
    }
    __syncthreads();
    const float* mod = (const float*)(p.ws + WS_MOD);
    bf16_t* H = (bf16_t*)(p.ws + WS_H);
    const int mstep = gridDim.x * NW * 2;
    float4 v[2][4], vn[2][4];
    int m0 = (blockIdx.x * NW + wave) * 2;
    if (m0 < T) {
#pragma unroll
        for (int q = 0; q < 2; ++q) { const float4* xr = (const float4*)(p.x + (size_t)(m0 + q) * D) + lane;
#pragma unroll
            for (int j = 0; j < 4; ++j) v[q][j] = ntload4(xr + 64 * j); }
    }
    for (; m0 < T; m0 += mstep) {
        const bool more = m0 + mstep < T;
        if (more) {
#pragma unroll
            for (int q = 0; q < 2; ++q) { const float4* xr = (const float4*)(p.x + (size_t)(m0 + mstep + q) * D) + lane;
#pragma unroll
                for (int j = 0; j < 4; ++j) vn[q][j] = ntload4(xr + 64 * j); }
        }
        const int b = m0 >> 13;
        float4 g[4], sh[4], sc[4];
#pragma unroll
        for (int j = 0; j < 4; ++j) { const int c = 4 * lane + 256 * j; g[j] = *(const float4*)(p.g_pre_mix + c); sh[j] = *(const float4*)(mod + b * 6144 + c); sc[j] = *(const float4*)(mod + b * 6144 + 1024 + c); }
#pragma unroll
        for (int q = 0; q < 2; ++q) {
            const int m = m0 + q;
            float ss = 0.f;
#pragma unroll
            for (int j = 0; j < 4; ++j) ss += v[q][j].x * v[q][j].x + v[q][j].y * v[q][j].y + v[q][j].z * v[q][j].z + v[q][j].w * v[q][j].w;
            const float rstd = rsqrtf(wave_sum(ss) * (1.f / D) + EPS);
#pragma unroll
            for (int j = 0; j < 4; ++j) { const int c = 4 * lane + 256 * j;
                const float h0 = v[q][j].x * rstd * g[j].x * (1.f + sc[j].x) + sh[j].x, h1 = v[q][j].y * rstd * g[j].y * (1.f + sc[j].y) + sh[j].y;
                const float h2 = v[q][j].z * rstd * g[j].z * (1.f + sc[j].z) + sh[j].z, h3 = v[q][j].w * rstd * g[j].w * (1.f + sc[j].w) + sh[j].w;
                uint2 o; o.x = pk2(h0, h1); o.y = pk2(h2, h3);
                *(uint2*)(H + (size_t)m * D + c) = o; }
        }
        if (more) {
#pragma unroll
            for (int q = 0; q < 2; ++q)
#pragma unroll
                for (int j = 0; j < 4; ++j) v[q][j] = vn[q][j];
        }
    }
}

struct EpiIn {
    static constexpr bool PERM = true, BINIT = false;
    unsigned char* ws;
    __device__ __forceinline__ void operator()(const f32x4 (&acc)[2][2][4][2], const pg8::Unit& u, int wr, int wc, int fr, int fq) const {
        const int cbase = u.pn * 256;
        if (cbase < 1024) {
            const bool isq = cbase < 512;
            bf16_t* dst = (bf16_t*)(ws + (isq ? WS_QA : WS_KA));
            const float2* rope = (const float2*)(ws + WS_ROPE);
            const float scl = isq ? 0.125f * LOG2E : 1.f;
            const int head = 4 * ((cbase & 511) >> 8) + wc;
#pragma unroll
            for (int ai = 0; ai < 2; ++ai) {
                float4 c[4][4];
#pragma unroll
                for (int m = 0; m < 4; ++m) { const int pos = (u.row0 + 128 * ai + 64 * wr + 16 * m + fr) & (S - 1);
#pragma unroll
                    for (int q = 0; q < 4; ++q) c[m][q] = *(const float4*)(rope + pos * 32 + 8 * fq + 2 * q); }
#pragma unroll
                for (int m = 0; m < 4; ++m) { const int row = u.row0 + 128 * ai + 64 * wr + 16 * m + fr, pos = row & (S - 1);
                    u32x4 lo, hi;
#pragma unroll
                    for (int bj = 0; bj < 2; ++bj) { const float4 c01 = c[m][2 * bj], c23 = c[m][2 * bj + 1];
                        const f32x4 x1 = acc[ai][bj][m][0], x2 = acc[ai][bj][m][1];
                        lo[2 * bj]     = pk2((x1[0] * c01.x - x2[0] * c01.y) * scl, (x1[1] * c01.z - x2[1] * c01.w) * scl);
                        lo[2 * bj + 1] = pk2((x1[2] * c23.x - x2[2] * c23.y) * scl, (x1[3] * c23.z - x2[3] * c23.w) * scl);
                        hi[2 * bj]     = pk2((x2[0] * c01.x + x1[0] * c01.y) * scl, (x2[1] * c01.z + x1[1] * c01.w) * scl);
                        hi[2 * bj + 1] = pk2((x2[2] * c23.x + x1[2] * c23.y) * scl, (x2[3] * c23.z + x1[3] * c23.w) * scl); }
                    const int bh = (row >> 13) * 8 + head;
                    bf16_t* o = dst + ((size_t)(bh * S + (pos & 15) * 512 + (pos >> 4)) * 64 + 8 * fq); *(u32x4*)o = lo; *(u32x4*)(o + 32) = hi; }
            }
        } else {
            bf16_t* dst; int ldc, cb;
            if (cbase < 1536) { dst = (bf16_t*)(ws + WS_VA); ldc = 512; cb = cbase - 1024; }
            else if (cbase < 1792) { dst = (bf16_t*)(ws + WS_QG); ldc = 256; cb = cbase - 1536; }
            else if (cbase < 2048) { dst = (bf16_t*)(ws + WS_KG); ldc = 256; cb = cbase - 1792; }
            else if (cbase < 2560) { dst = (bf16_t*)(ws + WS_VG); ldc = 512; cb = cbase - 2048; }
            else { dst = (bf16_t*)(ws + WS_RG); ldc = 512; cb = cbase - 2560; }
#pragma unroll
            for (int ai = 0; ai < 2; ++ai)
#pragma unroll
                for (int m = 0; m < 4; ++m) { const int row = u.row0 + 128 * ai + 64 * wr + 16 * m + fr;
#pragma unroll
                    for (int bj = 0; bj < 2; ++bj) { const f32x4 v0 = acc[ai][bj][m][0], v1 = acc[ai][bj][m][1];
                        u32x4 w; w.x = pk2(v0[0], v0[1]); w.y = pk2(v0[2], v0[3]); w.z = pk2(v1[0], v1[1]); w.w = pk2(v1[2], v1[3]);
                        *(u32x4*)(dst + (size_t)row * ldc + cb + 128 * bj + 32 * wc + 8 * fq) = w; } }
        }
    }
};

__device__ void phase_gemm_in(const Params& p, unsigned char* lds) {
    unsigned char* ws = p.ws;
    {
        pg8::DenseSched Sd; Sd.init(ws + WS_H, ws + WS_WINT, T, 3072, D);
        EpiIn E{ws};
        pg8::gemm_phase<EpiIn, pg8::DenseSched>((LAS unsigned char*)lds, D, Sd, E, pg8::uptr((const char*)ws));
    }
    const int tid = threadIdx.x, lane = tid & 63, wave = tid >> 6, fr = lane & 15, fq = lane >> 4;
    const bf16_t* H = (const bf16_t*)(ws + WS_H); const bf16_t* Wl = (const bf16_t*)(ws + WS_WINT) + (size_t)3072 * D;
    float* glr = (float*)(ws + WS_GLR);
    float* part = (float*)lds;
    for (int item = blockIdx.x; item < T / 64; item += gridDim.x) {
        const int mt = wave & 3, kh = wave >> 2, r0 = item * 64 + mt * 16;
        f32x4 a = (f32x4){0.f, 0.f, 0.f, 0.f};
        const bf16_t* ap = H + (size_t)(r0 + fr) * D + kh * 512 + fq * 8;
        const bf16_t* bp = Wl + (size_t)fr * D + kh * 512 + fq * 8;
        bf16x8 av[16], bv[16];
#pragma unroll
        for (int ks = 0; ks < 16; ++ks) { av[ks] = *(const bf16x8*)(ap + ks * 32); bv[ks] = *(const bf16x8*)(bp + ks * 32); }
#pragma unroll
        for (int ks = 0; ks < 16; ++ks) a = __builtin_amdgcn_mfma_f32_16x16x32_bf16(av[ks], bv[ks], a, 0, 0, 0);
        __syncthreads();
        if (kh == 1) {
#pragma unroll
            for (int j = 0; j < 4; ++j) part[(mt * 16 + 4 * fq + j) * 16 + fr] = a[j];
        }
        __syncthreads();
        if (kh == 0) {
#pragma unroll
            for (int j = 0; j < 4; ++j) glr[(size_t)(r0 + 4 * fq + j) * 16 + fr] = a[j] + part[(mt * 16 + 4 * fq + j) * 16 + fr];
        }
    }
    __syncthreads();
}

__device__ void vtrans_items(const Params& p, unsigned char* lds) {
    const int tid = threadIdx.x;
    unsigned char* ws = p.ws;
    const bf16_t* VA = (const bf16_t*)(ws + WS_VA);
    bf16_t* vb = (bf16_t*)(ws + WS_VB);
    constexpr int VS = 72;
    bf16_t* tile = (bf16_t*)lds;
    for (int item = blockIdx.x; item < 512; item += gridDim.x) {
        const int bh = item >> 5, blk = item & 31, b = bh >> 3, h = bh & 7, pos0 = blk * 256;
        { const int tok = tid >> 1, hf = tid & 1;
          const uint4* src = (const uint4*)(VA + (size_t)(b * S + pos0 + tok) * 512 + h * 64 + hf * 32);
          uint4 v0 = src[0], v1 = src[1], v2 = src[2], v3 = src[3];
          uint4* d = (uint4*)(tile + tok * VS + hf * 32);
          d[0] = v0; d[1] = v1; d[2] = v2; d[3] = v3; }
        __syncthreads();
        const int dv = tid >> 3, l8 = tid & 7;
#pragma unroll
        for (int cc = 0; cc < 2; ++cc) { const int cls = 2 * l8 + cc;
#pragma unroll
            for (int hh = 0; hh < 2; ++hh) { unsigned w[4];
#pragma unroll
                for (int i = 0; i < 4; ++i) w[i] = (unsigned)tile[(16 * (hh * 8 + 2 * i) + cls) * VS + dv] | ((unsigned)tile[(16 * (hh * 8 + 2 * i + 1) + cls) * VS + dv] << 16);
                const int blkidx = (bh * S + cls * 512 + 16 * blk + hh * 8) >> 3;
                *(uint4*)(vb + ((size_t)blkidx * 64 + dv) * 8) = make_uint4(w[0], w[1], w[2], w[3]); } }
        __syncthreads();
    }
}

struct AttnFrag { bf16x8 ka[4], vf[4]; };
__device__ __forceinline__ void attn_load(AttnFrag& f, const bf16_t* kp, const bf16_t* vp) {
    f.ka[0] = *(const bf16x8*)kp; f.ka[1] = *(const bf16x8*)(kp + 32); f.ka[2] = *(const bf16x8*)(kp + 256); f.ka[3] = *(const bf16x8*)(kp + 288);
#pragma unroll
    for (int n = 0; n < 4; ++n) f.vf[n] = *(const bf16x8*)(vp + n * 128);
}
struct AttnState { float m, l; f32x4 o[4]; bf16x8 q0, q1; };
__device__ __forceinline__ float max2a(float a, float b) { float r; asm("v_max_f32_e32 %0, %1, %2" : "=v"(r) : "v"(a), "v"(b)); return r; }
__device__ __forceinline__ float max3a(float a, float b, float c) { float r; asm("v_max3_f32 %0, %1, %2, %3" : "=v"(r) : "v"(a), "v"(b), "v"(c)); return r; }
__device__ __forceinline__ float rowmax4(float x) {
    const unsigned u = __builtin_bit_cast(unsigned, x);
    const auto a = __builtin_amdgcn_permlane16_swap(u, u, false, false);
    const float y = fmaxf(__builtin_bit_cast(float, a[0]), __builtin_bit_cast(float, a[1]));
    const unsigned v = __builtin_bit_cast(unsigned, y);
    const auto b = __builtin_amdgcn_permlane32_swap(v, v, false, false);
    return fmaxf(__builtin_bit_cast(float, b[0]), __builtin_bit_cast(float, b[1]));
}
template <bool FIRST>
__device__ __forceinline__ float attn_scores(const AttnFrag& f, const AttnState& t, const int d0, const int js, float (&sv)[8]) {
    const float nm = FIRST ? 0.f : -t.m;
    f32x4 st0 = (f32x4){nm, nm, nm, nm}, st1 = (f32x4){nm, nm, nm, nm};
    st0 = __builtin_amdgcn_mfma_f32_16x16x32_bf16(f.ka[0], t.q0, st0, 0, 0, 0);
    st0 = __builtin_amdgcn_mfma_f32_16x16x32_bf16(f.ka[1], t.q1, st0, 0, 0, 0);
    st1 = __builtin_amdgcn_mfma_f32_16x16x32_bf16(f.ka[2], t.q0, st1, 0, 0, 0);
    st1 = __builtin_amdgcn_mfma_f32_16x16x32_bf16(f.ka[3], t.q1, st1, 0, 0, 0);
#pragma unroll
    for (int j = 0; j < 8; ++j) { const bool vd = (unsigned)(d0 - (j << js)) <= 128u; const float x = (j < 4) ? st0[j] : st1[j - 4]; sv[j] = vd ? x : -3.0e38f; }
    float mx = max3a(max3a(sv[0], sv[1], sv[2]), max3a(sv[3], sv[4], sv[5]), max2a(sv[6], sv[7]));
    return rowmax4(mx);
}
__device__ __forceinline__ void attn_grow(AttnState& t, float (&sv)[8], const float mx) {
    const float gr = fmaxf(mx, 0.f), alpha = fexp2(-gr);
    t.m += gr;
#pragma unroll
    for (int j = 0; j < 8; ++j) sv[j] -= gr;
    t.l = t.l * alpha;
#pragma unroll
    for (int n = 0; n < 4; ++n) t.o[n] = t.o[n] * alpha;
}
__device__ __forceinline__ void attn_pv(const AttnFrag& f, AttnState& t, const float (&sv)[8]) {
    float pj[8];
#pragma unroll
    for (int j = 0; j < 8; ++j) pj[j] = fexp2(sv[j]);
    t.l += ((pj[0] + pj[1]) + (pj[2] + pj[3])) + ((pj[4] + pj[5]) + (pj[6] + pj[7]));
    u32x4 pw; pw.x = pk2(pj[0], pj[1]); pw.y = pk2(pj[2], pj[3]); pw.z = pk2(pj[4], pj[5]); pw.w = pk2(pj[6], pj[7]);
    const bf16x8 pf = __builtin_bit_cast(bf16x8, pw);
#pragma unroll
    for (int n = 0; n < 4; ++n) t.o[n] = __builtin_amdgcn_mfma_f32_16x16x32_bf16(f.vf[n], pf, t.o[n], 0, 0, 0);
}
template <bool FIRST>
__device__ __forceinline__ void attn_math2(const AttnFrag& fa, const AttnFrag& fb, AttnState& ta, AttnState& tb, const int d0a, const int d0b, const int js) {
    float sa[8], sb[8];
    const float mxa = attn_scores<FIRST>(fa, ta, d0a, js, sa), mxb = attn_scores<FIRST>(fb, tb, d0b, js, sb);
    if (FIRST) {
        ta.m = mxa; tb.m = mxb;
#pragma unroll
        for (int j = 0; j < 8; ++j) { sa[j] -= mxa; sb[j] -= mxb; }
    } else if (__any(fmaxf(mxa, mxb) > 8.f)) {
        attn_grow(ta, sa, mxa); attn_grow(tb, sb, mxb);
    }
    attn_pv(fa, ta, sa); attn_pv(fb, tb, sb);
}
__device__ void phase_attn(const Params& p, unsigned char* lds) {
    const int tid = threadIdx.x, lane = tid & 63, wave = tid >> 6, qi = lane & 15, g = lane >> 4, gp = qi >> 2, jj = qi & 3;
    unsigned char* ws = p.ws;
    const bf16_t* QA = (const bf16_t*)(ws + WS_QA);
    bf16_t* CAT = (bf16_t*)(ws + WS_CAT);
    const bf16_t* K = (const bf16_t*)(ws + WS_KA); const bf16_t* V = (const bf16_t*)(ws + WS_VB);
    constexpr int LV = 49152;
    constexpr int CLS8 = 8 * 512 * 64;
    const int nwg = gridDim.x, xg = blockIdx.x & 7, xl = blockIdx.x >> 3;
    const bool xord = (nwg & 7) == 0;
    const int k0 = xord ? xl : (int)blockIdx.x, kst = xord ? (nwg >> 3) : nwg, kend = xord ? 64 : 512;
    for (int k = k0; k < kend; k += kst) {
        const int idd = xord ? ((xg + 8 * (k >> 5)) << 5) + (k & 31) : k;
        const int bh = idd >> 5, blk = idd & 31, r = wave, b = bh >> 3, h = bh & 7;
        const int tq = 256 * blk + r + 16 * qi, rho4 = r & 3;
        __syncthreads();
        uint4 pre[12];
#pragma unroll
        for (int i = 0; i < 6; ++i) { const int pid = tid + 512 * i, row = pid >> 3, cls = row / 24, il = row - cls * 24;
            pre[i] = *(const uint4*)(K + ((bh * S + cls * 512 + 16 * blk - 8 + il) * 64 + (pid & 7) * 8)); }
#pragma unroll
        for (int i = 0; i < 6; ++i) { const int vp = tid + 512 * i, b3 = vp >> 6, cls = b3 / 3, bl = b3 - cls * 3;
            pre[6 + i] = *(const uint4*)(V + ((((bh * S + cls * 512 + 16 * blk - 8) >> 3) + bl) * 512 + (vp & 63) * 8)); }
        const int ks16 = ((16 * blk) & ~31) - 128;
        const int c16 = ks16 < 0 ? ((-ks16) >> 5) : 0;
        const int kb16 = (bh * S + r * 512 + ks16 + 8 * gp + jj) * 64 + 8 * g, vb16 = (((bh * S + r * 512 + ks16) >> 3) + g) * 512 + qi * 8;
        const int dq16 = 16 * blk + qi - (ks16 + 8 * g);
        const int c4 = blk == 0 ? 4 : (blk == 1 ? 2 : 0);
        const int kb4 = (bh * S + (rho4 + 4 * gp) * 512 + 16 * blk - 32 + jj) * 64 + 8 * g, vb4 = ((bh * S + (rho4 + 4 * g) * 512 + 16 * blk - 32) >> 3) * 512 + qi * 8;
        const int dq4 = 4 * qi + 128 + (r >> 2) - g;
        AttnFrag fxa, fxb, fya;
        attn_load(fxa, K + (kb16 + 4 * 2048), V + (vb16 + 4 * 2048)); attn_load(fxb, K + (kb16 + 4 * 2048 + CLS8), V + (vb16 + 4 * 2048 + CLS8));
        attn_load(fya, K + kb4, V + vb4);
        AttnState ta, tb;
        { const bf16_t* qrow = QA + ((size_t)(bh * S + r * 512 + 16 * blk + qi) * 64 + 8 * g);
          ta.q0 = *(const bf16x8*)qrow; ta.q1 = *(const bf16x8*)(qrow + 32); tb.q0 = *(const bf16x8*)(qrow + CLS8); tb.q1 = *(const bf16x8*)(qrow + CLS8 + 32); }
        ta.m = 0.f; tb.m = 0.f; ta.l = 0.f; tb.l = 0.f;
#pragma unroll
        for (int n = 0; n < 4; ++n) { ta.o[n] = (f32x4){0.f, 0.f, 0.f, 0.f}; tb.o[n] = ta.o[n]; }
        attn_math2<true>(fxa, fxb, ta, tb, dq16 - 128, dq16 - 128, 0);
        {
            const int m0 = c4 <= 0 ? 0 : (1 << 20), m1 = c4 <= 1 ? 0 : (1 << 20), m2 = c4 <= 2 ? 0 : (1 << 20);
            attn_load(fxa, K + (kb4 + 1 * 512), V + (vb4 + 1 * 512));
            attn_math2<false>(fya, fya, ta, tb, dq4 - m0, dq4 + 2 - m0, 2);
            attn_load(fya, K + (kb4 + 2 * 512), V + (vb4 + 2 * 512));
            attn_math2<false>(fxa, fxa, ta, tb, dq4 - 32 - m1, dq4 + 2 - 32 - m1, 2);
            attn_math2<false>(fya, fya, ta, tb, dq4 - 64 - m2, dq4 + 2 - 64 - m2, 2);
        }
#pragma unroll
        for (int i = 0; i < 12; ++i) *(uint4*)(lds + (tid + 512 * i) * 16) = pre[i];
        __syncthreads();
        {
            const int d1 = 16 * qi + 128 + r - g;
            const unsigned char* kl = lds + (gp * 24 + jj) * 128 + g * 16;
            const unsigned char* vl = lds + LV + g * 3072 + qi * 16;
            int c1 = (blk == 0 ? 4 : 0);
            const unsigned char* kl4 = lds + ((rho4 + 4 * gp) * 24 + jj) * 128 + g * 16;
            const unsigned char* vl4 = lds + LV + (rho4 + 4 * g) * 3072 + qi * 16;
            const int c4l = c4 > 3 ? c4 : 3;
#define ATTN_D1_CHUNK() do { const int w = c1 >> 2, q = c1 & 3; const unsigned char* kq = kl + q * 12288 + w * 1024; const unsigned char* vq = vl + q * 12288 + w * 1024; \
                fya.ka[0] = *(const bf16x8*)kq; fya.ka[1] = *(const bf16x8*)(kq + 64); fya.ka[2] = *(const bf16x8*)(kq + 512); fya.ka[3] = *(const bf16x8*)(kq + 576); \
                _Pragma("unroll") for (int n = 0; n < 4; ++n) fya.vf[n] = *(const bf16x8*)(vq + n * 256); \
                attn_math2<false>(fya, fya, ta, tb, d1 - 128 * w - 4 * q, d1 + 8 - 128 * w - 4 * q, 4); ++c1; } while (0)
#define ATTN_D4_CHUNK(w4) do { const unsigned char* kq = kl4 + ((w4) - 3) * 1024; const unsigned char* vq = vl4 + ((w4) - 3) * 1024; \
                fya.ka[0] = *(const bf16x8*)kq; fya.ka[1] = *(const bf16x8*)(kq + 64); fya.ka[2] = *(const bf16x8*)(kq + 512); fya.ka[3] = *(const bf16x8*)(kq + 576); \
                _Pragma("unroll") for (int n = 0; n < 4; ++n) fya.vf[n] = *(const bf16x8*)(vq + n * 256); \
                attn_math2<false>(fya, fya, ta, tb, dq4 - 32 * (w4), dq4 + 2 - 32 * (w4), 2); } while (0)
            for (int cc = c16; cc < 4; ++cc) {
                attn_load(fxa, K + (kb16 + cc * 2048), V + (vb16 + cc * 2048)); attn_load(fxb, K + (kb16 + cc * 2048 + CLS8), V + (vb16 + cc * 2048 + CLS8));
                for (int q3 = 0; q3 < 3 && c1 < 12; ++q3) ATTN_D1_CHUNK();
                if (3 + (cc - c16) >= c4l && 3 + (cc - c16) < 6) ATTN_D4_CHUNK(3 + (cc - c16));
                attn_math2<false>(fxa, fxb, ta, tb, dq16 - 32 * cc, dq16 - 32 * cc, 0);
            }
            while (c1 < 12) ATTN_D1_CHUNK();
            for (int w4 = (4 - c16 < 3 ? 3 + (4 - c16) : 6); w4 < 6; ++w4) { if (w4 >= c4l) ATTN_D4_CHUNK(w4); }
#undef ATTN_D1_CHUNK
#undef ATTN_D4_CHUNK
        }
        {
            float la = ta.l, lb = tb.l;
            la += __shfl_xor(la, 16); la += __shfl_xor(la, 32); lb += __shfl_xor(lb, 16); lb += __shfl_xor(lb, 32);
            const float ia = 1.f / la, ib = 1.f / lb;
            bf16_t* orow = CAT + (size_t)(b * S + tq) * D + h * 64 + 4 * g;
#pragma unroll
            for (int n = 0; n < 4; ++n) { uint2 ov; ov.x = pk2(ta.o[n][0] * ia, ta.o[n][1] * ia); ov.y = pk2(ta.o[n][2] * ia, ta.o[n][3] * ia); *(uint2*)(orow + 16 * n) = ov;
                uint2 ow; ow.x = pk2(tb.o[n][0] * ib, tb.o[n][1] * ib); ow.y = pk2(tb.o[n][2] * ib, tb.o[n][3] * ib); *(uint2*)(orow + 8 * D + 16 * n) = ow; }
        }
    }
}

constexpr int TS = 72;
constexpr int GL_LA = 0, GL_A1 = 16640, GL_A2 = GL_A1 + 64 * TS * 2, GL_VT = GL_A2 + 64 * TS * 2, GL_ATT = GL_VT + 128 * TS * 2;
static_assert(GL_ATT + 64 * TS * 2 <= 65536, "gla lds");

struct GlaIn { uint4 kr0, kr1, qr0, qr1, vr[4]; float4 gl; };
template <int MODE>
__device__ __forceinline__ void gla_fetch(const Params& p, int item, int tid, GlaIn& in) {
    unsigned char* ws = p.ws;
    const int bh4 = item >> 7, n = item & 127, b = bh4 >> 2, hh = bh4 & 3;
    const int t0 = b * S + n * 64;
    const int c = tid >> 2, d0 = (tid & 3) * 16, e0 = (tid & 3) * 32;
    const bf16_t* kp = (const bf16_t*)(ws + WS_KG) + (size_t)(t0 + c) * 256 + hh * 64 + d0;
    in.kr0 = *(const uint4*)kp; in.kr1 = *(const uint4*)(kp + 8);
    const bf16_t* qp = (const bf16_t*)(ws + WS_QG) + (size_t)(t0 + c) * 256 + hh * 64 + d0;
    in.qr0 = make_uint4(0, 0, 0, 0); in.qr1 = make_uint4(0, 0, 0, 0);
    if (MODE == 1) { in.qr0 = *(const uint4*)qp; in.qr1 = *(const uint4*)(qp + 8); }
    const bf16_t* vp = (const bf16_t*)(ws + WS_VG) + (size_t)(t0 + c) * 512 + hh * 128 + e0;
#pragma unroll
    for (int q = 0; q < 4; ++q) in.vr[q] = *(const uint4*)(vp + 8 * q);
    in.gl = *(const float4*)((const float*)(ws + WS_GLR) + (size_t)t0 * 16 + tid * 4);
}
template <int MODE>
__device__ __forceinline__ void gla_prep(const Params& p, unsigned char* lds, int item, int tid, const GlaIn& in) {
    const int bh4 = item >> 7, hh = bh4 & 3;
    float* LA = (float*)(lds + GL_LA);
    bf16_t* A1 = (bf16_t*)(lds + GL_A1); bf16_t* A2 = (bf16_t*)(lds + GL_A2); bf16_t* VTl = (bf16_t*)(lds + GL_VT);
    const int c = tid >> 2, d0 = (tid & 3) * 16, e0 = (tid & 3) * 32;
    const uint4 kr0 = in.kr0, kr1 = in.kr1, qr0 = in.qr0, qr1 = in.qr1;
    float* GLRL = (float*)(lds + GL_ATT + 1024);
    *(float4*)(GLRL + tid * 4) = in.gl;
    __syncthreads();
    {
        const int dd = tid & 63, cgp = tid >> 6;
        float w[16];
#pragma unroll
        for (int r = 0; r < 16; ++r) w[r] = p.w_gate_lr[r * 256 + hh * 64 + dd];
        const float bias = p.b_gate[hh * 64 + dd];
        float pre[16]; float run = 0.f;
#pragma unroll
        for (int i = 0; i < 16; ++i) {
            const float4* gp = (const float4*)(GLRL + (cgp * 16 + i) * 16);
            const float4 g0 = gp[0], g1 = gp[1], g2 = gp[2], g3 = gp[3];
            float z = bias;
            z += g0.x * w[0] + g0.y * w[1] + g0.z * w[2] + g0.w * w[3];
            z += g1.x * w[4] + g1.y * w[5] + g1.z * w[6] + g1.w * w[7];
            z += g2.x * w[8] + g2.y * w[9] + g2.z * w[10] + g2.w * w[11];
            z += g3.x * w[12] + g3.y * w[13] + g3.z * w[14] + g3.w * w[15];
            const float ls = fminf(z, 0.f) - flog(1.f + fexp(-fabsf(z)));
            run += ls * (1.f / 16.f); pre[i] = run;
        }
        float* tot = (float*)(lds + GL_ATT);
        tot[cgp * 64 + dd] = run;
        __syncthreads();
        float off = 0.f;
#pragma unroll
        for (int gq = 0; gq < 3; ++gq) off += (gq < cgp) ? tot[gq * 64 + dd] : 0.f;
#pragma unroll
        for (int i = 0; i < 16; ++i) LA[(cgp * 16 + i) * 65 + dd] = pre[i] + off;
    }
    __syncthreads();
    {
        unsigned kw[8] = {kr0.x, kr0.y, kr0.z, kr0.w, kr1.x, kr1.y, kr1.z, kr1.w};
        if (MODE == 0) {
#pragma unroll
            for (int i = 0; i < 16; ++i) { const int dd = d0 + i; const float kv = bf2f((unsigned short)((kw[i >> 1] >> ((i & 1) * 16)) & 0xffff));
                const float f = fexp(LA[63 * 65 + dd] - LA[c * 65 + dd]);
                A1[dd * TS + c] = (bf16_t)f2bf(kv * f); }
        } else {
            unsigned qw[8] = {qr0.x, qr0.y, qr0.z, qr0.w, qr1.x, qr1.y, qr1.z, qr1.w};
            unsigned oq[8], ok[8];
#pragma unroll
            for (int i = 0; i < 8; ++i) {
                const float bb0 = LA[c * 65 + d0 + 2 * i], bb1 = LA[c * 65 + d0 + 2 * i + 1];
                const float q0 = bf2f((unsigned short)(qw[i] & 0xffff)), q1 = bf2f((unsigned short)(qw[i] >> 16));
                const float k0 = bf2f((unsigned short)(kw[i] & 0xffff)), k1 = bf2f((unsigned short)(kw[i] >> 16));
                oq[i] = pk2(q0 * 0.125f * fexp(bb0), q1 * 0.125f * fexp(bb1));
                ok[i] = pk2(k0 * fexp(-bb0), k1 * fexp(-bb1));
            }
            *(uint4*)(A1 + c * TS + d0) = make_uint4(oq[0], oq[1], oq[2], oq[3]); *(uint4*)(A1 + c * TS + d0 + 8) = make_uint4(oq[4], oq[5], oq[6], oq[7]);
            *(uint4*)(A2 + c * TS + d0) = make_uint4(ok[0], ok[1], ok[2], ok[3]); *(uint4*)(A2 + c * TS + d0 + 8) = make_uint4(ok[4], ok[5], ok[6], ok[7]);
        }
#pragma unroll
        for (int q = 0; q < 4; ++q) { const unsigned vw[4] = {in.vr[q].x, in.vr[q].y, in.vr[q].z, in.vr[q].w};
#pragma unroll
            for (int i = 0; i < 4; ++i) { VTl[(e0 + 8 * q + 2 * i) * TS + c] = (bf16_t)(vw[i] & 0xffff); VTl[(e0 + 8 * q + 2 * i + 1) * TS + c] = (bf16_t)(vw[i] >> 16); } }
    }
    __syncthreads();
}

__device__ void gla1_items(const Params& p, unsigned char* lds0) {
    const int half = threadIdx.x >> 8, tid = threadIdx.x & 255, lane = tid & 63, w = tid >> 6, fr = lane & 15, fq = lane >> 4;
    unsigned char* lds = lds0 + half * 65536;
    float* UT = (float*)(p.ws + WS_UT); float* AG = (float*)(p.ws + WS_AG);
    const float* LA = (const float*)(lds + GL_LA);
    const bf16_t* A1 = (const bf16_t*)(lds + GL_A1); const bf16_t* VTl = (const bf16_t*)(lds + GL_VT);
    GlaIn cur, nxt;
    if ((int)blockIdx.x < 512) gla_fetch<0>(p, 2 * blockIdx.x + half, tid, cur);
    for (int it = blockIdx.x; it < 512; it += gridDim.x) {
        const int item = 2 * it + half;
        const bool more = it + (int)gridDim.x < 512;
        if (more) gla_fetch<0>(p, 2 * (it + gridDim.x) + half, tid, nxt);
        gla_prep<0>(p, lds, item, tid, cur);
        f32x4 acc[8];
#pragma unroll
        for (int n = 0; n < 8; ++n) acc[n] = (f32x4){0.f, 0.f, 0.f, 0.f};
#pragma unroll
        for (int ks = 0; ks < 2; ++ks) {
            const bf16x8 af = *(const bf16x8*)(A1 + (16 * w + fr) * TS + ks * 32 + fq * 8);
#pragma unroll
            for (int n = 0; n < 8; ++n) { const bf16x8 bfr = *(const bf16x8*)(VTl + (16 * n + fr) * TS + ks * 32 + fq * 8);
                acc[n] = __builtin_amdgcn_mfma_f32_16x16x32_bf16(af, bfr, acc[n], 0, 0, 0); }
        }
#pragma unroll
        for (int n = 0; n < 8; ++n) *(f32x4*)(UT + ((size_t)item * 128 + 16 * n + fr) * 64 + 16 * w + 4 * fq) = acc[n];
        if (tid < 64) AG[item * 64 + tid] = fexp(LA[63 * 65 + tid]);
        __syncthreads();
        if (more) cur = nxt;
    }
}
__device__ void gla2_scan(const Params& p) {
    const float* UT = (const float*)(p.ws + WS_UT); const float* AG = (const float*)(p.ws + WS_AG);
    bf16_t* SPT = (bf16_t*)(p.ws + WS_SPT);
    for (int rec = blockIdx.x * NTHREADS + threadIdx.x; rec < 65536; rec += gridDim.x * NTHREADS) {
        const int bh4 = rec >> 13, e = (rec >> 6) & 127, dd = rec & 63;
        float st = 0.f;
        for (int n0 = 0; n0 < 128; n0 += 32) {
            float av[32], uv[32];
#pragma unroll
            for (int q = 0; q < 32; ++q) { const int item = bh4 * 128 + n0 + q; av[q] = AG[item * 64 + dd]; uv[q] = UT[((size_t)item * 128 + e) * 64 + dd]; }
#pragma unroll
            for (int q = 0; q < 32; ++q) { const int item = bh4 * 128 + n0 + q; SPT[((size_t)item * 128 + e) * 64 + dd] = (bf16_t)f2bf(st); st = av[q] * st + uv[q]; }
        }
    }
}
__device__ void gla3_items(const Params& p, unsigned char* lds0) {
    const int half = threadIdx.x >> 8, tid = threadIdx.x & 255, lane = tid & 63, w = tid >> 6, fr = lane & 15, fq = lane >> 4;
    unsigned char* lds = lds0 + half * 65536;
    unsigned char* ws = p.ws;
    const bf16_t* SPT = (const bf16_t*)(ws + WS_SPT); const bf16_t* RG = (const bf16_t*)(ws + WS_RG);
    bf16_t* CAT = (bf16_t*)(ws + WS_CAT);
    const bf16_t* A1 = (const bf16_t*)(lds + GL_A1); const bf16_t* A2 = (const bf16_t*)(lds + GL_A2); const bf16_t* VTl = (const bf16_t*)(lds + GL_VT);
    bf16_t* ATT = (bf16_t*)(lds + GL_ATT);
    GlaIn cur, nxt;
    if ((int)blockIdx.x < 512) gla_fetch<1>(p, 2 * blockIdx.x + half, tid, cur);
    for (int it = blockIdx.x; it < 512; it += gridDim.x) {
        const int item = 2 * it + half;
        const bool more = it + (int)gridDim.x < 512;
        const int bh4 = item >> 7, n_ = item & 127, b = bh4 >> 2, hh = bh4 & 3;
        const int t0 = b * S + n_ * 64;
        bf16x8 sf[8][2]; uint2 rw[8];
#pragma unroll
        for (int n = 0; n < 8; ++n) { const bf16_t* sp = SPT + ((size_t)item * 128 + 16 * n + fr) * 64 + fq * 8; sf[n][0] = *(const bf16x8*)sp; sf[n][1] = *(const bf16x8*)(sp + 32);
            rw[n] = *(const uint2*)(RG + (size_t)(t0 + 16 * w + fr) * 512 + hh * 128 + 16 * n + 4 * fq); }
        if (more) gla_fetch<1>(p, 2 * (it + gridDim.x) + half, tid, nxt);
        gla_prep<1>(p, lds, item, tid, cur);
        const bf16x8 aq0 = *(const bf16x8*)(A1 + (16 * w + fr) * TS + fq * 8), aq1 = *(const bf16x8*)(A1 + (16 * w + fr) * TS + 32 + fq * 8);
#pragma unroll
        for (int np = 0; np < 4; ++np) {
            f32x4 a = (f32x4){0.f, 0.f, 0.f, 0.f};
            if (np <= w) {
                const bf16x8 b0 = *(const bf16x8*)(A2 + (16 * np + fr) * TS + fq * 8), b1 = *(const bf16x8*)(A2 + (16 * np + fr) * TS + 32 + fq * 8);
                a = __builtin_amdgcn_mfma_f32_16x16x32_bf16(aq0, b0, a, 0, 0, 0);
                a = __builtin_amdgcn_mfma_f32_16x16x32_bf16(aq1, b1, a, 0, 0, 0);
            }
#pragma unroll
            for (int j = 0; j < 4; ++j) { const int c = 16 * w + 4 * fq + j, cp = 16 * np + fr; ATT[c * TS + cp] = (bf16_t)f2bf(cp <= c ? a[j] : 0.f); }
        }
        __syncthreads();
        const bf16x8 at0 = *(const bf16x8*)(ATT + (16 * w + fr) * TS + fq * 8), at1 = *(const bf16x8*)(ATT + (16 * w + fr) * TS + 32 + fq * 8);
        f32x4 acc[8];
#pragma unroll
        for (int n = 0; n < 8; ++n) {
            acc[n] = (f32x4){0.f, 0.f, 0.f, 0.f};
            const bf16x8 v0 = *(const bf16x8*)(VTl + (16 * n + fr) * TS + fq * 8), v1 = *(const bf16x8*)(VTl + (16 * n + fr) * TS + 32 + fq * 8);
            const bf16x8 s0 = sf[n][0], s1 = sf[n][1];
            acc[n] = __builtin_amdgcn_mfma_f32_16x16x32_bf16(v0, at0, acc[n], 0, 0, 0);
            acc[n] = __builtin_amdgcn_mfma_f32_16x16x32_bf16(v1, at1, acc[n], 0, 0, 0);
            acc[n] = __builtin_amdgcn_mfma_f32_16x16x32_bf16(s0, aq0, acc[n], 0, 0, 0);
            acc[n] = __builtin_amdgcn_mfma_f32_16x16x32_bf16(s1, aq1, acc[n], 0, 0, 0);
        }
        {
            float ss = 0.f;
#pragma unroll
            for (int n = 0; n < 8; ++n) ss += acc[n][0] * acc[n][0] + acc[n][1] * acc[n][1] + acc[n][2] * acc[n][2] + acc[n][3] * acc[n][3];
            ss += __shfl_xor(ss, 16); ss += __shfl_xor(ss, 32);
            const float rstd = rsqrtf(ss * (1.f / 128.f) + EPS);
            const int t = t0 + 16 * w + fr;
#pragma unroll
            for (int n = 0; n < 8; ++n) { const int e = 16 * n + 4 * fq;
                const float4 gg = *(const float4*)(p.g_gla + e);
                const float r0 = bf2f((unsigned short)(rw[n].x & 0xffff)), r1 = bf2f((unsigned short)(rw[n].x >> 16)), r2 = bf2f((unsigned short)(rw[n].y & 0xffff)), r3 = bf2f((unsigned short)(rw[n].y >> 16));
                uint2 ov; ov.x = pk2(acc[n][0] * rstd * gg.x * fsilu(r0), acc[n][1] * rstd * gg.y * fsilu(r1)); ov.y = pk2(acc[n][2] * rstd * gg.z * fsilu(r2), acc[n][3] * rstd * gg.w * fsilu(r3));
                *(uint2*)(CAT + (size_t)t * D + 512 + hh * 128 + e) = ov; }
        }
        __syncthreads();
        if (more) cur = nxt;
    }
}

struct EpiBf16Plain {
    static constexpr bool PERM = true, BINIT = false;
    bf16_t* C; int ldc;
    __device__ __forceinline__ void operator()(const f32x4 (&acc)[2][2][4][2], const pg8::Unit& u, int wr, int wc, int fr, int fq) const {
#pragma unroll
        for (int ai = 0; ai < 2; ++ai)
#pragma unroll
            for (int m = 0; m < 4; ++m) { const int row = u.row0 + 128 * ai + 64 * wr + 16 * m + fr;
#pragma unroll
                for (int bj = 0; bj < 2; ++bj) { const f32x4 v0 = acc[ai][bj][m][0], v1 = acc[ai][bj][m][1];
                    u32x4 w; w.x = pk2(v0[0], v0[1]); w.y = pk2(v0[2], v0[3]); w.z = pk2(v1[0], v1[1]); w.w = pk2(v1[2], v1[3]);
                    *(u32x4*)(C + (size_t)row * ldc + 256 * u.pn + 128 * bj + 32 * wc + 8 * fq) = w; } }
    }
};
__device__ void phase_gemm_out(const Params& p, unsigned char* lds) {
    pg8::DenseSched Sd; Sd.init(p.ws + WS_CAT, p.ws + WS_WOUTT, T, D, D);
    EpiBf16Plain E{(bf16_t*)(p.ws + WS_YMIX), D};
    pg8::gemm_phase<EpiBf16Plain, pg8::DenseSched>((LAS unsigned char*)lds, D, Sd, E, pg8::uptr((const char*)p.ws));
}

constexpr int HS_STRIDE = 1028;
__device__ void phase_postmix(const Params& p, unsigned char* lds, const bool dry) {
    const int tid = threadIdx.x, lane = tid & 63, wave = tid >> 6;
    unsigned char* ws = p.ws;
    const float* mod = (const float*)(ws + WS_MOD);
    const bf16_t* Y = (const bf16_t*)(ws + WS_YMIX);
    bf16_t* H = (bf16_t*)(ws + WS_H);
    bf16_t* X1 = (bf16_t*)(ws + WS_X1);
    float* hs = (float*)lds;
    float* part = (float*)(lds + 66048);
    float* lg = (float*)(lds + 66048 + 16384);
    float* tvs = lg + 512;
    int* tis = (int*)(tvs + 64);
    constexpr int MAXG = 8;
    int* sel_e = tis + 64;
    float* sel_g = (float*)(sel_e + MAXG * 64);
    int* lrank = (int*)(sel_g + MAXG * 64);
    int* lcnt = lrank + MAXG * 64;
    int* lbase = lcnt + 32;
    int* CNT = (int*)(ws + WS_CTL) + CW_CNT;
    float wb0[32], wb1[32];
    { const float* wp = p.router_w + (size_t)(128 * wave + (lane >> 4)) * 32 + (lane & 15);
#pragma unroll
      for (int ks = 0; ks < 32; ++ks) { wb0[ks] = wp[(size_t)(4 * ks) * 32]; wb1[ks] = wp[(size_t)(4 * ks) * 32 + 16]; } }
    float* lv = (float*)(lds + 98304);
    for (int i = tid; i < 2048; i += NTHREADS) { const int v = i >> 8, c = (i & 255) * 4;
        float4 t;
        if (v == 0) t = *(const float4*)(p.g_post_mix + c); else if (v == 1) t = *(const float4*)(p.g_pre_ffn + c);
        else { const int q = v - 2, b = q / 3, k = q - 3 * b; t = *(const float4*)(mod + b * 6144 + 2048 + 1024 * k + c); }
        *(float4*)(lv + v * 1024 + c) = t; }
    if (tid < 32) lcnt[tid] = 0;
    __syncthreads();
    int gl = 0, grp0 = blockIdx.x;
    uint2 yw[2][4]; float4 xv[2][4];
    if ((int)blockIdx.x < T / 16) {
#pragma unroll
        for (int i = 0; i < 2; ++i) { const int m = blockIdx.x * 16 + wave * 2 + i;
            const uint2* yr = (const uint2*)(Y + (size_t)m * D) + lane; const float4* xr = (const float4*)(p.x + (size_t)m * D) + lane;
#pragma unroll
            for (int j = 0; j < 4; ++j) { yw[i][j] = ntload2(yr + 64 * j); xv[i][j] = ntload4(xr + 64 * j); } }
    }
    for (int grp = blockIdx.x; grp < T / 16; grp += gridDim.x) {
        const int m0 = grp * 16;
#pragma unroll
        for (int i = 0; i < 2; ++i) {
            const int rl = wave * 2 + i, m = m0 + rl, b = m >> 13;
            float4 yv[4]; float ss = 0.f;
#pragma unroll
            for (int j = 0; j < 4; ++j) { const uint2 w = yw[i][j];
                yv[j] = make_float4(bf2f((unsigned short)(w.x & 0xffff)), bf2f((unsigned short)(w.x >> 16)), bf2f((unsigned short)(w.y & 0xffff)), bf2f((unsigned short)(w.y >> 16)));
                ss += yv[j].x * yv[j].x + yv[j].y * yv[j].y + yv[j].z * yv[j].z + yv[j].w * yv[j].w; }
            const float rstd1 = rsqrtf(wave_sum(ss) * (1.f / D) + EPS);
            float4 x1[4]; float ss2 = 0.f;
#pragma unroll
            for (int j = 0; j < 4; ++j) { const int c = 4 * lane + 256 * j;
                const float4 xq = xv[i][j], g = *(const float4*)(lv + c), gt = *(const float4*)(lv + (2 + 3 * b) * 1024 + c);
                x1[j].x = xq.x + gt.x * (yv[j].x * rstd1 * g.x); x1[j].y = xq.y + gt.y * (yv[j].y * rstd1 * g.y);
                x1[j].z = xq.z + gt.z * (yv[j].z * rstd1 * g.z); x1[j].w = xq.w + gt.w * (yv[j].w * rstd1 * g.w);
                ss2 += x1[j].x * x1[j].x + x1[j].y * x1[j].y + x1[j].z * x1[j].z + x1[j].w * x1[j].w;
                { uint2 xo; xo.x = pk2(x1[j].x, x1[j].y); xo.y = pk2(x1[j].z, x1[j].w); ntstore2((uint2*)(X1 + (size_t)m * D + c), xo); } }
            const float rstd2 = rsqrtf(wave_sum(ss2) * (1.f / D) + EPS);
#pragma unroll
            for (int j = 0; j < 4; ++j) { const int c = 4 * lane + 256 * j;
                const float4 g = *(const float4*)(lv + 1024 + c), sh = *(const float4*)(lv + (3 + 3 * b) * 1024 + c), sc = *(const float4*)(lv + (4 + 3 * b) * 1024 + c);
                float4 h;
                h.x = x1[j].x * rstd2 * g.x * (1.f + sc.x) + sh.x; h.y = x1[j].y * rstd2 * g.y * (1.f + sc.y) + sh.y;
                h.z = x1[j].z * rstd2 * g.z * (1.f + sc.z) + sh.z; h.w = x1[j].w * rstd2 * g.w * (1.f + sc.w) + sh.w;
                uint2 o; o.x = pk2(h.x, h.y); o.y = pk2(h.z, h.w);
                *(uint2*)(H + (size_t)m * D + c) = o;
                *(float4*)(hs + rl * HS_STRIDE + c) = h; }
        }
        if (grp + (int)gridDim.x < T / 16) {
#pragma unroll
            for (int i = 0; i < 2; ++i) { const int m = (grp + gridDim.x) * 16 + wave * 2 + i;
                const uint2* yr = (const uint2*)(Y + (size_t)m * D) + lane; const float4* xr = (const float4*)(p.x + (size_t)m * D) + lane;
#pragma unroll
                for (int j = 0; j < 4; ++j) { yw[i][j] = ntload2(yr + 64 * j); xv[i][j] = ntload4(xr + 64 * j); } }
        }
        __syncthreads();
        f32x4 a0 = (f32x4){0.f, 0.f, 0.f, 0.f}, a1 = (f32x4){0.f, 0.f, 0.f, 0.f};
        {
            const float* hp = hs + (lane & 15) * HS_STRIDE + 128 * wave + (lane >> 4);
#pragma unroll
            for (int ks = 0; ks < 32; ++ks) {
                const float av = hp[4 * ks];
                a0 = __builtin_amdgcn_mfma_f32_16x16x4f32(av, wb0[ks], a0, 0, 0, 0);
                a1 = __builtin_amdgcn_mfma_f32_16x16x4f32(av, wb1[ks], a1, 0, 0, 0);
            }
        }
        {
            const int fr = lane & 15, fq = lane >> 4;
#pragma unroll
            for (int j = 0; j < 4; ++j) { part[(wave * 16 + 4 * fq + j) * 32 + fr] = a0[j]; part[(wave * 16 + 4 * fq + j) * 32 + 16 + fr] = a1[j]; }
        }
        __syncthreads();
        { const int e = tid & 31; float s = p.router_b[e];
#pragma unroll
          for (int w8 = 0; w8 < 8; ++w8) s += part[w8 * 512 + tid];
          lg[tid] = s; }
        __syncthreads();
        {
            const int row = tid >> 5, e = tid & 31; const float v = lg[tid]; int rank = 0;
#pragma unroll
            for (int q = 0; q < 32; ++q) { const float u = lg[row * 32 + q]; rank += (u > v || (u == v && q < e)) ? 1 : 0; }
            if (rank < 4) { tvs[row * 4 + rank] = v; tis[row * 4 + rank] = e; }
        }
        __syncthreads();
        if (tid < 64) { const int row = tid >> 2, k = tid & 3;
            const float t0 = tvs[row * 4], e1 = fexp(tvs[row * 4 + 1] - t0), e2 = fexp(tvs[row * 4 + 2] - t0), e3 = fexp(tvs[row * 4 + 3] - t0);
            const float inv = 1.f / (1.f + e1 + e2 + e3);
            const float ek = k == 0 ? 1.f : (k == 1 ? e1 : (k == 2 ? e2 : e3));
            const int e = tis[tid];
            sel_e[gl * 64 + tid] = e; sel_g[gl * 64 + tid] = ek * inv;
            lrank[gl * 64 + tid] = atomicAdd(&lcnt[e], 1); }
        ++gl;
        const bool lastg = grp + (int)gridDim.x >= T / 16;
        if (gl == MAXG || lastg) {
            __syncthreads();
            if (tid < 32) { const int c = lcnt[tid]; lbase[tid] = (c > 0 && !dry) ? atomicAdd(&CNT[tid], c) : 0; }
            __syncthreads();
            if (!dry) for (int i = tid; i < gl * 64; i += NTHREADS) { const int gq = i >> 6, a = (grp0 + gq * (int)gridDim.x) * 64 + (i & 63); const int e = sel_e[i];
                const int pos = lbase[e] + lrank[i];
                ((int*)(ws + WS_TOPI))[a] = e; ((float*)(ws + WS_GATE))[a] = sel_g[i]; ((int*)(ws + WS_POS))[a] = pos; ((int*)(ws + WS_TOK))[e * T + pos] = a >> 2; }
            __syncthreads();
            if (tid < 32) lcnt[tid] = 0;
            gl = 0; grp0 = grp + gridDim.x;
        }
        __syncthreads();
    }
}

__device__ __forceinline__ void compute_pstart(const Params& p, unsigned char* lds) {
    int* ps = (int*)(lds + LDS_PS); int* cn = (int*)(lds + LDS_CNT);
    if (threadIdx.x < 64) {
        const int lane = threadIdx.x;
        const int* CNT = (const int*)(p.ws + WS_CTL) + CW_CNT;
        const int c = lane < NE ? __hip_atomic_load(&CNT[lane], __ATOMIC_RELAXED, __HIP_MEMORY_SCOPE_AGENT) : 0;
        int incl = (c + 255) & ~255;
#pragma unroll
        for (int o = 1; o < 32; o <<= 1) { const int t = __shfl_up(incl, o); if (lane >= o) incl += t; }
        if (lane < NE) { ps[lane + 1] = incl; cn[lane] = c; }
        if (lane == 0) ps[0] = 0;
    }
    __syncthreads();
}

struct EpiUp {
    static constexpr bool PERM = true, BINIT = false;
    bf16_t* ACT; const float* bgu;
    __device__ __forceinline__ void operator()(const f32x4 (&acc)[2][2][4][2], const pg8::Unit& u, int wr, int wc, int fr, int fq) const {
        const int jc = 128 * u.pn + 32 * wc + 8 * fq;
#pragma unroll
        for (int ai = 0; ai < 2; ++ai)
#pragma unroll
            for (int m = 0; m < 4; ++m) { const int row = u.row0 + 128 * ai + 64 * wr + 16 * m + fr;
                u32x4 o;
#pragma unroll
                for (int bj = 0; bj < 2; ++bj) { float a[4];
#pragma unroll
                    for (int j = 0; j < 4; ++j) { float gl = acc[ai][bj][m][0][j], ln = acc[ai][bj][m][1][j];
                        gl = __builtin_amdgcn_fmed3f(gl, -3.0e38f, 7.f); ln = __builtin_amdgcn_fmed3f(ln, -7.f, 7.f);
                        a[j] = gl * __builtin_amdgcn_rcpf(1.f + fexp2(gl * (-1.702f * LOG2E))) * (ln + 1.f); }
                    o[2 * bj] = pk2(a[0], a[1]); o[2 * bj + 1] = pk2(a[2], a[3]); }
                *(u32x4*)(ACT + (size_t)row * DFF + jc) = o; }
    }
};
struct EpiDown {
    static constexpr bool PERM = true, BINIT = false;
    bf16_t* YE; const float* bd;
    __device__ __forceinline__ void operator()(const f32x4 (&acc)[2][2][4][2], const pg8::Unit& u, int wr, int wc, int fr, int fq) const {
#pragma unroll
        for (int bj = 0; bj < 2; ++bj) {
            const int c0 = 256 * u.pn + 128 * bj + 32 * wc + 8 * fq;
#pragma unroll
            for (int ai = 0; ai < 2; ++ai)
#pragma unroll
                for (int m = 0; m < 4; ++m) { const int row = u.row0 + 128 * ai + 64 * wr + 16 * m + fr;
                    const f32x4 v0 = acc[ai][bj][m][0], v1 = acc[ai][bj][m][1];
                    u32x4 w; w.x = pk2(v0[0], v0[1]); w.y = pk2(v0[2], v0[3]); w.z = pk2(v1[0], v1[1]); w.w = pk2(v1[2], v1[3]);
                    *(u32x4*)(YE + (size_t)row * D + c0) = w; }
        }
    }
};
struct EpiMoe {
    static constexpr bool PERM = true, BINIT = true;
    EpiUp up; EpiDown dn;
    __device__ __forceinline__ void init(f32x4 (&acc)[2][2][4][2], const pg8::Unit& u, int wc, int fq) const {
        f32x4 v[2][2];
        if (u.e < 32) { const float* bp = up.bgu + (size_t)u.e * 2048 + 2 * (128 * u.pn + 32 * wc + 8 * fq);
            const float4 c0 = *(const float4*)bp, c1 = *(const float4*)(bp + 4), c2 = *(const float4*)(bp + 8), c3 = *(const float4*)(bp + 12);
            v[0][0] = (f32x4){c0.x, c0.z, c1.x, c1.z}; v[0][1] = (f32x4){c0.y, c0.w, c1.y, c1.w}; v[1][0] = (f32x4){c2.x, c2.z, c3.x, c3.z}; v[1][1] = (f32x4){c2.y, c2.w, c3.y, c3.w}; }
        else { const float* bp = dn.bd + (size_t)(u.e & 31) * D + 256 * u.pn + 32 * wc + 8 * fq;
            const float4 b00 = *(const float4*)bp, b01 = *(const float4*)(bp + 4), b10 = *(const float4*)(bp + 128), b11 = *(const float4*)(bp + 132);
            v[0][0] = (f32x4){b00.x, b00.y, b00.z, b00.w}; v[0][1] = (f32x4){b01.x, b01.y, b01.z, b01.w}; v[1][0] = (f32x4){b10.x, b10.y, b10.z, b10.w}; v[1][1] = (f32x4){b11.x, b11.y, b11.z, b11.w}; }
#pragma unroll
        for (int a = 0; a < 2; ++a)
#pragma unroll
            for (int b = 0; b < 2; ++b)
#pragma unroll
                for (int m = 0; m < 4; ++m) { acc[a][b][m][0] = v[b][0]; acc[a][b][m][1] = v[b][1]; }
    }
    __device__ __forceinline__ void operator()(const f32x4 (&acc)[2][2][4][2], const pg8::Unit& u, int wr, int wc, int fr, int fq) const {
        if (u.e < 32) up(acc, u, wr, wc, fr, fq); else dn(acc, u, wr, wc, fr, fq);
    }
};
__device__ void phase_moe(const Params& p, unsigned char* lds) {
    int* ps = (int*)(lds + LDS_PS);
    compute_pstart(p, lds);
    const volatile unsigned* xs = (const volatile unsigned*)(lds + LDS_BARW);
    pg8::MoeSched2 Sm; Sm.init(p.ws, ps, (int)xs[0], (int)xs[2], (int)xs[3]);
    EpiMoe E{EpiUp{(bf16_t*)(p.ws + WS_ACT), p.b_gate_up}, EpiDown{(bf16_t*)(p.ws + WS_YE), p.b_down}};
    pg8::gemm_phase<EpiMoe, pg8::MoeSched2>((LAS unsigned char*)lds, D, Sm, E, pg8::uptr((const char*)p.ws));
}
__device__ void phase_combine(const Params& p, unsigned char* lds) {
    const int tid = threadIdx.x, lane = tid & 63, wave = tid >> 6;
    unsigned char* ws = p.ws;
    const float* mod = (const float*)(ws + WS_MOD);
    const bf16_t* YE = (const bf16_t*)(ws + WS_YE);
    const bf16_t* X1 = (const bf16_t*)(ws + WS_X1);
    const int* TOPI = (const int*)(ws + WS_TOPI); const int* POS = (const int*)(ws + WS_POS); const float* GATE = (const float*)(ws + WS_GATE);
    compute_pstart(p, lds);
    const int* ps = (const int*)(lds + LDS_PS);
    const int mstep = gridDim.x * NW * 2;
    int m0 = (blockIdx.x * NW + wave) * 2;
    int4 te0 = make_int4(0, 0, 0, 0), te1 = te0, tp0 = te0, tp1 = te0; float4 gk0 = make_float4(0.f, 0.f, 0.f, 0.f), gk1 = gk0;
    if (m0 < T) { te0 = *(const int4*)(TOPI + m0 * 4); te1 = *(const int4*)(TOPI + m0 * 4 + 4); tp0 = *(const int4*)(POS + m0 * 4); tp1 = *(const int4*)(POS + m0 * 4 + 4);
        gk0 = *(const float4*)(GATE + m0 * 4); gk1 = *(const float4*)(GATE + m0 * 4 + 4); }
    for (; m0 < T; m0 += mstep) {
        const int slot[2][4] = {{ps[te0.x] + tp0.x, ps[te0.y] + tp0.y, ps[te0.z] + tp0.z, ps[te0.w] + tp0.w}, {ps[te1.x] + tp1.x, ps[te1.y] + tp1.y, ps[te1.z] + tp1.z, ps[te1.w] + tp1.w}};
        const float gk[2][4] = {{gk0.x, gk0.y, gk0.z, gk0.w}, {gk1.x, gk1.y, gk1.z, gk1.w}};
        uint2 u[2][4][4]; float4 x1[2][4];
#pragma unroll
        for (int q = 0; q < 2; ++q) {
#pragma unroll
            for (int k = 0; k < 4; ++k) { const uint2* yr = (const uint2*)(YE + (size_t)slot[q][k] * D) + lane;
#pragma unroll
                for (int j = 0; j < 4; ++j) u[q][k][j] = ntload2(yr + 64 * j); }
            const uint2* xr = (const uint2*)(X1 + (size_t)(m0 + q) * D) + lane;
#pragma unroll
            for (int j = 0; j < 4; ++j) { const uint2 w = ntload2(xr + 64 * j);
                x1[q][j] = make_float4(bf2f((unsigned short)(w.x & 0xffff)), bf2f((unsigned short)(w.x >> 16)), bf2f((unsigned short)(w.y & 0xffff)), bf2f((unsigned short)(w.y >> 16))); }
        }
        const int mn = m0 + mstep;
        int4 ne0 = te0, ne1 = te1, np0 = tp0, np1 = tp1; float4 ng0 = gk0, ng1 = gk1;
        if (mn < T) { ne0 = *(const int4*)(TOPI + mn * 4); ne1 = *(const int4*)(TOPI + mn * 4 + 4); np0 = *(const int4*)(POS + mn * 4); np1 = *(const int4*)(POS + mn * 4 + 4);
            ng0 = *(const float4*)(GATE + mn * 4); ng1 = *(const float4*)(GATE + mn * 4 + 4); }
        float4 gpf[4], gtf[4];
#pragma unroll
        for (int j = 0; j < 4; ++j) { const int c = 4 * lane + 256 * j; gpf[j] = *(const float4*)(p.g_post_ffn + c); gtf[j] = *(const float4*)(mod + (m0 >> 13) * 6144 + 5120 + c); }
#pragma unroll
        for (int q = 0; q < 2; ++q) {
            const int m = m0 + q, b = m >> 13;
            float4 y[4];
#pragma unroll
            for (int j = 0; j < 4; ++j) { y[j] = make_float4(0.f, 0.f, 0.f, 0.f);
#pragma unroll
                for (int k = 0; k < 4; ++k) { const uint2 w = u[q][k][j]; const float g = gk[q][k];
                    y[j].x += g * bf2f((unsigned short)(w.x & 0xffff)); y[j].y += g * bf2f((unsigned short)(w.x >> 16));
                    y[j].z += g * bf2f((unsigned short)(w.y & 0xffff)); y[j].w += g * bf2f((unsigned short)(w.y >> 16)); } }
            float ss = 0.f;
#pragma unroll
            for (int j = 0; j < 4; ++j) ss += y[j].x * y[j].x + y[j].y * y[j].y + y[j].z * y[j].z + y[j].w * y[j].w;
            const float rstd = rsqrtf(wave_sum(ss) * (1.f / D) + EPS);
#pragma unroll
            for (int j = 0; j < 4; ++j) { const int c = 4 * lane + 256 * j;
                const float4 g = gpf[j], gt = gtf[j];
                float4 o;
                o.x = x1[q][j].x + gt.x * (y[j].x * rstd * g.x); o.y = x1[q][j].y + gt.y * (y[j].y * rstd * g.y);
                o.z = x1[q][j].z + gt.z * (y[j].z * rstd * g.z); o.w = x1[q][j].w + gt.w * (y[j].w * rstd * g.w);
                ntstore4((float4*)(p.out + (size_t)m * D + c), o); }
        }
        te0 = ne0; te1 = ne1; tp0 = np0; tp1 = np1; gk0 = ng0; gk1 = ng1;
    }
}

#define XB_TMO      128
#define XB_XCNT(j)  (256  + 64 * (j))
#define XB_XSUB(j)  (1280 + 64 * (j))
#define XB_XGEN(j)  (2304 + 64 * (j))
#define XB_TOP      3328
#define XB_TOPGEN   3392
#define XCD_BAR_WORDS 3456
#define XB_SPIN_CAP (1u << 18)
__device__ __forceinline__ unsigned xb_ld(unsigned* p)              { return __hip_atomic_load(p, __ATOMIC_RELAXED, __HIP_MEMORY_SCOPE_AGENT); }
__device__ __forceinline__ unsigned xb_add(unsigned* p, unsigned v) { return __hip_atomic_fetch_add(p, v, __ATOMIC_RELAXED, __HIP_MEMORY_SCOPE_AGENT); }
__device__ __forceinline__ unsigned xb_xcc_id() { return (unsigned)__builtin_amdgcn_s_getreg((3 << 11) | 20) & 0xFu; }
#define XB_SPIN(cond, bar) do { unsigned _sp = 0; while (cond) { __builtin_amdgcn_s_sleep(1); \
    if ((++_sp & 255u) == 0u) { if (xb_ld(&(bar)[XB_TMO])) break; if (_sp > XB_SPIN_CAP) { atomicAdd(&(bar)[XB_TMO], 1u); break; } } } } while (0)
struct XcdBarrier { unsigned* bar; unsigned x; volatile LAS unsigned* st; };
__device__ __forceinline__ XcdBarrier xcd_barrier_post(unsigned* bar, volatile LAS unsigned* st) {
    XcdBarrier b; b.bar = bar; b.x = xb_xcc_id(); b.st = st;
    if (threadIdx.x == 0) st[2] = xb_add(&bar[XB_XCNT(b.x)], 1u);
    return b;
}
__device__ __forceinline__ void xcd_barrier_complete(unsigned* bar, unsigned x, unsigned& nloc, unsigned& nx, unsigned& base) {
    const unsigned G = gridDim.x * gridDim.y * gridDim.z;
    unsigned sum, cnt, mine, sp = 0u;
    for (;;) {
        sum = 0u; cnt = 0u; mine = 0u; base = 0u;
#pragma unroll
        for (unsigned j = 0; j < 16; ++j) { const unsigned c = xb_ld(&bar[XB_XCNT(j)]); sum += c; cnt += (c > 0u) ? 1u : 0u; mine = (j == x) ? c : mine; base += (j < x) ? c : 0u; }
        if (sum == G) break;
        __builtin_amdgcn_s_sleep(1);
        if ((++sp & 255u) == 0u) { if (xb_ld(&bar[XB_TMO])) break; if (sp > XB_SPIN_CAP) { atomicAdd(&bar[XB_TMO], 1u); break; } }
    }
    nloc = mine > 0u ? mine : 1u; nx = cnt > 0u ? cnt : 1u;
}
__device__ __forceinline__ void xcd_barrier(const XcdBarrier& b) {
    asm volatile("s_waitcnt vmcnt(0)" ::: "memory");
    __syncthreads();
    if (threadIdx.x == 0) {
        unsigned* bar = b.bar;
        __builtin_amdgcn_s_waitcnt(0);
        unsigned nloc = b.st[0], nx = b.st[1];
        if (nloc == 0u) { unsigned base; xcd_barrier_complete(bar, b.x, nloc, nx, base); b.st[0] = nloc; b.st[1] = nx; b.st[3] = base; }
        const unsigned old = xb_add(&bar[XB_XSUB(b.x)], 1u);
        const unsigned gen = old / nloc;
        asm volatile("buffer_inv sc1" ::: "memory");
        if (old + 1u == (gen + 1u) * nloc) {
            __builtin_amdgcn_fence(__ATOMIC_RELEASE, "agent");
            asm volatile("s_waitcnt vmcnt(0)" ::: "memory");
            const unsigned og = xb_add(&bar[XB_TOP], 1u);
            const unsigned tg = og / nx;
            if (og + 1u == (tg + 1u) * nx) xb_add(&bar[XB_TOPGEN], 1u);
            else XB_SPIN(xb_ld(&bar[XB_TOPGEN]) == tg, bar);
            xb_add(&bar[XB_XGEN(b.x)], 1u);
            asm volatile("s_waitcnt vmcnt(0)" ::: "memory");
        } else {
            XB_SPIN(xb_ld(&bar[XB_XGEN(b.x)]) == gen, bar);
            asm volatile("s_waitcnt vmcnt(0)" ::: "memory");
        }
    }
    __syncthreads();
}

__global__ void __launch_bounds__(NTHREADS, 2) fwd_kernel(Params p) {
    extern __shared__ __attribute__((aligned(16))) unsigned char lds[];
    const int lo = p.ph_lo, hi = p.ph_hi;
    volatile LAS unsigned* st = (volatile LAS unsigned*)(lds + LDS_BARW);
    if (threadIdx.x == 0) { st[0] = 0u; st[1] = 0u; }
    __syncthreads();
    XcdBarrier bar; bar.bar = (unsigned*)(p.ws + WS_CTL); bar.x = 0; bar.st = st;
    if (hi - lo > 1) bar = xcd_barrier_post((unsigned*)(p.ws + WS_CTL), st);
#ifndef PROBE_DUP
#define PROBE_DUP -1
#endif
#define PHASE(k, call) if (lo <= (k) && (k) < hi) { const int nrep = ((k) == PROBE_DUP) ? hi - 9 : 1; for (int rep = 0; rep < nrep; ++rep) { const bool dry = rep > 0; (void)dry; call; if (rep + 1 < nrep) __syncthreads(); } if ((k) + 1 < hi) xcd_barrier(bar); }
    PHASE(0, { phase_prep(p, lds); phase_prenorm(p); })
    PHASE(2, phase_gemm_in(p, lds))
    PHASE(3, { vtrans_items(p, lds); gla1_items(p, lds); })
    PHASE(4, { gla2_scan(p); phase_attn(p, lds); })
    PHASE(5, gla3_items(p, lds))
    PHASE(6, phase_gemm_out(p, lds))
    PHASE(7, phase_postmix(p, lds, dry))
    PHASE(8, phase_moe(p, lds))
    PHASE(10, phase_combine(p, lds))
#undef PHASE
}

extern "C" void kernel_launch(void* const* d_in, const int* in_sizes, int n_in, void* d_out, int out_size, void* d_ws, size_t ws_size, hipStream_t stream) {
    static int grid_blocks = 0;
    if (grid_blocks == 0) {
        if (n_in != 19 || out_size != T * D || ws_size < WS_END) { fprintf(stderr, "kernel_launch: unexpected shapes (n_in %d out %d ws %zu need %zu)\n", n_in, out_size, ws_size, (size_t)WS_END); grid_blocks = -1; return; }
        int dev = 0, cus = 0, per_cu = 0;
        (void)hipGetDevice(&dev);
        (void)hipDeviceGetAttribute(&cus, hipDeviceAttributeMultiprocessorCount, dev);
        if (hipFuncSetAttribute((const void*)fwd_kernel, hipFuncAttributeMaxDynamicSharedMemorySize, LDS_BYTES) != hipSuccess) { fprintf(stderr, "kernel_launch: hipFuncSetAttribute failed\n"); grid_blocks = -1; return; }
        (void)hipOccupancyMaxActiveBlocksPerMultiprocessor(&per_cu, fwd_kernel, NTHREADS, LDS_BYTES);
        if (per_cu < 1) { fprintf(stderr, "kernel_launch: occupancy query reports %d blocks per CU\n", per_cu); per_cu = 1; }
        grid_blocks = cus;
        (void)hipGetLastError();
    }
    if (grid_blocks < 0) return;
    (void)hipMemsetAsync((char*)d_ws + WS_CTL, 0, CTL_BYTES, stream);
    Params p{};
    p.x = (const float*)d_in[0]; p.c = (const float*)d_in[1]; p.w_mod = (const float*)d_in[2]; p.b_mod = (const float*)d_in[3];
    p.g_pre_mix = (const float*)d_in[4]; p.w_in = (const float*)d_in[5]; p.w_gate_lr = (const float*)d_in[6]; p.b_gate = (const float*)d_in[7];
    p.g_gla = (const float*)d_in[8]; p.w_out = (const float*)d_in[9]; p.g_post_mix = (const float*)d_in[10]; p.g_pre_ffn = (const float*)d_in[11];
    p.router_w = (const float*)d_in[12]; p.router_b = (const float*)d_in[13]; p.w_gate_up = (const float*)d_in[14]; p.b_gate_up = (const float*)d_in[15];
    p.w_down = (const float*)d_in[16]; p.b_down = (const float*)d_in[17]; p.g_post_ffn = (const float*)d_in[18];
    p.out = (float*)d_out; p.ws = (unsigned char*)d_ws;
    for (int d = 0; d < 32; ++d) p.inv_freq[d] = powf(10000.0f, -(float)d / 32.0f);
#if ONE_LAUNCH
    p.ph_lo = 0; p.ph_hi = NPHASE;
    void* args[] = {&p};
    hipError_t e = hipLaunchCooperativeKernel((void*)fwd_kernel, dim3(grid_blocks), dim3(NTHREADS), args, LDS_BYTES, stream);
    if (e != hipSuccess) fprintf(stderr, "cooperative launch failed: %s (grid %d)\n", hipGetErrorString(e), grid_blocks);
#else
    for (int k = 0; k < NPHASE; ++k) { p.ph_lo = k; p.ph_hi = k + 1; hipLaunchKernelGGL(fwd_kernel, dim3(grid_blocks), dim3(NTHREADS), LDS_BYTES, stream, p); }
#endif
}
```
